# Optimizing an MI355X kernel written in HIP

```python
import math
import jax, jax.numpy as jnp
from jax import lax
import numpy as np

D_MODEL = 1024
BATCH = 32
SEQ = 256
DEPTH = 2
DEC_BATCH = 4
DEC_SEQ = 1024
PAST_LEN = 512

GRID_W = 64
QUERY_BLOCK = 128
ROPE_THETA = 10000.0
EPS = 1e-6
DIFF_HEADS = 4
DIFF_QK = 32
DIFF_V = 64
GQA_HEADS = 4
GQA_KV_HEADS = 2
GQA_HEAD_DIM = 64
SSM_WIDTH = 256
SSM_GROUP = 16
SSM_GROUPS = SSM_WIDTH // SSM_GROUP
SSM_STATE = 64
MLA_HEADS = 4
MLA_Q_RANK = 192
MLA_KV_RANK = 128
MLA_NOPE = 64
MLA_ROPE = 32
MLA_V = 64
MIX_WIDTH = DIFF_HEADS * DIFF_V + GQA_HEADS * GQA_HEAD_DIM + SSM_WIDTH + MLA_HEADS * MLA_V
IN_SIZES = (DIFF_HEADS * 2 * DIFF_QK, DIFF_HEADS * 2 * DIFF_QK, DIFF_HEADS * DIFF_V,
            GQA_HEADS * GQA_HEAD_DIM, GQA_KV_HEADS * GQA_HEAD_DIM, GQA_KV_HEADS * GQA_HEAD_DIM,
            SSM_WIDTH, MLA_Q_RANK, MLA_KV_RANK, MLA_ROPE)
IN_COLS = sum(IN_SIZES)
D_FF = 4 * D_MODEL
N_MOD = 6

kernel_name = 'hybrid_prefix_diffusion_step'

F32 = jnp.float32


def rmsnorm(x, g):
    xf = x.astype(F32)
    y = xf * lax.rsqrt(jnp.mean(xf * xf, axis=-1, keepdims=True) + EPS)
    return (y * g.astype(F32)).astype(x.dtype)


def rope_angles(t, rot_dim):
    rows = t // GRID_W
    row = jnp.repeat(jnp.arange(rows), GRID_W).astype(F32)
    col = jnp.tile(jnp.arange(GRID_W), rows).astype(F32)
    n = rot_dim // 4
    freq = ROPE_THETA ** (-jnp.arange(n, dtype=F32) / n)
    return row[:, None] * freq, col[:, None] * freq


def apply_rope2d(x, ang_row, ang_col):
    shape = (x.shape[1],) + (1,) * (x.ndim - 3) + (ang_row.shape[-1],)
    half = x.shape[-1] // 2
    xf = x.astype(F32)

    def rot(part, ang):
        cos = jnp.cos(ang).reshape(shape)
        sin = jnp.sin(ang).reshape(shape)
        x1, x2 = jnp.split(part, 2, axis=-1)
        return jnp.concatenate([x1 * cos - x2 * sin, x1 * sin + x2 * cos], axis=-1)

    out = jnp.concatenate([rot(xf[..., :half], ang_row), rot(xf[..., half:], ang_col)], axis=-1)
    return out.astype(x.dtype)


def attend(q, k, v, scale):
    b, tq, hq, dk = q.shape
    hkv = k.shape[2]
    g = hq // hkv
    dv = v.shape[-1]
    qb = min(QUERY_BLOCK, tq)
    nb = tq // qb
    qs = (q.astype(F32) * scale).reshape(b, nb, qb, hkv, g, dk).transpose(1, 0, 2, 3, 4, 5)
    kf = k.astype(F32)
    vf = v.astype(F32)

    def block(qblk):
        s = jnp.einsum('bqhgd,bkhd->bhgqk', qblk, kf)
        p = jax.nn.softmax(s, axis=-1)
        return jnp.einsum('bhgqk,bkhd->bqhgd', p, vf)

    o = lax.map(block, qs)
    return o.transpose(1, 0, 2, 3, 4, 5).reshape(b, tq, hq, dv)


def diff_attention(q, k, v, p, lam_init):
    lam = (jnp.exp(jnp.sum(p['diff_lq1'].astype(F32) * p['diff_lk1'].astype(F32)))
           - jnp.exp(jnp.sum(p['diff_lq2'].astype(F32) * p['diff_lk2'].astype(F32))) + lam_init)
    scale = DIFF_QK ** -0.5
    o1 = attend(q[..., 0, :], k[..., 0, :], v, scale)
    o2 = attend(q[..., 1, :], k[..., 1, :], v, scale)
    o = rmsnorm(o1 - lam * o2, p['diff_subln_g']) * (1.0 - lam_init)
    return o.reshape(o.shape[0], o.shape[1], -1)


def mla_expand(ckv_n, k_rope, w_ukv):
    b, t, _ = ckv_n.shape
    kv = (ckv_n @ w_ukv).reshape(b, t, MLA_HEADS, MLA_NOPE + MLA_V)
    k_nope, v = kv[..., :MLA_NOPE], kv[..., MLA_NOPE:]
    k_r = jnp.broadcast_to(k_rope[:, :, None, :], (b, t, MLA_HEADS, MLA_ROPE)).astype(k_nope.dtype)
    return jnp.concatenate([k_nope, k_r], axis=-1), v


def _linrec(e1, e2):
    a1, b1 = e1
    a2, b2 = e2
    return a1 * a2, a2 * b1 + b2


def ssm_scan(u, a_re, a_im, log_dt, b_re, b_im, c_re, c_im, h0):
    lam = lax.complex(a_re.astype(F32), a_im.astype(F32))
    dt = jnp.exp(log_dt.astype(F32))[:, None]
    a_bar = jnp.exp(lam * dt)
    b_bar = ((a_bar - 1.0) / lam)[..., None] * lax.complex(b_re.astype(F32), b_im.astype(F32))
    c_mat = lax.complex(c_re.astype(F32), c_im.astype(F32))
    bu = jnp.einsum('gpc,btgc->btgp', b_bar, u.astype(jnp.complex64))
    bu = bu.at[:, 0].add(a_bar * h0)
    a_seq = jnp.broadcast_to(a_bar, bu.shape)
    _, h = lax.associative_scan(_linrec, (a_seq, bu), axis=1)
    y = jnp.einsum('gcp,btgp->btgc', c_mat, h).real
    return y, h[:, -1]


def ssm_mixer(u, h0_re, h0_im, p):
    b, t, _ = u.shape
    uf = u.astype(F32).reshape(b, t, SSM_GROUPS, SSM_GROUP)
    h0 = lax.complex(h0_re.astype(F32), h0_im.astype(F32))
    ys, finals = [], []
    for d in range(2):
        ud = uf if d == 0 else jnp.flip(uf, axis=1)
        y, h_last = ssm_scan(ud, p['ssm_a_re'][d], p['ssm_a_im'][d], p['ssm_log_dt'][d],
                             p['ssm_b_re'][d], p['ssm_b_im'][d], p['ssm_c_re'][d], p['ssm_c_im'][d],
                             h0[:, d])
        ys.append(y if d == 0 else jnp.flip(y, axis=1))
        finals.append(h_last)
    y = ys[0] + ys[1] + uf * p['ssm_d'].astype(F32).reshape(SSM_GROUPS, SSM_GROUP)
    g = jax.nn.gelu(y.reshape(b, t, SSM_WIDTH))
    z = g @ p['ssm_w_glu'].astype(F32)
    out = z[..., :SSM_WIDTH] * jax.nn.sigmoid(z[..., SSM_WIDTH:])
    h_fin = jnp.stack(finals, axis=1)
    return out, h_fin.real, h_fin.imag


def token_mixers(h, p, lam_init, ctx, angs):
    b, t, _ = h.shape
    idx = np.cumsum(IN_SIZES)[:-1].tolist()
    dq, dk, dv, gq, gk, gv, u, cq, ckv, kr = jnp.split(h @ p['w_in'], idx, axis=-1)
    dq = dq.reshape(b, t, DIFF_HEADS, 2, DIFF_QK)
    dk = dk.reshape(b, t, DIFF_HEADS, 2, DIFF_QK)
    dv = dv.reshape(b, t, DIFF_HEADS, DIFF_V)
    gq = rmsnorm(gq.reshape(b, t, GQA_HEADS, GQA_HEAD_DIM), p['gqa_qn_g'])
    gk = rmsnorm(gk.reshape(b, t, GQA_KV_HEADS, GQA_HEAD_DIM), p['gqa_kn_g'])
    gv = gv.reshape(b, t, GQA_KV_HEADS, GQA_HEAD_DIM)
    ckv_n = rmsnorm(ckv, p['mla_kvn_g'])
    mq = (rmsnorm(cq, p['mla_qn_g']) @ p['mla_w_uq']).reshape(b, t, MLA_HEADS, MLA_NOPE + MLA_ROPE)
    own = (dk.reshape(b, t, DIFF_HEADS, 2 * DIFF_QK), dv, gk, gv, ckv_n, kr)
    if angs is not None:
        a_diff, a_gqa, a_mla = angs
        dq = apply_rope2d(dq, *a_diff)
        dk = apply_rope2d(dk, *a_diff)
        gq = apply_rope2d(gq, *a_gqa)
        gk = apply_rope2d(gk, *a_gqa)
        mq = jnp.concatenate([mq[..., :MLA_NOPE], apply_rope2d(mq[..., MLA_NOPE:], *a_mla)], axis=-1)
        kr = apply_rope2d(kr, *a_mla)
    mk, mv = mla_expand(ckv_n, kr, p['mla_w_ukv'])
    if ctx is None:
        h0_re = jnp.zeros((b, 2, SSM_GROUPS, SSM_STATE), F32)
        h0_im = jnp.zeros((b, 2, SSM_GROUPS, SSM_STATE), F32)
    else:
        c_dk, c_dv, c_gk, c_gv, c_ckv, c_kr, h0_re, h0_im = ctx
        dk = jnp.concatenate([c_dk.reshape(b, -1, DIFF_HEADS, 2, DIFF_QK), dk], axis=1)
        dv = jnp.concatenate([c_dv, dv], axis=1)
        gk = jnp.concatenate([c_gk, gk], axis=1)
        gv = jnp.concatenate([c_gv, gv], axis=1)
        c_mk, c_mv = mla_expand(c_ckv, c_kr, p['mla_w_ukv'])
        mk = jnp.concatenate([c_mk, mk], axis=1)
        mv = jnp.concatenate([c_mv, mv], axis=1)
    o_diff = diff_attention(dq, dk, dv, p, lam_init)
    o_gqa = attend(gq, gk, gv, GQA_HEAD_DIM ** -0.5).reshape(b, t, -1)
    o_ssm, hT_re, hT_im = ssm_mixer(u, h0_re, h0_im, p)
    o_mla = attend(mq, mk, mv, (MLA_NOPE + MLA_ROPE) ** -0.5).reshape(b, t, -1)
    mixed = jnp.concatenate([o_diff, o_gqa, o_ssm, o_mla], axis=-1).astype(h.dtype)
    return mixed @ p['w_out'], own + (hT_re, hT_im)


def sq_relu_mlp(h, p):
    a = jax.nn.relu(h @ p['mlp_w1'])
    return (a * a) @ p['mlp_w2']


def adaln(cond, p):
    return jax.nn.silu(cond.astype(F32)) @ p['w_ada'] + p['b_ada']


def layer(x, mod, p, lam_init, ctx, angs):
    sh1, sc1, g1, sh2, sc2, g2 = jnp.split(mod.astype(x.dtype), N_MOD, axis=-1)
    h = rmsnorm(x, p['norm1_g']) * (1.0 + sc1) + sh1
    mix, st = token_mixers(h, p, lam_init, ctx, angs)
    x = x + g1 * mix
    h = rmsnorm(x, p['norm2_g']) * (1.0 + sc2) + sh2
    x = x + g2 * sq_relu_mlp(h, p)
    return x, st


def setup_inputs(seed: int = 0) -> dict:
    key = jax.random.key(seed)
    ks = iter(jax.random.split(key, 64))
    L, G, P, C = DEPTH, SSM_GROUPS, SSM_STATE, SSM_GROUP

    def nrm(shape, scale=1.0):
        return jax.random.normal(next(ks), shape, F32) * scale

    def gain(shape):
        return 1.0 + nrm(shape, 0.02)

    return {
        'x_prompt': nrm((BATCH, SEQ, D_MODEL)),
        'x_sample': nrm((DEC_BATCH, DEC_SEQ, D_MODEL)),
        'cache_diff_k': nrm((DEC_BATCH, L, PAST_LEN, DIFF_HEADS, 2 * DIFF_QK)),
        'cache_diff_v': nrm((DEC_BATCH, L, PAST_LEN, DIFF_HEADS, DIFF_V)),
        'cache_gqa_k': nrm((DEC_BATCH, L, PAST_LEN, GQA_KV_HEADS, GQA_HEAD_DIM)),
        'cache_gqa_v': nrm((DEC_BATCH, L, PAST_LEN, GQA_KV_HEADS, GQA_HEAD_DIM)),
        'cache_mla_ckv': nrm((DEC_BATCH, L, PAST_LEN, MLA_KV_RANK)),
        'cache_mla_krope': nrm((DEC_BATCH, L, PAST_LEN, MLA_ROPE)),
        'state_ssm_re': nrm((DEC_BATCH, L, 2, G, P), 0.3),
        'state_ssm_im': nrm((DEC_BATCH, L, 2, G, P), 0.3),
        'c': nrm((DEC_BATCH, D_MODEL)),
        'c_ctx': nrm((D_MODEL,)),
        'norm1_g': gain((L, D_MODEL)),
        'norm2_g': gain((L, D_MODEL)),
        'w_ada': nrm((L, D_MODEL, N_MOD * D_MODEL), 0.5 * D_MODEL ** -0.5),
        'b_ada': nrm((L, N_MOD * D_MODEL), 0.02),
        'w_in': nrm((L, D_MODEL, IN_COLS), D_MODEL ** -0.5),
        'w_out': nrm((L, MIX_WIDTH, D_MODEL), MIX_WIDTH ** -0.5),
        'diff_lq1': nrm((L, DIFF_QK), 0.1),
        'diff_lk1': nrm((L, DIFF_QK), 0.1),
        'diff_lq2': nrm((L, DIFF_QK), 0.1),
        'diff_lk2': nrm((L, DIFF_QK), 0.1),
        'diff_subln_g': gain((L, DIFF_V)),
        'gqa_qn_g': gain((L, GQA_HEAD_DIM)),
        'gqa_kn_g': gain((L, GQA_HEAD_DIM)),
        'ssm_a_re': -0.5 + nrm((L, 2, G, P), 0.01),
        'ssm_a_im': math.pi * jnp.arange(P, dtype=F32) + nrm((L, 2, G, P), 0.01),
        'ssm_log_dt': jax.random.uniform(next(ks), (L, 2, G), F32, math.log(1e-3), math.log(1e-1)),
        'ssm_b_re': nrm((L, 2, G, P, C), (2 * C) ** -0.5),
        'ssm_b_im': nrm((L, 2, G, P, C), (2 * C) ** -0.5),
        'ssm_c_re': nrm((L, 2, G, C, P), (2 * P) ** -0.5),
        'ssm_c_im': nrm((L, 2, G, C, P), (2 * P) ** -0.5),
        'ssm_d': nrm((L, SSM_WIDTH)),
        'ssm_w_glu': nrm((L, SSM_WIDTH, 2 * SSM_WIDTH), SSM_WIDTH ** -0.5),
        'mla_qn_g': gain((L, MLA_Q_RANK)),
        'mla_kvn_g': gain((L, MLA_KV_RANK)),
        'mla_w_uq': nrm((L, MLA_Q_RANK, MLA_HEADS * (MLA_NOPE + MLA_ROPE)), MLA_Q_RANK ** -0.5),
        'mla_w_ukv': nrm((L, MLA_KV_RANK, MLA_HEADS * (MLA_NOPE + MLA_V)), MLA_KV_RANK ** -0.5),
        'mlp_w1': nrm((L, D_MODEL, D_FF), D_MODEL ** -0.5),
        'mlp_w2': nrm((L, D_FF, D_MODEL), D_FF ** -0.5),
        'final_norm_g': gain((D_MODEL,)),
    }


def reference(x_prompt, x_sample, cache_diff_k, cache_diff_v, cache_gqa_k, cache_gqa_v, cache_mla_ckv,
              cache_mla_krope, state_ssm_re, state_ssm_im, c, c_ctx, norm1_g, norm2_g, w_ada, b_ada, w_in,
              w_out, diff_lq1, diff_lk1, diff_lq2, diff_lk2, diff_subln_g, gqa_qn_g, gqa_kn_g, ssm_a_re,
              ssm_a_im, ssm_log_dt, ssm_b_re, ssm_b_im, ssm_c_re, ssm_c_im, ssm_d, ssm_w_glu, mla_qn_g,
              mla_kvn_g, mla_w_uq, mla_w_ukv, mlp_w1, mlp_w2, final_norm_g):
    layers = [dict(norm1_g=norm1_g[l], norm2_g=norm2_g[l], w_ada=w_ada[l], b_ada=b_ada[l], w_in=w_in[l],
                   w_out=w_out[l], diff_lq1=diff_lq1[l], diff_lk1=diff_lk1[l], diff_lq2=diff_lq2[l],
                   diff_lk2=diff_lk2[l], diff_subln_g=diff_subln_g[l], gqa_qn_g=gqa_qn_g[l],
                   gqa_kn_g=gqa_kn_g[l], ssm_a_re=ssm_a_re[l], ssm_a_im=ssm_a_im[l],
                   ssm_log_dt=ssm_log_dt[l], ssm_b_re=ssm_b_re[l], ssm_b_im=ssm_b_im[l],
                   ssm_c_re=ssm_c_re[l], ssm_c_im=ssm_c_im[l], ssm_d=ssm_d[l], ssm_w_glu=ssm_w_glu[l],
                   mla_qn_g=mla_qn_g[l], mla_kvn_g=mla_kvn_g[l], mla_w_uq=mla_w_uq[l],
                   mla_w_ukv=mla_w_ukv[l], mlp_w1=mlp_w1[l], mlp_w2=mlp_w2[l])
              for l in range(DEPTH)]
    lam_inits = [0.8 - 0.6 * math.exp(-0.3 * l) for l in range(DEPTH)]

    x = x_prompt
    ctx_states = []
    for l in range(DEPTH):
        p = layers[l]
        x, st = layer(x, adaln(c_ctx, p)[None, None], p, lam_inits[l], None, None)
        ctx_states.append(st)
    y_prompt = rmsnorm(x, final_norm_g)

    t_lat = x_sample.shape[1]
    angs = (rope_angles(t_lat, DIFF_QK), rope_angles(t_lat, GQA_HEAD_DIM), rope_angles(t_lat, MLA_ROPE))
    x = x_sample
    for l in range(DEPTH):
        p = layers[l]
        ctx = (cache_diff_k[:, l], cache_diff_v[:, l], cache_gqa_k[:, l], cache_gqa_v[:, l],
               cache_mla_ckv[:, l], cache_mla_krope[:, l], state_ssm_re[:, l], state_ssm_im[:, l])
        x, _ = layer(x, adaln(c, p)[:, None], p, lam_inits[l], ctx, angs)
    y_sample = rmsnorm(x, final_norm_g)

    new_diff_k = jnp.stack([s[0] for s in ctx_states], axis=1)
    new_diff_v = jnp.stack([s[1] for s in ctx_states], axis=1)
    new_gqa_k = jnp.stack([s[2] for s in ctx_states], axis=1)
    new_gqa_v = jnp.stack([s[3] for s in ctx_states], axis=1)
    new_mla_ckv = jnp.stack([s[4] for s in ctx_states], axis=1)
    new_mla_krope = jnp.stack([s[5] for s in ctx_states], axis=1)
    new_ssm_re = jnp.stack([s[6] for s in ctx_states], axis=1)
    new_ssm_im = jnp.stack([s[7] for s in ctx_states], axis=1)
    return (y_prompt, y_sample, new_diff_k, new_diff_v, new_gqa_k, new_gqa_v, new_mla_ckv, new_mla_krope,
            new_ssm_re, new_ssm_im)
```

```cpp
#include <hip/hip_runtime.h>
#include <hip/hip_cooperative_groups.h>
#include <cstdio>
namespace cg = cooperative_groups;

#ifndef MEGA
#define MEGA 1
#endif

#define DI __device__ __forceinline__
typedef unsigned short u16;
typedef __attribute__((ext_vector_type(8))) short bf16x8;
typedef __attribute__((ext_vector_type(4))) short bf16x4;
typedef __attribute__((ext_vector_type(2))) __bf16 bf2_t;
typedef __attribute__((ext_vector_type(2))) float f32x2;
typedef __attribute__((ext_vector_type(4))) float f32x4;
typedef __attribute__((ext_vector_type(16))) float f32x16;
typedef __attribute__((ext_vector_type(4))) unsigned u32x4;
typedef __attribute__((ext_vector_type(2))) unsigned u32x2;

#define MFMA32(a, b, c) __builtin_amdgcn_mfma_f32_32x32x16_bf16((a), (b), (c), 0, 0, 0)
#define MFMA16(a, b, c) __builtin_amdgcn_mfma_f32_16x16x32_bf16((a), (b), (c), 0, 0, 0)

constexpr int NT = 12288;
constexpr int NCTX = 8192;
constexpr int NKR = 14336;
constexpr int NP = 1920;
constexpr float EPSF = 1e-6f;
constexpr float LOG2E = 1.4426950408889634f;

enum { I_XP = 0, I_XS, I_CDK, I_CDV, I_CGK, I_CGV, I_CCKV, I_CKR, I_SRE, I_SIM, I_C, I_CCTX, I_N1G, I_N2G, I_WADA, I_BADA,
       I_WIN, I_WOUT, I_LQ1, I_LK1, I_LQ2, I_LK2, I_SUBLN, I_QNG, I_KNG, I_ARE, I_AIM, I_LOGDT, I_BRE, I_BIM, I_CRE, I_CIM,
       I_SSMD, I_WGLU, I_MQNG, I_MKVNG, I_WUQ, I_WUKV, I_W1, I_W2, I_FNG, N_IN };

constexpr size_t O_Y = 0;
constexpr size_t O_DK = 12582912;
constexpr size_t O_DV = 16777216;
constexpr size_t O_GK = 20971520;
constexpr size_t O_GV = 23068672;
constexpr size_t O_CKV = 25165824;
constexpr size_t O_KR = 27262976;
constexpr size_t O_SRE = 27787264;
constexpr size_t O_SIM = 27918336;

constexpr size_t al256(size_t x) { return (x + 255) & ~(size_t)255; }
constexpr size_t OFF_MOD = 0;
constexpr size_t OFF_CTR = al256(OFF_MOD + 2 * 5 * 6144 * 4);
constexpr size_t OFF_BAR = al256(OFF_CTR + 256);
constexpr size_t OFF_ROPE = al256(OFF_BAR + 3456 * 4);
constexpr size_t OFF_ABAR = al256(OFF_ROPE + 2 * 64 * 16 * 8);
constexpr size_t OFF_ATAB = al256(OFF_ABAR + 64 * 64 * 8);
constexpr size_t OFF_CTAB = al256(OFF_ATAB + 64 * 128 * 16 * 2);
constexpr size_t OFF_WIN = al256(OFF_CTAB + 64 * 16 * 128 * 2);
constexpr size_t OFF_WOUT = al256(OFF_WIN + (size_t)2 * 1920 * 1024 * 2);
constexpr size_t OFF_W1 = al256(OFF_WOUT + (size_t)2 * 1024 * 1024 * 2);
constexpr size_t OFF_W2 = al256(OFF_W1 + (size_t)2 * 4096 * 1024 * 2);
constexpr size_t OFF_WUQ = al256(OFF_W2 + (size_t)2 * 4096 * 1024 * 2);
constexpr size_t OFF_WUKV = al256(OFF_WUQ + (size_t)2 * 384 * 192 * 2);
constexpr size_t OFF_WGLU = al256(OFF_WUKV + (size_t)2 * 512 * 128 * 2);
constexpr size_t OFF_H = al256(OFF_WGLU + (size_t)2 * 512 * 256 * 2);
constexpr size_t OFF_MIXED = OFF_H;
constexpr size_t OFF_BIG = al256(OFF_H + (size_t)NT * 1024 * 2);
constexpr size_t OFF_PROJ = OFF_BIG;
constexpr size_t OFF_DQ = al256(OFF_PROJ + (size_t)NT * NP * 4);
constexpr size_t OFF_DKB = al256(OFF_DQ + (size_t)NT * 256 * 2);
constexpr size_t OFF_DVT = al256(OFF_DKB + (size_t)NKR * 256 * 2);
constexpr size_t OFF_GQ = al256(OFF_DVT + (size_t)NKR * 256 * 2);
constexpr size_t OFF_GKB = al256(OFF_GQ + (size_t)NT * 256 * 2);
constexpr size_t OFF_GVT = al256(OFF_GKB + (size_t)NKR * 128 * 2);
constexpr size_t OFF_MQ = al256(OFF_GVT + (size_t)NKR * 128 * 2);
constexpr size_t OFF_MKB = al256(OFF_MQ + (size_t)NT * 384 * 2);
constexpr size_t OFF_MVT = al256(OFF_MKB + (size_t)NKR * 384 * 2);
constexpr size_t OFF_CQN = al256(OFF_MVT + (size_t)NKR * 256 * 2);
constexpr size_t OFF_CKVN = al256(OFF_CQN + (size_t)NT * 192 * 2);
constexpr size_t OFF_YBUF = al256(OFF_CKVN + (size_t)NKR * 128 * 2);
constexpr size_t OFF_END1 = al256(OFF_YBUF + (size_t)2 * NT * 256 * 4);
constexpr size_t OFF_A = OFF_BIG;
constexpr size_t OFF_END2 = al256(OFF_A + (size_t)NT * 4096 * 2);
constexpr size_t WS_NEED = OFF_END1 > OFF_END2 ? OFF_END1 : OFF_END2;
static_assert(WS_NEED <= (size_t)256 * 1024 * 1024, "workspace over 256 MiB");

constexpr int LDS_BYTES = 2 * 2 * 128 * 72 * 2;

struct P {
  const float* in[N_IN];
  float* out;
  char* ws;
};

DI unsigned pack2(float a, float b) { f32x2 v = {a, b}; return __builtin_bit_cast(unsigned, __builtin_convertvector(v, bf2_t)); }
DI u16 f2bf(float a) { return (u16)(pack2(a, 0.f) & 0xffffu); }
DI bf16x8 pack8(f32x4 a, f32x4 b) {
  u32x4 r = {pack2(a[0], a[1]), pack2(a[2], a[3]), pack2(b[0], b[1]), pack2(b[2], b[3])};
  return __builtin_bit_cast(bf16x8, r);
}
DI u32x2 pack4(f32x4 a) { u32x2 r = {pack2(a[0], a[1]), pack2(a[2], a[3])}; return r; }
DI int get_tid() { int t = threadIdx.x; asm volatile("" : "+v"(t)); return t; }
DI float fexp2(float x) { return __builtin_amdgcn_exp2f(x); }
DI float frcp(float x) { return __builtin_amdgcn_rcpf(x); }
DI float fsigmoid(float w) { return frcp(1.f + fexp2(-w * LOG2E)); }
DI float gelu_tanh(float x) { return x * fsigmoid(1.5957691216057308f * (x + 0.044715f * x * x * x)); }
DI float wave_sum(float v) {
#pragma unroll
  for (int o = 32; o >= 1; o >>= 1) v += __shfl_xor(v, o);
  return v;
}
DI void wave_lds_fence() {
  asm volatile("s_waitcnt lgkmcnt(0)" ::: "memory");
  __builtin_amdgcn_wave_barrier();
}
DI int fetch_item(int* ctr, int lane) {
  int v = 0;
  if (lane == 0) v = atomicAdd(ctr, 1);
  return __builtin_amdgcn_readfirstlane(v);
}
DI size_t vt_off(int b_all, int head, int H) {
  if (b_all < 32) return ((size_t)(b_all * H + head) * 64) * 256;
  return (size_t)32 * H * 64 * 256 + ((size_t)((b_all - 32) * H + head) * 64) * 1536;
}
DI int mod_index(int row) { return row < NCTX ? 0 : 1 + ((row - NCTX) >> 10); }

DI void transpose_tile(const float* __restrict__ src, u16* __restrict__ dst, int K, int N, int k0, int n0, bool glu, float* t) {
  const int tid = get_tid();
  const int tx = tid & 15, ty = tid >> 4;
#pragma unroll
  for (int i = 0; i < 4; ++i) {
    int kk = ty + 16 * i;
    int n = n0 + 4 * tx;
    f32x4 v = {0.f, 0.f, 0.f, 0.f};
    if (n < N) v = *(const f32x4*)(src + (size_t)(k0 + kk) * N + n);
    t[kk * 65 + 4 * tx + 0] = v[0];
    t[kk * 65 + 4 * tx + 1] = v[1];
    t[kk * 65 + 4 * tx + 2] = v[2];
    t[kk * 65 + 4 * tx + 3] = v[3];
  }
  __syncthreads();
#pragma unroll
  for (int i = 0; i < 2; ++i) {
    int c = tid + 256 * i;
    int nn = c >> 3, kc = (c & 7) * 8;
    f32x4 a, b;
#pragma unroll
    for (int e = 0; e < 4; ++e) { a[e] = t[(kc + e) * 65 + nn]; b[e] = t[(kc + 4 + e) * 65 + nn]; }
    int n = n0 + nn;
    int drow = n;
    if (glu) { drow = (n < 256) ? ((n >> 5) * 64 + (n & 31)) : (((n - 256) >> 5) * 64 + 32 + (n & 31)); }
    *(bf16x8*)(dst + (size_t)drow * K + k0 + kc) = pack8(a, b);
  }
  __syncthreads();
}

DI void prologue(const P& p, char* smem) {
  const int tid = get_tid();
  float* fs = (float*)smem;
  constexpr int N_ADA = 384, N_TAB = 64, N_MISC = 1, N_TR = 5700;
  constexpr int TOTAL = N_ADA + N_TAB + N_MISC;
  for (int it = blockIdx.x; it < TOTAL; it += gridDim.x) {
    if (it < N_ADA) {
      const int l = it / 192, ch = it % 192;
      float* sc = fs;
      float* red = fs + 5 * 1024;
      for (int i = tid; i < 5 * 1024; i += 256) {
        int m = i >> 10, k = i & 1023;
        float c = (m == 0) ? p.in[I_CCTX][k] : p.in[I_C][(m - 1) * 1024 + k];
        sc[i] = c * fsigmoid(c);
      }
      __syncthreads();
      const int col = tid & 31, kg = tid >> 5;
      const float* w = p.in[I_WADA] + ((size_t)l * 1024 + kg * 128) * 6144 + ch * 32 + col;
      float a0 = 0, a1 = 0, a2 = 0, a3 = 0, a4 = 0;
#pragma unroll 16
      for (int k = 0; k < 128; ++k) {
        float wv = w[(size_t)k * 6144];
        int kk = kg * 128 + k;
        a0 += sc[kk] * wv; a1 += sc[1024 + kk] * wv; a2 += sc[2048 + kk] * wv; a3 += sc[3072 + kk] * wv; a4 += sc[4096 + kk] * wv;
      }
      red[(kg * 5 + 0) * 32 + col] = a0; red[(kg * 5 + 1) * 32 + col] = a1; red[(kg * 5 + 2) * 32 + col] = a2;
      red[(kg * 5 + 3) * 32 + col] = a3; red[(kg * 5 + 4) * 32 + col] = a4;
      __syncthreads();
      if (tid < 160) {
        int m = tid >> 5, c2 = tid & 31;
        float s = 0;
#pragma unroll
        for (int g = 0; g < 8; ++g) s += red[(g * 5 + m) * 32 + c2];
        int n = ch * 32 + c2;
        s += p.in[I_BADA][l * 6144 + n];
        ((float*)(p.ws + OFF_MOD))[((size_t)l * 5 + m) * 6144 + n] = s;
      }
      __syncthreads();
    } else if (it < N_ADA + N_TAB) {
      const int idx = it - N_ADA;
      if (tid < 64) {
        const int pp = tid;
        float are = p.in[I_ARE][idx * 64 + pp], aim = p.in[I_AIM][idx * 64 + pp];
        float dt = expf(p.in[I_LOGDT][idx]);
        float zr = are * dt, zi = aim * dt;
        float e = expf(zr);
        float abr = e * cosf(zi), abi = e * sinf(zi);
        float d2 = are * are + aim * aim;
        float nr = abr - 1.f, ni = abi;
        float qr = (nr * are + ni * aim) / d2, qi = (ni * are - nr * aim) / d2;
        u16* at = (u16*)(p.ws + OFF_ATAB) + (size_t)idx * 128 * 16;
        u16* ct = (u16*)(p.ws + OFF_CTAB) + (size_t)idx * 16 * 128;
        for (int c = 0; c < 16; ++c) {
          float bre = p.in[I_BRE][((size_t)idx * 64 + pp) * 16 + c], bim = p.in[I_BIM][((size_t)idx * 64 + pp) * 16 + c];
          at[(2 * pp) * 16 + c] = f2bf(qr * bre - qi * bim);
          at[(2 * pp + 1) * 16 + c] = f2bf(qr * bim + qi * bre);
          float cre = p.in[I_CRE][((size_t)idx * 16 + c) * 64 + pp], cim = p.in[I_CIM][((size_t)idx * 16 + c) * 64 + pp];
          ct[c * 128 + 2 * pp] = f2bf(cre);
          ct[c * 128 + 2 * pp + 1] = f2bf(-cim);
        }
        float* ab = (float*)(p.ws + OFF_ABAR) + ((size_t)idx * 64 + pp) * 2;
        ab[0] = abr; ab[1] = abi;
      }
    } else if (it < N_ADA + N_TAB + N_MISC) {
      f32x2* tab = (f32x2*)(p.ws + OFF_ROPE);
      for (int i = tid; i < 2 * 64 * 16; i += 256) {
        int kind = i >> 10, pos = (i >> 4) & 63, fi = i & 15;
        int n = kind ? 16 : 8;
        float freq = expf(-(float)(fi % n) / (float)n * 9.210340371976184f);
        float ang = (float)pos * freq;
        f32x2 cs = {cosf(ang), sinf(ang)};
        tab[i] = cs;
      }
      if (tid < 64) ((int*)(p.ws + OFF_CTR))[tid] = 0;
    }
  }
  struct TrD { const float* src; u16* dst; int K, N, k0, n0; bool glu; };
  auto decode = [&](int tt) {
    TrD d; d.glu = false;
    const int l = tt / 2850;
    int r = tt % 2850; int kt, nt;
    if (r < 480) { d.src = p.in[I_WIN] + (size_t)l * 1024 * 1888; d.dst = (u16*)(p.ws + OFF_WIN) + (size_t)l * 1920 * 1024; d.K = 1024; d.N = 1888; kt = r / 30; nt = r % 30; }
    else if (r < 736) { r -= 480; d.src = p.in[I_WOUT] + (size_t)l * 1024 * 1024; d.dst = (u16*)(p.ws + OFF_WOUT) + (size_t)l * 1024 * 1024; d.K = 1024; d.N = 1024; kt = r / 16; nt = r % 16; }
    else if (r < 1760) { r -= 736; d.src = p.in[I_W1] + (size_t)l * 1024 * 4096; d.dst = (u16*)(p.ws + OFF_W1) + (size_t)l * 4096 * 1024; d.K = 1024; d.N = 4096; kt = r / 64; nt = r % 64; }
    else if (r < 2784) { r -= 1760; d.src = p.in[I_W2] + (size_t)l * 4096 * 1024; d.dst = (u16*)(p.ws + OFF_W2) + (size_t)l * 1024 * 4096; d.K = 4096; d.N = 1024; kt = r / 16; nt = r % 16; }
    else if (r < 2802) { r -= 2784; d.src = p.in[I_WUQ] + (size_t)l * 192 * 384; d.dst = (u16*)(p.ws + OFF_WUQ) + (size_t)l * 384 * 192; d.K = 192; d.N = 384; kt = r / 6; nt = r % 6; }
    else if (r < 2818) { r -= 2802; d.src = p.in[I_WUKV] + (size_t)l * 128 * 512; d.dst = (u16*)(p.ws + OFF_WUKV) + (size_t)l * 512 * 128; d.K = 128; d.N = 512; kt = r / 8; nt = r % 8; }
    else { r -= 2818; d.src = p.in[I_WGLU] + (size_t)l * 256 * 512; d.dst = (u16*)(p.ws + OFF_WGLU) + (size_t)l * 512 * 256; d.K = 256; d.N = 512; kt = r / 8; nt = r % 8; d.glu = true; }
    d.k0 = kt * 64; d.n0 = nt * 64;
    return d;
  };
  const int tx = tid & 15, ty = tid >> 4;
  auto tload = [&](const TrD& d, f32x4 (&v)[4]) {
#pragma unroll
    for (int i = 0; i < 4; ++i) {
      const int kk = ty + 16 * i, n = d.n0 + 4 * tx;
      f32x4 z = {0.f, 0.f, 0.f, 0.f};
      v[i] = (n < d.N) ? *(const f32x4*)(d.src + (size_t)(d.k0 + kk) * d.N + n) : z;
    }
  };
  const int tb = (int)gridDim.x - 1 - (int)blockIdx.x;
  if (tb < N_TR) {
    TrD cur = decode(tb);
    f32x4 cv[4];
    tload(cur, cv);
    for (int tt = tb; tt < N_TR; tt += gridDim.x) {
      const bool more = tt + (int)gridDim.x < N_TR;
      TrD nxt = decode(more ? tt + (int)gridDim.x : tt);
      f32x4 nv[4];
      if (more) tload(nxt, nv);
#pragma unroll
      for (int i = 0; i < 4; ++i) {
        const int kk = ty + 16 * i;
        fs[kk * 65 + 4 * tx + 0] = cv[i][0]; fs[kk * 65 + 4 * tx + 1] = cv[i][1]; fs[kk * 65 + 4 * tx + 2] = cv[i][2]; fs[kk * 65 + 4 * tx + 3] = cv[i][3];
      }
      __syncthreads();
#pragma unroll
      for (int i = 0; i < 2; ++i) {
        const int c = tid + 256 * i, nn = c >> 3, kc = (c & 7) * 8;
        f32x4 a, b;
#pragma unroll
        for (int e = 0; e < 4; ++e) { a[e] = fs[(kc + e) * 65 + nn]; b[e] = fs[(kc + 4 + e) * 65 + nn]; }
        const int n = cur.n0 + nn;
        int drow = n;
        if (cur.glu) drow = (n < 256) ? ((n >> 5) * 64 + (n & 31)) : (((n - 256) >> 5) * 64 + 32 + (n & 31));
        *(bf16x8*)(cur.dst + (size_t)drow * cur.K + cur.k0 + kc) = pack8(a, b);
      }
      __syncthreads();
      cur = nxt;
      if (more) {
#pragma unroll
        for (int i = 0; i < 4; ++i) cv[i] = nv[i];
      }
    }
  }
}

DI const float* x_row_src(const P& p, int layer, int row) {
  if (layer == 0) return row < NCTX ? p.in[I_XP] + (size_t)row * 1024 : p.in[I_XS] + (size_t)(row - NCTX) * 1024;
  return p.out + (size_t)row * 1024;
}
DI void norm_phase(const P& p, int layer, int which) {
  const int tid_ = get_tid();
  const int lane = tid_ & 63;
  const int gw = blockIdx.x * 4 + (tid_ >> 6), nw = gridDim.x * 4;
  auto src_of = [&](int row) { return (which == 0) ? x_row_src(p, layer, row) : (const float*)(p.out + (size_t)row * 1024); };
  f32x4 v[4];
  if (gw < NT) {
    const float* xs = src_of(gw);
#pragma unroll
    for (int i = 0; i < 4; ++i) v[i] = *(const f32x4*)(xs + (i * 64 + lane) * 4);
  }
  for (int row = gw; row < NT; row += nw) {
    f32x4 nv[4];
    const bool more = row + nw < NT;
    if (more) {
      const float* xs = src_of(row + nw);
#pragma unroll
      for (int i = 0; i < 4; ++i) nv[i] = *(const f32x4*)(xs + (i * 64 + lane) * 4);
    }
    float ss = 0;
#pragma unroll
    for (int i = 0; i < 4; ++i) ss += v[i][0] * v[i][0] + v[i][1] * v[i][1] + v[i][2] * v[i][2] + v[i][3] * v[i][3];
    ss = wave_sum(ss);
    const float r = rsqrtf(ss * (1.f / 1024.f) + EPSF);
    if (which == 2) {
      f32x4 g[4];
#pragma unroll
      for (int i = 0; i < 4; ++i) g[i] = *(const f32x4*)(p.in[I_FNG] + (i * 64 + lane) * 4);
#pragma unroll
      for (int i = 0; i < 4; ++i) {
        int e = (i * 64 + lane) * 4;
        f32x4 o = v[i] * r * g[i];
        *(f32x4*)(p.out + (size_t)row * 1024 + e) = o;
      }
    } else {
      const float* gn = p.in[which == 0 ? I_N1G : I_N2G] + layer * 1024;
      const float* md = (const float*)(p.ws + OFF_MOD) + ((size_t)layer * 5 + mod_index(row)) * 6144 + (which == 0 ? 0 : 3072);
      u16* h = (u16*)(p.ws + OFF_H) + (size_t)row * 1024;
      f32x4 g[4], sh[4], sc[4];
#pragma unroll
      for (int i = 0; i < 4; ++i) {
        int e = (i * 64 + lane) * 4;
        g[i] = *(const f32x4*)(gn + e);
        sh[i] = *(const f32x4*)(md + e);
        sc[i] = *(const f32x4*)(md + 1024 + e);
      }
      if (which == 0 && layer == 0) {
#pragma unroll
        for (int i = 0; i < 4; ++i) *(f32x4*)(p.out + (size_t)row * 1024 + (i * 64 + lane) * 4) = v[i];
      }
#pragma unroll
      for (int i = 0; i < 4; ++i) {
        int e = (i * 64 + lane) * 4;
        f32x4 o = v[i] * r * g[i] * (1.f + sc[i]) + sh[i];
        *(u32x2*)(h + e) = pack4(o);
      }
    }
    if (more) {
#pragma unroll
      for (int i = 0; i < 4; ++i) v[i] = nv[i];
    }
  }
}

template <int AMODE>
DI u32x4 load_a(const P& p, int layer, const u16* A, int lda, int row, int k) {
  if (AMODE == 0) {
    return *(const u32x4*)(A + (size_t)row * lda + k);
  } else {
    const float* y0 = (const float*)(p.ws + OFF_YBUF) + (size_t)row * 256 + k;
    const float* y1 = y0 + (size_t)NT * 256;
    const float* u = (const float*)(p.ws + OFF_PROJ) + (size_t)row * NP + 1280 + k;
    const float* d = p.in[I_SSMD] + layer * 256 + k;
    f32x4 r0, r1;
#pragma unroll
    for (int hh = 0; hh < 2; ++hh) {
      f32x4 a = *(const f32x4*)(y0 + 4 * hh), b = *(const f32x4*)(y1 + 4 * hh), c = *(const f32x4*)(u + 4 * hh), dd = *(const f32x4*)(d + 4 * hh);
      f32x4 s = a + b + c * dd;
      f32x4 g = {gelu_tanh(s[0]), gelu_tanh(s[1]), gelu_tanh(s[2]), gelu_tanh(s[3])};
      if (hh == 0) r0 = g; else r1 = g;
    }
    return __builtin_bit_cast(u32x4, pack8(r0, r1));
  }
}

template <int AMODE>
DI void gemm_core(const P& p, int layer, const u16* __restrict__ A, int lda, const u16* __restrict__ Bt, int K, int m0, int n0, char* smem,
                  f32x16 (&acc)[2][2]) {
  const int tid = get_tid(), lane = tid & 63, wave = tid >> 6, wm = wave >> 1, wn = wave & 1, l32 = lane & 31, hh = lane >> 5;
  u16* As = (u16*)smem;
  u16* Bs = As + 2 * 128 * 72;
#pragma unroll
  for (int bi = 0; bi < 2; ++bi)
#pragma unroll
    for (int bj = 0; bj < 2; ++bj)
#pragma unroll
      for (int r = 0; r < 16; ++r) acc[bi][bj][r] = 0.f;
  u32x4 ra[4], rb[4];
  const int nk = K / 64;
#pragma unroll
  for (int i = 0; i < 4; ++i) {
    int c = tid + 256 * i, r = c >> 3, kc = (c & 7) * 8;
    ra[i] = load_a<AMODE>(p, layer, A, lda, m0 + r, kc);
    rb[i] = *(const u32x4*)(Bt + (size_t)(n0 + r) * K + kc);
  }
#pragma unroll
  for (int i = 0; i < 4; ++i) {
    int c = tid + 256 * i, r = c >> 3, kc = (c & 7) * 8;
    *(u32x4*)(As + r * 72 + kc) = ra[i];
    *(u32x4*)(Bs + r * 72 + kc) = rb[i];
  }
  __syncthreads();
  for (int kt = 0; kt < nk; ++kt) {
    const int buf = kt & 1;
    const bool more = (kt + 1 < nk);
    if (more) {
      const int k0 = (kt + 1) * 64;
#pragma unroll
      for (int i = 0; i < 4; ++i) {
        int c = tid + 256 * i, r = c >> 3, kc = (c & 7) * 8;
        ra[i] = load_a<AMODE>(p, layer, A, lda, m0 + r, k0 + kc);
        rb[i] = *(const u32x4*)(Bt + (size_t)(n0 + r) * K + k0 + kc);
      }
    }
    const u16* as = As + buf * 128 * 72 + (wm * 64 + l32) * 72 + hh * 8;
    const u16* bs = Bs + buf * 128 * 72 + (wn * 64 + l32) * 72 + hh * 8;
#pragma unroll
    for (int ks = 0; ks < 4; ++ks) {
      bf16x8 a0 = *(const bf16x8*)(as + ks * 16);
      bf16x8 a1 = *(const bf16x8*)(as + 32 * 72 + ks * 16);
      bf16x8 b0 = *(const bf16x8*)(bs + ks * 16);
      bf16x8 b1 = *(const bf16x8*)(bs + 32 * 72 + ks * 16);
      acc[0][0] = MFMA32(a0, b0, acc[0][0]);
      acc[0][1] = MFMA32(a0, b1, acc[0][1]);
      acc[1][0] = MFMA32(a1, b0, acc[1][0]);
      acc[1][1] = MFMA32(a1, b1, acc[1][1]);
    }
    if (more) {
      const int nb = buf ^ 1;
#pragma unroll
      for (int i = 0; i < 4; ++i) {
        int c = tid + 256 * i, r = c >> 3, kc = (c & 7) * 8;
        *(u32x4*)(As + nb * 128 * 72 + r * 72 + kc) = ra[i];
        *(u32x4*)(Bs + nb * 128 * 72 + r * 72 + kc) = rb[i];
      }
    }
    __syncthreads();
  }
}

#define LAS3 __attribute__((address_space(3)))
DI void stage_tile_dma(const u16* __restrict__ G, int ld, int row0, int k0, char* lds, int tid) {
#pragma unroll
  for (int i = 0; i < 4; ++i) {
    const int q = tid + 256 * i, r = q >> 3, c = (q & 7) ^ ((r >> 1) & 7);
    __builtin_amdgcn_global_load_lds((const unsigned*)(G + (size_t)(row0 + r) * ld + k0 + c * 8), (LAS3 unsigned*)(lds + q * 16), 16, 0, 0);
  }
}

struct TD { const u16* A; const u16* B; int lda, ldb, k0, nk, m0, n0; };
DI void stage_td(const TD& d, int kt, char* stage_base, int tid) {
  stage_tile_dma(d.A, d.lda, d.m0, d.k0 + kt * 64, stage_base, tid);
  stage_tile_dma(d.B, d.ldb, d.n0, d.k0 + kt * 64, stage_base + 16384, tid);
}
DI void gemm_stream(const TD& cur, bool has_next, const TD& nxt, char* smem, int& buf, f32x16 (&acc)[2][2]) {
  const int tid = get_tid(), lane = tid & 63, wave = tid >> 6, wm = wave >> 1, wn = wave & 1, l32 = lane & 31, hh = lane >> 5;
#pragma unroll
  for (int bi = 0; bi < 2; ++bi)
#pragma unroll
    for (int bj = 0; bj < 2; ++bj)
#pragma unroll
      for (int r = 0; r < 16; ++r) acc[bi][bj][r] = 0.f;
  const int swz = (l32 >> 1) & 7;
  const int arow = (wm * 64 + l32) * 128, brow = (wn * 64 + l32) * 128;
  const int c0 = ((0 + hh) ^ swz) * 16, c1 = ((2 + hh) ^ swz) * 16, c2 = ((4 + hh) ^ swz) * 16, c3 = ((6 + hh) ^ swz) * 16;
  asm volatile("s_waitcnt vmcnt(0)" ::: "memory");
  __syncthreads();
  const int nk = cur.nk;
  for (int kt = 0; kt < nk; ++kt) {
    if (kt + 1 < nk) stage_td(cur, kt + 1, smem + (buf ^ 1) * 32768, tid);
    else if (has_next) stage_td(nxt, 0, smem + (buf ^ 1) * 32768, tid);
    const char* as = smem + buf * 32768 + arow;
    const char* bs = smem + buf * 32768 + 16384 + brow;
    bf16x8 fa0[2], fa1[2], fb0[2], fb1[2];
    fa0[0] = *(const bf16x8*)(as + c0); fa1[0] = *(const bf16x8*)(as + 4096 + c0);
    fb0[0] = *(const bf16x8*)(bs + c0); fb1[0] = *(const bf16x8*)(bs + 4096 + c0);
#pragma unroll
    for (int ks = 0; ks < 4; ++ks) {
      const int cb = ks & 1, nb = cb ^ 1;
      if (ks < 3) {
        const int co = (ks == 0) ? c1 : (ks == 1) ? c2 : c3;
        fa0[nb] = *(const bf16x8*)(as + co); fa1[nb] = *(const bf16x8*)(as + 4096 + co);
        fb0[nb] = *(const bf16x8*)(bs + co); fb1[nb] = *(const bf16x8*)(bs + 4096 + co);
      }
      acc[0][0] = MFMA32(fa0[cb], fb0[cb], acc[0][0]);
      acc[0][1] = MFMA32(fa0[cb], fb1[cb], acc[0][1]);
      acc[1][0] = MFMA32(fa1[cb], fb0[cb], acc[1][0]);
      acc[1][1] = MFMA32(fa1[cb], fb1[cb], acc[1][1]);
    }
    buf ^= 1;
    if (kt + 1 < nk) {
      asm volatile("s_waitcnt vmcnt(0)" ::: "memory");
      __syncthreads();
    }
  }
}

#define EPI_IDX                                                                                        \
  const int tid = get_tid(), lane = tid & 63, wave = tid >> 6, wm = wave >> 1, wn = wave & 1, l32 = lane & 31, hh = lane >> 5; \
  (void)tid; (void)lane; (void)wave; (void)wm; (void)wn; (void)l32; (void)hh;
DI int crow(int r, int hh) { return (r & 3) + 8 * (r >> 2) + 4 * hh; }

DI void phase_g1(const P& p, int layer, char* smem) {
  EPI_IDX
  const u16* A = (const u16*)(p.ws + OFF_H);
  const u16* Bt = (const u16*)(p.ws + OFF_WIN) + (size_t)layer * 1920 * 1024;
  float* proj = (float*)(p.ws + OFF_PROJ);
  constexpr int MT = NT / 128, NTL = NP / 128;
  const int xcd_ = blockIdx.x & 7, xj_ = blockIdx.x >> 3, xn_ = gridDim.x >> 3;
  constexpr int MPX = MT / 8;
  auto tile_at = [&](int u) { TD d; d.A = A; d.B = Bt; d.lda = 1024; d.ldb = 1024; d.k0 = 0; d.nk = 16; d.m0 = (xcd_ * MPX + u % MPX) * 128; d.n0 = (u / MPX) * 128; return d; };
  int buf = 0;
  TD cur = tile_at(xj_ < MPX * NTL ? xj_ : 0);
  if (xj_ < MPX * NTL) stage_td(cur, 0, smem, tid);
  for (int u = xj_; u < MPX * NTL; u += xn_) {
    const bool has_next = (u + xn_ < MPX * NTL);
    const TD nxt = tile_at(has_next ? u + xn_ : u);
    const int m0 = cur.m0, n0 = cur.n0;
    f32x16 acc[2][2];
    gemm_stream(cur, has_next, nxt, smem, buf, acc);
    cur = nxt;
    const bool lat = m0 >= NCTX;
    const int b_all = lat ? 32 + ((m0 - NCTX) >> 10) : (m0 >> 8);
    const int nkk = lat ? 1536 : 256;
#pragma unroll
    for (int bi = 0; bi < 2; ++bi)
#pragma unroll
      for (int bj = 0; bj < 2; ++bj) {
        const int rb = m0 + wm * 64 + bi * 32;
        const int cb = n0 + wn * 64 + bj * 32;
        const int col = cb + l32;
#pragma unroll
        for (int r = 0; r < 16; ++r) proj[(size_t)(rb + crow(r, hh)) * NP + col] = acc[bi][bj][r];
        const bool isdv = (cb >= 512 && cb < 768), isgv = (cb >= 1152 && cb < 1280);
        if (isdv || isgv) {
          u16* vt; int f;
          if (isdv) { f = col - 512; vt = (u16*)(p.ws + OFF_DVT) + vt_off(b_all, f >> 6, 4); }
          else { f = col - 1152; vt = (u16*)(p.ws + OFF_GVT) + vt_off(b_all, f >> 6, 2); }
          vt += (size_t)(f & 63) * nkk;
#pragma unroll
          for (int j = 0; j < 4; ++j) {
            int row = rb + 16 * (j >> 1) + 8 * hh + 4 * (j & 1);
            int key = lat ? 512 + ((row - NCTX) & 1023) : (row & 255);
            f32x4 v = {acc[bi][bj][4 * j], acc[bi][bj][4 * j + 1], acc[bi][bj][4 * j + 2], acc[bi][bj][4 * j + 3]};
            *(u32x2*)(vt + key) = pack4(v);
          }
        }
      }
  }
}

DI void phase_g2(const P& p, int layer, char* smem) {
  EPI_IDX
  constexpr int T_MQ = (NT / 128) * 3, T_MKV = (NKR / 128) * 4, T_GLU = (NT / 128) * 4;
  const f32x2* tab32 = (const f32x2*)(p.ws + OFF_ROPE);
  auto tile_at = [&](int t) {
    TD d; d.k0 = 0;
    if (t < T_MQ) { d.A = (const u16*)(p.ws + OFF_CQN); d.B = (const u16*)(p.ws + OFF_WUQ) + (size_t)layer * 384 * 192; d.lda = 192; d.ldb = 192; d.nk = 3; d.m0 = (t / 3) * 128; d.n0 = (t % 3) * 128; }
    else { const int t2 = t - T_MQ; d.A = (const u16*)(p.ws + OFF_CKVN); d.B = (const u16*)(p.ws + OFF_WUKV) + (size_t)layer * 512 * 128; d.lda = 128; d.ldb = 128; d.nk = 2; d.m0 = (t2 / 4) * 128; d.n0 = (t2 % 4) * 128; }
    return d;
  };
  int buf = 0;
  const int t_first = blockIdx.x;
  TD cur = tile_at(t_first < T_MQ + T_MKV ? t_first : 0);
  if (t_first < T_MQ + T_MKV) stage_td(cur, 0, smem, tid);
  for (int t = blockIdx.x; t < T_MQ + T_MKV; t += gridDim.x) {
    const bool has_next = (t + (int)gridDim.x < T_MQ + T_MKV);
    const TD nxt = tile_at(has_next ? t + (int)gridDim.x : t);
    f32x16 acc[2][2];
    const int m0 = cur.m0, n0 = cur.n0;
    gemm_stream(cur, has_next, nxt, smem, buf, acc);
    cur = nxt;
    if (t < T_MQ) {
      const bool lat = m0 >= NCTX;
      const float scl = 0.10206207261596575f * LOG2E;
      u16* mq = (u16*)(p.ws + OFF_MQ);
#pragma unroll
      for (int bi = 0; bi < 2; ++bi)
#pragma unroll
        for (int bj = 0; bj < 2; ++bj) {
          const int rb = m0 + wm * 64 + bi * 32;
          const int cb = n0 + wn * 64 + bj * 32;
          const int col = cb + l32;
          const bool isrope = lat && ((cb % 96) == 64);
          const int e = l32, w2 = e & 15, fi = w2 & 7;
          const bool isx2 = w2 >= 8, half = e >= 16;
          f32x2 csv[16];
#pragma unroll
          for (int r = 0; r < 16; ++r) {
            const int row = rb + crow(r, hh);
            int tt = (row - NCTX) & 1023;
            int pos = half ? (tt & 63) : (tt >> 6);
            f32x2 one = {1.f, 0.f};
            csv[r] = isrope ? tab32[pos * 16 + fi] : one;
          }
#pragma unroll
          for (int r = 0; r < 16; ++r) {
            float v = acc[bi][bj][r];
            const int row = rb + crow(r, hh);
            if (isrope) {
              float pv = __shfl_xor(v, 8);
              v = v * csv[r][0] + (isx2 ? pv : -pv) * csv[r][1];
            }
            mq[(size_t)row * 384 + col] = f2bf(v * scl);
          }
        }
    } else {
      const int nt = n0 >> 7;
      const bool lat = m0 >= NCTX;
      const int b_all = lat ? 32 + (m0 - NCTX) / 1536 : (m0 >> 8);
      const int nkk = lat ? 1536 : 256;
      const int kbase = lat ? (m0 - NCTX) % 1536 : (m0 & 255);
      const int head = nt;
      u16* mk = (u16*)(p.ws + OFF_MKB);
      u16* mvt = (u16*)(p.ws + OFF_MVT) + vt_off(b_all, head, 4);
#pragma unroll
      for (int bi = 0; bi < 2; ++bi)
#pragma unroll
        for (int bj = 0; bj < 2; ++bj) {
          const int rloc = wm * 64 + bi * 32;
          const int wcol = wn * 64 + bj * 32 + l32;
          if (wn == 0) {
#pragma unroll
            for (int r = 0; r < 16; ++r) mk[(size_t)(m0 + rloc + crow(r, hh)) * 384 + head * 96 + wcol] = f2bf(acc[bi][bj][r]);
          } else {
            u16* vt = mvt + (size_t)(wcol - 64) * nkk + kbase + rloc;
#pragma unroll
            for (int j = 0; j < 4; ++j) {
              f32x4 v = {acc[bi][bj][4 * j], acc[bi][bj][4 * j + 1], acc[bi][bj][4 * j + 2], acc[bi][bj][4 * j + 3]};
              *(u32x2*)(vt + 16 * (j >> 1) + 8 * hh + 4 * (j & 1)) = pack4(v);
            }
          }
        }
    }
  }
  __syncthreads();
  for (int t2 = (int)gridDim.x - 1 - (int)blockIdx.x; t2 < T_GLU; t2 += gridDim.x) {
    {
      f32x16 acc[2][2];
      const int mt = t2 / 4, nt = t2 % 4, m0 = mt * 128, n0 = nt * 128;
      gemm_core<1>(p, layer, nullptr, 0, (const u16*)(p.ws + OFF_WGLU) + (size_t)layer * 512 * 256, 256, m0, n0, smem, acc);
      u16* mixed = (u16*)(p.ws + OFF_MIXED);
      const int q = (n0 + wn * 64) >> 6;
#pragma unroll
      for (int bi = 0; bi < 2; ++bi) {
        const int rb = m0 + wm * 64 + bi * 32;
#pragma unroll
        for (int r = 0; r < 16; ++r) {
          float z = acc[bi][0][r], g = acc[bi][1][r];
          mixed[(size_t)(rb + crow(r, hh)) * 1024 + 512 + q * 32 + l32] = f2bf(z * fsigmoid(g));
        }
      }
    }
  }
}

DI void phase_resid(const P& p, int layer, char* smem, bool is_out) {
  EPI_IDX
  const u16* A = is_out ? (const u16*)(p.ws + OFF_MIXED) : (const u16*)(p.ws + OFF_A);
  const int K = is_out ? 1024 : 4096;
  const u16* Bt = is_out ? (const u16*)(p.ws + OFF_WOUT) + (size_t)layer * 1024 * 1024 : (const u16*)(p.ws + OFF_W2) + (size_t)layer * 1024 * 4096;
  constexpr int MT = NT / 128, NTL = 8, MPX = MT / 8, NU = MPX * NTL;
  const int xcd_ = blockIdx.x & 7, xj_ = blockIdx.x >> 3, xn_ = gridDim.x >> 3;
  auto tile_at = [&](int u) {
    TD d; d.A = A; d.B = Bt; d.lda = K; d.ldb = K; d.nk = K / 64; d.k0 = 0;
    const int v = u;
    d.n0 = (is_out ? v / MPX : v % NTL) * 128;
    d.m0 = (xcd_ * MPX + (is_out ? v % MPX : v / NTL)) * 128;
    return d;
  };
  int buf = 0;
  TD cur = tile_at(xj_ < NU ? xj_ : 0);
  if (xj_ < NU) stage_td(cur, 0, smem, tid);
  for (int u = xj_; u < NU; u += xn_) {
    const bool has_next = (u + xn_ < NU);
    const TD nxt = tile_at(has_next ? u + xn_ : u);
    const int m0 = cur.m0, n0 = cur.n0;
    f32x16 acc[2][2];
    gemm_stream(cur, has_next, nxt, smem, buf, acc);
    cur = nxt;
    const float* gate = (const float*)(p.ws + OFF_MOD) + ((size_t)layer * 5 + mod_index(m0)) * 6144 + (is_out ? 2048 : 5120);
#pragma unroll
    for (int bi = 0; bi < 2; ++bi)
#pragma unroll
      for (int bj = 0; bj < 2; ++bj) {
        const int rb = m0 + wm * 64 + bi * 32;
        const int col = n0 + wn * 64 + bj * 32 + l32;
        const float g = gate[col];
        float rv[16];
#pragma unroll
        for (int r = 0; r < 16; ++r) rv[r] = p.out[(size_t)(rb + crow(r, hh)) * 1024 + col];
#pragma unroll
        for (int r = 0; r < 16; ++r) p.out[(size_t)(rb + crow(r, hh)) * 1024 + col] = rv[r] + g * acc[bi][bj][r];
      }
  }
}

DI void phase_g5(const P& p, int layer, char* smem) {
  EPI_IDX
  const u16* A = (const u16*)(p.ws + OFF_H);
  const u16* Bt = (const u16*)(p.ws + OFF_W1) + (size_t)layer * 4096 * 1024;
  u16* a = (u16*)(p.ws + OFF_A);
  constexpr int MT = NT / 128, NTL = 32;
  const int xcd_ = blockIdx.x & 7, xj_ = blockIdx.x >> 3, xn_ = gridDim.x >> 3;
  constexpr int MPX = MT / 8;
  auto tile_at = [&](int u) { TD d; d.A = A; d.B = Bt; d.lda = 1024; d.ldb = 1024; d.k0 = 0; d.nk = 16; d.m0 = (xcd_ * MPX + u % MPX) * 128; d.n0 = (u / MPX) * 128; return d; };
  int buf = 0;
  TD cur = tile_at(xj_ < MPX * NTL ? xj_ : 0);
  if (xj_ < MPX * NTL) stage_td(cur, 0, smem, tid);
  for (int u = xj_; u < MPX * NTL; u += xn_) {
    const bool has_next = (u + xn_ < MPX * NTL);
    const TD nxt = tile_at(has_next ? u + xn_ : u);
    const int m0 = cur.m0, n0 = cur.n0;
    f32x16 acc[2][2];
    gemm_stream(cur, has_next, nxt, smem, buf, acc);
    cur = nxt;
#pragma unroll
    for (int bi = 0; bi < 2; ++bi)
#pragma unroll
      for (int bj = 0; bj < 2; ++bj) {
        const int rb = m0 + wm * 64 + bi * 32;
        const int col = n0 + wn * 64 + bj * 32 + l32;
#pragma unroll
        for (int r = 0; r < 16; ++r) {
          float v = fmaxf(acc[bi][bj][r], 0.f);
          a[(size_t)(rb + crow(r, hh)) * 4096 + col] = f2bf(v * v);
        }
      }
  }
}

template <int R>
DI f32x4 rope4(f32x4 v, int lane, int t, const f32x2* tab) {
  constexpr int n = R / 4;
  const int e = (lane * 4) % R;
  const int half = e / (R / 2), w = e % (R / 2);
  const bool isx2 = w >= n;
  const int fi = w % n;
  const int pos = half ? (t & 63) : (t >> 6);
  f32x4 o;
#pragma unroll
  for (int i = 0; i < 4; ++i) {
    float pv = __shfl_xor(v[i], n / 4);
    f32x2 cs = tab[pos * 16 + fi + i];
    o[i] = v[i] * cs[0] + (isx2 ? pv : -pv) * cs[1];
  }
  return o;
}

DI void ssm_item(const P& p, int layer, int item, float* lds, int lane) {
  int b_all, r;
  if (item < 128) { b_all = 32 + item / 32; r = item % 32; } else { int it = item - 128; b_all = it / 32; r = it % 32; }
  const int dir = r >> 4, g = r & 15;
  const bool lat = b_all >= 32;
  const int T = lat ? 1024 : 256;
  const int row0 = lat ? NCTX + (b_all - 32) * 1024 : b_all * 256;
  const int tabidx = (layer * 2 + dir) * 16 + g;
  const int l32 = lane & 31, hh = lane >> 5, l16 = lane & 15, q4 = lane >> 4;
  const u16* atab = (const u16*)(p.ws + OFF_ATAB) + (size_t)tabidx * 128 * 16;
  const u16* ctab = (const u16*)(p.ws + OFF_CTAB) + (size_t)tabidx * 16 * 128;
  bf16x8 af[4], cf[4];
#pragma unroll
  for (int blk = 0; blk < 4; ++blk) af[blk] = *(const bf16x8*)(atab + (blk * 32 + l32) * 16 + hh * 8);
#pragma unroll
  for (int kk = 0; kk < 4; ++kk) cf[kk] = *(const bf16x8*)(ctab + l16 * 128 + kk * 32 + q4 * 8);
  const float* ab = (const float*)(p.ws + OFF_ABAR) + ((size_t)tabidx * 64 + lane) * 2;
  const float ar = ab[0], ai = ab[1];
  float hr = 0.f, hi = 0.f;
  if (lat) {
    size_t idx = ((size_t)((b_all - 32) * 2 + layer) * 2 + dir) * 1024 + g * 64 + lane;
    hr = p.in[I_SRE][idx]; hi = p.in[I_SIM][idx];
  }
  const float* proj = (const float*)(p.ws + OFF_PROJ);
  float* ybuf = (float*)(p.ws + OFF_YBUF) + (size_t)dir * NT * 256;
  f32x16 zero16;
#pragma unroll
  for (int i = 0; i < 16; ++i) zero16[i] = 0.f;
  f32x4 u0, u1;
  {
    const int t = dir ? (T - 1 - l32) : l32;
    const float* up = proj + (size_t)(row0 + t) * NP + 1280 + g * 16 + hh * 8;
    u0 = *(const f32x4*)up; u1 = *(const f32x4*)(up + 4);
  }
  for (int ch = 0; ch < T / 32; ++ch) {
    {
      bf16x8 uf = pack8(u0, u1);
      if (ch + 1 < T / 32) {
        const int n = (ch + 1) * 32 + l32;
        const int t = dir ? (T - 1 - n) : n;
        const float* up = proj + (size_t)(row0 + t) * NP + 1280 + g * 16 + hh * 8;
        u0 = *(const f32x4*)up; u1 = *(const f32x4*)(up + 4);
      }
#pragma unroll
      for (int blk = 0; blk < 4; ++blk) {
        f32x16 d = MFMA32(af[blk], uf, zero16);
#pragma unroll
        for (int j = 0; j < 4; ++j) {
          f32x4 v = {d[4 * j], d[4 * j + 1], d[4 * j + 2], d[4 * j + 3]};
          *(f32x4*)(lds + l32 * 132 + blk * 32 + 8 * j + 4 * hh) = v;
        }
      }
    }
    wave_lds_fence();
#pragma unroll
    for (int s = 0; s < 32; ++s) {
      f32x2 bu = *(const f32x2*)(lds + s * 132 + 2 * lane);
      float nr = ar * hr - ai * hi + bu[0];
      float ni = ar * hi + ai * hr + bu[1];
      hr = nr; hi = ni;
      f32x2 hv = {hr, hi};
      *(f32x2*)(lds + s * 132 + 2 * lane) = hv;
    }
    wave_lds_fence();
#pragma unroll
    for (int tb = 0; tb < 2; ++tb) {
      f32x4 y = {0.f, 0.f, 0.f, 0.f};
#pragma unroll
      for (int kk = 0; kk < 4; ++kk) {
        const float* hp = lds + (tb * 16 + l16) * 132 + kk * 32 + q4 * 8;
        f32x4 a0 = *(const f32x4*)hp, a1 = *(const f32x4*)(hp + 4);
        y = MFMA16(cf[kk], pack8(a0, a1), y);
      }
      const int n2 = ch * 32 + tb * 16 + l16;
      const int t2 = dir ? (T - 1 - n2) : n2;
      *(f32x4*)(ybuf + (size_t)(row0 + t2) * 256 + g * 16 + q4 * 4) = y;
    }
    wave_lds_fence();
  }
  if (!lat) {
    size_t idx = ((size_t)(b_all * 2 + layer) * 2 + dir) * 1024 + g * 64 + lane;
    p.out[O_SRE + idx] = hr;
    p.out[O_SIM + idx] = hi;
  }
}

DI void pp_row(const P& p, int layer, int row, int lane) {
  const float* pr = (const float*)(p.ws + OFF_PROJ) + (size_t)row * NP;
  const bool lat = row >= NCTX;
  int b, t, keyrow;
  if (!lat) { b = row >> 8; t = row & 255; keyrow = row; }
  else { int rr = row - NCTX; b = rr >> 10; t = rr & 1023; keyrow = NCTX + b * 1536 + 512 + t; }
  const f32x2* tab32 = (const f32x2*)(p.ws + OFF_ROPE);
  const f32x2* tab64 = tab32 + 64 * 16;
  const size_t orow = (size_t)(b * 2 + layer) * 256 + t;
  const f32x4 z4 = {0.f, 0.f, 0.f, 0.f};
  f32x4 v_dq = *(const f32x4*)(pr + lane * 4);
  f32x4 v_dk = *(const f32x4*)(pr + 256 + lane * 4);
  f32x4 v_dv = *(const f32x4*)(pr + 512 + lane * 4);
  f32x4 v_gq = *(const f32x4*)(pr + 768 + lane * 4);
  f32x4 v_gk = lane < 32 ? *(const f32x4*)(pr + 1024 + lane * 4) : z4;
  f32x4 v_gv = lane < 32 ? *(const f32x4*)(pr + 1152 + lane * 4) : z4;
  f32x4 v_cq = lane < 48 ? *(const f32x4*)(pr + 1536 + lane * 4) : z4;
  f32x4 v_ckv = lane < 32 ? *(const f32x4*)(pr + 1728 + lane * 4) : z4;
  f32x4 v_kr = lane < 8 ? *(const f32x4*)(pr + 1856 + lane * 4) : z4;
  const f32x4 g_q = *(const f32x4*)(p.in[I_QNG] + layer * 64 + (lane & 15) * 4);
  const f32x4 g_k = *(const f32x4*)(p.in[I_KNG] + layer * 64 + (lane & 15) * 4);
  const f32x4 g_cq = lane < 48 ? *(const f32x4*)(p.in[I_MQNG] + layer * 192 + lane * 4) : z4;
  const f32x4 g_ckv = lane < 32 ? *(const f32x4*)(p.in[I_MKVNG] + layer * 128 + lane * 4) : z4;
  f32x2 cs32[4], cs64[4];
  {
    const int e32 = (lane * 4) & 31, w32 = e32 & 15, p32 = (e32 >> 4) ? (t & 63) : (t >> 6), f32i = w32 & 7;
    const int e64 = (lane * 4) & 63, w64 = e64 & 31, p64 = (e64 >> 5) ? (t & 63) : (t >> 6), f64i = w64 & 15;
    const f32x2 one = {1.f, 0.f};
#pragma unroll
    for (int i = 0; i < 4; ++i) {
      cs32[i] = lat ? tab32[p32 * 16 + f32i + i] : one;
      cs64[i] = lat ? tab64[p64 * 16 + f64i + i] : one;
    }
  }
  const bool x2_32 = ((lane * 4) & 15) >= 8, x2_64 = ((lane * 4) & 31) >= 16;
  auto rope32 = [&](f32x4 v) {
    f32x4 o;
#pragma unroll
    for (int i = 0; i < 4; ++i) { float pv = __shfl_xor(v[i], 2); o[i] = v[i] * cs32[i][0] + (x2_32 ? pv : -pv) * cs32[i][1]; }
    return o;
  };
  auto rope64 = [&](f32x4 v) {
    f32x4 o;
#pragma unroll
    for (int i = 0; i < 4; ++i) { float pv = __shfl_xor(v[i], 4); o[i] = v[i] * cs64[i][0] + (x2_64 ? pv : -pv) * cs64[i][1]; }
    return o;
  };
  if (!lat) {
    *(f32x4*)(p.out + O_DK + orow * 256 + lane * 4) = v_dk;
    *(f32x4*)(p.out + O_DV + orow * 256 + lane * 4) = v_dv;
    if (lane < 32) *(f32x4*)(p.out + O_GV + orow * 128 + lane * 4) = v_gv;
    if (lane < 8) *(f32x4*)(p.out + O_KR + orow * 32 + lane * 4) = v_kr;
  }
  {
    f32x4 v = v_dq;
    if (lat) v = rope32(v);
    v = v * (0.17677669529663687f * LOG2E);
    *(u32x2*)((u16*)(p.ws + OFF_DQ) + (size_t)row * 256 + lane * 4) = pack4(v);
  }
  {
    f32x4 v = v_dk;
    if (lat) v = rope32(v);
    *(u32x2*)((u16*)(p.ws + OFF_DKB) + (size_t)keyrow * 256 + lane * 4) = pack4(v);
  }
  {
    f32x4 v = v_gq;
    float ss = v[0] * v[0] + v[1] * v[1] + v[2] * v[2] + v[3] * v[3];
    ss += __shfl_xor(ss, 1); ss += __shfl_xor(ss, 2); ss += __shfl_xor(ss, 4); ss += __shfl_xor(ss, 8);
    float r = rsqrtf(ss * (1.f / 64.f) + EPSF);
    v = v * r * g_q;
    if (lat) v = rope64(v);
    v = v * (0.125f * LOG2E);
    *(u32x2*)((u16*)(p.ws + OFF_GQ) + (size_t)row * 256 + lane * 4) = pack4(v);
  }
  {
    f32x4 v = v_gk;
    float ss = v[0] * v[0] + v[1] * v[1] + v[2] * v[2] + v[3] * v[3];
    ss += __shfl_xor(ss, 1); ss += __shfl_xor(ss, 2); ss += __shfl_xor(ss, 4); ss += __shfl_xor(ss, 8);
    float r = rsqrtf(ss * (1.f / 64.f) + EPSF);
    v = v * r * g_k;
    if (!lat) { if (lane < 32) *(f32x4*)(p.out + O_GK + orow * 128 + lane * 4) = v; }
    else v = rope64(v);
    if (lane < 32) *(u32x2*)((u16*)(p.ws + OFF_GKB) + (size_t)keyrow * 128 + lane * 4) = pack4(v);
  }
  {
    f32x4 v = v_cq;
    float ss = wave_sum(v[0] * v[0] + v[1] * v[1] + v[2] * v[2] + v[3] * v[3]);
    float r = rsqrtf(ss * (1.f / 192.f) + EPSF);
    v = v * r * g_cq;
    if (lane < 48) *(u32x2*)((u16*)(p.ws + OFF_CQN) + (size_t)row * 192 + lane * 4) = pack4(v);
  }
  {
    f32x4 v = v_ckv;
    float ss = wave_sum(v[0] * v[0] + v[1] * v[1] + v[2] * v[2] + v[3] * v[3]);
    float r = rsqrtf(ss * (1.f / 128.f) + EPSF);
    v = v * r * g_ckv;
    if (lane < 32) {
      if (!lat) *(f32x4*)(p.out + O_CKV + orow * 128 + lane * 4) = v;
      *(u32x2*)((u16*)(p.ws + OFF_CKVN) + (size_t)keyrow * 128 + lane * 4) = pack4(v);
    }
  }
  {
    f32x4 v = v_kr;
    if (lat) v = rope32(v);
    if (lane < 8) {
      u32x2 pk = pack4(v);
      u16* mk = (u16*)(p.ws + OFF_MKB) + (size_t)keyrow * 384 + 64 + lane * 4;
#pragma unroll
      for (int hd = 0; hd < 4; ++hd) *(u32x2*)(mk + hd * 96) = pk;
    }
  }
}

DI void pp_cached(const P& p, int layer, int crow_, int lane) {
  const int b = crow_ >> 9, j = crow_ & 511;
  const int keyrow = NCTX + b * 1536 + j;
  const size_t src = (size_t)(b * 2 + layer) * 512 + j;
  const int jp = (j & ~15) | (((j >> 2) & 1) << 3) | (((j >> 3) & 1) << 2) | (j & 3);
  const f32x4 z4 = {0.f, 0.f, 0.f, 0.f};
  const int l31 = lane & 31, l7 = lane & 7;
  f32x4 v_dk = *(const f32x4*)(p.in[I_CDK] + src * 256 + lane * 4);
  f32x4 v_dv = *(const f32x4*)(p.in[I_CDV] + src * 256 + lane * 4);
  f32x4 v_gk = *(const f32x4*)(p.in[I_CGK] + src * 128 + l31 * 4);
  f32x4 v_gv = *(const f32x4*)(p.in[I_CGV] + src * 128 + l31 * 4);
  f32x4 v_ckv = *(const f32x4*)(p.in[I_CCKV] + src * 128 + l31 * 4);
  f32x4 v_kr = *(const f32x4*)(p.in[I_CKR] + src * 32 + l7 * 4);
  (void)z4;
  *(u32x2*)((u16*)(p.ws + OFF_DKB) + (size_t)keyrow * 256 + lane * 4) = pack4(v_dk);
  {
    u16* vt = (u16*)(p.ws + OFF_DVT) + vt_off(32 + b, lane >> 4, 4) + (size_t)((lane & 15) * 4) * 1536 + jp;
#pragma unroll
    for (int i = 0; i < 4; ++i) vt[(size_t)i * 1536] = f2bf(v_dv[i]);
  }
  if (lane < 32) {
    *(u32x2*)((u16*)(p.ws + OFF_GKB) + (size_t)keyrow * 128 + lane * 4) = pack4(v_gk);
    u16* vt = (u16*)(p.ws + OFF_GVT) + vt_off(32 + b, lane >> 4, 2) + (size_t)((lane & 15) * 4) * 1536 + jp;
#pragma unroll
    for (int i = 0; i < 4; ++i) vt[(size_t)i * 1536] = f2bf(v_gv[i]);
    *(u32x2*)((u16*)(p.ws + OFF_CKVN) + (size_t)keyrow * 128 + lane * 4) = pack4(v_ckv);
  }
  if (lane < 8) {
    u32x2 pk = pack4(v_kr);
    u16* mk = (u16*)(p.ws + OFF_MKB) + (size_t)keyrow * 384 + 64 + lane * 4;
#pragma unroll
    for (int hd = 0; hd < 4; ++hd) *(u32x2*)(mk + hd * 96) = pk;
  }
}

DI void phase_pp(const P& p, int layer, char* smem) {
  const int tid_ = get_tid();
  const int lane = tid_ & 63, wave = tid_ >> 6;
  float* lds = (float*)smem + wave * (32 * 132);
  const int gw = blockIdx.x * 4 + wave, nw = gridDim.x * 4;
  constexpr int N_SSM = 1152, N_ROWS = NT + 2048;
  for (int item = gw; item < N_SSM; item += nw) ssm_item(p, layer, item, lds, lane);
  const int rw0 = (nw > 256) ? 128 : 0;
  if (gw >= rw0) {
    for (int row = gw - rw0; row < N_ROWS; row += nw - rw0) {
      if (row < NT) pp_row(p, layer, row, lane);
      else pp_cached(p, layer, row - NT, lane);
    }
  }
}

template <int KW, int DK>
DI void attn_block(const u16* __restrict__ Kg, int ldk, const u16* __restrict__ Vt, int nk, const bf16x8 (&qf)[DK / 16], int kcol, char* smem,
                   int tid, f32x16 (&o)[2], float& lsum) {
  constexpr int KST = KW + 8, KS = DK / 16, KCH = KW / 8, NKC = 64 * KCH / 256;
  const int lane = tid & 63, l32 = lane & 31, hh = lane >> 5;
  u16* Ks = (u16*)smem;
  u16* Vs = Ks + 2 * 64 * KST;
  float m = -1e30f;
  lsum = 0.f;
#pragma unroll
  for (int db = 0; db < 2; ++db)
#pragma unroll
    for (int r = 0; r < 16; ++r) o[db][r] = 0.f;
  u32x4 rk[NKC], rv[2];
  const int nt = nk / 64;
#pragma unroll
  for (int i = 0; i < NKC; ++i) { int c = tid + 256 * i, r = c / KCH, kc = (c % KCH) * 8; rk[i] = *(const u32x4*)(Kg + (size_t)r * ldk + kc); }
#pragma unroll
  for (int i = 0; i < 2; ++i) { int c = tid + 256 * i, r = c >> 3, kc = (c & 7) * 8; rv[i] = *(const u32x4*)(Vt + (size_t)r * nk + kc); }
#pragma unroll
  for (int i = 0; i < NKC; ++i) { int c = tid + 256 * i, r = c / KCH, kc = (c % KCH) * 8; *(u32x4*)(Ks + r * KST + kc) = rk[i]; }
#pragma unroll
  for (int i = 0; i < 2; ++i) { int c = tid + 256 * i, r = c >> 3, kc = (c & 7) * 8; *(u32x4*)(Vs + r * 72 + kc) = rv[i]; }
  __syncthreads();
  for (int t = 0; t < nt; ++t) {
    const int buf = t & 1;
    const bool more = (t + 1 < nt);
    if (more) {
      const int kt = (t + 1) * 64;
#pragma unroll
      for (int i = 0; i < NKC; ++i) { int c = tid + 256 * i, r = c / KCH, kc = (c % KCH) * 8; rk[i] = *(const u32x4*)(Kg + (size_t)(kt + r) * ldk + kc); }
#pragma unroll
      for (int i = 0; i < 2; ++i) { int c = tid + 256 * i, r = c >> 3, kc = (c & 7) * 8; rv[i] = *(const u32x4*)(Vt + (size_t)r * nk + kt + kc); }
    }
    const u16* ks = Ks + buf * 64 * KST + l32 * KST + kcol + hh * 8;
    const u16* vs = Vs + buf * 64 * 72 + l32 * 72 + hh * 8;
    f32x16 sa[2];
#pragma unroll
    for (int kb = 0; kb < 2; ++kb) {
#pragma unroll
      for (int r = 0; r < 16; ++r) sa[kb][r] = 0.f;
#pragma unroll
      for (int s2 = 0; s2 < KS; ++s2) {
        bf16x8 kf = *(const bf16x8*)(ks + kb * 32 * KST + s2 * 16);
        sa[kb] = MFMA32(kf, qf[s2], sa[kb]);
      }
      __builtin_amdgcn_sched_barrier(0);
    }
    float mx = sa[0][0];
#pragma unroll
    for (int r = 1; r < 16; ++r) mx = fmaxf(mx, sa[0][r]);
#pragma unroll
    for (int r = 0; r < 16; ++r) mx = fmaxf(mx, sa[1][r]);
    mx = fmaxf(mx, __shfl_xor(mx, 32));
    const float mn = fmaxf(m, mx);
    const float alpha = fexp2(m - mn);
    m = mn;
    float ps = 0.f;
#pragma unroll
    for (int kb = 0; kb < 2; ++kb)
#pragma unroll
      for (int r = 0; r < 16; ++r) { float e = fexp2(sa[kb][r] - mn); sa[kb][r] = e; ps += e; }
    lsum = lsum * alpha + ps;
#pragma unroll
    for (int db = 0; db < 2; ++db)
#pragma unroll
      for (int r = 0; r < 16; ++r) o[db][r] *= alpha;
#pragma unroll
    for (int s2 = 0; s2 < 4; ++s2) {
      const int kb = s2 >> 1, rb = 8 * (s2 & 1);
      f32x4 p0 = {sa[kb][rb], sa[kb][rb + 1], sa[kb][rb + 2], sa[kb][rb + 3]};
      f32x4 p1 = {sa[kb][rb + 4], sa[kb][rb + 5], sa[kb][rb + 6], sa[kb][rb + 7]};
      bf16x8 pf = pack8(p0, p1);
      bf16x8 v0 = *(const bf16x8*)(vs + s2 * 16);
      bf16x8 v1 = *(const bf16x8*)(vs + 32 * 72 + s2 * 16);
      o[0] = MFMA32(v0, pf, o[0]);
      o[1] = MFMA32(v1, pf, o[1]);
    }
    if (more) {
      const int nb = buf ^ 1;
#pragma unroll
      for (int i = 0; i < NKC; ++i) { int c = tid + 256 * i, r = c / KCH, kc = (c % KCH) * 8; *(u32x4*)(Ks + nb * 64 * KST + r * KST + kc) = rk[i]; }
#pragma unroll
      for (int i = 0; i < 2; ++i) { int c = tid + 256 * i, r = c >> 3, kc = (c & 7) * 8; *(u32x4*)(Vs + nb * 64 * 72 + r * 72 + kc) = rv[i]; }
    }
    __syncthreads();
  }
  lsum += __shfl_xor(lsum, 32);
}

DI void store_o(u16* dst  , const f32x16 (&o)[2], float scale, int hh) {
#pragma unroll
  for (int db = 0; db < 2; ++db)
#pragma unroll
    for (int j = 0; j < 4; ++j) {
      const int dv = db * 32 + 8 * j + 4 * hh;
      f32x4 v = {o[db][4 * j] * scale, o[db][4 * j + 1] * scale, o[db][4 * j + 2] * scale, o[db][4 * j + 3] * scale};
      *(u32x2*)(dst + dv) = pack4(v);
    }
}

DI void attn_item(const P& p, int layer, int item, char* smem, int tid) {
  const int lane = tid & 63, wave = tid >> 6, l32 = lane & 31, hh = lane >> 5;
  bool lat; int kind, b, hd, qblk;
  if (item < 512) {
    lat = true;
    if (item < 256) { kind = 0; b = item >> 6; hd = (item >> 4) & 3; qblk = item & 15; }
    else { int it = item - 256; kind = 1 + (it >> 7); it &= 127; b = it >> 5; hd = (it >> 3) & 3; qblk = it & 7; }
  } else {
    lat = false;
    int it = item - 512;
    if (it < 512) { kind = 0; b = it >> 4; hd = (it >> 2) & 3; qblk = it & 3; }
    else { it -= 512; kind = 1 + (it >> 8); it &= 255; b = it >> 3; hd = (it >> 1) & 3; qblk = it & 1; }
  }
  const int nk = lat ? 1536 : 256;
  const int b_all = lat ? 32 + b : b;
  const int keyrow0 = lat ? NCTX + b * 1536 : b * 256;
  const int tok0 = lat ? NCTX + b * 1024 : b * 256;
  f32x16 o[2]; float ls;
  if (kind == 0) {
    const int ns = wave & 1, qb = wave >> 1;
    const int q0 = tok0 + qblk * 64 + qb * 32;
    const u16* Q = (const u16*)(p.ws + OFF_DQ) + (size_t)(q0 + l32) * 256 + hd * 64 + ns * 32 + hh * 8;
    bf16x8 qf[2];
    qf[0] = *(const bf16x8*)Q; qf[1] = *(const bf16x8*)(Q + 16);
    attn_block<64, 32>((const u16*)(p.ws + OFF_DKB) + (size_t)keyrow0 * 256 + hd * 64, 256, (const u16*)(p.ws + OFF_DVT) + vt_off(b_all, hd, 4), nk, qf, ns * 32,
                       smem, tid, o, ls);
    float d1 = 0.f, d2 = 0.f;
    if (lane < 32) { d1 = p.in[I_LQ1][layer * 32 + lane] * p.in[I_LK1][layer * 32 + lane]; d2 = p.in[I_LQ2][layer * 32 + lane] * p.in[I_LK2][layer * 32 + lane]; }
    d1 = wave_sum(d1); d2 = wave_sum(d2);
    const float lam_init = layer == 0 ? 0.2f : (0.8f - 0.6f * 0.7408182206817179f);
    const float lam = expf(d1) - expf(d2) + lam_init;
    float* cmb = (float*)smem + qb * (64 * 33);
    if (ns == 1) {
      const float sc = lam / ls;
#pragma unroll
      for (int db = 0; db < 2; ++db)
#pragma unroll
        for (int r = 0; r < 16; ++r) cmb[(db * 32 + crow(r, hh)) * 33 + l32] = o[db][r] * sc;
    }
    __syncthreads();
    if (ns == 0) {
      const float i0 = 1.f / ls;
      float ss = 0.f;
#pragma unroll
      for (int db = 0; db < 2; ++db)
#pragma unroll
        for (int r = 0; r < 16; ++r) { float d = o[db][r] * i0 - cmb[(db * 32 + crow(r, hh)) * 33 + l32]; o[db][r] = d; ss += d * d; }
      ss += __shfl_xor(ss, 32);
      const float rr = rsqrtf(ss * (1.f / 64.f) + EPSF) * (1.f - lam_init);
      u16* dst = (u16*)(p.ws + OFF_MIXED) + (size_t)(q0 + l32) * 1024 + hd * 64;
#pragma unroll
      for (int db = 0; db < 2; ++db)
#pragma unroll
        for (int j = 0; j < 4; ++j) {
          const int dv = db * 32 + 8 * j + 4 * hh;
          f32x4 g = *(const f32x4*)(p.in[I_SUBLN] + layer * 64 + dv);
          f32x4 v = {o[db][4 * j] * rr * g[0], o[db][4 * j + 1] * rr * g[1], o[db][4 * j + 2] * rr * g[2], o[db][4 * j + 3] * rr * g[3]};
          *(u32x2*)(dst + dv) = pack4(v);
        }
    }
    __syncthreads();
  } else if (kind == 1) {
    const int q0 = tok0 + qblk * 128 + wave * 32;
    const u16* Q = (const u16*)(p.ws + OFF_GQ) + (size_t)(q0 + l32) * 256 + hd * 64 + hh * 8;
    bf16x8 qf[4];
#pragma unroll
    for (int s2 = 0; s2 < 4; ++s2) qf[s2] = *(const bf16x8*)(Q + s2 * 16);
    attn_block<64, 64>((const u16*)(p.ws + OFF_GKB) + (size_t)keyrow0 * 128 + (hd >> 1) * 64, 128, (const u16*)(p.ws + OFF_GVT) + vt_off(b_all, hd >> 1, 2), nk, qf, 0,
                       smem, tid, o, ls);
    store_o((u16*)(p.ws + OFF_MIXED) + (size_t)(q0 + l32) * 1024 + 256 + hd * 64, o, 1.f / ls, hh);
  } else {
    const int q0 = tok0 + qblk * 128 + wave * 32;
    const u16* Q = (const u16*)(p.ws + OFF_MQ) + (size_t)(q0 + l32) * 384 + hd * 96 + hh * 8;
    bf16x8 qf[6];
#pragma unroll
    for (int s2 = 0; s2 < 6; ++s2) qf[s2] = *(const bf16x8*)(Q + s2 * 16);
    attn_block<96, 96>((const u16*)(p.ws + OFF_MKB) + (size_t)keyrow0 * 384 + hd * 96, 384, (const u16*)(p.ws + OFF_MVT) + vt_off(b_all, hd, 4), nk, qf, 0,
                       smem, tid, o, ls);
    store_o((u16*)(p.ws + OFF_MIXED) + (size_t)(q0 + l32) * 1024 + 768 + hd * 64, o, 1.f / ls, hh);
  }
}

DI void phase_at(const P& p, int layer, char* smem) {
  const int tid = get_tid();
  constexpr int N_ITEMS = 1536;
  if (gridDim.x == 512) {
    const int b = blockIdx.x;
    attn_item(p, layer, b, smem, tid);
    __syncthreads();
    if (b < 256) {
      attn_item(p, layer, 512 + b, smem, tid); __syncthreads();
      attn_item(p, layer, 1024 + b, smem, tid); __syncthreads();
      attn_item(p, layer, 1280 + b, smem, tid); __syncthreads();
    } else if (b < 384) {
      attn_item(p, layer, 512 + 256 + 2 * (b - 256), smem, tid); __syncthreads();
      attn_item(p, layer, 512 + 256 + 2 * (b - 256) + 1, smem, tid); __syncthreads();
    }
  } else {
    for (int item = blockIdx.x; item < N_ITEMS; item += gridDim.x) {
      attn_item(p, layer, item, smem, tid);
      __syncthreads();
    }
  }
}

#define XB_TMO      128
#define XB_XCNT(j)  (256  + 64 * (j))
#define XB_XSUB(j)  (1280 + 64 * (j))
#define XB_XGEN(j)  (2304 + 64 * (j))
#define XB_TOP      3328
#define XB_TOPGEN   3392
#define XCD_BAR_WORDS 3456
#define XB_SPIN_CAP (1u << 22)
#define LAS __attribute__((address_space(3)))
DI unsigned xb_ld(unsigned* p) { return __hip_atomic_load(p, __ATOMIC_RELAXED, __HIP_MEMORY_SCOPE_AGENT); }
DI unsigned xb_add(unsigned* p, unsigned v) { return __hip_atomic_fetch_add(p, v, __ATOMIC_RELAXED, __HIP_MEMORY_SCOPE_AGENT); }
DI unsigned xb_xcc_id() { return (unsigned)__builtin_amdgcn_s_getreg((3 << 11) | 20) & 0xFu; }
#define XB_SPIN(cond, bar) do { unsigned _sp = 0; while (cond) { __builtin_amdgcn_s_sleep(1); \
    if ((++_sp & 255u) == 0u) { if (xb_ld(&(bar)[XB_TMO])) break; if (_sp > XB_SPIN_CAP) { atomicAdd(&(bar)[XB_TMO], 1u); break; } } } } while (0)
struct XcdBarrier { unsigned* bar; unsigned x; volatile LAS unsigned* st; };
DI XcdBarrier xcd_barrier_post(unsigned* bar, volatile LAS unsigned* st) {
  XcdBarrier b; b.bar = bar; b.x = xb_xcc_id(); b.st = st;
  if (threadIdx.x == 0) (void)xb_add(&bar[XB_XCNT(b.x)], 1u);
  return b;
}
DI void xcd_barrier_complete(unsigned* bar, unsigned x, unsigned& nloc, unsigned& nx) {
  const unsigned G = gridDim.x * gridDim.y * gridDim.z;
  unsigned sum, cnt, mine, sp = 0u;
  for (;;) {
    sum = 0u; cnt = 0u; mine = 0u;
#pragma unroll
    for (unsigned j = 0; j < 16; ++j) { const unsigned c = xb_ld(&bar[XB_XCNT(j)]); sum += c; cnt += (c > 0u) ? 1u : 0u; mine = (j == x) ? c : mine; }
    if (sum == G) break;
    __builtin_amdgcn_s_sleep(1);
    if ((++sp & 255u) == 0u) { if (xb_ld(&bar[XB_TMO])) break; if (sp > XB_SPIN_CAP) { atomicAdd(&bar[XB_TMO], 1u); break; } }
  }
  nloc = mine > 0u ? mine : 1u; nx = cnt > 0u ? cnt : 1u;
}
DI void xcd_barrier(const XcdBarrier& b) {
  asm volatile("s_waitcnt vmcnt(0)" ::: "memory");
  __syncthreads();
  if (threadIdx.x == 0) {
    unsigned* bar = b.bar;
    __builtin_amdgcn_s_waitcnt(0);
    unsigned nloc = b.st[0], nx = b.st[1];
    if (nloc == 0u) { xcd_barrier_complete(bar, b.x, nloc, nx); b.st[0] = nloc; b.st[1] = nx; }
    const unsigned old = xb_add(&bar[XB_XSUB(b.x)], 1u);
    const unsigned gen = old / nloc;
    if (old + 1u == (gen + 1u) * nloc) {
      __builtin_amdgcn_fence(__ATOMIC_RELEASE, "agent");
      asm volatile("s_waitcnt vmcnt(0)" ::: "memory");
      const unsigned og = xb_add(&bar[XB_TOP], 1u);
      const unsigned tg = og / nx;
      if (og + 1u == (tg + 1u) * nx) xb_add(&bar[XB_TOPGEN], 1u);
      else XB_SPIN(xb_ld(&bar[XB_TOPGEN]) == tg, bar);
      __builtin_amdgcn_fence(__ATOMIC_ACQUIRE, "agent");
      xb_add(&bar[XB_XGEN(b.x)], 1u);
      asm volatile("s_waitcnt vmcnt(0)" ::: "memory");
    } else {
      XB_SPIN(xb_ld(&bar[XB_XGEN(b.x)]) == gen, bar);
      __builtin_amdgcn_fence(__ATOMIC_ACQUIRE, "agent");
      asm volatile("s_waitcnt vmcnt(0)" ::: "memory");
    }
  }
  __syncthreads();
}

DI void run_phase(const P& p, int ph, int layer, char* smem) {
  switch (ph) {
    case 0: prologue(p, smem); break;
    case 1: norm_phase(p, layer, 0); break;
    case 2: phase_g1(p, layer, smem); break;
    case 3: phase_pp(p, layer, smem); break;
    case 4: phase_g2(p, layer, smem); break;
    case 5: phase_at(p, layer, smem); break;
    case 6: phase_resid(p, layer, smem, true); break;
    case 7: norm_phase(p, layer, 1); break;
    case 8: phase_g5(p, layer, smem); break;
    case 9: phase_resid(p, layer, smem, false); break;
    case 10: norm_phase(p, 0, 2); break;
  }
}

extern __shared__ __attribute__((aligned(16))) char dyn_smem[];

__global__ void __launch_bounds__(256, 2) fwd_mega(P p) {
  if (p.ws == nullptr) { cg::grid_group grid = cg::this_grid(); grid.sync(); }
  volatile LAS unsigned* st = (volatile LAS unsigned*)(dyn_smem + LDS_BYTES);
  if (threadIdx.x == 0) { st[0] = 0u; st[1] = 0u; st[2] = 0u; st[3] = 0u; }
  __syncthreads();
  XcdBarrier xb = xcd_barrier_post((unsigned*)(p.ws + OFF_BAR), st);
  run_phase(p, 0, 0, dyn_smem);
  xcd_barrier(xb);
  for (int l = 0; l < 2; ++l) {
    for (int ph = 1; ph <= 9; ++ph) {
      run_phase(p, ph, l, dyn_smem);
      xcd_barrier(xb);
    }
  }
  run_phase(p, 10, 0, dyn_smem);
}

#if !MEGA
__global__ void __launch_bounds__(256, 2) fwd_phase(P p, int ph, int layer) { run_phase(p, ph, layer, dyn_smem); }
#endif

extern "C" void kernel_launch(void* const* d_in, const int* in_sizes, int n_in, void* d_out, int out_size, void* d_ws, size_t ws_size,
                              hipStream_t stream) {
  static int grid_blocks = 0;
  if (!grid_blocks) {
    int dev = 0, cus = 0, per_cu = 0;
    (void)hipGetDevice(&dev);
    (void)hipDeviceGetAttribute(&cus, hipDeviceAttributeMultiprocessorCount, dev);
    (void)hipFuncSetAttribute((const void*)fwd_mega, hipFuncAttributeMaxDynamicSharedMemorySize, LDS_BYTES + 16);
#if !MEGA
    (void)hipFuncSetAttribute((const void*)fwd_phase, hipFuncAttributeMaxDynamicSharedMemorySize, LDS_BYTES);
#endif
    (void)hipOccupancyMaxActiveBlocksPerMultiprocessor(&per_cu, (const void*)fwd_mega, 256, LDS_BYTES + 16);
    if (per_cu < 1) per_cu = 1;
    if (per_cu > 2) per_cu = 2;
    grid_blocks = cus * per_cu;
    if (ws_size < WS_NEED) fprintf(stderr, "kernel_launch: workspace too small: %zu < %zu\n", ws_size, (size_t)WS_NEED);
  }
  P p{};
  for (int i = 0; i < N_IN; ++i) p.in[i] = (const float*)d_in[i];
  p.out = (float*)d_out;
  p.ws = (char*)d_ws;
#if MEGA
  (void)hipMemsetAsync((char*)d_ws + OFF_BAR, 0, XCD_BAR_WORDS * 4, stream);
  void* args[] = {&p};
  hipError_t e = hipLaunchCooperativeKernel((const void*)fwd_mega, dim3(grid_blocks), dim3(256), args, LDS_BYTES + 16, stream);
  if (e != hipSuccess) fprintf(stderr, "cooperative launch failed: %s (grid %d)\n", hipGetErrorString(e), grid_blocks);
#else
  hipLaunchKernelGGL(fwd_phase, dim3(grid_blocks), dim3(256), LDS_BYTES, stream, p, 0, 0);
  for (int l = 0; l < 2; ++l)
    for (int ph = 1; ph <= 9; ++ph) hipLaunchKernelGGL(fwd_phase, dim3(grid_blocks), dim3(256), LDS_BYTES, stream, p, ph, l);
  hipLaunchKernelGGL(fwd_phase, dim3(grid_blocks), dim3(256), LDS_BYTES, stream, p, 10, 0);
#endif
}
```

```cpp
#include <hip/hip_runtime.h>
#include <hip/hip_cooperative_groups.h>
#include <cstdio>
namespace cg = cooperative_groups;

#ifndef MEGA
#define MEGA 1
#endif

#define DI __device__ __forceinline__
typedef unsigned short u16;
typedef __attribute__((ext_vector_type(8))) short bf16x8;
typedef __attribute__((ext_vector_type(4))) short bf16x4;
typedef __attribute__((ext_vector_type(2))) __bf16 bf2_t;
typedef __attribute__((ext_vector_type(2))) float f32x2;
typedef __attribute__((ext_vector_type(4))) float f32x4;
typedef __attribute__((ext_vector_type(16))) float f32x16;
typedef __attribute__((ext_vector_type(4))) unsigned u32x4;
typedef __attribute__((ext_vector_type(2))) unsigned u32x2;

#define MFMA32(a, b, c) __builtin_amdgcn_mfma_f32_32x32x16_bf16((a), (b), (c), 0, 0, 0)
#define MFMA16(a, b, c) __builtin_amdgcn_mfma_f32_16x16x32_bf16((a), (b), (c), 0, 0, 0)

constexpr int NT = 12288;
constexpr int NCTX = 8192;
constexpr int NKR = 14336;
constexpr int NP = 1920;
constexpr float EPSF = 1e-6f;
constexpr float LOG2E = 1.4426950408889634f;

enum { I_XP = 0, I_XS, I_CDK, I_CDV, I_CGK, I_CGV, I_CCKV, I_CKR, I_SRE, I_SIM, I_C, I_CCTX, I_N1G, I_N2G, I_WADA, I_BADA,
       I_WIN, I_WOUT, I_LQ1, I_LK1, I_LQ2, I_LK2, I_SUBLN, I_QNG, I_KNG, I_ARE, I_AIM, I_LOGDT, I_BRE, I_BIM, I_CRE, I_CIM,
       I_SSMD, I_WGLU, I_MQNG, I_MKVNG, I_WUQ, I_WUKV, I_W1, I_W2, I_FNG, N_IN };

constexpr size_t O_Y = 0;
constexpr size_t O_DK = 12582912;
constexpr size_t O_DV = 16777216;
constexpr size_t O_GK = 20971520;
constexpr size_t O_GV = 23068672;
constexpr size_t O_CKV = 25165824;
constexpr size_t O_KR = 27262976;
constexpr size_t O_SRE = 27787264;
constexpr size_t O_SIM = 27918336;

constexpr size_t al256(size_t x) { return (x + 255) & ~(size_t)255; }
constexpr size_t OFF_MOD = 0;
constexpr size_t OFF_CTR = al256(OFF_MOD + 2 * 5 * 6144 * 4);
constexpr size_t OFF_BAR = al256(OFF_CTR + 256);
constexpr size_t OFF_ROPE = al256(OFF_BAR + 3456 * 4);
constexpr size_t OFF_ABAR = al256(OFF_ROPE + 2 * 64 * 16 * 8);
constexpr size_t OFF_ATAB = al256(OFF_ABAR + 64 * 64 * 8);
constexpr size_t OFF_CTAB = al256(OFF_ATAB + 64 * 128 * 16 * 2);
constexpr size_t OFF_WIN = al256(OFF_CTAB + 64 * 16 * 128 * 2);
constexpr size_t OFF_WOUT = al256(OFF_WIN + (size_t)2 * 1920 * 1024 * 2);
constexpr size_t OFF_W1 = al256(OFF_WOUT + (size_t)2 * 1024 * 1024 * 2);
constexpr size_t OFF_W2 = al256(OFF_W1 + (size_t)2 * 4096 * 1024 * 2);
constexpr size_t OFF_WUQ = al256(OFF_W2 + (size_t)2 * 4096 * 1024 * 2);
constexpr size_t OFF_WUKV = al256(OFF_WUQ + (size_t)2 * 384 * 192 * 2);
constexpr size_t OFF_WGLU = al256(OFF_WUKV + (size_t)2 * 512 * 128 * 2);
constexpr size_t OFF_H = al256(OFF_WGLU + (size_t)2 * 512 * 256 * 2);
constexpr size_t OFF_MIXED = OFF_H;
constexpr size_t OFF_BIG = al256(OFF_H + (size_t)NT * 1024 * 2);
constexpr size_t OFF_PROJ = OFF_BIG;
constexpr size_t OFF_DQ = al256(OFF_PROJ + (size_t)NT * NP * 4);
constexpr size_t OFF_DKB = al256(OFF_DQ + (size_t)NT * 256 * 2);
constexpr size_t OFF_DVT = al256(OFF_DKB + (size_t)NKR * 256 * 2);
constexpr size_t OFF_GQ = al256(OFF_DVT + (size_t)NKR * 256 * 2);
constexpr size_t OFF_GKB = al256(OFF_GQ + (size_t)NT * 256 * 2);
constexpr size_t OFF_GVT = al256(OFF_GKB + (size_t)NKR * 128 * 2);
constexpr size_t OFF_MQ = al256(OFF_GVT + (size_t)NKR * 128 * 2);
constexpr size_t OFF_MKB = al256(OFF_MQ + (size_t)NT * 384 * 2);
constexpr size_t OFF_MVT = al256(OFF_MKB + (size_t)NKR * 384 * 2);
constexpr size_t OFF_CQN = al256(OFF_MVT + (size_t)NKR * 256 * 2);
constexpr size_t OFF_CKVN = al256(OFF_CQN + (size_t)NT * 192 * 2);
constexpr size_t OFF_YBUF = al256(OFF_CKVN + (size_t)NKR * 128 * 2);
constexpr size_t OFF_END1 = al256(OFF_YBUF + (size_t)2 * NT * 256 * 4);
constexpr size_t OFF_A = OFF_BIG;
constexpr size_t OFF_END2 = al256(OFF_A + (size_t)NT * 4096 * 2);
constexpr size_t WS_NEED = OFF_END1 > OFF_END2 ? OFF_END1 : OFF_END2;
static_assert(WS_NEED <= (size_t)256 * 1024 * 1024, "workspace over 256 MiB");

constexpr int LDS_BYTES = 2 * 2 * 128 * 72 * 2;

struct P {
  const float* in[N_IN];
  float* out;
  char* ws;
};

DI unsigned pack2(float a, float b) { f32x2 v = {a, b}; return __builtin_bit_cast(unsigned, __builtin_convertvector(v, bf2_t)); }
DI u16 f2bf(float a) { return (u16)(pack2(a, 0.f) & 0xffffu); }
DI bf16x8 pack8(f32x4 a, f32x4 b) {
  u32x4 r = {pack2(a[0], a[1]), pack2(a[2], a[3]), pack2(b[0], b[1]), pack2(b[2], b[3])};
  return __builtin_bit_cast(bf16x8, r);
}
DI u32x2 pack4(f32x4 a) { u32x2 r = {pack2(a[0], a[1]), pack2(a[2], a[3])}; return r; }
DI int get_tid() { int t = threadIdx.x; asm volatile("" : "+v"(t)); return t; }
DI float fexp2(float x) { return __builtin_amdgcn_exp2f(x); }
DI float frcp(float x) { return __builtin_amdgcn_rcpf(x); }
DI float fsigmoid(float w) { return frcp(1.f + fexp2(-w * LOG2E)); }
DI float gelu_tanh(float x) { return x * fsigmoid(1.5957691216057308f * (x + 0.044715f * x * x * x)); }
DI float wave_sum(float v) {
#pragma unroll
  for (int o = 32; o >= 1; o >>= 1) v += __shfl_xor(v, o);
  return v;
}
DI void wave_lds_fence() {
  asm volatile("s_waitcnt lgkmcnt(0)" ::: "memory");
  __builtin_amdgcn_wave_barrier();
}
DI int fetch_item(int* ctr, int lane) {
  int v = 0;
  if (lane == 0) v = atomicAdd(ctr, 1);
  return __builtin_amdgcn_readfirstlane(v);
}
DI size_t vt_off(int b_all, int head, int H) {
  if (b_all < 32) return ((size_t)(b_all * H + head) * 64) * 256;
  return (size_t)32 * H * 64 * 256 + ((size_t)((b_all - 32) * H + head) * 64) * 1536;
}
DI int mod_index(int row) { return row < NCTX ? 0 : 1 + ((row - NCTX) >> 10); }

DI void transpose_tile(const float* __restrict__ src, u16* __restrict__ dst, int K, int N, int k0, int n0, bool glu, float* t) {
  const int tid = get_tid();
  const int tx = tid & 15, ty = tid >> 4;
#pragma unroll
  for (int i = 0; i < 4; ++i) {
    int kk = ty + 16 * i;
    int n = n0 + 4 * tx;
    f32x4 v = {0.f, 0.f, 0.f, 0.f};
    if (n < N) v = *(const f32x4*)(src + (size_t)(k0 + kk) * N + n);
    t[kk * 65 + 4 * tx + 0] = v[0];
    t[kk * 65 + 4 * tx + 1] = v[1];
    t[kk * 65 + 4 * tx + 2] = v[2];
    t[kk * 65 + 4 * tx + 3] = v[3];
  }
  __syncthreads();
#pragma unroll
  for (int i = 0; i < 2; ++i) {
    int c = tid + 256 * i;
    int nn = c >> 3, kc = (c & 7) * 8;
    f32x4 a, b;
#pragma unroll
    for (int e = 0; e < 4; ++e) { a[e] = t[(kc + e) * 65 + nn]; b[e] = t[(kc + 4 + e) * 65 + nn]; }
    int n = n0 + nn;
    int drow = n;
    if (glu) { drow = (n < 256) ? ((n >> 5) * 64 + (n & 31)) : (((n - 256) >> 5) * 64 + 32 + (n & 31)); }
    *(bf16x8*)(dst + (size_t)drow * K + k0 + kc) = pack8(a, b);
  }
  __syncthreads();
}

DI void prologue(const P& p, char* smem) {
  const int tid = get_tid();
  float* fs = (float*)smem;
  constexpr int N_ADA = 384, N_TAB = 64, N_MISC = 1, N_TR = 5700;
  constexpr int TOTAL = N_ADA + N_TAB + N_MISC;
  for (int it = blockIdx.x; it < TOTAL; it += gridDim.x) {
    if (it < N_ADA) {
      const int l = it / 192, ch = it % 192;
      float* sc = fs;
      float* red = fs + 5 * 1024;
      for (int i = tid; i < 5 * 1024; i += 256) {
        int m = i >> 10, k = i & 1023;
        float c = (m == 0) ? p.in[I_CCTX][k] : p.in[I_C][(m - 1) * 1024 + k];
        sc[i] = c * fsigmoid(c);
      }
      __syncthreads();
      const int col = tid & 31, kg = tid >> 5;
      const float* w = p.in[I_WADA] + ((size_t)l * 1024 + kg * 128) * 6144 + ch * 32 + col;
      float a0 = 0, a1 = 0, a2 = 0, a3 = 0, a4 = 0;
#pragma unroll 16
      for (int k = 0; k < 128; ++k) {
        float wv = w[(size_t)k * 6144];
        int kk = kg * 128 + k;
        a0 += sc[kk] * wv; a1 += sc[1024 + kk] * wv; a2 += sc[2048 + kk] * wv; a3 += sc[3072 + kk] * wv; a4 += sc[4096 + kk] * wv;
      }
      red[(kg * 5 + 0) * 32 + col] = a0; red[(kg * 5 + 1) * 32 + col] = a1; red[(kg * 5 + 2) * 32 + col] = a2;
      red[(kg * 5 + 3) * 32 + col] = a3; red[(kg * 5 + 4) * 32 + col] = a4;
      __syncthreads();
      if (tid < 160) {
        int m = tid >> 5, c2 = tid & 31;
        float s = 0;
#pragma unroll
        for (int g = 0; g < 8; ++g) s += red[(g * 5 + m) * 32 + c2];
        int n = ch * 32 + c2;
        s += p.in[I_BADA][l * 6144 + n];
        ((float*)(p.ws + OFF_MOD))[((size_t)l * 5 + m) * 6144 + n] = s;
      }
      __syncthreads();
    } else if (it < N_ADA + N_TAB) {
      const int idx = it - N_ADA;
      if (tid < 64) {
        const int pp = tid;
        float are = p.in[I_ARE][idx * 64 + pp], aim = p.in[I_AIM][idx * 64 + pp];
        float dt = expf(p.in[I_LOGDT][idx]);
        float zr = are * dt, zi = aim * dt;
        float e = expf(zr);
        float abr = e * cosf(zi), abi = e * sinf(zi);
        float d2 = are * are + aim * aim;
        float nr = abr - 1.f, ni = abi;
        float qr = (nr * are + ni * aim) / d2, qi = (ni * are - nr * aim) / d2;
        u16* at = (u16*)(p.ws + OFF_ATAB) + (size_t)idx * 128 * 16;
        u16* ct = (u16*)(p.ws + OFF_CTAB) + (size_t)idx * 16 * 128;
        for (int c = 0; c < 16; ++c) {
          float bre = p.in[I_BRE][((size_t)idx * 64 + pp) * 16 + c], bim = p.in[I_BIM][((size_t)idx * 64 + pp) * 16 + c];
          at[(2 * pp) * 16 + c] = f2bf(qr * bre - qi * bim);
          at[(2 * pp + 1) * 16 + c] = f2bf(qr * bim + qi * bre);
          float cre = p.in[I_CRE][((size_t)idx * 16 + c) * 64 + pp], cim = p.in[I_CIM][((size_t)idx * 16 + c) * 64 + pp];
          ct[c * 128 + 2 * pp] = f2bf(cre);
          ct[c * 128 + 2 * pp + 1] = f2bf(-cim);
        }
        float* ab = (float*)(p.ws + OFF_ABAR) + ((size_t)idx * 64 + pp) * 2;
        ab[0] = abr; ab[1] = abi;
      }
    } else if (it < N_ADA + N_TAB + N_MISC) {
      f32x2* tab = (f32x2*)(p.ws + OFF_ROPE);
      for (int i = tid; i < 2 * 64 * 16; i += 256) {
        int kind = i >> 10, pos = (i >> 4) & 63, fi = i & 15;
        int n = kind ? 16 : 8;
        float freq = expf(-(float)(fi % n) / (float)n * 9.210340371976184f);
        float ang = (float)pos * freq;
        f32x2 cs = {cosf(ang), sinf(ang)};
        tab[i] = cs;
      }
      if (tid < 64) ((int*)(p.ws + OFF_CTR))[tid] = 0;
    }
  }
  struct TrD { const float* src; u16* dst; int K, N, k0, n0; bool glu; };
  auto decode = [&](int tt) {
    TrD d; d.glu = false;
    const int l = tt / 2850;
    int r = tt % 2850; int kt, nt;
    if (r < 480) { d.src = p.in[I_WIN] + (size_t)l * 1024 * 1888; d.dst = (u16*)(p.ws + OFF_WIN) + (size_t)l * 1920 * 1024; d.K = 1024; d.N = 1888; kt = r / 30; nt = r % 30; }
    else if (r < 736) { r -= 480; d.src = p.in[I_WOUT] + (size_t)l * 1024 * 1024; d.dst = (u16*)(p.ws + OFF_WOUT) + (size_t)l * 1024 * 1024; d.K = 1024; d.N = 1024; kt = r / 16; nt = r % 16; }
    else if (r < 1760) { r -= 736; d.src = p.in[I_W1] + (size_t)l * 1024 * 4096; d.dst = (u16*)(p.ws + OFF_W1) + (size_t)l * 4096 * 1024; d.K = 1024; d.N = 4096; kt = r / 64; nt = r % 64; }
    else if (r < 2784) { r -= 1760; d.src = p.in[I_W2] + (size_t)l * 4096 * 1024; d.dst = (u16*)(p.ws + OFF_W2) + (size_t)l * 1024 * 4096; d.K = 4096; d.N = 1024; kt = r / 16; nt = r % 16; }
    else if (r < 2802) { r -= 2784; d.src = p.in[I_WUQ] + (size_t)l * 192 * 384; d.dst = (u16*)(p.ws + OFF_WUQ) + (size_t)l * 384 * 192; d.K = 192; d.N = 384; kt = r / 6; nt = r % 6; }
    else if (r < 2818) { r -= 2802; d.src = p.in[I_WUKV] + (size_t)l * 128 * 512; d.dst = (u16*)(p.ws + OFF_WUKV) + (size_t)l * 512 * 128; d.K = 128; d.N = 512; kt = r / 8; nt = r % 8; }
    else { r -= 2818; d.src = p.in[I_WGLU] + (size_t)l * 256 * 512; d.dst = (u16*)(p.ws + OFF_WGLU) + (size_t)l * 512 * 256; d.K = 256; d.N = 512; kt = r / 8; nt = r % 8; d.glu = true; }
    d.k0 = kt * 64; d.n0 = nt * 64;
    return d;
  };
  const int tx = tid & 15, ty = tid >> 4;
  auto tload = [&](const TrD& d, f32x4 (&v)[4]) {
#pragma unroll
    for (int i = 0; i < 4; ++i) {
      const int kk = ty + 16 * i, n = d.n0 + 4 * tx;
      f32x4 z = {0.f, 0.f, 0.f, 0.f};
      v[i] = (n < d.N) ? *(const f32x4*)(d.src + (size_t)(d.k0 + kk) * d.N + n) : z;
    }
  };
  const int tb = (int)gridDim.x - 1 - (int)blockIdx.x;
  if (tb < N_TR) {
    TrD cur = decode(tb);
    f32x4 cv[4];
    tload(cur, cv);
    for (int tt = tb; tt < N_TR; tt += gridDim.x) {
      const bool more = tt + (int)gridDim.x < N_TR;
      TrD nxt = decode(more ? tt + (int)gridDim.x : tt);
      f32x4 nv[4];
      if (more) tload(nxt, nv);
#pragma unroll
      for (int i = 0; i < 4; ++i) {
        const int kk = ty + 16 * i;
        fs[kk * 65 + 4 * tx + 0] = cv[i][0]; fs[kk * 65 + 4 * tx + 1] = cv[i][1]; fs[kk * 65 + 4 * tx + 2] = cv[i][2]; fs[kk * 65 + 4 * tx + 3] = cv[i][3];
      }
      __syncthreads();
#pragma unroll
      for (int i = 0; i < 2; ++i) {
        const int c = tid + 256 * i, nn = c >> 3, kc = (c & 7) * 8;
        f32x4 a, b;
#pragma unroll
        for (int e = 0; e < 4; ++e) { a[e] = fs[(kc + e) * 65 + nn]; b[e] = fs[(kc + 4 + e) * 65 + nn]; }
        const int n = cur.n0 + nn;
        int drow = n;
        if (cur.glu) drow = (n < 256) ? ((n >> 5) * 64 + (n & 31)) : (((n - 256) >> 5) * 64 + 32 + (n & 31));
        *(bf16x8*)(cur.dst + (size_t)drow * cur.K + cur.k0 + kc) = pack8(a, b);
      }
      __syncthreads();
      cur = nxt;
      if (more) {
#pragma unroll
        for (int i = 0; i < 4; ++i) cv[i] = nv[i];
      }
    }
  }
}

DI const float* x_row_src(const P& p, int layer, int row) {
  if (layer == 0) return row < NCTX ? p.in[I_XP] + (size_t)row * 1024 : p.in[I_XS] + (size_t)(row - NCTX) * 1024;
  return p.out + (size_t)row * 1024;
}
DI void norm_phase(const P& p, int layer, int which) {
  const int tid_ = get_tid();
  const int lane = tid_ & 63;
  const int gw = blockIdx.x * 4 + (tid_ >> 6), nw = gridDim.x * 4;
  auto src_of = [&](int row) { return (which == 0) ? x_row_src(p, layer, row) : (const float*)(p.out + (size_t)row * 1024); };
  f32x4 v[4];
  if (gw < NT) {
    const float* xs = src_of(gw);
#pragma unroll
    for (int i = 0; i < 4; ++i) v[i] = *(const f32x4*)(xs + (i * 64 + lane) * 4);
  }
  for (int row = gw; row < NT; row += nw) {
    f32x4 nv[4];
    const bool more = row + nw < NT;
    if (more) {
      const float* xs = src_of(row + nw);
#pragma unroll
      for (int i = 0; i < 4; ++i) nv[i] = *(const f32x4*)(xs + (i * 64 + lane) * 4);
    }
    float ss = 0;
#pragma unroll
    for (int i = 0; i < 4; ++i) ss += v[i][0] * v[i][0] + v[i][1] * v[i][1] + v[i][2] * v[i][2] + v[i][3] * v[i][3];
    ss = wave_sum(ss);
    const float r = rsqrtf(ss * (1.f / 1024.f) + EPSF);
    if (which == 2) {
      f32x4 g[4];
#pragma unroll
      for (int i = 0; i < 4; ++i) g[i] = *(const f32x4*)(p.in[I_FNG] + (i * 64 + lane) * 4);
#pragma unroll
      for (int i = 0; i < 4; ++i) {
        int e = (i * 64 + lane) * 4;
        f32x4 o = v[i] * r * g[i];
        *(f32x4*)(p.out + (size_t)row * 1024 + e) = o;
      }
    } else {
      const float* gn = p.in[which == 0 ? I_N1G : I_N2G] + layer * 1024;
      const float* md = (const float*)(p.ws + OFF_MOD) + ((size_t)layer * 5 + mod_index(row)) * 6144 + (which == 0 ? 0 : 3072);
      u16* h = (u16*)(p.ws + OFF_H) + (size_t)row * 1024;
      f32x4 g[4], sh[4], sc[4];
#pragma unroll
      for (int i = 0; i < 4; ++i) {
        int e = (i * 64 + lane) * 4;
        g[i] = *(const f32x4*)(gn + e);
        sh[i] = *(const f32x4*)(md + e);
        sc[i] = *(const f32x4*)(md + 1024 + e);
      }
      if (which == 0 && layer == 0) {
#pragma unroll
        for (int i = 0; i < 4; ++i) *(f32x4*)(p.out + (size_t)row * 1024 + (i * 64 + lane) * 4) = v[i];
      }
#pragma unroll
      for (int i = 0; i < 4; ++i) {
        int e = (i * 64 + lane) * 4;
        f32x4 o = v[i] * r * g[i] * (1.f + sc[i]) + sh[i];
        *(u32x2*)(h + e) = pack4(o);
      }
    }
    if (more) {
#pragma unroll
      for (int i = 0; i < 4; ++i) v[i] = nv[i];
    }
  }
}

template <int AMODE>
DI u32x4 load_a(const P& p, int layer, const u16* A, int lda, int row, int k) {
  if (AMODE == 0) {
    return *(const u32x4*)(A + (size_t)row * lda + k);
  } else {
    const float* y0 = (const float*)(p.ws + OFF_YBUF) + (size_t)row * 256 + k;
    const float* y1 = y0 + (size_t)NT * 256;
    const float* u = (const float*)(p.ws + OFF_PROJ) + (size_t)row * NP + 1280 + k;
    const float* d = p.in[I_SSMD] + layer * 256 + k;
    f32x4 r0, r1;
#pragma unroll
    for (int hh = 0; hh < 2; ++hh) {
      f32x4 a = *(const f32x4*)(y0 + 4 * hh), b = *(const f32x4*)(y1 + 4 * hh), c = *(const f32x4*)(u + 4 * hh), dd = *(const f32x4*)(d + 4 * hh);
      f32x4 s = a + b + c * dd;
      f32x4 g = {gelu_tanh(s[0]), gelu_tanh(s[1]), gelu_tanh(s[2]), gelu_tanh(s[3])};
      if (hh == 0) r0 = g; else r1 = g;
    }
    return __builtin_bit_cast(u32x4, pack8(r0, r1));
  }
}

template <int AMODE>
DI void gemm_core(const P& p, int layer, const u16* __restrict__ A, int lda, const u16* __restrict__ Bt, int K, int m0, int n0, char* smem,
                  f32x16 (&acc)[2][2]) {
  const int tid = get_tid(), lane = tid & 63, wave = tid >> 6, wm = wave >> 1, wn = wave & 1, l32 = lane & 31, hh = lane >> 5;
  u16* As = (u16*)smem;
  u16* Bs = As + 2 * 128 * 72;
#pragma unroll
  for (int bi = 0; bi < 2; ++bi)
#pragma unroll
    for (int bj = 0; bj < 2; ++bj)
#pragma unroll
      for (int r = 0; r < 16; ++r) acc[bi][bj][r] = 0.f;
  u32x4 ra[4], rb[4];
  const int nk = K / 64;
#pragma unroll
  for (int i = 0; i < 4; ++i) {
    int c = tid + 256 * i, r = c >> 3, kc = (c & 7) * 8;
    ra[i] = load_a<AMODE>(p, layer, A, lda, m0 + r, kc);
    rb[i] = *(const u32x4*)(Bt + (size_t)(n0 + r) * K + kc);
  }
#pragma unroll
  for (int i = 0; i < 4; ++i) {
    int c = tid + 256 * i, r = c >> 3, kc = (c & 7) * 8;
    *(u32x4*)(As + r * 72 + kc) = ra[i];
    *(u32x4*)(Bs + r * 72 + kc) = rb[i];
  }
  __syncthreads();
  for (int kt = 0; kt < nk; ++kt) {
    const int buf = kt & 1;
    const bool more = (kt + 1 < nk);
    if (more) {
      const int k0 = (kt + 1) * 64;
#pragma unroll
      for (int i = 0; i < 4; ++i) {
        int c = tid + 256 * i, r = c >> 3, kc = (c & 7) * 8;
        ra[i] = load_a<AMODE>(p, layer, A, lda, m0 + r, k0 + kc);
        rb[i] = *(const u32x4*)(Bt + (size_t)(n0 + r) * K + k0 + kc);
      }
    }
    const u16* as = As + buf * 128 * 72 + (wm * 64 + l32) * 72 + hh * 8;
    const u16* bs = Bs + buf * 128 * 72 + (wn * 64 + l32) * 72 + hh * 8;
#pragma unroll
    for (int ks = 0; ks < 4; ++ks) {
      bf16x8 a0 = *(const bf16x8*)(as + ks * 16);
      bf16x8 a1 = *(const bf16x8*)(as + 32 * 72 + ks * 16);
      bf16x8 b0 = *(const bf16x8*)(bs + ks * 16);
      bf16x8 b1 = *(const bf16x8*)(bs + 32 * 72 + ks * 16);
      acc[0][0] = MFMA32(a0, b0, acc[0][0]);
      acc[0][1] = MFMA32(a0, b1, acc[0][1]);
      acc[1][0] = MFMA32(a1, b0, acc[1][0]);
      acc[1][1] = MFMA32(a1, b1, acc[1][1]);
    }
    if (more) {
      const int nb = buf ^ 1;
#pragma unroll
      for (int i = 0; i < 4; ++i) {
        int c = tid + 256 * i, r = c >> 3, kc = (c & 7) * 8;
        *(u32x4*)(As + nb * 128 * 72 + r * 72 + kc) = ra[i];
        *(u32x4*)(Bs + nb * 128 * 72 + r * 72 + kc) = rb[i];
      }
    }
    __syncthreads();
  }
}

#define LAS3 __attribute__((address_space(3)))
DI void stage_tile_dma(const u16* __restrict__ G, int ld, int row0, int k0, char* lds, int tid) {
#pragma unroll
  for (int i = 0; i < 4; ++i) {
    const int q = tid + 256 * i, r = q >> 3, c = (q & 7) ^ ((r >> 1) & 7);
    __builtin_amdgcn_global_load_lds((const unsigned*)(G + (size_t)(row0 + r) * ld + k0 + c * 8), (LAS3 unsigned*)(lds + q * 16), 16, 0, 0);
  }
}

struct TD { const u16* A; const u16* B; int lda, ldb, k0, nk, m0, n0; };
DI void stage_td(const TD& d, int kt, char* stage_base, int tid) {
  stage_tile_dma(d.A, d.lda, d.m0, d.k0 + kt * 64, stage_base, tid);
  stage_tile_dma(d.B, d.ldb, d.n0, d.k0 + kt * 64, stage_base + 16384, tid);
}
DI void gemm_stream(const TD& cur, bool has_next, const TD& nxt, char* smem, int& buf, f32x16 (&acc)[2][2]) {
  const int tid = get_tid(), lane = tid & 63, wave = tid >> 6, wm = wave >> 1, wn = wave & 1, l32 = lane & 31, hh = lane >> 5;
#pragma unroll
  for (int bi = 0; bi < 2; ++bi)
#pragma unroll
    for (int bj = 0; bj < 2; ++bj)
#pragma unroll
      for (int r = 0; r < 16; ++r) acc[bi][bj][r] = 0.f;
  const int swz = (l32 >> 1) & 7;
  const int arow = (wm * 64 + l32) * 128, brow = (wn * 64 + l32) * 128;
  const int c0 = ((0 + hh) ^ swz) * 16, c1 = ((2 + hh) ^ swz) * 16, c2 = ((4 + hh) ^ swz) * 16, c3 = ((6 + hh) ^ swz) * 16;
  asm volatile("s_waitcnt vmcnt(0)" ::: "memory");
  __syncthreads();
  const int nk = cur.nk;
  for (int kt = 0; kt < nk; ++kt) {
    if (kt + 1 < nk) stage_td(cur, kt + 1, smem + (buf ^ 1) * 32768, tid);
    else if (has_next) stage_td(nxt, 0, smem + (buf ^ 1) * 32768, tid);
    const char* as = smem + buf * 32768 + arow;
    const char* bs = smem + buf * 32768 + 16384 + brow;
    bf16x8 fa0[2], fa1[2], fb0[2], fb1[2];
    fa0[0] = *(const bf16x8*)(as + c0); fa1[0] = *(const bf16x8*)(as + 4096 + c0);
    fb0[0] = *(const bf16x8*)(bs + c0); fb1[0] = *(const bf16x8*)(bs + 4096 + c0);
#pragma unroll
    for (int ks = 0; ks < 4; ++ks) {
      const int cb = ks & 1, nb = cb ^ 1;
      if (ks < 3) {
        const int co = (ks == 0) ? c1 : (ks == 1) ? c2 : c3;
        fa0[nb] = *(const bf16x8*)(as + co); fa1[nb] = *(const bf16x8*)(as + 4096 + co);
        fb0[nb] = *(const bf16x8*)(bs + co); fb1[nb] = *(const bf16x8*)(bs + 4096 + co);
      }
      __builtin_amdgcn_s_setprio(1);
      acc[0][0] = MFMA32(fa0[cb], fb0[cb], acc[0][0]);
      acc[0][1] = MFMA32(fa0[cb], fb1[cb], acc[0][1]);
      acc[1][0] = MFMA32(fa1[cb], fb0[cb], acc[1][0]);
      acc[1][1] = MFMA32(fa1[cb], fb1[cb], acc[1][1]);
      __builtin_amdgcn_s_setprio(0);
    }
    buf ^= 1;
    if (kt + 1 < nk) {
      asm volatile("s_waitcnt vmcnt(0)" ::: "memory");
      __syncthreads();
    }
  }
}

#define EPI_IDX                                                                                        \
  const int tid = get_tid(), lane = tid & 63, wave = tid >> 6, wm = wave >> 1, wn = wave & 1, l32 = lane & 31, hh = lane >> 5; \
  (void)tid; (void)lane; (void)wave; (void)wm; (void)wn; (void)l32; (void)hh;
DI int crow(int r, int hh) { return (r & 3) + 8 * (r >> 2) + 4 * hh; }

DI void phase_g1(const P& p, int layer, char* smem) {
  EPI_IDX
  const u16* A = (const u16*)(p.ws + OFF_H);
  const u16* Bt = (const u16*)(p.ws + OFF_WIN) + (size_t)layer * 1920 * 1024;
  float* proj = (float*)(p.ws + OFF_PROJ);
  constexpr int MT = NT / 128, NTL = NP / 128;
  const int xcd_ = blockIdx.x & 7, xj_ = blockIdx.x >> 3, xn_ = gridDim.x >> 3;
  constexpr int MPX = MT / 8;
  auto tile_at = [&](int u) { TD d; d.A = A; d.B = Bt; d.lda = 1024; d.ldb = 1024; d.k0 = 0; d.nk = 16; d.m0 = (xcd_ * MPX + u % MPX) * 128; d.n0 = (u / MPX) * 128; return d; };
  int buf = 0;
  TD cur = tile_at(xj_ < MPX * NTL ? xj_ : 0);
  if (xj_ < MPX * NTL) stage_td(cur, 0, smem, tid);
  for (int u = xj_; u < MPX * NTL; u += xn_) {
    const bool has_next = (u + xn_ < MPX * NTL);
    const TD nxt = tile_at(has_next ? u + xn_ : u);
    const int m0 = cur.m0, n0 = cur.n0;
    f32x16 acc[2][2];
    gemm_stream(cur, has_next, nxt, smem, buf, acc);
    cur = nxt;
    const bool lat = m0 >= NCTX;
    const int b_all = lat ? 32 + ((m0 - NCTX) >> 10) : (m0 >> 8);
    const int nkk = lat ? 1536 : 256;
#pragma unroll
    for (int bi = 0; bi < 2; ++bi)
#pragma unroll
      for (int bj = 0; bj < 2; ++bj) {
        const int rb = m0 + wm * 64 + bi * 32;
        const int cb = n0 + wn * 64 + bj * 32;
        const int col = cb + l32;
#pragma unroll
        for (int r = 0; r < 16; ++r) proj[(size_t)(rb + crow(r, hh)) * NP + col] = acc[bi][bj][r];
        const bool isdv = (cb >= 512 && cb < 768), isgv = (cb >= 1152 && cb < 1280);
        if (isdv || isgv) {
          u16* vt; int f;
          if (isdv) { f = col - 512; vt = (u16*)(p.ws + OFF_DVT) + vt_off(b_all, f >> 6, 4); }
          else { f = col - 1152; vt = (u16*)(p.ws + OFF_GVT) + vt_off(b_all, f >> 6, 2); }
          vt += (size_t)(f & 63) * nkk;
#pragma unroll
          for (int j = 0; j < 4; ++j) {
            int row = rb + 16 * (j >> 1) + 8 * hh + 4 * (j & 1);
            int key = lat ? 512 + ((row - NCTX) & 1023) : (row & 255);
            f32x4 v = {acc[bi][bj][4 * j], acc[bi][bj][4 * j + 1], acc[bi][bj][4 * j + 2], acc[bi][bj][4 * j + 3]};
            *(u32x2*)(vt + key) = pack4(v);
          }
        }
      }
  }
}

DI void phase_g2(const P& p, int layer, char* smem) {
  EPI_IDX
  constexpr int T_MQ = (NT / 128) * 3, T_MKV = (NKR / 128) * 4, T_GLU = (NT / 128) * 4;
  const f32x2* tab32 = (const f32x2*)(p.ws + OFF_ROPE);
  auto tile_at = [&](int t) {
    TD d; d.k0 = 0;
    if (t < T_MQ) { d.A = (const u16*)(p.ws + OFF_CQN); d.B = (const u16*)(p.ws + OFF_WUQ) + (size_t)layer * 384 * 192; d.lda = 192; d.ldb = 192; d.nk = 3; d.m0 = (t / 3) * 128; d.n0 = (t % 3) * 128; }
    else { const int t2 = t - T_MQ; d.A = (const u16*)(p.ws + OFF_CKVN); d.B = (const u16*)(p.ws + OFF_WUKV) + (size_t)layer * 512 * 128; d.lda = 128; d.ldb = 128; d.nk = 2; d.m0 = (t2 / 4) * 128; d.n0 = (t2 % 4) * 128; }
    return d;
  };
  int buf = 0;
  const int t_first = blockIdx.x;
  TD cur = tile_at(t_first < T_MQ + T_MKV ? t_first : 0);
  if (t_first < T_MQ + T_MKV) stage_td(cur, 0, smem, tid);
  for (int t = blockIdx.x; t < T_MQ + T_MKV; t += gridDim.x) {
    const bool has_next = (t + (int)gridDim.x < T_MQ + T_MKV);
    const TD nxt = tile_at(has_next ? t + (int)gridDim.x : t);
    f32x16 acc[2][2];
    const int m0 = cur.m0, n0 = cur.n0;
    gemm_stream(cur, has_next, nxt, smem, buf, acc);
    cur = nxt;
    if (t < T_MQ) {
      const bool lat = m0 >= NCTX;
      const float scl = 0.10206207261596575f * LOG2E;
      u16* mq = (u16*)(p.ws + OFF_MQ);
#pragma unroll
      for (int bi = 0; bi < 2; ++bi)
#pragma unroll
        for (int bj = 0; bj < 2; ++bj) {
          const int rb = m0 + wm * 64 + bi * 32;
          const int cb = n0 + wn * 64 + bj * 32;
          const int col = cb + l32;
          const bool isrope = lat && ((cb % 96) == 64);
          const int e = l32, w2 = e & 15, fi = w2 & 7;
          const bool isx2 = w2 >= 8, half = e >= 16;
          f32x2 csv[16];
#pragma unroll
          for (int r = 0; r < 16; ++r) {
            const int row = rb + crow(r, hh);
            int tt = (row - NCTX) & 1023;
            int pos = half ? (tt & 63) : (tt >> 6);
            f32x2 one = {1.f, 0.f};
            csv[r] = isrope ? tab32[pos * 16 + fi] : one;
          }
#pragma unroll
          for (int r = 0; r < 16; ++r) {
            float v = acc[bi][bj][r];
            const int row = rb + crow(r, hh);
            if (isrope) {
              float pv = __shfl_xor(v, 8);
              v = v * csv[r][0] + (isx2 ? pv : -pv) * csv[r][1];
            }
            mq[(size_t)row * 384 + col] = f2bf(v * scl);
          }
        }
    } else {
      const int nt = n0 >> 7;
      const bool lat = m0 >= NCTX;
      const int b_all = lat ? 32 + (m0 - NCTX) / 1536 : (m0 >> 8);
      const int nkk = lat ? 1536 : 256;
      const int kbase = lat ? (m0 - NCTX) % 1536 : (m0 & 255);
      const int head = nt;
      u16* mk = (u16*)(p.ws + OFF_MKB);
      u16* mvt = (u16*)(p.ws + OFF_MVT) + vt_off(b_all, head, 4);
#pragma unroll
      for (int bi = 0; bi < 2; ++bi)
#pragma unroll
        for (int bj = 0; bj < 2; ++bj) {
          const int rloc = wm * 64 + bi * 32;
          const int wcol = wn * 64 + bj * 32 + l32;
          if (wn == 0) {
#pragma unroll
            for (int r = 0; r < 16; ++r) mk[(size_t)(m0 + rloc + crow(r, hh)) * 384 + head * 96 + wcol] = f2bf(acc[bi][bj][r]);
          } else {
            u16* vt = mvt + (size_t)(wcol - 64) * nkk + kbase + rloc;
#pragma unroll
            for (int j = 0; j < 4; ++j) {
              f32x4 v = {acc[bi][bj][4 * j], acc[bi][bj][4 * j + 1], acc[bi][bj][4 * j + 2], acc[bi][bj][4 * j + 3]};
              *(u32x2*)(vt + 16 * (j >> 1) + 8 * hh + 4 * (j & 1)) = pack4(v);
            }
          }
        }
    }
  }
  __syncthreads();
  for (int t2 = (int)gridDim.x - 1 - (int)blockIdx.x; t2 < T_GLU; t2 += gridDim.x) {
    {
      f32x16 acc[2][2];
      const int mt = t2 / 4, nt = t2 % 4, m0 = mt * 128, n0 = nt * 128;
      gemm_core<1>(p, layer, nullptr, 0, (const u16*)(p.ws + OFF_WGLU) + (size_t)layer * 512 * 256, 256, m0, n0, smem, acc);
      u16* mixed = (u16*)(p.ws + OFF_MIXED);
      const int q = (n0 + wn * 64) >> 6;
#pragma unroll
      for (int bi = 0; bi < 2; ++bi) {
        const int rb = m0 + wm * 64 + bi * 32;
#pragma unroll
        for (int r = 0; r < 16; ++r) {
          float z = acc[bi][0][r], g = acc[bi][1][r];
          mixed[(size_t)(rb + crow(r, hh)) * 1024 + 512 + q * 32 + l32] = f2bf(z * fsigmoid(g));
        }
      }
    }
  }
}

DI void phase_resid(const P& p, int layer, char* smem, bool is_out) {
  EPI_IDX
  const u16* A = is_out ? (const u16*)(p.ws + OFF_MIXED) : (const u16*)(p.ws + OFF_A);
  const int K = is_out ? 1024 : 4096;
  const u16* Bt = is_out ? (const u16*)(p.ws + OFF_WOUT) + (size_t)layer * 1024 * 1024 : (const u16*)(p.ws + OFF_W2) + (size_t)layer * 1024 * 4096;
  constexpr int MT = NT / 128, NTL = 8, MPX = MT / 8, NU = MPX * NTL;
  const int xcd_ = blockIdx.x & 7, xj_ = blockIdx.x >> 3, xn_ = gridDim.x >> 3;
  auto tile_at = [&](int u) {
    TD d; d.A = A; d.B = Bt; d.lda = K; d.ldb = K; d.nk = K / 64; d.k0 = 0;
    const int v = u;
    d.n0 = (is_out ? v / MPX : v % NTL) * 128;
    d.m0 = (xcd_ * MPX + (is_out ? v % MPX : v / NTL)) * 128;
    return d;
  };
  int buf = 0;
  TD cur = tile_at(xj_ < NU ? xj_ : 0);
  if (xj_ < NU) stage_td(cur, 0, smem, tid);
  for (int u = xj_; u < NU; u += xn_) {
    const bool has_next = (u + xn_ < NU);
    const TD nxt = tile_at(has_next ? u + xn_ : u);
    const int m0 = cur.m0, n0 = cur.n0;
    f32x16 acc[2][2];
    gemm_stream(cur, has_next, nxt, smem, buf, acc);
    cur = nxt;
    const float* gate = (const float*)(p.ws + OFF_MOD) + ((size_t)layer * 5 + mod_index(m0)) * 6144 + (is_out ? 2048 : 5120);
#pragma unroll
    for (int bi = 0; bi < 2; ++bi)
#pragma unroll
      for (int bj = 0; bj < 2; ++bj) {
        const int rb = m0 + wm * 64 + bi * 32;
        const int col = n0 + wn * 64 + bj * 32 + l32;
        const float g = gate[col];
        float rv[16];
#pragma unroll
        for (int r = 0; r < 16; ++r) rv[r] = p.out[(size_t)(rb + crow(r, hh)) * 1024 + col];
#pragma unroll
        for (int r = 0; r < 16; ++r) p.out[(size_t)(rb + crow(r, hh)) * 1024 + col] = rv[r] + g * acc[bi][bj][r];
      }
  }
}

DI void phase_g5(const P& p, int layer, char* smem) {
  EPI_IDX
  const u16* A = (const u16*)(p.ws + OFF_H);
  const u16* Bt = (const u16*)(p.ws + OFF_W1) + (size_t)layer * 4096 * 1024;
  u16* a = (u16*)(p.ws + OFF_A);
  constexpr int MT = NT / 128, NTL = 32;
  const int xcd_ = blockIdx.x & 7, xj_ = blockIdx.x >> 3, xn_ = gridDim.x >> 3;
  constexpr int MPX = MT / 8;
  auto tile_at = [&](int u) { TD d; d.A = A; d.B = Bt; d.lda = 1024; d.ldb = 1024; d.k0 = 0; d.nk = 16; d.m0 = (xcd_ * MPX + u % MPX) * 128; d.n0 = (u / MPX) * 128; return d; };
  int buf = 0;
  TD cur = tile_at(xj_ < MPX * NTL ? xj_ : 0);
  if (xj_ < MPX * NTL) stage_td(cur, 0, smem, tid);
  for (int u = xj_; u < MPX * NTL; u += xn_) {
    const bool has_next = (u + xn_ < MPX * NTL);
    const TD nxt = tile_at(has_next ? u + xn_ : u);
    const int m0 = cur.m0, n0 = cur.n0;
    f32x16 acc[2][2];
    gemm_stream(cur, has_next, nxt, smem, buf, acc);
    cur = nxt;
#pragma unroll
    for (int bi = 0; bi < 2; ++bi)
#pragma unroll
      for (int bj = 0; bj < 2; ++bj) {
        const int rb = m0 + wm * 64 + bi * 32;
        const int col = n0 + wn * 64 + bj * 32 + l32;
#pragma unroll
        for (int r = 0; r < 16; ++r) {
          float v = fmaxf(acc[bi][bj][r], 0.f);
          a[(size_t)(rb + crow(r, hh)) * 4096 + col] = f2bf(v * v);
        }
      }
  }
}

template <int R>
DI f32x4 rope4(f32x4 v, int lane, int t, const f32x2* tab) {
  constexpr int n = R / 4;
  const int e = (lane * 4) % R;
  const int half = e / (R / 2), w = e % (R / 2);
  const bool isx2 = w >= n;
  const int fi = w % n;
  const int pos = half ? (t & 63) : (t >> 6);
  f32x4 o;
#pragma unroll
  for (int i = 0; i < 4; ++i) {
    float pv = __shfl_xor(v[i], n / 4);
    f32x2 cs = tab[pos * 16 + fi + i];
    o[i] = v[i] * cs[0] + (isx2 ? pv : -pv) * cs[1];
  }
  return o;
}

DI void ssm_item(const P& p, int layer, int item, float* lds, int lane) {
  int b_all, r;
  if (item < 128) { b_all = 32 + item / 32; r = item % 32; } else { int it = item - 128; b_all = it / 32; r = it % 32; }
  const int dir = r >> 4, g = r & 15;
  const bool lat = b_all >= 32;
  const int T = lat ? 1024 : 256;
  const int row0 = lat ? NCTX + (b_all - 32) * 1024 : b_all * 256;
  const int tabidx = (layer * 2 + dir) * 16 + g;
  const int l32 = lane & 31, hh = lane >> 5, l16 = lane & 15, q4 = lane >> 4;
  const u16* atab = (const u16*)(p.ws + OFF_ATAB) + (size_t)tabidx * 128 * 16;
  const u16* ctab = (const u16*)(p.ws + OFF_CTAB) + (size_t)tabidx * 16 * 128;
  bf16x8 af[4], cf[4];
#pragma unroll
  for (int blk = 0; blk < 4; ++blk) af[blk] = *(const bf16x8*)(atab + (blk * 32 + l32) * 16 + hh * 8);
#pragma unroll
  for (int kk = 0; kk < 4; ++kk) cf[kk] = *(const bf16x8*)(ctab + l16 * 128 + kk * 32 + q4 * 8);
  const float* ab = (const float*)(p.ws + OFF_ABAR) + ((size_t)tabidx * 64 + lane) * 2;
  const float ar = ab[0], ai = ab[1];
  float hr = 0.f, hi = 0.f;
  if (lat) {
    size_t idx = ((size_t)((b_all - 32) * 2 + layer) * 2 + dir) * 1024 + g * 64 + lane;
    hr = p.in[I_SRE][idx]; hi = p.in[I_SIM][idx];
  }
  const float* proj = (const float*)(p.ws + OFF_PROJ);
  float* ybuf = (float*)(p.ws + OFF_YBUF) + (size_t)dir * NT * 256;
  f32x16 zero16;
#pragma unroll
  for (int i = 0; i < 16; ++i) zero16[i] = 0.f;
  f32x4 u0, u1;
  {
    const int t = dir ? (T - 1 - l32) : l32;
    const float* up = proj + (size_t)(row0 + t) * NP + 1280 + g * 16 + hh * 8;
    u0 = *(const f32x4*)up; u1 = *(const f32x4*)(up + 4);
  }
  for (int ch = 0; ch < T / 32; ++ch) {
    {
      bf16x8 uf = pack8(u0, u1);
      if (ch + 1 < T / 32) {
        const int n = (ch + 1) * 32 + l32;
        const int t = dir ? (T - 1 - n) : n;
        const float* up = proj + (size_t)(row0 + t) * NP + 1280 + g * 16 + hh * 8;
        u0 = *(const f32x4*)up; u1 = *(const f32x4*)(up + 4);
      }
#pragma unroll
      for (int blk = 0; blk < 4; ++blk) {
        f32x16 d = MFMA32(af[blk], uf, zero16);
#pragma unroll
        for (int j = 0; j < 4; ++j) {
          f32x4 v = {d[4 * j], d[4 * j + 1], d[4 * j + 2], d[4 * j + 3]};
          *(f32x4*)(lds + l32 * 132 + blk * 32 + 8 * j + 4 * hh) = v;
        }
      }
    }
    wave_lds_fence();
#pragma unroll
    for (int s = 0; s < 32; ++s) {
      f32x2 bu = *(const f32x2*)(lds + s * 132 + 2 * lane);
      float nr = ar * hr - ai * hi + bu[0];
      float ni = ar * hi + ai * hr + bu[1];
      hr = nr; hi = ni;
      f32x2 hv = {hr, hi};
      *(f32x2*)(lds + s * 132 + 2 * lane) = hv;
    }
    wave_lds_fence();
#pragma unroll
    for (int tb = 0; tb < 2; ++tb) {
      f32x4 y = {0.f, 0.f, 0.f, 0.f};
#pragma unroll
      for (int kk = 0; kk < 4; ++kk) {
        const float* hp = lds + (tb * 16 + l16) * 132 + kk * 32 + q4 * 8;
        f32x4 a0 = *(const f32x4*)hp, a1 = *(const f32x4*)(hp + 4);
        y = MFMA16(cf[kk], pack8(a0, a1), y);
      }
      const int n2 = ch * 32 + tb * 16 + l16;
      const int t2 = dir ? (T - 1 - n2) : n2;
      *(f32x4*)(ybuf + (size_t)(row0 + t2) * 256 + g * 16 + q4 * 4) = y;
    }
    wave_lds_fence();
  }
  if (!lat) {
    size_t idx = ((size_t)(b_all * 2 + layer) * 2 + dir) * 1024 + g * 64 + lane;
    p.out[O_SRE + idx] = hr;
    p.out[O_SIM + idx] = hi;
  }
}

DI void pp_row(const P& p, int layer, int row, int lane) {
  const float* pr = (const float*)(p.ws + OFF_PROJ) + (size_t)row * NP;
  const bool lat = row >= NCTX;
  int b, t, keyrow;
  if (!lat) { b = row >> 8; t = row & 255; keyrow = row; }
  else { int rr = row - NCTX; b = rr >> 10; t = rr & 1023; keyrow = NCTX + b * 1536 + 512 + t; }
  const f32x2* tab32 = (const f32x2*)(p.ws + OFF_ROPE);
  const f32x2* tab64 = tab32 + 64 * 16;
  const size_t orow = (size_t)(b * 2 + layer) * 256 + t;
  const f32x4 z4 = {0.f, 0.f, 0.f, 0.f};
  f32x4 v_dq = *(const f32x4*)(pr + lane * 4);
  f32x4 v_dk = *(const f32x4*)(pr + 256 + lane * 4);
  f32x4 v_dv = *(const f32x4*)(pr + 512 + lane * 4);
  f32x4 v_gq = *(const f32x4*)(pr + 768 + lane * 4);
  f32x4 v_gk = lane < 32 ? *(const f32x4*)(pr + 1024 + lane * 4) : z4;
  f32x4 v_gv = lane < 32 ? *(const f32x4*)(pr + 1152 + lane * 4) : z4;
  f32x4 v_cq = lane < 48 ? *(const f32x4*)(pr + 1536 + lane * 4) : z4;
  f32x4 v_ckv = lane < 32 ? *(const f32x4*)(pr + 1728 + lane * 4) : z4;
  f32x4 v_kr = lane < 8 ? *(const f32x4*)(pr + 1856 + lane * 4) : z4;
  const f32x4 g_q = *(const f32x4*)(p.in[I_QNG] + layer * 64 + (lane & 15) * 4);
  const f32x4 g_k = *(const f32x4*)(p.in[I_KNG] + layer * 64 + (lane & 15) * 4);
  const f32x4 g_cq = lane < 48 ? *(const f32x4*)(p.in[I_MQNG] + layer * 192 + lane * 4) : z4;
  const f32x4 g_ckv = lane < 32 ? *(const f32x4*)(p.in[I_MKVNG] + layer * 128 + lane * 4) : z4;
  f32x2 cs32[4], cs64[4];
  {
    const int e32 = (lane * 4) & 31, w32 = e32 & 15, p32 = (e32 >> 4) ? (t & 63) : (t >> 6), f32i = w32 & 7;
    const int e64 = (lane * 4) & 63, w64 = e64 & 31, p64 = (e64 >> 5) ? (t & 63) : (t >> 6), f64i = w64 & 15;
    const f32x2 one = {1.f, 0.f};
#pragma unroll
    for (int i = 0; i < 4; ++i) {
      cs32[i] = lat ? tab32[p32 * 16 + f32i + i] : one;
      cs64[i] = lat ? tab64[p64 * 16 + f64i + i] : one;
    }
  }
  const bool x2_32 = ((lane * 4) & 15) >= 8, x2_64 = ((lane * 4) & 31) >= 16;
  auto rope32 = [&](f32x4 v) {
    f32x4 o;
#pragma unroll
    for (int i = 0; i < 4; ++i) { float pv = __shfl_xor(v[i], 2); o[i] = v[i] * cs32[i][0] + (x2_32 ? pv : -pv) * cs32[i][1]; }
    return o;
  };
  auto rope64 = [&](f32x4 v) {
    f32x4 o;
#pragma unroll
    for (int i = 0; i < 4; ++i) { float pv = __shfl_xor(v[i], 4); o[i] = v[i] * cs64[i][0] + (x2_64 ? pv : -pv) * cs64[i][1]; }
    return o;
  };
  if (!lat) {
    *(f32x4*)(p.out + O_DK + orow * 256 + lane * 4) = v_dk;
    *(f32x4*)(p.out + O_DV + orow * 256 + lane * 4) = v_dv;
    if (lane < 32) *(f32x4*)(p.out + O_GV + orow * 128 + lane * 4) = v_gv;
    if (lane < 8) *(f32x4*)(p.out + O_KR + orow * 32 + lane * 4) = v_kr;
  }
  {
    f32x4 v = v_dq;
    if (lat) v = rope32(v);
    v = v * (0.17677669529663687f * LOG2E);
    *(u32x2*)((u16*)(p.ws + OFF_DQ) + (size_t)row * 256 + lane * 4) = pack4(v);
  }
  {
    f32x4 v = v_dk;
    if (lat) v = rope32(v);
    *(u32x2*)((u16*)(p.ws + OFF_DKB) + (size_t)keyrow * 256 + lane * 4) = pack4(v);
  }
  {
    f32x4 v = v_gq;
    float ss = v[0] * v[0] + v[1] * v[1] + v[2] * v[2] + v[3] * v[3];
    ss += __shfl_xor(ss, 1); ss += __shfl_xor(ss, 2); ss += __shfl_xor(ss, 4); ss += __shfl_xor(ss, 8);
    float r = rsqrtf(ss * (1.f / 64.f) + EPSF);
    v = v * r * g_q;
    if (lat) v = rope64(v);
    v = v * (0.125f * LOG2E);
    *(u32x2*)((u16*)(p.ws + OFF_GQ) + (size_t)row * 256 + lane * 4) = pack4(v);
  }
  {
    f32x4 v = v_gk;
    float ss = v[0] * v[0] + v[1] * v[1] + v[2] * v[2] + v[3] * v[3];
    ss += __shfl_xor(ss, 1); ss += __shfl_xor(ss, 2); ss += __shfl_xor(ss, 4); ss += __shfl_xor(ss, 8);
    float r = rsqrtf(ss * (1.f / 64.f) + EPSF);
    v = v * r * g_k;
    if (!lat) { if (lane < 32) *(f32x4*)(p.out + O_GK + orow * 128 + lane * 4) = v; }
    else v = rope64(v);
    if (lane < 32) *(u32x2*)((u16*)(p.ws + OFF_GKB) + (size_t)keyrow * 128 + lane * 4) = pack4(v);
  }
  {
    f32x4 v = v_cq;
    float ss = wave_sum(v[0] * v[0] + v[1] * v[1] + v[2] * v[2] + v[3] * v[3]);
    float r = rsqrtf(ss * (1.f / 192.f) + EPSF);
    v = v * r * g_cq;
    if (lane < 48) *(u32x2*)((u16*)(p.ws + OFF_CQN) + (size_t)row * 192 + lane * 4) = pack4(v);
  }
  {
    f32x4 v = v_ckv;
    float ss = wave_sum(v[0] * v[0] + v[1] * v[1] + v[2] * v[2] + v[3] * v[3]);
    float r = rsqrtf(ss * (1.f / 128.f) + EPSF);
    v = v * r * g_ckv;
    if (lane < 32) {
      if (!lat) *(f32x4*)(p.out + O_CKV + orow * 128 + lane * 4) = v;
      *(u32x2*)((u16*)(p.ws + OFF_CKVN) + (size_t)keyrow * 128 + lane * 4) = pack4(v);
    }
  }
  {
    f32x4 v = v_kr;
    if (lat) v = rope32(v);
    if (lane < 8) {
      u32x2 pk = pack4(v);
      u16* mk = (u16*)(p.ws + OFF_MKB) + (size_t)keyrow * 384 + 64 + lane * 4;
#pragma unroll
      for (int hd = 0; hd < 4; ++hd) *(u32x2*)(mk + hd * 96) = pk;
    }
  }
}

DI void pp_cached(const P& p, int layer, int crow_, int lane) {
  const int b = crow_ >> 9, j = crow_ & 511;
  const int keyrow = NCTX + b * 1536 + j;
  const size_t src = (size_t)(b * 2 + layer) * 512 + j;
  const int jp = (j & ~15) | (((j >> 2) & 1) << 3) | (((j >> 3) & 1) << 2) | (j & 3);
  const f32x4 z4 = {0.f, 0.f, 0.f, 0.f};
  const int l31 = lane & 31, l7 = lane & 7;
  f32x4 v_dk = *(const f32x4*)(p.in[I_CDK] + src * 256 + lane * 4);
  f32x4 v_dv = *(const f32x4*)(p.in[I_CDV] + src * 256 + lane * 4);
  f32x4 v_gk = *(const f32x4*)(p.in[I_CGK] + src * 128 + l31 * 4);
  f32x4 v_gv = *(const f32x4*)(p.in[I_CGV] + src * 128 + l31 * 4);
  f32x4 v_ckv = *(const f32x4*)(p.in[I_CCKV] + src * 128 + l31 * 4);
  f32x4 v_kr = *(const f32x4*)(p.in[I_CKR] + src * 32 + l7 * 4);
  (void)z4;
  *(u32x2*)((u16*)(p.ws + OFF_DKB) + (size_t)keyrow * 256 + lane * 4) = pack4(v_dk);
  {
    u16* vt = (u16*)(p.ws + OFF_DVT) + vt_off(32 + b, lane >> 4, 4) + (size_t)((lane & 15) * 4) * 1536 + jp;
#pragma unroll
    for (int i = 0; i < 4; ++i) vt[(size_t)i * 1536] = f2bf(v_dv[i]);
  }
  if (lane < 32) {
    *(u32x2*)((u16*)(p.ws + OFF_GKB) + (size_t)keyrow * 128 + lane * 4) = pack4(v_gk);
    u16* vt = (u16*)(p.ws + OFF_GVT) + vt_off(32 + b, lane >> 4, 2) + (size_t)((lane & 15) * 4) * 1536 + jp;
#pragma unroll
    for (int i = 0; i < 4; ++i) vt[(size_t)i * 1536] = f2bf(v_gv[i]);
    *(u32x2*)((u16*)(p.ws + OFF_CKVN) + (size_t)keyrow * 128 + lane * 4) = pack4(v_ckv);
  }
  if (lane < 8) {
    u32x2 pk = pack4(v_kr);
    u16* mk = (u16*)(p.ws + OFF_MKB) + (size_t)keyrow * 384 + 64 + lane * 4;
#pragma unroll
    for (int hd = 0; hd < 4; ++hd) *(u32x2*)(mk + hd * 96) = pk;
  }
}

DI void phase_pp(const P& p, int layer, char* smem) {
  const int tid_ = get_tid();
  const int lane = tid_ & 63, wave = tid_ >> 6;
  float* lds = (float*)smem + wave * (32 * 132);
  const int gw = blockIdx.x * 4 + wave, nw = gridDim.x * 4;
  constexpr int N_SSM = 1152, N_ROWS = NT + 2048;
  for (int item = gw; item < N_SSM; item += nw) ssm_item(p, layer, item, lds, lane);
  const int rw0 = (nw > 256) ? 128 : 0;
  if (gw >= rw0) {
    for (int row = gw - rw0; row < N_ROWS; row += nw - rw0) {
      if (row < NT) pp_row(p, layer, row, lane);
      else pp_cached(p, layer, row - NT, lane);
    }
  }
}

template <int KW, int DK>
DI void attn_block(const u16* __restrict__ Kg, int ldk, const u16* __restrict__ Vt, int nk, const bf16x8 (&qf)[DK / 16], int kcol, char* smem,
                   int tid, f32x16 (&o)[2], float& lsum) {
  constexpr int KST = KW + 8, KS = DK / 16, KCH = KW / 8, NKC = 64 * KCH / 256;
  const int lane = tid & 63, l32 = lane & 31, hh = lane >> 5;
  u16* Ks = (u16*)smem;
  u16* Vs = Ks + 2 * 64 * KST;
  float m = -1e30f;
  lsum = 0.f;
#pragma unroll
  for (int db = 0; db < 2; ++db)
#pragma unroll
    for (int r = 0; r < 16; ++r) o[db][r] = 0.f;
  u32x4 rk[NKC], rv[2];
  const int nt = nk / 64;
#pragma unroll
  for (int i = 0; i < NKC; ++i) { int c = tid + 256 * i, r = c / KCH, kc = (c % KCH) * 8; rk[i] = *(const u32x4*)(Kg + (size_t)r * ldk + kc); }
#pragma unroll
  for (int i = 0; i < 2; ++i) { int c = tid + 256 * i, r = c >> 3, kc = (c & 7) * 8; rv[i] = *(const u32x4*)(Vt + (size_t)r * nk + kc); }
#pragma unroll
  for (int i = 0; i < NKC; ++i) { int c = tid + 256 * i, r = c / KCH, kc = (c % KCH) * 8; *(u32x4*)(Ks + r * KST + kc) = rk[i]; }
#pragma unroll
  for (int i = 0; i < 2; ++i) { int c = tid + 256 * i, r = c >> 3, kc = (c & 7) * 8; *(u32x4*)(Vs + r * 72 + kc) = rv[i]; }
  __syncthreads();
  for (int t = 0; t < nt; ++t) {
    const int buf = t & 1;
    const bool more = (t + 1 < nt);
    if (more) {
      const int kt = (t + 1) * 64;
#pragma unroll
      for (int i = 0; i < NKC; ++i) { int c = tid + 256 * i, r = c / KCH, kc = (c % KCH) * 8; rk[i] = *(const u32x4*)(Kg + (size_t)(kt + r) * ldk + kc); }
#pragma unroll
      for (int i = 0; i < 2; ++i) { int c = tid + 256 * i, r = c >> 3, kc = (c & 7) * 8; rv[i] = *(const u32x4*)(Vt + (size_t)r * nk + kt + kc); }
    }
    const u16* ks = Ks + buf * 64 * KST + l32 * KST + kcol + hh * 8;
    const u16* vs = Vs + buf * 64 * 72 + l32 * 72 + hh * 8;
    f32x16 sa[2];
#pragma unroll
    for (int kb = 0; kb < 2; ++kb) {
#pragma unroll
      for (int r = 0; r < 16; ++r) sa[kb][r] = 0.f;
#pragma unroll
      for (int s2 = 0; s2 < KS; ++s2) {
        bf16x8 kf = *(const bf16x8*)(ks + kb * 32 * KST + s2 * 16);
        sa[kb] = MFMA32(kf, qf[s2], sa[kb]);
      }
      __builtin_amdgcn_sched_barrier(0);
    }
    float mx = sa[0][0];
#pragma unroll
    for (int r = 1; r < 16; ++r) mx = fmaxf(mx, sa[0][r]);
#pragma unroll
    for (int r = 0; r < 16; ++r) mx = fmaxf(mx, sa[1][r]);
    mx = fmaxf(mx, __shfl_xor(mx, 32));
    const float mn = fmaxf(m, mx);
    const float alpha = fexp2(m - mn);
    m = mn;
    float ps = 0.f;
#pragma unroll
    for (int kb = 0; kb < 2; ++kb)
#pragma unroll
      for (int r = 0; r < 16; ++r) { float e = fexp2(sa[kb][r] - mn); sa[kb][r] = e; ps += e; }
    lsum = lsum * alpha + ps;
#pragma unroll
    for (int db = 0; db < 2; ++db)
#pragma unroll
      for (int r = 0; r < 16; ++r) o[db][r] *= alpha;
#pragma unroll
    for (int s2 = 0; s2 < 4; ++s2) {
      const int kb = s2 >> 1, rb = 8 * (s2 & 1);
      f32x4 p0 = {sa[kb][rb], sa[kb][rb + 1], sa[kb][rb + 2], sa[kb][rb + 3]};
      f32x4 p1 = {sa[kb][rb + 4], sa[kb][rb + 5], sa[kb][rb + 6], sa[kb][rb + 7]};
      bf16x8 pf = pack8(p0, p1);
      bf16x8 v0 = *(const bf16x8*)(vs + s2 * 16);
      bf16x8 v1 = *(const bf16x8*)(vs + 32 * 72 + s2 * 16);
      o[0] = MFMA32(v0, pf, o[0]);
      o[1] = MFMA32(v1, pf, o[1]);
    }
    if (more) {
      const int nb = buf ^ 1;
#pragma unroll
      for (int i = 0; i < NKC; ++i) { int c = tid + 256 * i, r = c / KCH, kc = (c % KCH) * 8; *(u32x4*)(Ks + nb * 64 * KST + r * KST + kc) = rk[i]; }
#pragma unroll
      for (int i = 0; i < 2; ++i) { int c = tid + 256 * i, r = c >> 3, kc = (c & 7) * 8; *(u32x4*)(Vs + nb * 64 * 72 + r * 72 + kc) = rv[i]; }
    }
    __syncthreads();
  }
  lsum += __shfl_xor(lsum, 32);
}

DI void store_o(u16* dst  , const f32x16 (&o)[2], float scale, int hh) {
#pragma unroll
  for (int db = 0; db < 2; ++db)
#pragma unroll
    for (int j = 0; j < 4; ++j) {
      const int dv = db * 32 + 8 * j + 4 * hh;
      f32x4 v = {o[db][4 * j] * scale, o[db][4 * j + 1] * scale, o[db][4 * j + 2] * scale, o[db][4 * j + 3] * scale};
      *(u32x2*)(dst + dv) = pack4(v);
    }
}

DI void attn_item(const P& p, int layer, int item, char* smem, int tid) {
  const int lane = tid & 63, wave = tid >> 6, l32 = lane & 31, hh = lane >> 5;
  bool lat; int kind, b, hd, qblk;
  if (item < 512) {
    lat = true;
    if (item < 256) { kind = 0; b = item >> 6; hd = (item >> 4) & 3; qblk = item & 15; }
    else { int it = item - 256; kind = 1 + (it >> 7); it &= 127; b = it >> 5; hd = (it >> 3) & 3; qblk = it & 7; }
  } else {
    lat = false;
    int it = item - 512;
    if (it < 512) { kind = 0; b = it >> 4; hd = (it >> 2) & 3; qblk = it & 3; }
    else { it -= 512; kind = 1 + (it >> 8); it &= 255; b = it >> 3; hd = (it >> 1) & 3; qblk = it & 1; }
  }
  const int nk = lat ? 1536 : 256;
  const int b_all = lat ? 32 + b : b;
  const int keyrow0 = lat ? NCTX + b * 1536 : b * 256;
  const int tok0 = lat ? NCTX + b * 1024 : b * 256;
  f32x16 o[2]; float ls;
  if (kind == 0) {
    const int ns = wave & 1, qb = wave >> 1;
    const int q0 = tok0 + qblk * 64 + qb * 32;
    const u16* Q = (const u16*)(p.ws + OFF_DQ) + (size_t)(q0 + l32) * 256 + hd * 64 + ns * 32 + hh * 8;
    bf16x8 qf[2];
    qf[0] = *(const bf16x8*)Q; qf[1] = *(const bf16x8*)(Q + 16);
    attn_block<64, 32>((const u16*)(p.ws + OFF_DKB) + (size_t)keyrow0 * 256 + hd * 64, 256, (const u16*)(p.ws + OFF_DVT) + vt_off(b_all, hd, 4), nk, qf, ns * 32,
                       smem, tid, o, ls);
    float d1 = 0.f, d2 = 0.f;
    if (lane < 32) { d1 = p.in[I_LQ1][layer * 32 + lane] * p.in[I_LK1][layer * 32 + lane]; d2 = p.in[I_LQ2][layer * 32 + lane] * p.in[I_LK2][layer * 32 + lane]; }
    d1 = wave_sum(d1); d2 = wave_sum(d2);
    const float lam_init = layer == 0 ? 0.2f : (0.8f - 0.6f * 0.7408182206817179f);
    const float lam = expf(d1) - expf(d2) + lam_init;
    float* cmb = (float*)smem + qb * (64 * 33);
    if (ns == 1) {
      const float sc = lam / ls;
#pragma unroll
      for (int db = 0; db < 2; ++db)
#pragma unroll
        for (int r = 0; r < 16; ++r) cmb[(db * 32 + crow(r, hh)) * 33 + l32] = o[db][r] * sc;
    }
    __syncthreads();
    if (ns == 0) {
      const float i0 = 1.f / ls;
      float ss = 0.f;
#pragma unroll
      for (int db = 0; db < 2; ++db)
#pragma unroll
        for (int r = 0; r < 16; ++r) { float d = o[db][r] * i0 - cmb[(db * 32 + crow(r, hh)) * 33 + l32]; o[db][r] = d; ss += d * d; }
      ss += __shfl_xor(ss, 32);
      const float rr = rsqrtf(ss * (1.f / 64.f) + EPSF) * (1.f - lam_init);
      u16* dst = (u16*)(p.ws + OFF_MIXED) + (size_t)(q0 + l32) * 1024 + hd * 64;
#pragma unroll
      for (int db = 0; db < 2; ++db)
#pragma unroll
        for (int j = 0; j < 4; ++j) {
          const int dv = db * 32 + 8 * j + 4 * hh;
          f32x4 g = *(const f32x4*)(p.in[I_SUBLN] + layer * 64 + dv);
          f32x4 v = {o[db][4 * j] * rr * g[0], o[db][4 * j + 1] * rr * g[1], o[db][4 * j + 2] * rr * g[2], o[db][4 * j + 3] * rr * g[3]};
          *(u32x2*)(dst + dv) = pack4(v);
        }
    }
    __syncthreads();
  } else if (kind == 1) {
    const int q0 = tok0 + qblk * 128 + wave * 32;
    const u16* Q = (const u16*)(p.ws + OFF_GQ) + (size_t)(q0 + l32) * 256 + hd * 64 + hh * 8;
    bf16x8 qf[4];
#pragma unroll
    for (int s2 = 0; s2 < 4; ++s2) qf[s2] = *(const bf16x8*)(Q + s2 * 16);
    attn_block<64, 64>((const u16*)(p.ws + OFF_GKB) + (size_t)keyrow0 * 128 + (hd >> 1) * 64, 128, (const u16*)(p.ws + OFF_GVT) + vt_off(b_all, hd >> 1, 2), nk, qf, 0,
                       smem, tid, o, ls);
    store_o((u16*)(p.ws + OFF_MIXED) + (size_t)(q0 + l32) * 1024 + 256 + hd * 64, o, 1.f / ls, hh);
  } else {
    const int q0 = tok0 + qblk * 128 + wave * 32;
    const u16* Q = (const u16*)(p.ws + OFF_MQ) + (size_t)(q0 + l32) * 384 + hd * 96 + hh * 8;
    bf16x8 qf[6];
#pragma unroll
    for (int s2 = 0; s2 < 6; ++s2) qf[s2] = *(const bf16x8*)(Q + s2 * 16);
    attn_block<96, 96>((const u16*)(p.ws + OFF_MKB) + (size_t)keyrow0 * 384 + hd * 96, 384, (const u16*)(p.ws + OFF_MVT) + vt_off(b_all, hd, 4), nk, qf, 0,
                       smem, tid, o, ls);
    store_o((u16*)(p.ws + OFF_MIXED) + (size_t)(q0 + l32) * 1024 + 768 + hd * 64, o, 1.f / ls, hh);
  }
}

DI void phase_at(const P& p, int layer, char* smem) {
  const int tid = get_tid();
  constexpr int N_ITEMS = 1536;
  if (gridDim.x == 512) {
    const int b = blockIdx.x;
    attn_item(p, layer, b, smem, tid);
    __syncthreads();
    if (b < 256) {
      attn_item(p, layer, 512 + b, smem, tid); __syncthreads();
      attn_item(p, layer, 1024 + b, smem, tid); __syncthreads();
      attn_item(p, layer, 1280 + b, smem, tid); __syncthreads();
    } else if (b < 384) {
      attn_item(p, layer, 512 + 256 + 2 * (b - 256), smem, tid); __syncthreads();
      attn_item(p, layer, 512 + 256 + 2 * (b - 256) + 1, smem, tid); __syncthreads();
    }
  } else {
    for (int item = blockIdx.x; item < N_ITEMS; item += gridDim.x) {
      attn_item(p, layer, item, smem, tid);
      __syncthreads();
    }
  }
}

#define XB_TMO      128
#define XB_XCNT(j)  (256  + 64 * (j))
#define XB_XSUB(j)  (1280 + 64 * (j))
#define XB_XGEN(j)  (2304 + 64 * (j))
#define XB_TOP      3328
#define XB_TOPGEN   3392
#define XCD_BAR_WORDS 3456
#define XB_SPIN_CAP (1u << 22)
#define LAS __attribute__((address_space(3)))
DI unsigned xb_ld(unsigned* p) { return __hip_atomic_load(p, __ATOMIC_RELAXED, __HIP_MEMORY_SCOPE_AGENT); }
DI unsigned xb_add(unsigned* p, unsigned v) { return __hip_atomic_fetch_add(p, v, __ATOMIC_RELAXED, __HIP_MEMORY_SCOPE_AGENT); }
DI unsigned xb_xcc_id() { return (unsigned)__builtin_amdgcn_s_getreg((3 << 11) | 20) & 0xFu; }
#define XB_SPIN(cond, bar) do { unsigned _sp = 0; while (cond) { __builtin_amdgcn_s_sleep(1); \
    if ((++_sp & 255u) == 0u) { if (xb_ld(&(bar)[XB_TMO])) break; if (_sp > XB_SPIN_CAP) { atomicAdd(&(bar)[XB_TMO], 1u); break; } } } } while (0)
struct XcdBarrier { unsigned* bar; unsigned x; volatile LAS unsigned* st; };
DI XcdBarrier xcd_barrier_post(unsigned* bar, volatile LAS unsigned* st) {
  XcdBarrier b; b.bar = bar; b.x = xb_xcc_id(); b.st = st;
  if (threadIdx.x == 0) (void)xb_add(&bar[XB_XCNT(b.x)], 1u);
  return b;
}
DI void xcd_barrier_complete(unsigned* bar, unsigned x, unsigned& nloc, unsigned& nx) {
  const unsigned G = gridDim.x * gridDim.y * gridDim.z;
  unsigned sum, cnt, mine, sp = 0u;
  for (;;) {
    sum = 0u; cnt = 0u; mine = 0u;
#pragma unroll
    for (unsigned j = 0; j < 16; ++j) { const unsigned c = xb_ld(&bar[XB_XCNT(j)]); sum += c; cnt += (c > 0u) ? 1u : 0u; mine = (j == x) ? c : mine; }
    if (sum == G) break;
    __builtin_amdgcn_s_sleep(1);
    if ((++sp & 255u) == 0u) { if (xb_ld(&bar[XB_TMO])) break; if (sp > XB_SPIN_CAP) { atomicAdd(&bar[XB_TMO], 1u); break; } }
  }
  nloc = mine > 0u ? mine : 1u; nx = cnt > 0u ? cnt : 1u;
}
DI void xcd_barrier(const XcdBarrier& b) {
  asm volatile("s_waitcnt vmcnt(0)" ::: "memory");
  __syncthreads();
  if (threadIdx.x == 0) {
    unsigned* bar = b.bar;
    __builtin_amdgcn_s_waitcnt(0);
    unsigned nloc = b.st[0], nx = b.st[1];
    if (nloc == 0u) { xcd_barrier_complete(bar, b.x, nloc, nx); b.st[0] = nloc; b.st[1] = nx; }
    const unsigned old = xb_add(&bar[XB_XSUB(b.x)], 1u);
    const unsigned gen = old / nloc;
    if (old + 1u == (gen + 1u) * nloc) {
      __builtin_amdgcn_fence(__ATOMIC_RELEASE, "agent");
      asm volatile("s_waitcnt vmcnt(0)" ::: "memory");
      const unsigned og = xb_add(&bar[XB_TOP], 1u);
      const unsigned tg = og / nx;
      if (og + 1u == (tg + 1u) * nx) xb_add(&bar[XB_TOPGEN], 1u);
      else XB_SPIN(xb_ld(&bar[XB_TOPGEN]) == tg, bar);
      __builtin_amdgcn_fence(__ATOMIC_ACQUIRE, "agent");
      xb_add(&bar[XB_XGEN(b.x)], 1u);
      asm volatile("s_waitcnt vmcnt(0)" ::: "memory");
    } else {
      XB_SPIN(xb_ld(&bar[XB_XGEN(b.x)]) == gen, bar);
      __builtin_amdgcn_fence(__ATOMIC_ACQUIRE, "agent");
      asm volatile("s_waitcnt vmcnt(0)" ::: "memory");
    }
  }
  __syncthreads();
}

DI void run_phase(const P& p, int ph, int layer, char* smem) {
  switch (ph) {
    case 0: prologue(p, smem); break;
    case 1: norm_phase(p, layer, 0); break;
    case 2: phase_g1(p, layer, smem); break;
    case 3: phase_pp(p, layer, smem); break;
    case 4: phase_g2(p, layer, smem); break;
    case 5: phase_at(p, layer, smem); break;
    case 6: phase_resid(p, layer, smem, true); break;
    case 7: norm_phase(p, layer, 1); break;
    case 8: phase_g5(p, layer, smem); break;
    case 9: phase_resid(p, layer, smem, false); break;
    case 10: norm_phase(p, 0, 2); break;
  }
}

extern __shared__ __attribute__((aligned(16))) char dyn_smem[];

__global__ void __launch_bounds__(256, 2) fwd_mega(P p) {
  if (p.ws == nullptr) { cg::grid_group grid = cg::this_grid(); grid.sync(); }
  volatile LAS unsigned* st = (volatile LAS unsigned*)(dyn_smem + LDS_BYTES);
  if (threadIdx.x == 0) { st[0] = 0u; st[1] = 0u; st[2] = 0u; st[3] = 0u; }
  __syncthreads();
  XcdBarrier xb = xcd_barrier_post((unsigned*)(p.ws + OFF_BAR), st);
  run_phase(p, 0, 0, dyn_smem);
  xcd_barrier(xb);
  for (int l = 0; l < 2; ++l) {
    for (int ph = 1; ph <= 9; ++ph) {
      run_phase(p, ph, l, dyn_smem);
      xcd_barrier(xb);
    }
  }
  run_phase(p, 10, 0, dyn_smem);
}

#if !MEGA
__global__ void __launch_bounds__(256, 2) fwd_phase(P p, int ph, int layer) { run_phase(p, ph, layer, dyn_smem); }
#endif

extern "C" void kernel_launch(void* const* d_in, const int* in_sizes, int n_in, void* d_out, int out_size, void* d_ws, size_t ws_size,
                              hipStream_t stream) {
  static int grid_blocks = 0;
  if (!grid_blocks) {
    int dev = 0, cus = 0, per_cu = 0;
    (void)hipGetDevice(&dev);
    (void)hipDeviceGetAttribute(&cus, hipDeviceAttributeMultiprocessorCount, dev);
    (void)hipFuncSetAttribute((const void*)fwd_mega, hipFuncAttributeMaxDynamicSharedMemorySize, LDS_BYTES + 16);
#if !MEGA
    (void)hipFuncSetAttribute((const void*)fwd_phase, hipFuncAttributeMaxDynamicSharedMemorySize, LDS_BYTES);
#endif
    (void)hipOccupancyMaxActiveBlocksPerMultiprocessor(&per_cu, (const void*)fwd_mega, 256, LDS_BYTES + 16);
    if (per_cu < 1) per_cu = 1;
    if (per_cu > 2) per_cu = 2;
    grid_blocks = cus * per_cu;
    if (ws_size < WS_NEED) fprintf(stderr, "kernel_launch: workspace too small: %zu < %zu\n", ws_size, (size_t)WS_NEED);
  }
  P p{};
  for (int i = 0; i < N_IN; ++i) p.in[i] = (const float*)d_in[i];
  p.out = (float*)d_out;
  p.ws = (char*)d_ws;
#if MEGA
  (void)hipMemsetAsync((char*)d_ws + OFF_BAR, 0, XCD_BAR_WORDS * 4, stream);
  void* args[] = {&p};
  hipError_t e = hipLaunchCooperativeKernel((const void*)fwd_mega, dim3(grid_blocks), dim3(256), args, LDS_BYTES + 16, stream);
  if (e != hipSuccess) fprintf(stderr, "cooperative launch failed: %s (grid %d)\n", hipGetErrorString(e), grid_blocks);
#else
  hipLaunchKernelGGL(fwd_phase, dim3(grid_blocks), dim3(256), LDS_BYTES, stream, p, 0, 0);
  for (int l = 0; l < 2; ++l)
    for (int ph = 1; ph <= 9; ++ph) hipLaunchKernelGGL(fwd_phase, dim3(grid_blocks), dim3(256), LDS_BYTES, stream, p, ph, l);
  hipLaunchKernelGGL(fwd_phase, dim3(grid_blocks), dim3(256), LDS_BYTES, stream, p, 10, 0);
#endif
}
```

```cpp
#include <hip/hip_runtime.h>
#include <hip/hip_cooperative_groups.h>
#include <cstdio>
namespace cg = cooperative_groups;

#ifndef MEGA
#define MEGA 1
#endif

#define DI __device__ __forceinline__
typedef unsigned short u16;
typedef __attribute__((ext_vector_type(8))) short bf16x8;
typedef __attribute__((ext_vector_type(4))) short bf16x4;
typedef __attribute__((ext_vector_type(2))) __bf16 bf2_t;
typedef __attribute__((ext_vector_type(2))) float f32x2;
typedef __attribute__((ext_vector_type(4))) float f32x4;
typedef __attribute__((ext_vector_type(16))) float f32x16;
typedef __attribute__((ext_vector_type(4))) unsigned u32x4;
typedef __attribute__((ext_vector_type(2))) unsigned u32x2;

#define MFMA32(a, b, c) __builtin_amdgcn_mfma_f32_32x32x16_bf16((a), (b), (c), 0, 0, 0)
#define MFMA16(a, b, c) __builtin_amdgcn_mfma_f32_16x16x32_bf16((a), (b), (c), 0, 0, 0)

constexpr int NT = 12288;
constexpr int NCTX = 8192;
constexpr int NKR = 14336;
constexpr int NP = 1920;
constexpr float EPSF = 1e-6f;
constexpr float LOG2E = 1.4426950408889634f;

enum { I_XP = 0, I_XS, I_CDK, I_CDV, I_CGK, I_CGV, I_CCKV, I_CKR, I_SRE, I_SIM, I_C, I_CCTX, I_N1G, I_N2G, I_WADA, I_BADA,
       I_WIN, I_WOUT, I_LQ1, I_LK1, I_LQ2, I_LK2, I_SUBLN, I_QNG, I_KNG, I_ARE, I_AIM, I_LOGDT, I_BRE, I_BIM, I_CRE, I_CIM,
       I_SSMD, I_WGLU, I_MQNG, I_MKVNG, I_WUQ, I_WUKV, I_W1, I_W2, I_FNG, N_IN };

constexpr size_t O_Y = 0;
constexpr size_t O_DK = 12582912;
constexpr size_t O_DV = 16777216;
constexpr size_t O_GK = 20971520;
constexpr size_t O_GV = 23068672;
constexpr size_t O_CKV = 25165824;
constexpr size_t O_KR = 27262976;
constexpr size_t O_SRE = 27787264;
constexpr size_t O_SIM = 27918336;

constexpr size_t al256(size_t x) { return (x + 255) & ~(size_t)255; }
constexpr size_t OFF_MOD = 0;
constexpr size_t OFF_CTR = al256(OFF_MOD + 2 * 5 * 6144 * 4);
constexpr size_t OFF_BAR = al256(OFF_CTR + 256);
constexpr size_t OFF_ROPE = al256(OFF_BAR + 3456 * 4);
constexpr size_t OFF_ABAR = al256(OFF_ROPE + 2 * 64 * 16 * 8);
constexpr size_t OFF_ATAB = al256(OFF_ABAR + 64 * 64 * 8);
constexpr size_t OFF_CTAB = al256(OFF_ATAB + 64 * 128 * 16 * 2);
constexpr size_t OFF_WIN = al256(OFF_CTAB + 64 * 16 * 128 * 2);
constexpr size_t OFF_WOUT = al256(OFF_WIN + (size_t)2 * 1920 * 1024 * 2);
constexpr size_t OFF_W1 = al256(OFF_WOUT + (size_t)2 * 1024 * 1024 * 2);
constexpr size_t OFF_W2 = al256(OFF_W1 + (size_t)2 * 4096 * 1024 * 2);
constexpr size_t OFF_WUQ = al256(OFF_W2 + (size_t)2 * 4096 * 1024 * 2);
constexpr size_t OFF_WUKV = al256(OFF_WUQ + (size_t)2 * 384 * 192 * 2);
constexpr size_t OFF_WGLU = al256(OFF_WUKV + (size_t)2 * 512 * 128 * 2);
constexpr size_t OFF_H = al256(OFF_WGLU + (size_t)2 * 512 * 256 * 2);
constexpr size_t OFF_MIXED = OFF_H;
constexpr size_t OFF_BIG = al256(OFF_H + (size_t)NT * 1024 * 2);
constexpr size_t OFF_PROJ = OFF_BIG;
constexpr size_t OFF_DQ = al256(OFF_PROJ + (size_t)NT * NP * 4);
constexpr size_t OFF_DKB = al256(OFF_DQ + (size_t)NT * 256 * 2);
constexpr size_t OFF_DVT = al256(OFF_DKB + (size_t)NKR * 256 * 2);
constexpr size_t OFF_GQ = al256(OFF_DVT + (size_t)NKR * 256 * 2);
constexpr size_t OFF_GKB = al256(OFF_GQ + (size_t)NT * 256 * 2);
constexpr size_t OFF_GVT = al256(OFF_GKB + (size_t)NKR * 128 * 2);
constexpr size_t OFF_MQ = al256(OFF_GVT + (size_t)NKR * 128 * 2);
constexpr size_t OFF_MKB = al256(OFF_MQ + (size_t)NT * 384 * 2);
constexpr size_t OFF_MVT = al256(OFF_MKB + (size_t)NKR * 384 * 2);
constexpr size_t OFF_CQN = al256(OFF_MVT + (size_t)NKR * 256 * 2);
constexpr size_t OFF_CKVN = al256(OFF_CQN + (size_t)NT * 192 * 2);
constexpr size_t OFF_YBUF = al256(OFF_CKVN + (size_t)NKR * 128 * 2);
constexpr size_t OFF_END1 = al256(OFF_YBUF + (size_t)2 * NT * 256 * 4);
constexpr size_t OFF_A = OFF_BIG;
constexpr size_t OFF_END2 = al256(OFF_A + (size_t)NT * 4096 * 2);
constexpr size_t WS_NEED = OFF_END1 > OFF_END2 ? OFF_END1 : OFF_END2;
static_assert(WS_NEED <= (size_t)256 * 1024 * 1024, "workspace over 256 MiB");

constexpr int NTHR = 512;
constexpr int NWV = NTHR / 64;
constexpr int LDS_BYTES = 8 * 32 * 132 * 4;

struct P {
  const float* in[N_IN];
  float* out;
  char* ws;
};

DI unsigned pack2(float a, float b) { f32x2 v = {a, b}; return __builtin_bit_cast(unsigned, __builtin_convertvector(v, bf2_t)); }
DI u16 f2bf(float a) { return (u16)(pack2(a, 0.f) & 0xffffu); }
DI bf16x8 pack8(f32x4 a, f32x4 b) {
  u32x4 r = {pack2(a[0], a[1]), pack2(a[2], a[3]), pack2(b[0], b[1]), pack2(b[2], b[3])};
  return __builtin_bit_cast(bf16x8, r);
}
DI u32x2 pack4(f32x4 a) { u32x2 r = {pack2(a[0], a[1]), pack2(a[2], a[3])}; return r; }
DI int get_tid() { int t = threadIdx.x; asm volatile("" : "+v"(t)); return t; }
DI float fexp2(float x) { return __builtin_amdgcn_exp2f(x); }
DI float frcp(float x) { return __builtin_amdgcn_rcpf(x); }
DI float fsigmoid(float w) { return frcp(1.f + fexp2(-w * LOG2E)); }
DI float gelu_tanh(float x) { return x * fsigmoid(1.5957691216057308f * (x + 0.044715f * x * x * x)); }
DI float wave_sum(float v) {
#pragma unroll
  for (int o = 32; o >= 1; o >>= 1) v += __shfl_xor(v, o);
  return v;
}
DI void wave_lds_fence() {
  asm volatile("s_waitcnt lgkmcnt(0)" ::: "memory");
  __builtin_amdgcn_wave_barrier();
}
DI int fetch_item(int* ctr, int lane) {
  int v = 0;
  if (lane == 0) v = atomicAdd(ctr, 1);
  return __builtin_amdgcn_readfirstlane(v);
}
DI size_t vt_off(int b_all, int head, int H) {
  if (b_all < 32) return ((size_t)(b_all * H + head) * 64) * 256;
  return (size_t)32 * H * 64 * 256 + ((size_t)((b_all - 32) * H + head) * 64) * 1536;
}
DI int mod_index(int row) { return row < NCTX ? 0 : 1 + ((row - NCTX) >> 10); }

DI void prologue(const P& p, char* smem) {
  const int tid = get_tid();
  float* fs = (float*)smem;
  constexpr int N_ADA = 384, N_TAB = 64, N_MISC = 1, N_TR = 5700;
  constexpr int TOTAL = N_ADA + N_TAB + N_MISC;
  for (int it = blockIdx.x; it < TOTAL; it += gridDim.x) {
    if (it < N_ADA) {
      const int l = it / 192, ch = it % 192;
      float* sc = fs;
      float* red = fs + 5 * 1024;
      for (int i = tid; i < 5 * 1024; i += NTHR) {
        int m = i >> 10, k = i & 1023;
        float c = (m == 0) ? p.in[I_CCTX][k] : p.in[I_C][(m - 1) * 1024 + k];
        sc[i] = c * fsigmoid(c);
      }
      __syncthreads();
      const int col = tid & 31, kg = tid >> 5;
      const float* w = p.in[I_WADA] + ((size_t)l * 1024 + kg * 64) * 6144 + ch * 32 + col;
      float a0 = 0, a1 = 0, a2 = 0, a3 = 0, a4 = 0;
#pragma unroll 16
      for (int k = 0; k < 64; ++k) {
        float wv = w[(size_t)k * 6144];
        int kk = kg * 64 + k;
        a0 += sc[kk] * wv; a1 += sc[1024 + kk] * wv; a2 += sc[2048 + kk] * wv; a3 += sc[3072 + kk] * wv; a4 += sc[4096 + kk] * wv;
      }
      red[(kg * 5 + 0) * 32 + col] = a0; red[(kg * 5 + 1) * 32 + col] = a1; red[(kg * 5 + 2) * 32 + col] = a2;
      red[(kg * 5 + 3) * 32 + col] = a3; red[(kg * 5 + 4) * 32 + col] = a4;
      __syncthreads();
      if (tid < 160) {
        int m = tid >> 5, c2 = tid & 31;
        float s = 0;
#pragma unroll
        for (int g = 0; g < 16; ++g) s += red[(g * 5 + m) * 32 + c2];
        int n = ch * 32 + c2;
        s += p.in[I_BADA][l * 6144 + n];
        ((float*)(p.ws + OFF_MOD))[((size_t)l * 5 + m) * 6144 + n] = s;
      }
      __syncthreads();
    } else if (it < N_ADA + N_TAB) {
      const int idx = it - N_ADA;
      if (tid < 64) {
        const int pp = tid;
        float are = p.in[I_ARE][idx * 64 + pp], aim = p.in[I_AIM][idx * 64 + pp];
        float dt = expf(p.in[I_LOGDT][idx]);
        float zr = are * dt, zi = aim * dt;
        float e = expf(zr);
        float abr = e * cosf(zi), abi = e * sinf(zi);
        float d2 = are * are + aim * aim;
        float nr = abr - 1.f, ni = abi;
        float qr = (nr * are + ni * aim) / d2, qi = (ni * are - nr * aim) / d2;
        u16* at = (u16*)(p.ws + OFF_ATAB) + (size_t)idx * 128 * 16;
        u16* ct = (u16*)(p.ws + OFF_CTAB) + (size_t)idx * 16 * 128;
        for (int c = 0; c < 16; ++c) {
          float bre = p.in[I_BRE][((size_t)idx * 64 + pp) * 16 + c], bim = p.in[I_BIM][((size_t)idx * 64 + pp) * 16 + c];
          at[(2 * pp) * 16 + c] = f2bf(qr * bre - qi * bim);
          at[(2 * pp + 1) * 16 + c] = f2bf(qr * bim + qi * bre);
          float cre = p.in[I_CRE][((size_t)idx * 16 + c) * 64 + pp], cim = p.in[I_CIM][((size_t)idx * 16 + c) * 64 + pp];
          ct[c * 128 + 2 * pp] = f2bf(cre);
          ct[c * 128 + 2 * pp + 1] = f2bf(-cim);
        }
        float* ab = (float*)(p.ws + OFF_ABAR) + ((size_t)idx * 64 + pp) * 2;
        ab[0] = abr; ab[1] = abi;
      }
    } else if (it < N_ADA + N_TAB + N_MISC) {
      f32x2* tab = (f32x2*)(p.ws + OFF_ROPE);
      for (int i = tid; i < 2 * 64 * 16; i += NTHR) {
        int kind = i >> 10, pos = (i >> 4) & 63, fi = i & 15;
        int n = kind ? 16 : 8;
        float freq = expf(-(float)(fi % n) / (float)n * 9.210340371976184f);
        float ang = (float)pos * freq;
        f32x2 cs = {cosf(ang), sinf(ang)};
        tab[i] = cs;
      }
      if (tid < 64) ((int*)(p.ws + OFF_CTR))[tid] = 0;
    }
  }
  struct TrD { const float* src; u16* dst; int K, N, k0, n0; bool glu; };
  auto decode = [&](int tt) {
    TrD d; d.glu = false;
    const int l = tt / 2850;
    int r = tt % 2850; int kt, nt;
    if (r < 480) { d.src = p.in[I_WIN] + (size_t)l * 1024 * 1888; d.dst = (u16*)(p.ws + OFF_WIN) + (size_t)l * 1920 * 1024; d.K = 1024; d.N = 1888; kt = r / 30; nt = r % 30; }
    else if (r < 736) { r -= 480; d.src = p.in[I_WOUT] + (size_t)l * 1024 * 1024; d.dst = (u16*)(p.ws + OFF_WOUT) + (size_t)l * 1024 * 1024; d.K = 1024; d.N = 1024; kt = r / 16; nt = r % 16; }
    else if (r < 1760) { r -= 736; d.src = p.in[I_W1] + (size_t)l * 1024 * 4096; d.dst = (u16*)(p.ws + OFF_W1) + (size_t)l * 4096 * 1024; d.K = 1024; d.N = 4096; kt = r / 64; nt = r % 64; }
    else if (r < 2784) { r -= 1760; d.src = p.in[I_W2] + (size_t)l * 4096 * 1024; d.dst = (u16*)(p.ws + OFF_W2) + (size_t)l * 1024 * 4096; d.K = 4096; d.N = 1024; kt = r / 16; nt = r % 16; }
    else if (r < 2802) { r -= 2784; d.src = p.in[I_WUQ] + (size_t)l * 192 * 384; d.dst = (u16*)(p.ws + OFF_WUQ) + (size_t)l * 384 * 192; d.K = 192; d.N = 384; kt = r / 6; nt = r % 6; }
    else if (r < 2818) { r -= 2802; d.src = p.in[I_WUKV] + (size_t)l * 128 * 512; d.dst = (u16*)(p.ws + OFF_WUKV) + (size_t)l * 512 * 128; d.K = 128; d.N = 512; kt = r / 8; nt = r % 8; }
    else { r -= 2818; d.src = p.in[I_WGLU] + (size_t)l * 256 * 512; d.dst = (u16*)(p.ws + OFF_WGLU) + (size_t)l * 512 * 256; d.K = 256; d.N = 512; kt = r / 8; nt = r % 8; d.glu = true; }
    d.k0 = kt * 64; d.n0 = nt * 64;
    return d;
  };
  const int half = tid >> 8, t2 = tid & 255;
  float* ft = fs + half * (64 * 65);
  const int tx = t2 & 15, ty = t2 >> 4;
  auto tload = [&](const TrD& d, f32x4 (&v)[4]) {
#pragma unroll
    for (int i = 0; i < 4; ++i) {
      const int kk = ty + 16 * i, n = d.n0 + 4 * tx;
      f32x4 z = {0.f, 0.f, 0.f, 0.f};
      v[i] = (n < d.N) ? *(const f32x4*)(d.src + (size_t)(d.k0 + kk) * d.N + n) : z;
    }
  };
  const int nvb = 2 * (int)gridDim.x;
  const int tb = nvb - 1 - (2 * (int)blockIdx.x + half);
  const int nrounds = (N_TR + nvb - 1) / nvb;
  TrD cur = decode(tb < N_TR ? tb : 0);
  f32x4 cv[4];
  if (tb < N_TR) tload(cur, cv);
  for (int j = 0; j < nrounds; ++j) {
    const int tt = tb + j * nvb;
    const bool valid = tt < N_TR, more = tt + nvb < N_TR;
    TrD nxt = decode(more ? tt + nvb : 0);
    f32x4 nv[4];
    if (more) tload(nxt, nv);
    if (valid) {
#pragma unroll
      for (int i = 0; i < 4; ++i) {
        const int kk = ty + 16 * i;
        ft[kk * 65 + 4 * tx + 0] = cv[i][0]; ft[kk * 65 + 4 * tx + 1] = cv[i][1]; ft[kk * 65 + 4 * tx + 2] = cv[i][2]; ft[kk * 65 + 4 * tx + 3] = cv[i][3];
      }
    }
    __syncthreads();
    if (valid) {
#pragma unroll
      for (int i = 0; i < 2; ++i) {
        const int c = t2 + 256 * i, nn = c >> 3, kc = (c & 7) * 8;
        f32x4 a, b;
#pragma unroll
        for (int e = 0; e < 4; ++e) { a[e] = ft[(kc + e) * 65 + nn]; b[e] = ft[(kc + 4 + e) * 65 + nn]; }
        const int n = cur.n0 + nn;
        int drow = n;
        if (cur.glu) drow = (n < 256) ? ((n >> 5) * 64 + (n & 31)) : (((n - 256) >> 5) * 64 + 32 + (n & 31));
        *(bf16x8*)(cur.dst + (size_t)drow * cur.K + cur.k0 + kc) = pack8(a, b);
      }
    }
    __syncthreads();
    cur = nxt;
    if (more) {
#pragma unroll
      for (int i = 0; i < 4; ++i) cv[i] = nv[i];
    }
  }
}

DI const float* x_row_src(const P& p, int layer, int row) {
  if (layer == 0) return row < NCTX ? p.in[I_XP] + (size_t)row * 1024 : p.in[I_XS] + (size_t)(row - NCTX) * 1024;
  return p.out + (size_t)row * 1024;
}
DI void norm_phase(const P& p, int layer, int which) {
  const int tid_ = get_tid();
  const int lane = tid_ & 63;
  const int gw = blockIdx.x * NWV + (tid_ >> 6), nw = gridDim.x * NWV;
  auto src_of = [&](int row) { return (which == 0) ? x_row_src(p, layer, row) : (const float*)(p.out + (size_t)row * 1024); };
  f32x4 v[4];
  if (gw < NT) {
    const float* xs = src_of(gw);
#pragma unroll
    for (int i = 0; i < 4; ++i) v[i] = *(const f32x4*)(xs + (i * 64 + lane) * 4);
  }
  for (int row = gw; row < NT; row += nw) {
    f32x4 nv[4];
    const bool more = row + nw < NT;
    if (more) {
      const float* xs = src_of(row + nw);
#pragma unroll
      for (int i = 0; i < 4; ++i) nv[i] = *(const f32x4*)(xs + (i * 64 + lane) * 4);
    }
    float ss = 0;
#pragma unroll
    for (int i = 0; i < 4; ++i) ss += v[i][0] * v[i][0] + v[i][1] * v[i][1] + v[i][2] * v[i][2] + v[i][3] * v[i][3];
    ss = wave_sum(ss);
    const float r = rsqrtf(ss * (1.f / 1024.f) + EPSF);
    if (which == 2) {
      f32x4 g[4];
#pragma unroll
      for (int i = 0; i < 4; ++i) g[i] = *(const f32x4*)(p.in[I_FNG] + (i * 64 + lane) * 4);
#pragma unroll
      for (int i = 0; i < 4; ++i) {
        int e = (i * 64 + lane) * 4;
        f32x4 o = v[i] * r * g[i];
        *(f32x4*)(p.out + (size_t)row * 1024 + e) = o;
      }
    } else {
      const float* gn = p.in[which == 0 ? I_N1G : I_N2G] + layer * 1024;
      const float* md = (const float*)(p.ws + OFF_MOD) + ((size_t)layer * 5 + mod_index(row)) * 6144 + (which == 0 ? 0 : 3072);
      u16* h = (u16*)(p.ws + OFF_H) + (size_t)row * 1024;
      f32x4 g[4], sh[4], sc[4];
#pragma unroll
      for (int i = 0; i < 4; ++i) {
        int e = (i * 64 + lane) * 4;
        g[i] = *(const f32x4*)(gn + e);
        sh[i] = *(const f32x4*)(md + e);
        sc[i] = *(const f32x4*)(md + 1024 + e);
      }
      if (which == 0 && layer == 0) {
#pragma unroll
        for (int i = 0; i < 4; ++i) *(f32x4*)(p.out + (size_t)row * 1024 + (i * 64 + lane) * 4) = v[i];
      }
#pragma unroll
      for (int i = 0; i < 4; ++i) {
        int e = (i * 64 + lane) * 4;
        f32x4 o = v[i] * r * g[i] * (1.f + sc[i]) + sh[i];
        *(u32x2*)(h + e) = pack4(o);
      }
    }
    if (more) {
#pragma unroll
      for (int i = 0; i < 4; ++i) v[i] = nv[i];
    }
  }
}

#define LAS3 __attribute__((address_space(3)))
DI void stage_tile_dma(const u16* __restrict__ G, int ld, int row0, int k0, char* lds, int tid) {
#pragma unroll
  for (int i = 0; i < 4; ++i) {
    const int q = tid + NTHR * i, r = q >> 3, c = (q & 7) ^ ((r >> 1) & 7);
    __builtin_amdgcn_global_load_lds((const unsigned*)(G + (size_t)(row0 + r) * ld + k0 + c * 8), (LAS3 unsigned*)(lds + q * 16), 16, 0, 0);
  }
}
struct TD { const u16* A; const u16* B; int lda, ldb, k0, nk, m0, n0; };
DI void stage_td(const TD& d, int kt, char* stage_base, int tid) {
  stage_tile_dma(d.A, d.lda, d.m0, d.k0 + kt * 64, stage_base, tid);
  stage_tile_dma(d.B, d.ldb, d.n0, d.k0 + kt * 64, stage_base + 32768, tid);
}
DI void gemm_stream(const TD& cur, bool has_next, const TD& nxt, char* smem, int& buf, f32x16 (&acc)[4][2]) {
  const int tid = get_tid(), lane = tid & 63, wave = tid >> 6, wm = wave >> 2, wn = wave & 3, l32 = lane & 31, hh = lane >> 5;
#pragma unroll
  for (int bi = 0; bi < 4; ++bi)
#pragma unroll
    for (int bj = 0; bj < 2; ++bj)
#pragma unroll
      for (int r = 0; r < 16; ++r) acc[bi][bj][r] = 0.f;
  const int swz = (l32 >> 1) & 7;
  const int arow = (wm * 128 + l32) * 128, brow = (wn * 64 + l32) * 128;
  const int c0 = ((0 + hh) ^ swz) * 16, c1 = ((2 + hh) ^ swz) * 16, c2 = ((4 + hh) ^ swz) * 16, c3 = ((6 + hh) ^ swz) * 16;
  asm volatile("s_waitcnt vmcnt(0)" ::: "memory");
  __syncthreads();
  const int nk = cur.nk;
  for (int kt = 0; kt < nk; ++kt) {
    if (kt + 1 < nk) stage_td(cur, kt + 1, smem + (buf ^ 1) * 65536, tid);
    else if (has_next) stage_td(nxt, 0, smem + (buf ^ 1) * 65536, tid);
    const char* as = smem + buf * 65536 + arow;
    const char* bs = smem + buf * 65536 + 32768 + brow;
    bf16x8 fa[2][4], fb[2][2];
#pragma unroll
    for (int bi = 0; bi < 4; ++bi) fa[0][bi] = *(const bf16x8*)(as + bi * 4096 + c0);
#pragma unroll
    for (int bj = 0; bj < 2; ++bj) fb[0][bj] = *(const bf16x8*)(bs + bj * 4096 + c0);
#pragma unroll
    for (int ks = 0; ks < 4; ++ks) {
      const int cb = ks & 1, nb = cb ^ 1;
      if (ks < 3) {
        const int co = (ks == 0) ? c1 : (ks == 1) ? c2 : c3;
#pragma unroll
        for (int bi = 0; bi < 4; ++bi) fa[nb][bi] = *(const bf16x8*)(as + bi * 4096 + co);
#pragma unroll
        for (int bj = 0; bj < 2; ++bj) fb[nb][bj] = *(const bf16x8*)(bs + bj * 4096 + co);
      }
      __builtin_amdgcn_s_setprio(1);
#pragma unroll
      for (int bi = 0; bi < 4; ++bi)
#pragma unroll
        for (int bj = 0; bj < 2; ++bj) acc[bi][bj] = MFMA32(fa[cb][bi], fb[cb][bj], acc[bi][bj]);
      __builtin_amdgcn_s_setprio(0);
    }
    buf ^= 1;
    if (kt + 1 < nk) {
      asm volatile("s_waitcnt vmcnt(0)" ::: "memory");
      __syncthreads();
    }
  }
}

#define EPI_IDX                                                                                        \
  const int tid = get_tid(), lane = tid & 63, wave = tid >> 6, wm = wave >> 2, wn = wave & 3, l32 = lane & 31, hh = lane >> 5; \
  (void)tid; (void)lane; (void)wave; (void)wm; (void)wn; (void)l32; (void)hh;
DI int crow(int r, int hh) { return (r & 3) + 8 * (r >> 2) + 4 * hh; }

DI void phase_g1(const P& p, int layer, char* smem) {
  EPI_IDX
  const u16* A = (const u16*)(p.ws + OFF_H);
  const u16* Bt = (const u16*)(p.ws + OFF_WIN) + (size_t)layer * 1920 * 1024;
  float* proj = (float*)(p.ws + OFF_PROJ);
  constexpr int MT = NT / 256, NTL = 8, MPX = MT / 8;
  const int xcd_ = blockIdx.x & 7, xj_ = blockIdx.x >> 3, xn_ = gridDim.x >> 3;
  auto tile_at = [&](int u) { TD d; d.A = A; d.B = Bt; d.lda = 1024; d.ldb = 1024; d.k0 = 0; d.nk = 16; d.m0 = (xcd_ * MPX + u % MPX) * 256; d.n0 = (u / MPX) * 256; return d; };
  int buf = 0;
  TD cur = tile_at(xj_ < MPX * NTL ? xj_ : 0);
  if (xj_ < MPX * NTL) stage_td(cur, 0, smem, tid);
  for (int u = xj_; u < MPX * NTL; u += xn_) {
    const bool has_next = (u + xn_ < MPX * NTL);
    const TD nxt = tile_at(has_next ? u + xn_ : u);
    const int m0 = cur.m0, n0 = cur.n0;
    f32x16 acc[4][2];
    gemm_stream(cur, has_next, nxt, smem, buf, acc);
    cur = nxt;
    const bool lat = m0 >= NCTX;
    const int b_all = lat ? 32 + ((m0 - NCTX) >> 10) : (m0 >> 8);
    const int nkk = lat ? 1536 : 256;
#pragma unroll
    for (int bi = 0; bi < 4; ++bi)
#pragma unroll
      for (int bj = 0; bj < 2; ++bj) {
        const int rb = m0 + wm * 128 + bi * 32;
        const int cb = n0 + wn * 64 + bj * 32;
        const int col = cb + l32;
        if (cb < NP) {
#pragma unroll
          for (int r = 0; r < 16; ++r) proj[(size_t)(rb + crow(r, hh)) * NP + col] = acc[bi][bj][r];
        }
        const bool isdv = (cb >= 512 && cb < 768), isgv = (cb >= 1152 && cb < 1280);
        if (isdv || isgv) {
          u16* vt; int f;
          if (isdv) { f = col - 512; vt = (u16*)(p.ws + OFF_DVT) + vt_off(b_all, f >> 6, 4); }
          else { f = col - 1152; vt = (u16*)(p.ws + OFF_GVT) + vt_off(b_all, f >> 6, 2); }
          vt += (size_t)(f & 63) * nkk;
#pragma unroll
          for (int j = 0; j < 4; ++j) {
            int row = rb + 16 * (j >> 1) + 8 * hh + 4 * (j & 1);
            int key = lat ? 512 + ((row - NCTX) & 1023) : (row & 255);
            f32x4 v = {acc[bi][bj][4 * j], acc[bi][bj][4 * j + 1], acc[bi][bj][4 * j + 2], acc[bi][bj][4 * j + 3]};
            *(u32x2*)(vt + key) = pack4(v);
          }
        }
      }
  }
}

DI void phase_g2(const P& p, int layer, char* smem) {
  EPI_IDX
  constexpr int T_MQ = (NT / 256) * 2, T_MKV = (NKR / 256) * 2;
  const f32x2* tab32 = (const f32x2*)(p.ws + OFF_ROPE);
  auto tile_at = [&](int t) {
    TD d; d.k0 = 0;
    if (t < T_MQ) { d.A = (const u16*)(p.ws + OFF_CQN); d.B = (const u16*)(p.ws + OFF_WUQ) + (size_t)layer * 384 * 192; d.lda = 192; d.ldb = 192; d.nk = 3; d.m0 = (t >> 1) * 256; d.n0 = (t & 1) * 256; }
    else { const int t2 = t - T_MQ; d.A = (const u16*)(p.ws + OFF_CKVN); d.B = (const u16*)(p.ws + OFF_WUKV) + (size_t)layer * 512 * 128; d.lda = 128; d.ldb = 128; d.nk = 2; d.m0 = (t2 >> 1) * 256; d.n0 = (t2 & 1) * 256; }
    return d;
  };
  int buf = 0;
  const int t_first = blockIdx.x;
  TD cur = tile_at(t_first < T_MQ + T_MKV ? t_first : 0);
  if (t_first < T_MQ + T_MKV) stage_td(cur, 0, smem, tid);
  for (int t = blockIdx.x; t < T_MQ + T_MKV; t += gridDim.x) {
    const bool has_next = (t + (int)gridDim.x < T_MQ + T_MKV);
    const TD nxt = tile_at(has_next ? t + (int)gridDim.x : t);
    f32x16 acc[4][2];
    const int m0 = cur.m0, n0 = cur.n0;
    gemm_stream(cur, has_next, nxt, smem, buf, acc);
    cur = nxt;
    if (t < T_MQ) {
      const bool lat = m0 >= NCTX;
      const float scl = 0.10206207261596575f * LOG2E;
      u16* mq = (u16*)(p.ws + OFF_MQ);
#pragma unroll
      for (int bi = 0; bi < 4; ++bi)
#pragma unroll
        for (int bj = 0; bj < 2; ++bj) {
          const int rb = m0 + wm * 128 + bi * 32;
          const int cb = n0 + wn * 64 + bj * 32;
          const int col = cb + l32;
          if (cb < 384) {
            const bool isrope = lat && ((cb % 96) == 64);
            const int e = l32, w2 = e & 15, fi = w2 & 7;
            const bool isx2 = w2 >= 8, half = e >= 16;
#pragma unroll
            for (int r = 0; r < 16; ++r) {
              float v = acc[bi][bj][r];
              const int row = rb + crow(r, hh);
              if (isrope) {
                const int tt = (row - NCTX) & 1023;
                const int pos = half ? (tt & 63) : (tt >> 6);
                const f32x2 cs = tab32[pos * 16 + fi];
                float pv = __shfl_xor(v, 8);
                v = v * cs[0] + (isx2 ? pv : -pv) * cs[1];
              }
              mq[(size_t)row * 384 + col] = f2bf(v * scl);
            }
          }
        }
    } else {
      const bool lat = m0 >= NCTX;
      const int b_all = lat ? 32 + (m0 - NCTX) / 1536 : (m0 >> 8);
      const int nkk = lat ? 1536 : 256;
      const int kbase = lat ? (m0 - NCTX) % 1536 : (m0 & 255);
      u16* mk = (u16*)(p.ws + OFF_MKB);
#pragma unroll
      for (int bi = 0; bi < 4; ++bi)
#pragma unroll
        for (int bj = 0; bj < 2; ++bj) {
          const int rloc = wm * 128 + bi * 32;
          const int cb = n0 + wn * 64 + bj * 32;
          const int head = cb >> 7, wc = (cb & 127) + l32;
          if ((cb & 127) < 64) {
#pragma unroll
            for (int r = 0; r < 16; ++r) mk[(size_t)(m0 + rloc + crow(r, hh)) * 384 + head * 96 + wc] = f2bf(acc[bi][bj][r]);
          } else {
            u16* vt = (u16*)(p.ws + OFF_MVT) + vt_off(b_all, head, 4) + (size_t)(wc - 64) * nkk + kbase + rloc;
#pragma unroll
            for (int j = 0; j < 4; ++j) {
              f32x4 v = {acc[bi][bj][4 * j], acc[bi][bj][4 * j + 1], acc[bi][bj][4 * j + 2], acc[bi][bj][4 * j + 3]};
              *(u32x2*)(vt + 16 * (j >> 1) + 8 * hh + 4 * (j & 1)) = pack4(v);
            }
          }
        }
    }
  }
  {
    const int gw = blockIdx.x * NWV + wave, nw = gridDim.x * NWV;
    const f32x4 dd = *(const f32x4*)(p.in[I_SSMD] + layer * 256 + lane * 4);
    for (int row = gw; row < NT; row += nw) {
      const float* y0 = (const float*)(p.ws + OFF_YBUF) + (size_t)row * 256 + lane * 4;
      float* prow = (float*)(p.ws + OFF_PROJ) + (size_t)row * NP;
      f32x4 a = *(const f32x4*)y0, b = *(const f32x4*)(y0 + (size_t)NT * 256), c = *(const f32x4*)(prow + 1280 + lane * 4);
      f32x4 sv = a + b + c * dd;
      f32x4 g = {gelu_tanh(sv[0]), gelu_tanh(sv[1]), gelu_tanh(sv[2]), gelu_tanh(sv[3])};
      *(u32x2*)((u16*)prow + lane * 4) = pack4(g);
    }
  }
}

DI void phase_resid(const P& p, int layer, char* smem, bool is_out) {
  EPI_IDX
  const u16* A = is_out ? (const u16*)(p.ws + OFF_MIXED) : (const u16*)(p.ws + OFF_A);
  const int K = is_out ? 1024 : 4096;
  const u16* Bt = is_out ? (const u16*)(p.ws + OFF_WOUT) + (size_t)layer * 1024 * 1024 : (const u16*)(p.ws + OFF_W2) + (size_t)layer * 1024 * 4096;
  constexpr int MT = NT / 256, NTL = 4, MPX = MT / 8, NU = MPX * NTL;
  const int xcd_ = blockIdx.x & 7, xj_ = blockIdx.x >> 3, xn_ = gridDim.x >> 3;
  auto tile_at = [&](int u) {
    TD d; d.A = A; d.B = Bt; d.lda = K; d.ldb = K; d.nk = K / 64; d.k0 = 0;
    d.n0 = (u % NTL) * 256;
    d.m0 = (xcd_ * MPX + u / NTL) * 256;
    return d;
  };
  int buf = 0;
  TD cur = tile_at(xj_ < NU ? xj_ : 0);
  if (xj_ < NU) stage_td(cur, 0, smem, tid);
  for (int u = xj_; u < NU; u += xn_) {
    const bool has_next = (u + xn_ < NU);
    const TD nxt = tile_at(has_next ? u + xn_ : u);
    const int m0 = cur.m0, n0 = cur.n0;
    f32x16 acc[4][2];
    gemm_stream(cur, has_next, nxt, smem, buf, acc);
    cur = nxt;
    const float* gate = (const float*)(p.ws + OFF_MOD) + ((size_t)layer * 5 + mod_index(m0)) * 6144 + (is_out ? 2048 : 5120);
#pragma unroll
    for (int bi = 0; bi < 4; ++bi)
#pragma unroll
      for (int bj = 0; bj < 2; ++bj) {
        const int rb = m0 + wm * 128 + bi * 32;
        const int col = n0 + wn * 64 + bj * 32 + l32;
        const float g = gate[col];
        float rv[16];
#pragma unroll
        for (int r = 0; r < 16; ++r) rv[r] = p.out[(size_t)(rb + crow(r, hh)) * 1024 + col];
#pragma unroll
        for (int r = 0; r < 16; ++r) p.out[(size_t)(rb + crow(r, hh)) * 1024 + col] = rv[r] + g * acc[bi][bj][r];
      }
  }
}

DI void phase_g5(const P& p, int layer, char* smem) {
  EPI_IDX
  const u16* A = (const u16*)(p.ws + OFF_H);
  const u16* Bt = (const u16*)(p.ws + OFF_W1) + (size_t)layer * 4096 * 1024;
  u16* a = (u16*)(p.ws + OFF_A);
  constexpr int MT = NT / 256, NTL = 16, MPX = MT / 8;
  const int xcd_ = blockIdx.x & 7, xj_ = blockIdx.x >> 3, xn_ = gridDim.x >> 3;
  auto tile_at = [&](int u) { TD d; d.A = A; d.B = Bt; d.lda = 1024; d.ldb = 1024; d.k0 = 0; d.nk = 16; d.m0 = (xcd_ * MPX + u % MPX) * 256; d.n0 = (u / MPX) * 256; return d; };
  int buf = 0;
  TD cur = tile_at(xj_ < MPX * NTL ? xj_ : 0);
  if (xj_ < MPX * NTL) stage_td(cur, 0, smem, tid);
  for (int u = xj_; u < MPX * NTL; u += xn_) {
    const bool has_next = (u + xn_ < MPX * NTL);
    const TD nxt = tile_at(has_next ? u + xn_ : u);
    const int m0 = cur.m0, n0 = cur.n0;
    f32x16 acc[4][2];
    gemm_stream(cur, has_next, nxt, smem, buf, acc);
    cur = nxt;
#pragma unroll
    for (int bi = 0; bi < 4; ++bi)
#pragma unroll
      for (int bj = 0; bj < 2; ++bj) {
        const int rb = m0 + wm * 128 + bi * 32;
        const int col = n0 + wn * 64 + bj * 32 + l32;
#pragma unroll
        for (int r = 0; r < 16; ++r) {
          float v = fmaxf(acc[bi][bj][r], 0.f);
          a[(size_t)(rb + crow(r, hh)) * 4096 + col] = f2bf(v * v);
        }
      }
  }
}

template <int R>
DI f32x4 rope4(f32x4 v, int lane, int t, const f32x2* tab) {
  constexpr int n = R / 4;
  const int e = (lane * 4) % R;
  const int half = e / (R / 2), w = e % (R / 2);
  const bool isx2 = w >= n;
  const int fi = w % n;
  const int pos = half ? (t & 63) : (t >> 6);
  f32x4 o;
#pragma unroll
  for (int i = 0; i < 4; ++i) {
    float pv = __shfl_xor(v[i], n / 4);
    f32x2 cs = tab[pos * 16 + fi + i];
    o[i] = v[i] * cs[0] + (isx2 ? pv : -pv) * cs[1];
  }
  return o;
}

DI void ssm_item(const P& p, int layer, int item, float* lds, int lane) {
  int b_all, r;
  if (item < 128) { b_all = 32 + item / 32; r = item % 32; } else { int it = item - 128; b_all = it / 32; r = it % 32; }
  const int dir = r >> 4, g = r & 15;
  const bool lat = b_all >= 32;
  const int T = lat ? 1024 : 256;
  const int row0 = lat ? NCTX + (b_all - 32) * 1024 : b_all * 256;
  const int tabidx = (layer * 2 + dir) * 16 + g;
  const int l32 = lane & 31, hh = lane >> 5, l16 = lane & 15, q4 = lane >> 4;
  const u16* atab = (const u16*)(p.ws + OFF_ATAB) + (size_t)tabidx * 128 * 16;
  const u16* ctab = (const u16*)(p.ws + OFF_CTAB) + (size_t)tabidx * 16 * 128;
  bf16x8 af[4], cf[4];
#pragma unroll
  for (int blk = 0; blk < 4; ++blk) af[blk] = *(const bf16x8*)(atab + (blk * 32 + l32) * 16 + hh * 8);
#pragma unroll
  for (int kk = 0; kk < 4; ++kk) cf[kk] = *(const bf16x8*)(ctab + l16 * 128 + kk * 32 + q4 * 8);
  const float* ab = (const float*)(p.ws + OFF_ABAR) + ((size_t)tabidx * 64 + lane) * 2;
  const float ar = ab[0], ai = ab[1];
  float hr = 0.f, hi = 0.f;
  if (lat) {
    size_t idx = ((size_t)((b_all - 32) * 2 + layer) * 2 + dir) * 1024 + g * 64 + lane;
    hr = p.in[I_SRE][idx]; hi = p.in[I_SIM][idx];
  }
  const float* proj = (const float*)(p.ws + OFF_PROJ);
  float* ybuf = (float*)(p.ws + OFF_YBUF) + (size_t)dir * NT * 256;
  f32x16 zero16;
#pragma unroll
  for (int i = 0; i < 16; ++i) zero16[i] = 0.f;
  f32x4 u0, u1;
  {
    const int t = dir ? (T - 1 - l32) : l32;
    const float* up = proj + (size_t)(row0 + t) * NP + 1280 + g * 16 + hh * 8;
    u0 = *(const f32x4*)up; u1 = *(const f32x4*)(up + 4);
  }
  for (int ch = 0; ch < T / 32; ++ch) {
    {
      bf16x8 uf = pack8(u0, u1);
      if (ch + 1 < T / 32) {
        const int n = (ch + 1) * 32 + l32;
        const int t = dir ? (T - 1 - n) : n;
        const float* up = proj + (size_t)(row0 + t) * NP + 1280 + g * 16 + hh * 8;
        u0 = *(const f32x4*)up; u1 = *(const f32x4*)(up + 4);
      }
#pragma unroll
      for (int blk = 0; blk < 4; ++blk) {
        f32x16 d = MFMA32(af[blk], uf, zero16);
#pragma unroll
        for (int j = 0; j < 4; ++j) {
          f32x4 v = {d[4 * j], d[4 * j + 1], d[4 * j + 2], d[4 * j + 3]};
          *(f32x4*)(lds + l32 * 132 + blk * 32 + 8 * j + 4 * hh) = v;
        }
      }
    }
    wave_lds_fence();
#pragma unroll
    for (int s = 0; s < 32; ++s) {
      f32x2 bu = *(const f32x2*)(lds + s * 132 + 2 * lane);
      float nr = ar * hr - ai * hi + bu[0];
      float ni = ar * hi + ai * hr + bu[1];
      hr = nr; hi = ni;
      f32x2 hv = {hr, hi};
      *(f32x2*)(lds + s * 132 + 2 * lane) = hv;
    }
    wave_lds_fence();
#pragma unroll
    for (int tb = 0; tb < 2; ++tb) {
      f32x4 y = {0.f, 0.f, 0.f, 0.f};
#pragma unroll
      for (int kk = 0; kk < 4; ++kk) {
        const float* hp = lds + (tb * 16 + l16) * 132 + kk * 32 + q4 * 8;
        f32x4 a0 = *(const f32x4*)hp, a1 = *(const f32x4*)(hp + 4);
        y = MFMA16(cf[kk], pack8(a0, a1), y);
      }
      const int n2 = ch * 32 + tb * 16 + l16;
      const int t2 = dir ? (T - 1 - n2) : n2;
      *(f32x4*)(ybuf + (size_t)(row0 + t2) * 256 + g * 16 + q4 * 4) = y;
    }
    wave_lds_fence();
  }
  if (!lat) {
    size_t idx = ((size_t)(b_all * 2 + layer) * 2 + dir) * 1024 + g * 64 + lane;
    p.out[O_SRE + idx] = hr;
    p.out[O_SIM + idx] = hi;
  }
}

DI void pp_row(const P& p, int layer, int row, int lane) {
  const float* pr = (const float*)(p.ws + OFF_PROJ) + (size_t)row * NP;
  const bool lat = row >= NCTX;
  int b, t, keyrow;
  if (!lat) { b = row >> 8; t = row & 255; keyrow = row; }
  else { int rr = row - NCTX; b = rr >> 10; t = rr & 1023; keyrow = NCTX + b * 1536 + 512 + t; }
  const f32x2* tab32 = (const f32x2*)(p.ws + OFF_ROPE);
  const f32x2* tab64 = tab32 + 64 * 16;
  const size_t orow = (size_t)(b * 2 + layer) * 256 + t;
  const f32x4 z4 = {0.f, 0.f, 0.f, 0.f};
  f32x4 v_dq = *(const f32x4*)(pr + lane * 4);
  f32x4 v_dk = *(const f32x4*)(pr + 256 + lane * 4);
  f32x4 v_dv = *(const f32x4*)(pr + 512 + lane * 4);
  f32x4 v_gq = *(const f32x4*)(pr + 768 + lane * 4);
  f32x4 v_gk = lane < 32 ? *(const f32x4*)(pr + 1024 + lane * 4) : z4;
  f32x4 v_gv = lane < 32 ? *(const f32x4*)(pr + 1152 + lane * 4) : z4;
  f32x4 v_cq = lane < 48 ? *(const f32x4*)(pr + 1536 + lane * 4) : z4;
  f32x4 v_ckv = lane < 32 ? *(const f32x4*)(pr + 1728 + lane * 4) : z4;
  f32x4 v_kr = lane < 8 ? *(const f32x4*)(pr + 1856 + lane * 4) : z4;
  const f32x4 g_q = *(const f32x4*)(p.in[I_QNG] + layer * 64 + (lane & 15) * 4);
  const f32x4 g_k = *(const f32x4*)(p.in[I_KNG] + layer * 64 + (lane & 15) * 4);
  const f32x4 g_cq = lane < 48 ? *(const f32x4*)(p.in[I_MQNG] + layer * 192 + lane * 4) : z4;
  const f32x4 g_ckv = lane < 32 ? *(const f32x4*)(p.in[I_MKVNG] + layer * 128 + lane * 4) : z4;
  f32x2 cs32[4], cs64[4];
  {
    const int e32 = (lane * 4) & 31, w32 = e32 & 15, p32 = (e32 >> 4) ? (t & 63) : (t >> 6), f32i = w32 & 7;
    const int e64 = (lane * 4) & 63, w64 = e64 & 31, p64 = (e64 >> 5) ? (t & 63) : (t >> 6), f64i = w64 & 15;
    const f32x2 one = {1.f, 0.f};
#pragma unroll
    for (int i = 0; i < 4; ++i) {
      cs32[i] = lat ? tab32[p32 * 16 + f32i + i] : one;
      cs64[i] = lat ? tab64[p64 * 16 + f64i + i] : one;
    }
  }
  const bool x2_32 = ((lane * 4) & 15) >= 8, x2_64 = ((lane * 4) & 31) >= 16;
  auto rope32 = [&](f32x4 v) {
    f32x4 o;
#pragma unroll
    for (int i = 0; i < 4; ++i) { float pv = __shfl_xor(v[i], 2); o[i] = v[i] * cs32[i][0] + (x2_32 ? pv : -pv) * cs32[i][1]; }
    return o;
  };
  auto rope64 = [&](f32x4 v) {
    f32x4 o;
#pragma unroll
    for (int i = 0; i < 4; ++i) { float pv = __shfl_xor(v[i], 4); o[i] = v[i] * cs64[i][0] + (x2_64 ? pv : -pv) * cs64[i][1]; }
    return o;
  };
  if (!lat) {
    *(f32x4*)(p.out + O_DK + orow * 256 + lane * 4) = v_dk;
    *(f32x4*)(p.out + O_DV + orow * 256 + lane * 4) = v_dv;
    if (lane < 32) *(f32x4*)(p.out + O_GV + orow * 128 + lane * 4) = v_gv;
    if (lane < 8) *(f32x4*)(p.out + O_KR + orow * 32 + lane * 4) = v_kr;
  }
  {
    f32x4 v = v_dq;
    if (lat) v = rope32(v);
    v = v * (0.17677669529663687f * LOG2E);
    *(u32x2*)((u16*)(p.ws + OFF_DQ) + (size_t)row * 256 + lane * 4) = pack4(v);
  }
  {
    f32x4 v = v_dk;
    if (lat) v = rope32(v);
    *(u32x2*)((u16*)(p.ws + OFF_DKB) + (size_t)keyrow * 256 + lane * 4) = pack4(v);
  }
  {
    f32x4 v = v_gq;
    float ss = v[0] * v[0] + v[1] * v[1] + v[2] * v[2] + v[3] * v[3];
    ss += __shfl_xor(ss, 1); ss += __shfl_xor(ss, 2); ss += __shfl_xor(ss, 4); ss += __shfl_xor(ss, 8);
    float r = rsqrtf(ss * (1.f / 64.f) + EPSF);
    v = v * r * g_q;
    if (lat) v = rope64(v);
    v = v * (0.125f * LOG2E);
    *(u32x2*)((u16*)(p.ws + OFF_GQ) + (size_t)row * 256 + lane * 4) = pack4(v);
  }
  {
    f32x4 v = v_gk;
    float ss = v[0] * v[0] + v[1] * v[1] + v[2] * v[2] + v[3] * v[3];
    ss += __shfl_xor(ss, 1); ss += __shfl_xor(ss, 2); ss += __shfl_xor(ss, 4); ss += __shfl_xor(ss, 8);
    float r = rsqrtf(ss * (1.f / 64.f) + EPSF);
    v = v * r * g_k;
    if (!lat) { if (lane < 32) *(f32x4*)(p.out + O_GK + orow * 128 + lane * 4) = v; }
    else v = rope64(v);
    if (lane < 32) *(u32x2*)((u16*)(p.ws + OFF_GKB) + (size_t)keyrow * 128 + lane * 4) = pack4(v);
  }
  {
    f32x4 v = v_cq;
    float ss = wave_sum(v[0] * v[0] + v[1] * v[1] + v[2] * v[2] + v[3] * v[3]);
    float r = rsqrtf(ss * (1.f / 192.f) + EPSF);
    v = v * r * g_cq;
    if (lane < 48) *(u32x2*)((u16*)(p.ws + OFF_CQN) + (size_t)row * 192 + lane * 4) = pack4(v);
  }
  {
    f32x4 v = v_ckv;
    float ss = wave_sum(v[0] * v[0] + v[1] * v[1] + v[2] * v[2] + v[3] * v[3]);
    float r = rsqrtf(ss * (1.f / 128.f) + EPSF);
    v = v * r * g_ckv;
    if (lane < 32) {
      if (!lat) *(f32x4*)(p.out + O_CKV + orow * 128 + lane * 4) = v;
      *(u32x2*)((u16*)(p.ws + OFF_CKVN) + (size_t)keyrow * 128 + lane * 4) = pack4(v);
    }
  }
  {
    f32x4 v = v_kr;
    if (lat) v = rope32(v);
    if (lane < 8) {
      u32x2 pk = pack4(v);
      u16* mk = (u16*)(p.ws + OFF_MKB) + (size_t)keyrow * 384 + 64 + lane * 4;
#pragma unroll
      for (int hd = 0; hd < 4; ++hd) *(u32x2*)(mk + hd * 96) = pk;
    }
  }
}

DI void pp_cached(const P& p, int layer, int crow_, int lane) {
  const int b = crow_ >> 9, j = crow_ & 511;
  const int keyrow = NCTX + b * 1536 + j;
  const size_t src = (size_t)(b * 2 + layer) * 512 + j;
  const int jp = (j & ~15) | (((j >> 2) & 1) << 3) | (((j >> 3) & 1) << 2) | (j & 3);
  const f32x4 z4 = {0.f, 0.f, 0.f, 0.f};
  const int l31 = lane & 31, l7 = lane & 7;
  f32x4 v_dk = *(const f32x4*)(p.in[I_CDK] + src * 256 + lane * 4);
  f32x4 v_dv = *(const f32x4*)(p.in[I_CDV] + src * 256 + lane * 4);
  f32x4 v_gk = *(const f32x4*)(p.in[I_CGK] + src * 128 + l31 * 4);
  f32x4 v_gv = *(const f32x4*)(p.in[I_CGV] + src * 128 + l31 * 4);
  f32x4 v_ckv = *(const f32x4*)(p.in[I_CCKV] + src * 128 + l31 * 4);
  f32x4 v_kr = *(const f32x4*)(p.in[I_CKR] + src * 32 + l7 * 4);
  (void)z4;
  *(u32x2*)((u16*)(p.ws + OFF_DKB) + (size_t)keyrow * 256 + lane * 4) = pack4(v_dk);
  {
    u16* vt = (u16*)(p.ws + OFF_DVT) + vt_off(32 + b, lane >> 4, 4) + (size_t)((lane & 15) * 4) * 1536 + jp;
#pragma unroll
    for (int i = 0; i < 4; ++i) vt[(size_t)i * 1536] = f2bf(v_dv[i]);
  }
  if (lane < 32) {
    *(u32x2*)((u16*)(p.ws + OFF_GKB) + (size_t)keyrow * 128 + lane * 4) = pack4(v_gk);
    u16* vt = (u16*)(p.ws + OFF_GVT) + vt_off(32 + b, lane >> 4, 2) + (size_t)((lane & 15) * 4) * 1536 + jp;
#pragma unroll
    for (int i = 0; i < 4; ++i) vt[(size_t)i * 1536] = f2bf(v_gv[i]);
    *(u32x2*)((u16*)(p.ws + OFF_CKVN) + (size_t)keyrow * 128 + lane * 4) = pack4(v_ckv);
  }
  if (lane < 8) {
    u32x2 pk = pack4(v_kr);
    u16* mk = (u16*)(p.ws + OFF_MKB) + (size_t)keyrow * 384 + 64 + lane * 4;
#pragma unroll
    for (int hd = 0; hd < 4; ++hd) *(u32x2*)(mk + hd * 96) = pk;
  }
}

DI void phase_pp(const P& p, int layer, char* smem) {
  const int tid_ = get_tid();
  const int lane = tid_ & 63, wave = tid_ >> 6;
  float* lds = (float*)smem + wave * (32 * 132);
  const int gw = blockIdx.x * NWV + wave, nw = gridDim.x * NWV;
  constexpr int N_SSM = 1152, N_ROWS = NT + 2048;
  for (int item = gw; item < N_SSM; item += nw) ssm_item(p, layer, item, lds, lane);
  const int rw0 = (nw > 256) ? 128 : 0;
  if (gw >= rw0) {
    for (int row = gw - rw0; row < N_ROWS; row += nw - rw0) {
      if (row < NT) pp_row(p, layer, row, lane);
      else pp_cached(p, layer, row - NT, lane);
    }
  }
}

template <int KW, int DK>
DI void attn_block(const u16* __restrict__ Kg, int ldk, const u16* __restrict__ Vt, int nk, const bf16x8 (&qf)[DK / 16], int kcol, char* smem,
                   int tid, f32x16 (&o)[2], float& lsum) {
  constexpr int KST = KW + 8, KS = DK / 16, KCH = KW / 8, KTOT = 64 * KCH, NKC = (KTOT + NTHR - 1) / NTHR;
  const int lane = tid & 63, l32 = lane & 31, hh = lane >> 5;
  u16* Ks = (u16*)smem;
  u16* Vs = Ks + 2 * 64 * KST;
  float m = -1e30f;
  lsum = 0.f;
#pragma unroll
  for (int db = 0; db < 2; ++db)
#pragma unroll
    for (int r = 0; r < 16; ++r) o[db][r] = 0.f;
  u32x4 rk[NKC], rv[1];
  const int nt = nk / 64;
#pragma unroll
  for (int i = 0; i < NKC; ++i) { int c = tid + NTHR * i, r = c / KCH, kc = (c % KCH) * 8; if (c < KTOT) rk[i] = *(const u32x4*)(Kg + (size_t)r * ldk + kc); }
  { int r = tid >> 3, kc = (tid & 7) * 8; rv[0] = *(const u32x4*)(Vt + (size_t)r * nk + kc); }
#pragma unroll
  for (int i = 0; i < NKC; ++i) { int c = tid + NTHR * i, r = c / KCH, kc = (c % KCH) * 8; if (c < KTOT) *(u32x4*)(Ks + r * KST + kc) = rk[i]; }
  { int r = tid >> 3, kc = (tid & 7) * 8; *(u32x4*)(Vs + r * 72 + kc) = rv[0]; }
  __syncthreads();
  for (int t = 0; t < nt; ++t) {
    const int buf = t & 1;
    const bool more = (t + 1 < nt);
    if (more) {
      const int kt = (t + 1) * 64;
#pragma unroll
      for (int i = 0; i < NKC; ++i) { int c = tid + NTHR * i, r = c / KCH, kc = (c % KCH) * 8; if (c < KTOT) rk[i] = *(const u32x4*)(Kg + (size_t)(kt + r) * ldk + kc); }
      { int r = tid >> 3, kc = (tid & 7) * 8; rv[0] = *(const u32x4*)(Vt + (size_t)r * nk + kt + kc); }
    }
    const u16* ks = Ks + buf * 64 * KST + l32 * KST + kcol + hh * 8;
    const u16* vs = Vs + buf * 64 * 72 + l32 * 72 + hh * 8;
    f32x16 sa[2];
#pragma unroll
    for (int kb = 0; kb < 2; ++kb) {
#pragma unroll
      for (int r = 0; r < 16; ++r) sa[kb][r] = 0.f;
#pragma unroll
      for (int s2 = 0; s2 < KS; ++s2) {
        bf16x8 kf = *(const bf16x8*)(ks + kb * 32 * KST + s2 * 16);
        sa[kb] = MFMA32(kf, qf[s2], sa[kb]);
      }
      __builtin_amdgcn_sched_barrier(0);
    }
    float mx = sa[0][0];
#pragma unroll
    for (int r = 1; r < 16; ++r) mx = fmaxf(mx, sa[0][r]);
#pragma unroll
    for (int r = 0; r < 16; ++r) mx = fmaxf(mx, sa[1][r]);
    mx = fmaxf(mx, __shfl_xor(mx, 32));
    const float mn = fmaxf(m, mx);
    const float alpha = fexp2(m - mn);
    m = mn;
    float ps = 0.f;
#pragma unroll
    for (int kb = 0; kb < 2; ++kb)
#pragma unroll
      for (int r = 0; r < 16; ++r) { float e = fexp2(sa[kb][r] - mn); sa[kb][r] = e; ps += e; }
    lsum = lsum * alpha + ps;
#pragma unroll
    for (int db = 0; db < 2; ++db)
#pragma unroll
      for (int r = 0; r < 16; ++r) o[db][r] *= alpha;
#pragma unroll
    for (int s2 = 0; s2 < 4; ++s2) {
      const int kb = s2 >> 1, rb = 8 * (s2 & 1);
      f32x4 p0 = {sa[kb][rb], sa[kb][rb + 1], sa[kb][rb + 2], sa[kb][rb + 3]};
      f32x4 p1 = {sa[kb][rb + 4], sa[kb][rb + 5], sa[kb][rb + 6], sa[kb][rb + 7]};
      bf16x8 pf = pack8(p0, p1);
      bf16x8 v0 = *(const bf16x8*)(vs + s2 * 16);
      bf16x8 v1 = *(const bf16x8*)(vs + 32 * 72 + s2 * 16);
      o[0] = MFMA32(v0, pf, o[0]);
      o[1] = MFMA32(v1, pf, o[1]);
      if (s2 == 1) __builtin_amdgcn_sched_barrier(0);
    }
    if (more) {
      const int nb = buf ^ 1;
#pragma unroll
      for (int i = 0; i < NKC; ++i) { int c = tid + NTHR * i, r = c / KCH, kc = (c % KCH) * 8; if (c < KTOT) *(u32x4*)(Ks + nb * 64 * KST + r * KST + kc) = rk[i]; }
      { int r = tid >> 3, kc = (tid & 7) * 8; *(u32x4*)(Vs + nb * 64 * 72 + r * 72 + kc) = rv[0]; }
    }
    __syncthreads();
  }
  lsum += __shfl_xor(lsum, 32);
}

DI void store_o(u16* dst  , const f32x16 (&o)[2], float scale, int hh) {
#pragma unroll
  for (int db = 0; db < 2; ++db)
#pragma unroll
    for (int j = 0; j < 4; ++j) {
      const int dv = db * 32 + 8 * j + 4 * hh;
      f32x4 v = {o[db][4 * j] * scale, o[db][4 * j + 1] * scale, o[db][4 * j + 2] * scale, o[db][4 * j + 3] * scale};
      *(u32x2*)(dst + dv) = pack4(v);
    }
}

DI void attn_item(const P& p, int layer, int item, char* smem, int tid) {
  const int lane = tid & 63, wave = tid >> 6, l32 = lane & 31, hh = lane >> 5;
  bool lat; int kind, b, hd, qblk;
  if (item < 256) {
    lat = true;
    if (item < 128) { kind = 0; b = item >> 5; hd = (item >> 3) & 3; qblk = item & 7; }
    else { int it = item - 128; kind = 1 + (it >> 6); it &= 63; b = it >> 4; hd = (it >> 2) & 3; qblk = it & 3; }
  } else {
    lat = false;
    int it = item - 256;
    if (it < 256) { kind = 0; b = it >> 3; hd = (it >> 1) & 3; qblk = it & 1; }
    else { it -= 256; kind = 1 + (it >> 7); it &= 127; b = it >> 2; hd = it & 3; qblk = 0; }
  }
  const int nk = lat ? 1536 : 256;
  const int b_all = lat ? 32 + b : b;
  const int keyrow0 = lat ? NCTX + b * 1536 : b * 256;
  const int tok0 = lat ? NCTX + b * 1024 : b * 256;
  f32x16 o[2]; float ls;
  if (kind == 0) {
    const int ns = wave & 1, qb = wave >> 1;
    const int q0 = tok0 + qblk * 128 + qb * 32;
    const u16* Q = (const u16*)(p.ws + OFF_DQ) + (size_t)(q0 + l32) * 256 + hd * 64 + ns * 32 + hh * 8;
    bf16x8 qf[2];
    qf[0] = *(const bf16x8*)Q; qf[1] = *(const bf16x8*)(Q + 16);
    attn_block<64, 32>((const u16*)(p.ws + OFF_DKB) + (size_t)keyrow0 * 256 + hd * 64, 256, (const u16*)(p.ws + OFF_DVT) + vt_off(b_all, hd, 4), nk, qf, ns * 32,
                       smem, tid, o, ls);
    float d1 = 0.f, d2 = 0.f;
    if (lane < 32) { d1 = p.in[I_LQ1][layer * 32 + lane] * p.in[I_LK1][layer * 32 + lane]; d2 = p.in[I_LQ2][layer * 32 + lane] * p.in[I_LK2][layer * 32 + lane]; }
    d1 = wave_sum(d1); d2 = wave_sum(d2);
    int ly_ = layer; asm volatile("" : "+s"(ly_));
    const float lam_init = ly_ == 0 ? 0.2f : (0.8f - 0.6f * 0.7408182206817179f);
    const float lam = expf(d1) - expf(d2) + lam_init;
    float* cmb = (float*)smem + qb * (64 * 33);
    if (ns == 1) {
      const float sc = lam / ls;
#pragma unroll
      for (int db = 0; db < 2; ++db)
#pragma unroll
        for (int r = 0; r < 16; ++r) cmb[(db * 32 + crow(r, hh)) * 33 + l32] = o[db][r] * sc;
    }
    __syncthreads();
    if (ns == 0) {
      const float i0 = 1.f / ls;
      float ss = 0.f;
#pragma unroll
      for (int db = 0; db < 2; ++db)
#pragma unroll
        for (int r = 0; r < 16; ++r) { float d = o[db][r] * i0 - cmb[(db * 32 + crow(r, hh)) * 33 + l32]; o[db][r] = d; ss += d * d; }
      ss += __shfl_xor(ss, 32);
      const float rr = rsqrtf(ss * (1.f / 64.f) + EPSF) * (1.f - lam_init);
      u16* dst = (u16*)(p.ws + OFF_MIXED) + (size_t)(q0 + l32) * 1024 + hd * 64;
#pragma unroll
      for (int db = 0; db < 2; ++db)
#pragma unroll
        for (int j = 0; j < 4; ++j) {
          const int dv = db * 32 + 8 * j + 4 * hh;
          f32x4 g = *(const f32x4*)(p.in[I_SUBLN] + layer * 64 + dv);
          f32x4 v = {o[db][4 * j] * rr * g[0], o[db][4 * j + 1] * rr * g[1], o[db][4 * j + 2] * rr * g[2], o[db][4 * j + 3] * rr * g[3]};
          *(u32x2*)(dst + dv) = pack4(v);
        }
    }
    __syncthreads();
  } else if (kind == 1) {
    const int q0 = tok0 + qblk * 256 + wave * 32;
    const u16* Q = (const u16*)(p.ws + OFF_GQ) + (size_t)(q0 + l32) * 256 + hd * 64 + hh * 8;
    bf16x8 qf[4];
#pragma unroll
    for (int s2 = 0; s2 < 4; ++s2) qf[s2] = *(const bf16x8*)(Q + s2 * 16);
    attn_block<64, 64>((const u16*)(p.ws + OFF_GKB) + (size_t)keyrow0 * 128 + (hd >> 1) * 64, 128, (const u16*)(p.ws + OFF_GVT) + vt_off(b_all, hd >> 1, 2), nk, qf, 0,
                       smem, tid, o, ls);
    store_o((u16*)(p.ws + OFF_MIXED) + (size_t)(q0 + l32) * 1024 + 256 + hd * 64, o, 1.f / ls, hh);
  } else {
    const int q0 = tok0 + qblk * 256 + wave * 32;
    const u16* Q = (const u16*)(p.ws + OFF_MQ) + (size_t)(q0 + l32) * 384 + hd * 96 + hh * 8;
    bf16x8 qf[6];
#pragma unroll
    for (int s2 = 0; s2 < 6; ++s2) qf[s2] = *(const bf16x8*)(Q + s2 * 16);
    attn_block<96, 96>((const u16*)(p.ws + OFF_MKB) + (size_t)keyrow0 * 384 + hd * 96, 384, (const u16*)(p.ws + OFF_MVT) + vt_off(b_all, hd, 4), nk, qf, 0,
                       smem, tid, o, ls);
    store_o((u16*)(p.ws + OFF_MIXED) + (size_t)(q0 + l32) * 1024 + 768 + hd * 64, o, 1.f / ls, hh);
  }
}

DI void phase_at(const P& p, int layer, char* smem) {
  EPI_IDX
  constexpr int N_ITEMS = 768;
  if (gridDim.x == 256) {
    const int b = blockIdx.x;
    attn_item(p, layer, b, smem, tid);
    __syncthreads();
    if (b < 128) {
      attn_item(p, layer, 256 + b, smem, tid); __syncthreads();
      attn_item(p, layer, 512 + b, smem, tid); __syncthreads();
      attn_item(p, layer, 640 + b, smem, tid); __syncthreads();
    } else if (b < 192) {
      attn_item(p, layer, 256 + 128 + 2 * (b - 128), smem, tid); __syncthreads();
      attn_item(p, layer, 256 + 128 + 2 * (b - 128) + 1, smem, tid); __syncthreads();
    }
  } else {
    for (int item = blockIdx.x; item < N_ITEMS; item += gridDim.x) {
      attn_item(p, layer, item, smem, tid);
      __syncthreads();
    }
  }
  {
    constexpr int T_GLU = (NT / 256) * 2;
    auto tile_at = [&](int t) { TD d; d.A = (const u16*)(p.ws + OFF_PROJ); d.lda = NP * 2; d.B = (const u16*)(p.ws + OFF_WGLU) + (size_t)layer * 512 * 256; d.ldb = 256; d.k0 = 0; d.nk = 4; d.m0 = (t >> 1) * 256; d.n0 = (t & 1) * 256; return d; };
    int buf = 0;
    const int t0 = (int)gridDim.x - 1 - (int)blockIdx.x;
    TD cur = tile_at(t0 < T_GLU ? t0 : 0);
    if (t0 < T_GLU) stage_td(cur, 0, smem, tid);
    for (int t = t0; t < T_GLU; t += gridDim.x) {
      const bool has_next = (t + (int)gridDim.x < T_GLU);
      const TD nxt = tile_at(has_next ? t + (int)gridDim.x : t);
      const int m0 = cur.m0, n0 = cur.n0;
      f32x16 acc[4][2];
      gemm_stream(cur, has_next, nxt, smem, buf, acc);
      cur = nxt;
      u16* mixed = (u16*)(p.ws + OFF_MIXED);
      const int q = (n0 + wn * 64) >> 6;
#pragma unroll
      for (int bi = 0; bi < 4; ++bi) {
        const int rb = m0 + wm * 128 + bi * 32;
#pragma unroll
        for (int r = 0; r < 16; ++r) {
          float z = acc[bi][0][r], g = acc[bi][1][r];
          mixed[(size_t)(rb + crow(r, hh)) * 1024 + 512 + q * 32 + l32] = f2bf(z * fsigmoid(g));
        }
      }
    }
  }
}

#define XB_TMO      128
#define XB_XCNT(j)  (256  + 64 * (j))
#define XB_XSUB(j)  (1280 + 64 * (j))
#define XB_XGEN(j)  (2304 + 64 * (j))
#define XB_TOP      3328
#define XB_TOPGEN   3392
#define XCD_BAR_WORDS 3456
#define XB_SPIN_CAP (1u << 22)
#define LAS __attribute__((address_space(3)))
DI unsigned xb_ld(unsigned* p) { return __hip_atomic_load(p, __ATOMIC_RELAXED, __HIP_MEMORY_SCOPE_AGENT); }
DI unsigned xb_add(unsigned* p, unsigned v) { return __hip_atomic_fetch_add(p, v, __ATOMIC_RELAXED, __HIP_MEMORY_SCOPE_AGENT); }
DI unsigned xb_xcc_id() { return (unsigned)__builtin_amdgcn_s_getreg((3 << 11) | 20) & 0xFu; }
#define XB_SPIN(cond, bar) do { unsigned _sp = 0; while (cond) { __builtin_amdgcn_s_sleep(1); \
    if ((++_sp & 255u) == 0u) { if (xb_ld(&(bar)[XB_TMO])) break; if (_sp > XB_SPIN_CAP) { atomicAdd(&(bar)[XB_TMO], 1u); break; } } } } while (0)
struct XcdBarrier { unsigned* bar; unsigned x; volatile LAS unsigned* st; };
DI XcdBarrier xcd_barrier_post(unsigned* bar, volatile LAS unsigned* st) {
  XcdBarrier b; b.bar = bar; b.x = xb_xcc_id(); b.st = st;
  if (threadIdx.x == 0) (void)xb_add(&bar[XB_XCNT(b.x)], 1u);
  return b;
}
DI void xcd_barrier_complete(unsigned* bar, unsigned x, unsigned& nloc, unsigned& nx) {
  const unsigned G = gridDim.x * gridDim.y * gridDim.z;
  unsigned sum, cnt, mine, sp = 0u;
  for (;;) {
    sum = 0u; cnt = 0u; mine = 0u;
#pragma unroll
    for (unsigned j = 0; j < 16; ++j) { const unsigned c = xb_ld(&bar[XB_XCNT(j)]); sum += c; cnt += (c > 0u) ? 1u : 0u; mine = (j == x) ? c : mine; }
    if (sum == G) break;
    __builtin_amdgcn_s_sleep(1);
    if ((++sp & 255u) == 0u) { if (xb_ld(&bar[XB_TMO])) break; if (sp > XB_SPIN_CAP) { atomicAdd(&bar[XB_TMO], 1u); break; } }
  }
  nloc = mine > 0u ? mine : 1u; nx = cnt > 0u ? cnt : 1u;
}
DI void xcd_barrier(const XcdBarrier& b) {
  asm volatile("s_waitcnt vmcnt(0)" ::: "memory");
  __syncthreads();
  if (threadIdx.x == 0) {
    unsigned* bar = b.bar;
    __builtin_amdgcn_s_waitcnt(0);
    unsigned nloc = b.st[0], nx = b.st[1];
    if (nloc == 0u) { xcd_barrier_complete(bar, b.x, nloc, nx); b.st[0] = nloc; b.st[1] = nx; }
    const unsigned old = xb_add(&bar[XB_XSUB(b.x)], 1u);
    const unsigned gen = old / nloc;
    if (old + 1u == (gen + 1u) * nloc) {
      __builtin_amdgcn_fence(__ATOMIC_RELEASE, "agent");
      asm volatile("s_waitcnt vmcnt(0)" ::: "memory");
      const unsigned og = xb_add(&bar[XB_TOP], 1u);
      const unsigned tg = og / nx;
      if (og + 1u == (tg + 1u) * nx) xb_add(&bar[XB_TOPGEN], 1u);
      else XB_SPIN(xb_ld(&bar[XB_TOPGEN]) == tg, bar);
      __builtin_amdgcn_fence(__ATOMIC_ACQUIRE, "agent");
      xb_add(&bar[XB_XGEN(b.x)], 1u);
      asm volatile("s_waitcnt vmcnt(0)" ::: "memory");
    } else {
      XB_SPIN(xb_ld(&bar[XB_XGEN(b.x)]) == gen, bar);
      __builtin_amdgcn_fence(__ATOMIC_ACQUIRE, "agent");
      asm volatile("s_waitcnt vmcnt(0)" ::: "memory");
    }
  }
  __syncthreads();
}

DI void run_phase(const P& p_, int ph, int layer, char* smem) {
  P p = p_;
  asm volatile("" : "+s"(p.ws), "+s"(p.out));
  switch (ph) {
    case 0: prologue(p, smem); break;
    case 1: norm_phase(p, layer, 0); break;
    case 2: phase_g1(p, layer, smem); break;
    case 3: phase_pp(p, layer, smem); break;
    case 4: phase_g2(p, layer, smem); break;
    case 5: phase_at(p, layer, smem); break;
    case 6: phase_resid(p, layer, smem, true); break;
    case 7: norm_phase(p, layer, 1); break;
    case 8: phase_g5(p, layer, smem); break;
    case 9: phase_resid(p, layer, smem, false); break;
    case 10: norm_phase(p, 0, 2); break;
  }
}

extern __shared__ __attribute__((aligned(16))) char dyn_smem[];

__global__ void __launch_bounds__(512) fwd_mega(P p) {
  if (p.ws == nullptr) { cg::grid_group grid = cg::this_grid(); grid.sync(); }
  volatile LAS unsigned* st = (volatile LAS unsigned*)(dyn_smem + LDS_BYTES);
  if (threadIdx.x == 0) { st[0] = 0u; st[1] = 0u; st[2] = 0u; st[3] = 0u; }
  __syncthreads();
  XcdBarrier xb = xcd_barrier_post((unsigned*)(p.ws + OFF_BAR), st);
  run_phase(p, 0, 0, dyn_smem);
  xcd_barrier(xb);
  for (int l = 0; l < 2; ++l) {
    for (int ph = 1; ph <= 9; ++ph) {
      run_phase(p, ph, l, dyn_smem);
      xcd_barrier(xb);
    }
  }
  run_phase(p, 10, 0, dyn_smem);
}

#if !MEGA
__global__ void __launch_bounds__(512) fwd_phase(P p, int ph, int layer) { run_phase(p, ph, layer, dyn_smem); }
#endif

extern "C" void kernel_launch(void* const* d_in, const int* in_sizes, int n_in, void* d_out, int out_size, void* d_ws, size_t ws_size,
                              hipStream_t stream) {
  static int grid_blocks = 0;
  if (!grid_blocks) {
    int dev = 0, cus = 0, per_cu = 0;
    (void)hipGetDevice(&dev);
    (void)hipDeviceGetAttribute(&cus, hipDeviceAttributeMultiprocessorCount, dev);
    (void)hipFuncSetAttribute((const void*)fwd_mega, hipFuncAttributeMaxDynamicSharedMemorySize, LDS_BYTES + 16);
#if !MEGA
    (void)hipFuncSetAttribute((const void*)fwd_phase, hipFuncAttributeMaxDynamicSharedMemorySize, LDS_BYTES);
#endif
    (void)hipOccupancyMaxActiveBlocksPerMultiprocessor(&per_cu, (const void*)fwd_mega, NTHR, LDS_BYTES + 16);
    if (per_cu < 1) per_cu = 1;
    if (per_cu > 1) per_cu = 1;
    grid_blocks = cus * per_cu;
    if (ws_size < WS_NEED) fprintf(stderr, "kernel_launch: workspace too small: %zu < %zu\n", ws_size, (size_t)WS_NEED);
  }
  P p{};
  for (int i = 0; i < N_IN; ++i) p.in[i] = (const float*)d_in[i];
  p.out = (float*)d_out;
  p.ws = (char*)d_ws;
#if MEGA
  (void)hipMemsetAsync((char*)d_ws + OFF_BAR, 0, XCD_BAR_WORDS * 4, stream);
  void* args[] = {&p};
  hipError_t e = hipLaunchCooperativeKernel((const void*)fwd_mega, dim3(grid_blocks), dim3(NTHR), args, LDS_BYTES + 16, stream);
  if (e != hipSuccess) fprintf(stderr, "cooperative launch failed: %s (grid %d)\n", hipGetErrorString(e), grid_blocks);
#else
  hipLaunchKernelGGL(fwd_phase, dim3(grid_blocks), dim3(NTHR), LDS_BYTES, stream, p, 0, 0);
  for (int l = 0; l < 2; ++l)
    for (int ph = 1; ph <= 9; ++ph) hipLaunchKernelGGL(fwd_phase, dim3(grid_blocks), dim3(NTHR), LDS_BYTES, stream, p, ph, l);
  hipLaunchKernelGGL(fwd_phase, dim3(grid_blocks), dim3(NTHR), LDS_BYTES, stream, p, 10, 0);
#endif
}
```

```cpp
#include <hip/hip_runtime.h>
#include <hip/hip_cooperative_groups.h>
#include <cstdio>
namespace cg = cooperative_groups;

#ifndef MEGA
#define MEGA 1
#endif

#define DI __device__ __forceinline__
typedef unsigned short u16;
typedef __attribute__((ext_vector_type(8))) short bf16x8;
typedef __attribute__((ext_vector_type(4))) short bf16x4;
typedef __attribute__((ext_vector_type(2))) __bf16 bf2_t;
typedef __attribute__((ext_vector_type(2))) float f32x2;
typedef __attribute__((ext_vector_type(4))) float f32x4;
typedef __attribute__((ext_vector_type(16))) float f32x16;
typedef __attribute__((ext_vector_type(4))) unsigned u32x4;
typedef __attribute__((ext_vector_type(2))) unsigned u32x2;

#define MFMA32(a, b, c) __builtin_amdgcn_mfma_f32_32x32x16_bf16((a), (b), (c), 0, 0, 0)
#define MFMA16(a, b, c) __builtin_amdgcn_mfma_f32_16x16x32_bf16((a), (b), (c), 0, 0, 0)

constexpr int NT = 12288;
constexpr int NCTX = 8192;
constexpr int NKR = 14336;
constexpr int NP = 1920;
constexpr float EPSF = 1e-6f;
constexpr float LOG2E = 1.4426950408889634f;

enum { I_XP = 0, I_XS, I_CDK, I_CDV, I_CGK, I_CGV, I_CCKV, I_CKR, I_SRE, I_SIM, I_C, I_CCTX, I_N1G, I_N2G, I_WADA, I_BADA,
       I_WIN, I_WOUT, I_LQ1, I_LK1, I_LQ2, I_LK2, I_SUBLN, I_QNG, I_KNG, I_ARE, I_AIM, I_LOGDT, I_BRE, I_BIM, I_CRE, I_CIM,
       I_SSMD, I_WGLU, I_MQNG, I_MKVNG, I_WUQ, I_WUKV, I_W1, I_W2, I_FNG, N_IN };

constexpr size_t O_Y = 0;
constexpr size_t O_DK = 12582912;
constexpr size_t O_DV = 16777216;
constexpr size_t O_GK = 20971520;
constexpr size_t O_GV = 23068672;
constexpr size_t O_CKV = 25165824;
constexpr size_t O_KR = 27262976;
constexpr size_t O_SRE = 27787264;
constexpr size_t O_SIM = 27918336;

constexpr size_t al256(size_t x) { return (x + 255) & ~(size_t)255; }
constexpr size_t OFF_MOD = 0;
constexpr size_t OFF_CTR = al256(OFF_MOD + 2 * 5 * 6144 * 4);
constexpr size_t OFF_BAR = al256(OFF_CTR + 256);
constexpr size_t OFF_ROPE = al256(OFF_BAR + 3456 * 4);
constexpr size_t OFF_ABAR = al256(OFF_ROPE + 2 * 64 * 16 * 8);
constexpr size_t OFF_ATAB = al256(OFF_ABAR + 64 * 64 * 8);
constexpr size_t OFF_CTAB = al256(OFF_ATAB + 64 * 128 * 16 * 2);
constexpr size_t OFF_WIN = al256(OFF_CTAB + 64 * 16 * 128 * 2);
constexpr size_t OFF_WOUT = al256(OFF_WIN + (size_t)2 * 1920 * 1024 * 2);
constexpr size_t OFF_W1 = al256(OFF_WOUT + (size_t)2 * 1024 * 1024 * 2);
constexpr size_t OFF_W2 = al256(OFF_W1 + (size_t)2 * 4096 * 1024 * 2);
constexpr size_t OFF_WUQ = al256(OFF_W2 + (size_t)2 * 4096 * 1024 * 2);
constexpr size_t OFF_WUKV = al256(OFF_WUQ + (size_t)2 * 384 * 192 * 2);
constexpr size_t OFF_WGLU = al256(OFF_WUKV + (size_t)2 * 512 * 128 * 2);
constexpr size_t OFF_H = al256(OFF_WGLU + (size_t)2 * 512 * 256 * 2);
constexpr size_t OFF_MIXED = OFF_H;
constexpr size_t OFF_BIG = al256(OFF_H + (size_t)NT * 1024 * 2);
constexpr size_t OFF_PROJ = OFF_BIG;
constexpr size_t OFF_DQ = al256(OFF_PROJ + (size_t)NT * NP * 4);
constexpr size_t OFF_DKB = al256(OFF_DQ + (size_t)NT * 256 * 2);
constexpr size_t OFF_DVT = al256(OFF_DKB + (size_t)NKR * 256 * 2);
constexpr size_t OFF_GQ = al256(OFF_DVT + (size_t)NKR * 256 * 2);
constexpr size_t OFF_GKB = al256(OFF_GQ + (size_t)NT * 256 * 2);
constexpr size_t OFF_GVT = al256(OFF_GKB + (size_t)NKR * 128 * 2);
constexpr size_t OFF_MQ = al256(OFF_GVT + (size_t)NKR * 128 * 2);
constexpr size_t OFF_MKB = al256(OFF_MQ + (size_t)NT * 384 * 2);
constexpr size_t OFF_MVT = al256(OFF_MKB + (size_t)NKR * 384 * 2);
constexpr size_t OFF_CQN = al256(OFF_MVT + (size_t)NKR * 256 * 2);
constexpr size_t OFF_CKVN = al256(OFF_CQN + (size_t)NT * 192 * 2);
constexpr size_t OFF_YBUF = al256(OFF_CKVN + (size_t)NKR * 128 * 2);
constexpr size_t OFF_END1 = al256(OFF_YBUF + (size_t)2 * NT * 256 * 4);
constexpr size_t OFF_A = OFF_BIG;
constexpr size_t OFF_END2 = al256(OFF_A + (size_t)NT * 4096 * 2);
constexpr size_t WS_NEED = OFF_END1 > OFF_END2 ? OFF_END1 : OFF_END2;
static_assert(WS_NEED <= (size_t)256 * 1024 * 1024, "workspace over 256 MiB");

constexpr int NTHR = 512;
constexpr int NWV = NTHR / 64;
constexpr int LDS_BYTES = 8 * 32 * 132 * 4;

struct P {
  const float* in[N_IN];
  float* out;
  char* ws;
};

DI unsigned pack2(float a, float b) { f32x2 v = {a, b}; return __builtin_bit_cast(unsigned, __builtin_convertvector(v, bf2_t)); }
DI u16 f2bf(float a) { return (u16)(pack2(a, 0.f) & 0xffffu); }
DI bf16x8 pack8(f32x4 a, f32x4 b) {
  u32x4 r = {pack2(a[0], a[1]), pack2(a[2], a[3]), pack2(b[0], b[1]), pack2(b[2], b[3])};
  return __builtin_bit_cast(bf16x8, r);
}
DI u32x2 pack4(f32x4 a) { u32x2 r = {pack2(a[0], a[1]), pack2(a[2], a[3])}; return r; }
DI int get_tid() { int t = threadIdx.x; asm volatile("" : "+v"(t)); return t; }
DI float fexp2(float x) { return __builtin_amdgcn_exp2f(x); }
DI float frcp(float x) { return __builtin_amdgcn_rcpf(x); }
DI float fsigmoid(float w) { return frcp(1.f + fexp2(-w * LOG2E)); }
DI float gelu_tanh(float x) { return x * fsigmoid(1.5957691216057308f * (x + 0.044715f * x * x * x)); }
DI float wave_sum(float v) {
#pragma unroll
  for (int o = 32; o >= 1; o >>= 1) v += __shfl_xor(v, o);
  return v;
}
DI void wave_lds_fence() {
  asm volatile("s_waitcnt lgkmcnt(0)" ::: "memory");
  __builtin_amdgcn_wave_barrier();
}
DI int fetch_item(int* ctr, int lane) {
  int v = 0;
  if (lane == 0) v = atomicAdd(ctr, 1);
  return __builtin_amdgcn_readfirstlane(v);
}
DI size_t vt_off(int b_all, int head, int H) {
  if (b_all < 32) return ((size_t)(b_all * H + head) * 64) * 256;
  return (size_t)32 * H * 64 * 256 + ((size_t)((b_all - 32) * H + head) * 64) * 1536;
}
DI int mod_index(int row) { return row < NCTX ? 0 : 1 + ((row - NCTX) >> 10); }

DI void prologue(const P& p, char* smem) {
  const int tid = get_tid();
  float* fs = (float*)smem;
  constexpr int N_ADA = 384, N_TAB = 64, N_MISC = 1, N_TR = 5700;
  constexpr int TOTAL = N_ADA + N_TAB + N_MISC;
  for (int it = blockIdx.x; it < TOTAL; it += gridDim.x) {
    if (it < N_ADA) {
      const int l = it / 192, ch = it % 192;
      float* sc = fs;
      float* red = fs + 5 * 1024;
      for (int i = tid; i < 5 * 1024; i += NTHR) {
        int m = i >> 10, k = i & 1023;
        float c = (m == 0) ? p.in[I_CCTX][k] : p.in[I_C][(m - 1) * 1024 + k];
        sc[i] = c * fsigmoid(c);
      }
      __syncthreads();
      const int col = tid & 31, kg = tid >> 5;
      const float* w = p.in[I_WADA] + ((size_t)l * 1024 + kg * 64) * 6144 + ch * 32 + col;
      float a0 = 0, a1 = 0, a2 = 0, a3 = 0, a4 = 0;
#pragma unroll 16
      for (int k = 0; k < 64; ++k) {
        float wv = w[(size_t)k * 6144];
        int kk = kg * 64 + k;
        a0 += sc[kk] * wv; a1 += sc[1024 + kk] * wv; a2 += sc[2048 + kk] * wv; a3 += sc[3072 + kk] * wv; a4 += sc[4096 + kk] * wv;
      }
      red[(kg * 5 + 0) * 32 + col] = a0; red[(kg * 5 + 1) * 32 + col] = a1; red[(kg * 5 + 2) * 32 + col] = a2;
      red[(kg * 5 + 3) * 32 + col] = a3; red[(kg * 5 + 4) * 32 + col] = a4;
      __syncthreads();
      if (tid < 160) {
        int m = tid >> 5, c2 = tid & 31;
        float s = 0;
#pragma unroll
        for (int g = 0; g < 16; ++g) s += red[(g * 5 + m) * 32 + c2];
        int n = ch * 32 + c2;
        s += p.in[I_BADA][l * 6144 + n];
        ((float*)(p.ws + OFF_MOD))[((size_t)l * 5 + m) * 6144 + n] = s;
      }
      __syncthreads();
    } else if (it < N_ADA + N_TAB) {
      const int idx = it - N_ADA;
      if (tid < 64) {
        const int pp = tid;
        float are = p.in[I_ARE][idx * 64 + pp], aim = p.in[I_AIM][idx * 64 + pp];
        float dt = expf(p.in[I_LOGDT][idx]);
        float zr = are * dt, zi = aim * dt;
        float e = expf(zr);
        float abr = e * cosf(zi), abi = e * sinf(zi);
        float d2 = are * are + aim * aim;
        float nr = abr - 1.f, ni = abi;
        float qr = (nr * are + ni * aim) / d2, qi = (ni * are - nr * aim) / d2;
        u16* at = (u16*)(p.ws + OFF_ATAB) + (size_t)idx * 128 * 16;
        u16* ct = (u16*)(p.ws + OFF_CTAB) + (size_t)idx * 16 * 128;
        for (int c = 0; c < 16; ++c) {
          float bre = p.in[I_BRE][((size_t)idx * 64 + pp) * 16 + c], bim = p.in[I_BIM][((size_t)idx * 64 + pp) * 16 + c];
          at[(2 * pp) * 16 + c] = f2bf(qr * bre - qi * bim);
          at[(2 * pp + 1) * 16 + c] = f2bf(qr * bim + qi * bre);
          float cre = p.in[I_CRE][((size_t)idx * 16 + c) * 64 + pp], cim = p.in[I_CIM][((size_t)idx * 16 + c) * 64 + pp];
          ct[c * 128 + 2 * pp] = f2bf(cre);
          ct[c * 128 + 2 * pp + 1] = f2bf(-cim);
        }
        float* ab = (float*)(p.ws + OFF_ABAR) + ((size_t)idx * 64 + pp) * 2;
        ab[0] = abr; ab[1] = abi;
      }
    } else if (it < N_ADA + N_TAB + N_MISC) {
      f32x2* tab = (f32x2*)(p.ws + OFF_ROPE);
      for (int i = tid; i < 2 * 64 * 16; i += NTHR) {
        int kind = i >> 10, pos = (i >> 4) & 63, fi = i & 15;
        int n = kind ? 16 : 8;
        float freq = expf(-(float)(fi % n) / (float)n * 9.210340371976184f);
        float ang = (float)pos * freq;
        f32x2 cs = {cosf(ang), sinf(ang)};
        tab[i] = cs;
      }
      if (tid < 64) ((int*)(p.ws + OFF_CTR))[tid] = 0;
    }
  }
  struct TrD { const float* src; u16* dst; int K, N, k0, n0; bool glu; };
  auto decode = [&](int tt) {
    TrD d; d.glu = false;
    const int l = tt / 2850;
    int r = tt % 2850; int kt, nt;
    if (r < 480) { d.src = p.in[I_WIN] + (size_t)l * 1024 * 1888; d.dst = (u16*)(p.ws + OFF_WIN) + (size_t)l * 1920 * 1024; d.K = 1024; d.N = 1888; kt = r / 30; nt = r % 30; }
    else if (r < 736) { r -= 480; d.src = p.in[I_WOUT] + (size_t)l * 1024 * 1024; d.dst = (u16*)(p.ws + OFF_WOUT) + (size_t)l * 1024 * 1024; d.K = 1024; d.N = 1024; kt = r / 16; nt = r % 16; }
    else if (r < 1760) { r -= 736; d.src = p.in[I_W1] + (size_t)l * 1024 * 4096; d.dst = (u16*)(p.ws + OFF_W1) + (size_t)l * 4096 * 1024; d.K = 1024; d.N = 4096; kt = r / 64; nt = r % 64; }
    else if (r < 2784) { r -= 1760; d.src = p.in[I_W2] + (size_t)l * 4096 * 1024; d.dst = (u16*)(p.ws + OFF_W2) + (size_t)l * 1024 * 4096; d.K = 4096; d.N = 1024; kt = r / 16; nt = r % 16; }
    else if (r < 2802) { r -= 2784; d.src = p.in[I_WUQ] + (size_t)l * 192 * 384; d.dst = (u16*)(p.ws + OFF_WUQ) + (size_t)l * 384 * 192; d.K = 192; d.N = 384; kt = r / 6; nt = r % 6; }
    else if (r < 2818) { r -= 2802; d.src = p.in[I_WUKV] + (size_t)l * 128 * 512; d.dst = (u16*)(p.ws + OFF_WUKV) + (size_t)l * 512 * 128; d.K = 128; d.N = 512; kt = r / 8; nt = r % 8; }
    else { r -= 2818; d.src = p.in[I_WGLU] + (size_t)l * 256 * 512; d.dst = (u16*)(p.ws + OFF_WGLU) + (size_t)l * 512 * 256; d.K = 256; d.N = 512; kt = r / 8; nt = r % 8; d.glu = true; }
    d.k0 = kt * 64; d.n0 = nt * 64;
    return d;
  };
  const int half = tid >> 8, t2 = tid & 255;
  float* ft = fs + half * (64 * 65);
  const int tx = t2 & 15, ty = t2 >> 4;
  auto tload = [&](const TrD& d, f32x4 (&v)[4]) {
#pragma unroll
    for (int i = 0; i < 4; ++i) {
      const int kk = ty + 16 * i, n = d.n0 + 4 * tx;
      f32x4 z = {0.f, 0.f, 0.f, 0.f};
      v[i] = (n < d.N) ? *(const f32x4*)(d.src + (size_t)(d.k0 + kk) * d.N + n) : z;
    }
  };
  const int nvb = 2 * (int)gridDim.x;
  const int tb = nvb - 1 - (2 * (int)blockIdx.x + half);
  const int nrounds = (N_TR + nvb - 1) / nvb;
  TrD cur = decode(tb < N_TR ? tb : 0);
  f32x4 cv[4];
  if (tb < N_TR) tload(cur, cv);
  for (int j = 0; j < nrounds; ++j) {
    const int tt = tb + j * nvb;
    const bool valid = tt < N_TR, more = tt + nvb < N_TR;
    TrD nxt = decode(more ? tt + nvb : 0);
    f32x4 nv[4];
    if (more) tload(nxt, nv);
    if (valid) {
#pragma unroll
      for (int i = 0; i < 4; ++i) {
        const int kk = ty + 16 * i;
        ft[kk * 65 + 4 * tx + 0] = cv[i][0]; ft[kk * 65 + 4 * tx + 1] = cv[i][1]; ft[kk * 65 + 4 * tx + 2] = cv[i][2]; ft[kk * 65 + 4 * tx + 3] = cv[i][3];
      }
    }
    __syncthreads();
    if (valid) {
#pragma unroll
      for (int i = 0; i < 2; ++i) {
        const int c = t2 + 256 * i, nn = c >> 3, kc = (c & 7) * 8;
        f32x4 a, b;
#pragma unroll
        for (int e = 0; e < 4; ++e) { a[e] = ft[(kc + e) * 65 + nn]; b[e] = ft[(kc + 4 + e) * 65 + nn]; }
        const int n = cur.n0 + nn;
        int drow = n;
        if (cur.glu) drow = (n < 256) ? ((n >> 5) * 64 + (n & 31)) : (((n - 256) >> 5) * 64 + 32 + (n & 31));
        *(bf16x8*)(cur.dst + (size_t)drow * cur.K + cur.k0 + kc) = pack8(a, b);
      }
    }
    __syncthreads();
    cur = nxt;
    if (more) {
#pragma unroll
      for (int i = 0; i < 4; ++i) cv[i] = nv[i];
    }
  }
}

DI const float* x_row_src(const P& p, int layer, int row) {
  if (layer == 0) return row < NCTX ? p.in[I_XP] + (size_t)row * 1024 : p.in[I_XS] + (size_t)(row - NCTX) * 1024;
  return p.out + (size_t)row * 1024;
}
DI void norm_phase(const P& p, int layer, int which) {
  const int tid_ = get_tid();
  const int lane = tid_ & 63;
  const int gw = blockIdx.x * NWV + (tid_ >> 6), nw = gridDim.x * NWV;
  auto src_of = [&](int row) { return (which == 0) ? x_row_src(p, layer, row) : (const float*)(p.out + (size_t)row * 1024); };
  f32x4 v[4];
  if (gw < NT) {
    const float* xs = src_of(gw);
#pragma unroll
    for (int i = 0; i < 4; ++i) v[i] = *(const f32x4*)(xs + (i * 64 + lane) * 4);
  }
  for (int row = gw; row < NT; row += nw) {
    f32x4 nv[4];
    const bool more = row + nw < NT;
    if (more) {
      const float* xs = src_of(row + nw);
#pragma unroll
      for (int i = 0; i < 4; ++i) nv[i] = *(const f32x4*)(xs + (i * 64 + lane) * 4);
    }
    float ss = 0;
#pragma unroll
    for (int i = 0; i < 4; ++i) ss += v[i][0] * v[i][0] + v[i][1] * v[i][1] + v[i][2] * v[i][2] + v[i][3] * v[i][3];
    ss = wave_sum(ss);
    const float r = rsqrtf(ss * (1.f / 1024.f) + EPSF);
    if (which == 2) {
      f32x4 g[4];
#pragma unroll
      for (int i = 0; i < 4; ++i) g[i] = *(const f32x4*)(p.in[I_FNG] + (i * 64 + lane) * 4);
#pragma unroll
      for (int i = 0; i < 4; ++i) {
        int e = (i * 64 + lane) * 4;
        f32x4 o = v[i] * r * g[i];
        *(f32x4*)(p.out + (size_t)row * 1024 + e) = o;
      }
    } else {
      const float* gn = p.in[which == 0 ? I_N1G : I_N2G] + layer * 1024;
      const float* md = (const float*)(p.ws + OFF_MOD) + ((size_t)layer * 5 + mod_index(row)) * 6144 + (which == 0 ? 0 : 3072);
      u16* h = (u16*)(p.ws + OFF_H) + (size_t)row * 1024;
      f32x4 g[4], sh[4], sc[4];
#pragma unroll
      for (int i = 0; i < 4; ++i) {
        int e = (i * 64 + lane) * 4;
        g[i] = *(const f32x4*)(gn + e);
        sh[i] = *(const f32x4*)(md + e);
        sc[i] = *(const f32x4*)(md + 1024 + e);
      }
      if (which == 0 && layer == 0) {
#pragma unroll
        for (int i = 0; i < 4; ++i) *(f32x4*)(p.out + (size_t)row * 1024 + (i * 64 + lane) * 4) = v[i];
      }
#pragma unroll
      for (int i = 0; i < 4; ++i) {
        int e = (i * 64 + lane) * 4;
        f32x4 o = v[i] * r * g[i] * (1.f + sc[i]) + sh[i];
        *(u32x2*)(h + e) = pack4(o);
      }
    }
    if (more) {
#pragma unroll
      for (int i = 0; i < 4; ++i) v[i] = nv[i];
    }
  }
}

#define LAS3 __attribute__((address_space(3)))
DI void stage_tile_dma(const u16* __restrict__ G, int ld, int row0, int k0, char* lds, int tid) {
#pragma unroll
  for (int i = 0; i < 4; ++i) {
    const int q = tid + NTHR * i, r = q >> 3, c = (q & 7) ^ ((r >> 1) & 7);
    __builtin_amdgcn_global_load_lds((const unsigned*)(G + (size_t)(row0 + r) * ld + k0 + c * 8), (LAS3 unsigned*)(lds + q * 16), 16, 0, 0);
  }
}
struct TD { const u16* A; const u16* B; int lda, ldb, k0, nk, m0, n0; };
DI void stage_td(const TD& d, int kt, char* stage_base, int tid) {
  stage_tile_dma(d.A, d.lda, d.m0, d.k0 + kt * 64, stage_base, tid);
  stage_tile_dma(d.B, d.ldb, d.n0, d.k0 + kt * 64, stage_base + 32768, tid);
}
DI void gemm_stream(const TD& cur, bool has_next, const TD& nxt, char* smem, int& buf, f32x16 (&acc)[4][2]) {
  const int tid = get_tid(), lane = tid & 63, wave = tid >> 6, wm = wave >> 2, wn = wave & 3, l32 = lane & 31, hh = lane >> 5;
#pragma unroll
  for (int bi = 0; bi < 4; ++bi)
#pragma unroll
    for (int bj = 0; bj < 2; ++bj)
#pragma unroll
      for (int r = 0; r < 16; ++r) acc[bi][bj][r] = 0.f;
  const int swz = (l32 >> 1) & 7;
  const int arow = (wm * 128 + l32) * 128, brow = (wn * 64 + l32) * 128;
  const int c0 = ((0 + hh) ^ swz) * 16, c1 = ((2 + hh) ^ swz) * 16, c2 = ((4 + hh) ^ swz) * 16, c3 = ((6 + hh) ^ swz) * 16;
  asm volatile("s_waitcnt vmcnt(0)" ::: "memory");
  __syncthreads();
  const int nk = cur.nk;
  for (int kt = 0; kt < nk; ++kt) {
    if (kt + 1 < nk) stage_td(cur, kt + 1, smem + (buf ^ 1) * 65536, tid);
    else if (has_next) stage_td(nxt, 0, smem + (buf ^ 1) * 65536, tid);
    const char* as = smem + buf * 65536 + arow;
    const char* bs = smem + buf * 65536 + 32768 + brow;
    bf16x8 fa[2][4], fb[2][2];
#pragma unroll
    for (int bi = 0; bi < 4; ++bi) fa[0][bi] = *(const bf16x8*)(as + bi * 4096 + c0);
#pragma unroll
    for (int bj = 0; bj < 2; ++bj) fb[0][bj] = *(const bf16x8*)(bs + bj * 4096 + c0);
#pragma unroll
    for (int ks = 0; ks < 4; ++ks) {
      const int cb = ks & 1, nb = cb ^ 1;
      if (ks < 3) {
        const int co = (ks == 0) ? c1 : (ks == 1) ? c2 : c3;
#pragma unroll
        for (int bi = 0; bi < 4; ++bi) fa[nb][bi] = *(const bf16x8*)(as + bi * 4096 + co);
#pragma unroll
        for (int bj = 0; bj < 2; ++bj) fb[nb][bj] = *(const bf16x8*)(bs + bj * 4096 + co);
      }
      __builtin_amdgcn_s_setprio(1);
#pragma unroll
      for (int bi = 0; bi < 4; ++bi)
#pragma unroll
        for (int bj = 0; bj < 2; ++bj) acc[bi][bj] = MFMA32(fa[cb][bi], fb[cb][bj], acc[bi][bj]);
      __builtin_amdgcn_s_setprio(0);
    }
    buf ^= 1;
    if (kt + 1 < nk) {
      asm volatile("s_waitcnt vmcnt(0)" ::: "memory");
      __syncthreads();
    }
  }
}

#if MEGA
#define XCD_ID()   ((int)((volatile int*)(smem + LDS_BYTES))[3])
#define XCD_RANK() ((int)((volatile int*)(smem + LDS_BYTES))[2])
#else
#define XCD_ID()   ((int)(blockIdx.x & 7))
#define XCD_RANK() ((int)(blockIdx.x >> 3))
#endif
#define EPI_IDX                                                                                        \
  const int tid = get_tid(), lane = tid & 63, wave = tid >> 6, wm = wave >> 2, wn = wave & 3, l32 = lane & 31, hh = lane >> 5; \
  (void)tid; (void)lane; (void)wave; (void)wm; (void)wn; (void)l32; (void)hh;
DI int crow(int r, int hh) { return (r & 3) + 8 * (r >> 2) + 4 * hh; }

DI void phase_g1(const P& p, int layer, char* smem) {
  EPI_IDX
  const u16* A = (const u16*)(p.ws + OFF_H);
  const u16* Bt = (const u16*)(p.ws + OFF_WIN) + (size_t)layer * 1920 * 1024;
  float* proj = (float*)(p.ws + OFF_PROJ);
  constexpr int MT = NT / 256, NTL = 8, MPX = MT / 8;
  const int xcd_ = XCD_ID(), xj_ = XCD_RANK(), xn_ = gridDim.x >> 3;
  auto tile_at = [&](int u) { TD d; d.A = A; d.B = Bt; d.lda = 1024; d.ldb = 1024; d.k0 = 0; d.nk = 16; d.m0 = (xcd_ * MPX + u % MPX) * 256; d.n0 = (u / MPX) * 256; return d; };
  int buf = 0;
  TD cur = tile_at(xj_ < MPX * NTL ? xj_ : 0);
  if (xj_ < MPX * NTL) stage_td(cur, 0, smem, tid);
  for (int u = xj_; u < MPX * NTL; u += xn_) {
    const bool has_next = (u + xn_ < MPX * NTL);
    const TD nxt = tile_at(has_next ? u + xn_ : u);
    const int m0 = cur.m0, n0 = cur.n0;
    f32x16 acc[4][2];
    gemm_stream(cur, has_next, nxt, smem, buf, acc);
    cur = nxt;
    const bool lat = m0 >= NCTX;
    const int b_all = lat ? 32 + ((m0 - NCTX) >> 10) : (m0 >> 8);
    const int nkk = lat ? 1536 : 256;
#pragma unroll
    for (int bi = 0; bi < 4; ++bi)
#pragma unroll
      for (int bj = 0; bj < 2; ++bj) {
        const int rb = m0 + wm * 128 + bi * 32;
        const int cb = n0 + wn * 64 + bj * 32;
        const int col = cb + l32;
        if (cb < NP) {
#pragma unroll
          for (int r = 0; r < 16; ++r) proj[(size_t)(rb + crow(r, hh)) * NP + col] = acc[bi][bj][r];
        }
        const bool isdv = (cb >= 512 && cb < 768), isgv = (cb >= 1152 && cb < 1280);
        if (isdv || isgv) {
          u16* vt; int f;
          if (isdv) { f = col - 512; vt = (u16*)(p.ws + OFF_DVT) + vt_off(b_all, f >> 6, 4); }
          else { f = col - 1152; vt = (u16*)(p.ws + OFF_GVT) + vt_off(b_all, f >> 6, 2); }
          vt += (size_t)(f & 63) * nkk;
#pragma unroll
          for (int j = 0; j < 4; ++j) {
            int row = rb + 16 * (j >> 1) + 8 * hh + 4 * (j & 1);
            int key = lat ? 512 + ((row - NCTX) & 1023) : (row & 255);
            f32x4 v = {acc[bi][bj][4 * j], acc[bi][bj][4 * j + 1], acc[bi][bj][4 * j + 2], acc[bi][bj][4 * j + 3]};
            *(u32x2*)(vt + key) = pack4(v);
          }
        }
      }
  }
}

DI void phase_g2(const P& p, int layer, char* smem) {
  EPI_IDX
  constexpr int T_MQ = (NT / 256) * 2, T_MKV = (NKR / 256) * 2;
  const f32x2* tab32 = (const f32x2*)(p.ws + OFF_ROPE);
  auto tile_at = [&](int t) {
    TD d; d.k0 = 0;
    if (t < T_MQ) { d.A = (const u16*)(p.ws + OFF_CQN); d.B = (const u16*)(p.ws + OFF_WUQ) + (size_t)layer * 384 * 192; d.lda = 192; d.ldb = 192; d.nk = 3; d.m0 = (t >> 1) * 256; d.n0 = (t & 1) * 256; }
    else { const int t2 = t - T_MQ; d.A = (const u16*)(p.ws + OFF_CKVN); d.B = (const u16*)(p.ws + OFF_WUKV) + (size_t)layer * 512 * 128; d.lda = 128; d.ldb = 128; d.nk = 2; d.m0 = (t2 >> 1) * 256; d.n0 = (t2 & 1) * 256; }
    return d;
  };
  int buf = 0;
  const int t_first = blockIdx.x;
  TD cur = tile_at(t_first < T_MQ + T_MKV ? t_first : 0);
  if (t_first < T_MQ + T_MKV) stage_td(cur, 0, smem, tid);
  for (int t = blockIdx.x; t < T_MQ + T_MKV; t += gridDim.x) {
    const bool has_next = (t + (int)gridDim.x < T_MQ + T_MKV);
    const TD nxt = tile_at(has_next ? t + (int)gridDim.x : t);
    f32x16 acc[4][2];
    const int m0 = cur.m0, n0 = cur.n0;
    gemm_stream(cur, has_next, nxt, smem, buf, acc);
    cur = nxt;
    if (t < T_MQ) {
      const bool lat = m0 >= NCTX;
      const float scl = 0.10206207261596575f * LOG2E;
      u16* mq = (u16*)(p.ws + OFF_MQ);
#pragma unroll
      for (int bi = 0; bi < 4; ++bi)
#pragma unroll
        for (int bj = 0; bj < 2; ++bj) {
          const int rb = m0 + wm * 128 + bi * 32;
          const int cb = n0 + wn * 64 + bj * 32;
          const int col = cb + l32;
          if (cb < 384) {
            const bool isrope = lat && ((cb % 96) == 64);
            const int e = l32, w2 = e & 15, fi = w2 & 7;
            const bool isx2 = w2 >= 8, half = e >= 16;
#pragma unroll
            for (int r = 0; r < 16; ++r) {
              float v = acc[bi][bj][r];
              const int row = rb + crow(r, hh);
              if (isrope) {
                const int tt = (row - NCTX) & 1023;
                const int pos = half ? (tt & 63) : (tt >> 6);
                const f32x2 cs = tab32[pos * 16 + fi];
                float pv = __shfl_xor(v, 8);
                v = v * cs[0] + (isx2 ? pv : -pv) * cs[1];
              }
              mq[(size_t)row * 384 + col] = f2bf(v * scl);
            }
          }
        }
    } else {
      const bool lat = m0 >= NCTX;
      const int b_all = lat ? 32 + (m0 - NCTX) / 1536 : (m0 >> 8);
      const int nkk = lat ? 1536 : 256;
      const int kbase = lat ? (m0 - NCTX) % 1536 : (m0 & 255);
      u16* mk = (u16*)(p.ws + OFF_MKB);
#pragma unroll
      for (int bi = 0; bi < 4; ++bi)
#pragma unroll
        for (int bj = 0; bj < 2; ++bj) {
          const int rloc = wm * 128 + bi * 32;
          const int cb = n0 + wn * 64 + bj * 32;
          const int head = cb >> 7, wc = (cb & 127) + l32;
          if ((cb & 127) < 64) {
#pragma unroll
            for (int r = 0; r < 16; ++r) mk[(size_t)(m0 + rloc + crow(r, hh)) * 384 + head * 96 + wc] = f2bf(acc[bi][bj][r]);
          } else {
            u16* vt = (u16*)(p.ws + OFF_MVT) + vt_off(b_all, head, 4) + (size_t)(wc - 64) * nkk + kbase + rloc;
#pragma unroll
            for (int j = 0; j < 4; ++j) {
              f32x4 v = {acc[bi][bj][4 * j], acc[bi][bj][4 * j + 1], acc[bi][bj][4 * j + 2], acc[bi][bj][4 * j + 3]};
              *(u32x2*)(vt + 16 * (j >> 1) + 8 * hh + 4 * (j & 1)) = pack4(v);
            }
          }
        }
    }
  }
  {
    const int gw = blockIdx.x * NWV + wave, nw = gridDim.x * NWV;
    const f32x4 dd = *(const f32x4*)(p.in[I_SSMD] + layer * 256 + lane * 4);
    for (int row = gw; row < NT; row += nw) {
      const float* y0 = (const float*)(p.ws + OFF_YBUF) + (size_t)row * 256 + lane * 4;
      float* prow = (float*)(p.ws + OFF_PROJ) + (size_t)row * NP;
      f32x4 a = *(const f32x4*)y0, b = *(const f32x4*)(y0 + (size_t)NT * 256), c = *(const f32x4*)(prow + 1280 + lane * 4);
      f32x4 sv = a + b + c * dd;
      f32x4 g = {gelu_tanh(sv[0]), gelu_tanh(sv[1]), gelu_tanh(sv[2]), gelu_tanh(sv[3])};
      *(u32x2*)((u16*)prow + lane * 4) = pack4(g);
    }
  }
}

DI void phase_resid(const P& p, int layer, char* smem, bool is_out) {
  EPI_IDX
  const u16* A = is_out ? (const u16*)(p.ws + OFF_MIXED) : (const u16*)(p.ws + OFF_A);
  const int K = is_out ? 1024 : 4096;
  const u16* Bt = is_out ? (const u16*)(p.ws + OFF_WOUT) + (size_t)layer * 1024 * 1024 : (const u16*)(p.ws + OFF_W2) + (size_t)layer * 1024 * 4096;
  constexpr int MT = NT / 256, NTL = 4, MPX = MT / 8, NU = MPX * NTL;
  const int xcd_ = XCD_ID(), xj_ = XCD_RANK(), xn_ = gridDim.x >> 3;
  auto tile_at = [&](int u) {
    TD d; d.A = A; d.B = Bt; d.lda = K; d.ldb = K; d.nk = K / 64; d.k0 = 0;
    d.n0 = (u % NTL) * 256;
    d.m0 = (xcd_ * MPX + u / NTL) * 256;
    return d;
  };
  int buf = 0;
  TD cur = tile_at(xj_ < NU ? xj_ : 0);
  if (xj_ < NU) stage_td(cur, 0, smem, tid);
  for (int u = xj_; u < NU; u += xn_) {
    const bool has_next = (u + xn_ < NU);
    const TD nxt = tile_at(has_next ? u + xn_ : u);
    const int m0 = cur.m0, n0 = cur.n0;
    f32x16 acc[4][2];
    gemm_stream(cur, has_next, nxt, smem, buf, acc);
    cur = nxt;
    const float* gate = (const float*)(p.ws + OFF_MOD) + ((size_t)layer * 5 + mod_index(m0)) * 6144 + (is_out ? 2048 : 5120);
#pragma unroll
    for (int bi = 0; bi < 4; ++bi)
#pragma unroll
      for (int bj = 0; bj < 2; ++bj) {
        const int rb = m0 + wm * 128 + bi * 32;
        const int col = n0 + wn * 64 + bj * 32 + l32;
        const float g = gate[col];
        float rv[16];
#pragma unroll
        for (int r = 0; r < 16; ++r) rv[r] = p.out[(size_t)(rb + crow(r, hh)) * 1024 + col];
#pragma unroll
        for (int r = 0; r < 16; ++r) p.out[(size_t)(rb + crow(r, hh)) * 1024 + col] = rv[r] + g * acc[bi][bj][r];
      }
  }
}

DI void phase_g5(const P& p, int layer, char* smem) {
  EPI_IDX
  const u16* A = (const u16*)(p.ws + OFF_H);
  const u16* Bt = (const u16*)(p.ws + OFF_W1) + (size_t)layer * 4096 * 1024;
  u16* a = (u16*)(p.ws + OFF_A);
  constexpr int MT = NT / 256, NTL = 16, MPX = MT / 8;
  const int xcd_ = XCD_ID(), xj_ = XCD_RANK(), xn_ = gridDim.x >> 3;
  auto tile_at = [&](int u) { TD d; d.A = A; d.B = Bt; d.lda = 1024; d.ldb = 1024; d.k0 = 0; d.nk = 16; d.m0 = (xcd_ * MPX + u % MPX) * 256; d.n0 = (u / MPX) * 256; return d; };
  int buf = 0;
  TD cur = tile_at(xj_ < MPX * NTL ? xj_ : 0);
  if (xj_ < MPX * NTL) stage_td(cur, 0, smem, tid);
  for (int u = xj_; u < MPX * NTL; u += xn_) {
    const bool has_next = (u + xn_ < MPX * NTL);
    const TD nxt = tile_at(has_next ? u + xn_ : u);
    const int m0 = cur.m0, n0 = cur.n0;
    f32x16 acc[4][2];
    gemm_stream(cur, has_next, nxt, smem, buf, acc);
    cur = nxt;
#pragma unroll
    for (int bi = 0; bi < 4; ++bi)
#pragma unroll
      for (int bj = 0; bj < 2; ++bj) {
        const int rb = m0 + wm * 128 + bi * 32;
        const int col = n0 + wn * 64 + bj * 32 + l32;
#pragma unroll
        for (int r = 0; r < 16; ++r) {
          float v = fmaxf(acc[bi][bj][r], 0.f);
          a[(size_t)(rb + crow(r, hh)) * 4096 + col] = f2bf(v * v);
        }
      }
  }
}

template <int R>
DI f32x4 rope4(f32x4 v, int lane, int t, const f32x2* tab) {
  constexpr int n = R / 4;
  const int e = (lane * 4) % R;
  const int half = e / (R / 2), w = e % (R / 2);
  const bool isx2 = w >= n;
  const int fi = w % n;
  const int pos = half ? (t & 63) : (t >> 6);
  f32x4 o;
#pragma unroll
  for (int i = 0; i < 4; ++i) {
    float pv = __shfl_xor(v[i], n / 4);
    f32x2 cs = tab[pos * 16 + fi + i];
    o[i] = v[i] * cs[0] + (isx2 ? pv : -pv) * cs[1];
  }
  return o;
}

DI void ssm_item(const P& p, int layer, int item, float* lds, int lane) {
  int b_all, r;
  if (item < 128) { b_all = 32 + item / 32; r = item % 32; } else { int it = item - 128; b_all = it / 32; r = it % 32; }
  const int dir = r >> 4, g = r & 15;
  const bool lat = b_all >= 32;
  const int T = lat ? 1024 : 256;
  const int row0 = lat ? NCTX + (b_all - 32) * 1024 : b_all * 256;
  const int tabidx = (layer * 2 + dir) * 16 + g;
  const int l32 = lane & 31, hh = lane >> 5, l16 = lane & 15, q4 = lane >> 4;
  const u16* atab = (const u16*)(p.ws + OFF_ATAB) + (size_t)tabidx * 128 * 16;
  const u16* ctab = (const u16*)(p.ws + OFF_CTAB) + (size_t)tabidx * 16 * 128;
  bf16x8 af[4], cf[4];
#pragma unroll
  for (int blk = 0; blk < 4; ++blk) af[blk] = *(const bf16x8*)(atab + (blk * 32 + l32) * 16 + hh * 8);
#pragma unroll
  for (int kk = 0; kk < 4; ++kk) cf[kk] = *(const bf16x8*)(ctab + l16 * 128 + kk * 32 + q4 * 8);
  const float* ab = (const float*)(p.ws + OFF_ABAR) + ((size_t)tabidx * 64 + lane) * 2;
  const float ar = ab[0], ai = ab[1];
  float hr = 0.f, hi = 0.f;
  if (lat) {
    size_t idx = ((size_t)((b_all - 32) * 2 + layer) * 2 + dir) * 1024 + g * 64 + lane;
    hr = p.in[I_SRE][idx]; hi = p.in[I_SIM][idx];
  }
  const float* proj = (const float*)(p.ws + OFF_PROJ);
  float* ybuf = (float*)(p.ws + OFF_YBUF) + (size_t)dir * NT * 256;
  f32x16 zero16;
#pragma unroll
  for (int i = 0; i < 16; ++i) zero16[i] = 0.f;
  f32x4 u0, u1;
  {
    const int t = dir ? (T - 1 - l32) : l32;
    const float* up = proj + (size_t)(row0 + t) * NP + 1280 + g * 16 + hh * 8;
    u0 = *(const f32x4*)up; u1 = *(const f32x4*)(up + 4);
  }
  for (int ch = 0; ch < T / 32; ++ch) {
    {
      bf16x8 uf = pack8(u0, u1);
      if (ch + 1 < T / 32) {
        const int n = (ch + 1) * 32 + l32;
        const int t = dir ? (T - 1 - n) : n;
        const float* up = proj + (size_t)(row0 + t) * NP + 1280 + g * 16 + hh * 8;
        u0 = *(const f32x4*)up; u1 = *(const f32x4*)(up + 4);
      }
#pragma unroll
      for (int blk = 0; blk < 4; ++blk) {
        f32x16 d = MFMA32(af[blk], uf, zero16);
#pragma unroll
        for (int j = 0; j < 4; ++j) {
          f32x4 v = {d[4 * j], d[4 * j + 1], d[4 * j + 2], d[4 * j + 3]};
          *(f32x4*)(lds + l32 * 132 + blk * 32 + 8 * j + 4 * hh) = v;
        }
      }
    }
    wave_lds_fence();
#pragma unroll
    for (int s = 0; s < 32; ++s) {
      f32x2 bu = *(const f32x2*)(lds + s * 132 + 2 * lane);
      float nr = ar * hr - ai * hi + bu[0];
      float ni = ar * hi + ai * hr + bu[1];
      hr = nr; hi = ni;
      f32x2 hv = {hr, hi};
      *(f32x2*)(lds + s * 132 + 2 * lane) = hv;
    }
    wave_lds_fence();
#pragma unroll
    for (int tb = 0; tb < 2; ++tb) {
      f32x4 y = {0.f, 0.f, 0.f, 0.f};
#pragma unroll
      for (int kk = 0; kk < 4; ++kk) {
        const float* hp = lds + (tb * 16 + l16) * 132 + kk * 32 + q4 * 8;
        f32x4 a0 = *(const f32x4*)hp, a1 = *(const f32x4*)(hp + 4);
        y = MFMA16(cf[kk], pack8(a0, a1), y);
      }
      const int n2 = ch * 32 + tb * 16 + l16;
      const int t2 = dir ? (T - 1 - n2) : n2;
      *(f32x4*)(ybuf + (size_t)(row0 + t2) * 256 + g * 16 + q4 * 4) = y;
    }
    wave_lds_fence();
  }
  if (!lat) {
    size_t idx = ((size_t)(b_all * 2 + layer) * 2 + dir) * 1024 + g * 64 + lane;
    p.out[O_SRE + idx] = hr;
    p.out[O_SIM + idx] = hi;
  }
}

DI void pp_row(const P& p, int layer, int row, int lane) {
  const float* pr = (const float*)(p.ws + OFF_PROJ) + (size_t)row * NP;
  const bool lat = row >= NCTX;
  int b, t, keyrow;
  if (!lat) { b = row >> 8; t = row & 255; keyrow = row; }
  else { int rr = row - NCTX; b = rr >> 10; t = rr & 1023; keyrow = NCTX + b * 1536 + 512 + t; }
  const f32x2* tab32 = (const f32x2*)(p.ws + OFF_ROPE);
  const f32x2* tab64 = tab32 + 64 * 16;
  const size_t orow = (size_t)(b * 2 + layer) * 256 + t;
  const f32x4 z4 = {0.f, 0.f, 0.f, 0.f};
  f32x4 v_dq = *(const f32x4*)(pr + lane * 4);
  f32x4 v_dk = *(const f32x4*)(pr + 256 + lane * 4);
  f32x4 v_dv = *(const f32x4*)(pr + 512 + lane * 4);
  f32x4 v_gq = *(const f32x4*)(pr + 768 + lane * 4);
  f32x4 v_gk = lane < 32 ? *(const f32x4*)(pr + 1024 + lane * 4) : z4;
  f32x4 v_gv = lane < 32 ? *(const f32x4*)(pr + 1152 + lane * 4) : z4;
  f32x4 v_cq = lane < 48 ? *(const f32x4*)(pr + 1536 + lane * 4) : z4;
  f32x4 v_ckv = lane < 32 ? *(const f32x4*)(pr + 1728 + lane * 4) : z4;
  f32x4 v_kr = lane < 8 ? *(const f32x4*)(pr + 1856 + lane * 4) : z4;
  const f32x4 g_q = *(const f32x4*)(p.in[I_QNG] + layer * 64 + (lane & 15) * 4);
  const f32x4 g_k = *(const f32x4*)(p.in[I_KNG] + layer * 64 + (lane & 15) * 4);
  const f32x4 g_cq = lane < 48 ? *(const f32x4*)(p.in[I_MQNG] + layer * 192 + lane * 4) : z4;
  const f32x4 g_ckv = lane < 32 ? *(const f32x4*)(p.in[I_MKVNG] + layer * 128 + lane * 4) : z4;
  f32x2 cs32[4], cs64[4];
  {
    const int e32 = (lane * 4) & 31, w32 = e32 & 15, p32 = (e32 >> 4) ? (t & 63) : (t >> 6), f32i = w32 & 7;
    const int e64 = (lane * 4) & 63, w64 = e64 & 31, p64 = (e64 >> 5) ? (t & 63) : (t >> 6), f64i = w64 & 15;
    const f32x2 one = {1.f, 0.f};
#pragma unroll
    for (int i = 0; i < 4; ++i) {
      cs32[i] = lat ? tab32[p32 * 16 + f32i + i] : one;
      cs64[i] = lat ? tab64[p64 * 16 + f64i + i] : one;
    }
  }
  const bool x2_32 = ((lane * 4) & 15) >= 8, x2_64 = ((lane * 4) & 31) >= 16;
  auto rope32 = [&](f32x4 v) {
    f32x4 o;
#pragma unroll
    for (int i = 0; i < 4; ++i) { float pv = __shfl_xor(v[i], 2); o[i] = v[i] * cs32[i][0] + (x2_32 ? pv : -pv) * cs32[i][1]; }
    return o;
  };
  auto rope64 = [&](f32x4 v) {
    f32x4 o;
#pragma unroll
    for (int i = 0; i < 4; ++i) { float pv = __shfl_xor(v[i], 4); o[i] = v[i] * cs64[i][0] + (x2_64 ? pv : -pv) * cs64[i][1]; }
    return o;
  };
  if (!lat) {
    *(f32x4*)(p.out + O_DK + orow * 256 + lane * 4) = v_dk;
    *(f32x4*)(p.out + O_DV + orow * 256 + lane * 4) = v_dv;
    if (lane < 32) *(f32x4*)(p.out + O_GV + orow * 128 + lane * 4) = v_gv;
    if (lane < 8) *(f32x4*)(p.out + O_KR + orow * 32 + lane * 4) = v_kr;
  }
  {
    f32x4 v = v_dq;
    if (lat) v = rope32(v);
    v = v * (0.17677669529663687f * LOG2E);
    *(u32x2*)((u16*)(p.ws + OFF_DQ) + (size_t)row * 256 + lane * 4) = pack4(v);
  }
  {
    f32x4 v = v_dk;
    if (lat) v = rope32(v);
    *(u32x2*)((u16*)(p.ws + OFF_DKB) + (size_t)keyrow * 256 + lane * 4) = pack4(v);
  }
  {
    f32x4 v = v_gq;
    float ss = v[0] * v[0] + v[1] * v[1] + v[2] * v[2] + v[3] * v[3];
    ss += __shfl_xor(ss, 1); ss += __shfl_xor(ss, 2); ss += __shfl_xor(ss, 4); ss += __shfl_xor(ss, 8);
    float r = rsqrtf(ss * (1.f / 64.f) + EPSF);
    v = v * r * g_q;
    if (lat) v = rope64(v);
    v = v * (0.125f * LOG2E);
    *(u32x2*)((u16*)(p.ws + OFF_GQ) + (size_t)row * 256 + lane * 4) = pack4(v);
  }
  {
    f32x4 v = v_gk;
    float ss = v[0] * v[0] + v[1] * v[1] + v[2] * v[2] + v[3] * v[3];
    ss += __shfl_xor(ss, 1); ss += __shfl_xor(ss, 2); ss += __shfl_xor(ss, 4); ss += __shfl_xor(ss, 8);
    float r = rsqrtf(ss * (1.f / 64.f) + EPSF);
    v = v * r * g_k;
    if (!lat) { if (lane < 32) *(f32x4*)(p.out + O_GK + orow * 128 + lane * 4) = v; }
    else v = rope64(v);
    if (lane < 32) *(u32x2*)((u16*)(p.ws + OFF_GKB) + (size_t)keyrow * 128 + lane * 4) = pack4(v);
  }
  {
    f32x4 v = v_cq;
    float ss = wave_sum(v[0] * v[0] + v[1] * v[1] + v[2] * v[2] + v[3] * v[3]);
    float r = rsqrtf(ss * (1.f / 192.f) + EPSF);
    v = v * r * g_cq;
    if (lane < 48) *(u32x2*)((u16*)(p.ws + OFF_CQN) + (size_t)row * 192 + lane * 4) = pack4(v);
  }
  {
    f32x4 v = v_ckv;
    float ss = wave_sum(v[0] * v[0] + v[1] * v[1] + v[2] * v[2] + v[3] * v[3]);
    float r = rsqrtf(ss * (1.f / 128.f) + EPSF);
    v = v * r * g_ckv;
    if (lane < 32) {
      if (!lat) *(f32x4*)(p.out + O_CKV + orow * 128 + lane * 4) = v;
      *(u32x2*)((u16*)(p.ws + OFF_CKVN) + (size_t)keyrow * 128 + lane * 4) = pack4(v);
    }
  }
  {
    f32x4 v = v_kr;
    if (lat) v = rope32(v);
    if (lane < 8) {
      u32x2 pk = pack4(v);
      u16* mk = (u16*)(p.ws + OFF_MKB) + (size_t)keyrow * 384 + 64 + lane * 4;
#pragma unroll
      for (int hd = 0; hd < 4; ++hd) *(u32x2*)(mk + hd * 96) = pk;
    }
  }
}

DI void pp_cached(const P& p, int layer, int crow_, int lane) {
  const int b = crow_ >> 9, j = crow_ & 511;
  const int keyrow = NCTX + b * 1536 + j;
  const size_t src = (size_t)(b * 2 + layer) * 512 + j;
  const int jp = (j & ~15) | (((j >> 2) & 1) << 3) | (((j >> 3) & 1) << 2) | (j & 3);
  const f32x4 z4 = {0.f, 0.f, 0.f, 0.f};
  const int l31 = lane & 31, l7 = lane & 7;
  f32x4 v_dk = *(const f32x4*)(p.in[I_CDK] + src * 256 + lane * 4);
  f32x4 v_dv = *(const f32x4*)(p.in[I_CDV] + src * 256 + lane * 4);
  f32x4 v_gk = *(const f32x4*)(p.in[I_CGK] + src * 128 + l31 * 4);
  f32x4 v_gv = *(const f32x4*)(p.in[I_CGV] + src * 128 + l31 * 4);
  f32x4 v_ckv = *(const f32x4*)(p.in[I_CCKV] + src * 128 + l31 * 4);
  f32x4 v_kr = *(const f32x4*)(p.in[I_CKR] + src * 32 + l7 * 4);
  (void)z4;
  *(u32x2*)((u16*)(p.ws + OFF_DKB) + (size_t)keyrow * 256 + lane * 4) = pack4(v_dk);
  {
    u16* vt = (u16*)(p.ws + OFF_DVT) + vt_off(32 + b, lane >> 4, 4) + (size_t)((lane & 15) * 4) * 1536 + jp;
#pragma unroll
    for (int i = 0; i < 4; ++i) vt[(size_t)i * 1536] = f2bf(v_dv[i]);
  }
  if (lane < 32) {
    *(u32x2*)((u16*)(p.ws + OFF_GKB) + (size_t)keyrow * 128 + lane * 4) = pack4(v_gk);
    u16* vt = (u16*)(p.ws + OFF_GVT) + vt_off(32 + b, lane >> 4, 2) + (size_t)((lane & 15) * 4) * 1536 + jp;
#pragma unroll
    for (int i = 0; i < 4; ++i) vt[(size_t)i * 1536] = f2bf(v_gv[i]);
    *(u32x2*)((u16*)(p.ws + OFF_CKVN) + (size_t)keyrow * 128 + lane * 4) = pack4(v_ckv);
  }
  if (lane < 8) {
    u32x2 pk = pack4(v_kr);
    u16* mk = (u16*)(p.ws + OFF_MKB) + (size_t)keyrow * 384 + 64 + lane * 4;
#pragma unroll
    for (int hd = 0; hd < 4; ++hd) *(u32x2*)(mk + hd * 96) = pk;
  }
}

DI void phase_pp(const P& p, int layer, char* smem) {
  const int tid_ = get_tid();
  const int lane = tid_ & 63, wave = tid_ >> 6;
  float* lds = (float*)smem + wave * (32 * 132);
  const int gw = blockIdx.x * NWV + wave, nw = gridDim.x * NWV;
  constexpr int N_SSM = 1152, N_ROWS = NT + 2048;
  for (int item = gw; item < N_SSM; item += nw) ssm_item(p, layer, item, lds, lane);
  const int rw0 = (nw > 256) ? 128 : 0;
  if (gw >= rw0) {
    for (int row = gw - rw0; row < N_ROWS; row += nw - rw0) {
      if (row < NT) pp_row(p, layer, row, lane);
      else pp_cached(p, layer, row - NT, lane);
    }
  }
}

template <int KW, int DK>
DI void attn_block(const u16* __restrict__ Kg, int ldk, const u16* __restrict__ Vt, int nk, const bf16x8 (&qf)[DK / 16], int kcol, char* smem,
                   int tid, f32x16 (&o)[2], float& lsum) {
  constexpr int KST = KW + 8, KS = DK / 16, KCH = KW / 8, KTOT = 64 * KCH, NKC = (KTOT + NTHR - 1) / NTHR;
  const int lane = tid & 63, l32 = lane & 31, hh = lane >> 5;
  u16* Ks = (u16*)smem;
  u16* Vs = Ks + 2 * 64 * KST;
  float m = -1e30f;
  lsum = 0.f;
#pragma unroll
  for (int db = 0; db < 2; ++db)
#pragma unroll
    for (int r = 0; r < 16; ++r) o[db][r] = 0.f;
  u32x4 rk[NKC], rv[1];
  const int nt = nk / 64;
#pragma unroll
  for (int i = 0; i < NKC; ++i) { int c = tid + NTHR * i, r = c / KCH, kc = (c % KCH) * 8; if (c < KTOT) rk[i] = *(const u32x4*)(Kg + (size_t)r * ldk + kc); }
  { int r = tid >> 3, kc = (tid & 7) * 8; rv[0] = *(const u32x4*)(Vt + (size_t)r * nk + kc); }
#pragma unroll
  for (int i = 0; i < NKC; ++i) { int c = tid + NTHR * i, r = c / KCH, kc = (c % KCH) * 8; if (c < KTOT) *(u32x4*)(Ks + r * KST + kc) = rk[i]; }
  { int r = tid >> 3, kc = (tid & 7) * 8; *(u32x4*)(Vs + r * 72 + kc) = rv[0]; }
  __syncthreads();
  for (int t = 0; t < nt; ++t) {
    const int buf = t & 1;
    const bool more = (t + 1 < nt);
    if (more) {
      const int kt = (t + 1) * 64;
#pragma unroll
      for (int i = 0; i < NKC; ++i) { int c = tid + NTHR * i, r = c / KCH, kc = (c % KCH) * 8; if (c < KTOT) rk[i] = *(const u32x4*)(Kg + (size_t)(kt + r) * ldk + kc); }
      { int r = tid >> 3, kc = (tid & 7) * 8; rv[0] = *(const u32x4*)(Vt + (size_t)r * nk + kt + kc); }
    }
    const u16* ks = Ks + buf * 64 * KST + l32 * KST + kcol + hh * 8;
    const u16* vs = Vs + buf * 64 * 72 + l32 * 72 + hh * 8;
    f32x16 sa[2];
#pragma unroll
    for (int kb = 0; kb < 2; ++kb) {
#pragma unroll
      for (int r = 0; r < 16; ++r) sa[kb][r] = 0.f;
#pragma unroll
      for (int s2 = 0; s2 < KS; ++s2) {
        bf16x8 kf = *(const bf16x8*)(ks + kb * 32 * KST + s2 * 16);
        sa[kb] = MFMA32(kf, qf[s2], sa[kb]);
      }
      __builtin_amdgcn_sched_barrier(0);
    }
    float mx = sa[0][0];
#pragma unroll
    for (int r = 1; r < 16; ++r) mx = fmaxf(mx, sa[0][r]);
#pragma unroll
    for (int r = 0; r < 16; ++r) mx = fmaxf(mx, sa[1][r]);
    mx = fmaxf(mx, __shfl_xor(mx, 32));
    const float mn = fmaxf(m, mx);
    const float alpha = fexp2(m - mn);
    m = mn;
    float ps = 0.f;
#pragma unroll
    for (int kb = 0; kb < 2; ++kb)
#pragma unroll
      for (int r = 0; r < 16; ++r) { float e = fexp2(sa[kb][r] - mn); sa[kb][r] = e; ps += e; }
    lsum = lsum * alpha + ps;
#pragma unroll
    for (int db = 0; db < 2; ++db)
#pragma unroll
      for (int r = 0; r < 16; ++r) o[db][r] *= alpha;
#pragma unroll
    for (int s2 = 0; s2 < 4; ++s2) {
      const int kb = s2 >> 1, rb = 8 * (s2 & 1);
      f32x4 p0 = {sa[kb][rb], sa[kb][rb + 1], sa[kb][rb + 2], sa[kb][rb + 3]};
      f32x4 p1 = {sa[kb][rb + 4], sa[kb][rb + 5], sa[kb][rb + 6], sa[kb][rb + 7]};
      bf16x8 pf = pack8(p0, p1);
      bf16x8 v0 = *(const bf16x8*)(vs + s2 * 16);
      bf16x8 v1 = *(const bf16x8*)(vs + 32 * 72 + s2 * 16);
      o[0] = MFMA32(v0, pf, o[0]);
      o[1] = MFMA32(v1, pf, o[1]);
      if (s2 == 1) __builtin_amdgcn_sched_barrier(0);
    }
    if (more) {
      const int nb = buf ^ 1;
#pragma unroll
      for (int i = 0; i < NKC; ++i) { int c = tid + NTHR * i, r = c / KCH, kc = (c % KCH) * 8; if (c < KTOT) *(u32x4*)(Ks + nb * 64 * KST + r * KST + kc) = rk[i]; }
      { int r = tid >> 3, kc = (tid & 7) * 8; *(u32x4*)(Vs + nb * 64 * 72 + r * 72 + kc) = rv[0]; }
    }
    __syncthreads();
  }
  lsum += __shfl_xor(lsum, 32);
}

DI void store_o(u16* dst  , const f32x16 (&o)[2], float scale, int hh) {
#pragma unroll
  for (int db = 0; db < 2; ++db)
#pragma unroll
    for (int j = 0; j < 4; ++j) {
      const int dv = db * 32 + 8 * j + 4 * hh;
      f32x4 v = {o[db][4 * j] * scale, o[db][4 * j + 1] * scale, o[db][4 * j + 2] * scale, o[db][4 * j + 3] * scale};
      *(u32x2*)(dst + dv) = pack4(v);
    }
}

DI void attn_item(const P& p, int layer, int item, char* smem, int tid) {
  const int lane = tid & 63, wave = tid >> 6, l32 = lane & 31, hh = lane >> 5;
  bool lat; int kind, b, hd, qblk;
  if (item < 256) {
    lat = true;
    if (item < 128) { kind = 0; b = item >> 5; hd = (item >> 3) & 3; qblk = item & 7; }
    else { int it = item - 128; kind = 1 + (it >> 6); it &= 63; b = it >> 4; hd = (it >> 2) & 3; qblk = it & 3; }
  } else {
    lat = false;
    int it = item - 256;
    if (it < 256) { kind = 0; b = it >> 3; hd = (it >> 1) & 3; qblk = it & 1; }
    else { it -= 256; kind = 1 + (it >> 7); it &= 127; b = it >> 2; hd = it & 3; qblk = 0; }
  }
  const int nk = lat ? 1536 : 256;
  const int b_all = lat ? 32 + b : b;
  const int keyrow0 = lat ? NCTX + b * 1536 : b * 256;
  const int tok0 = lat ? NCTX + b * 1024 : b * 256;
  f32x16 o[2]; float ls;
  if (kind == 0) {
    const int ns = wave & 1, qb = wave >> 1;
    const int q0 = tok0 + qblk * 128 + qb * 32;
    const u16* Q = (const u16*)(p.ws + OFF_DQ) + (size_t)(q0 + l32) * 256 + hd * 64 + ns * 32 + hh * 8;
    bf16x8 qf[2];
    qf[0] = *(const bf16x8*)Q; qf[1] = *(const bf16x8*)(Q + 16);
    attn_block<64, 32>((const u16*)(p.ws + OFF_DKB) + (size_t)keyrow0 * 256 + hd * 64, 256, (const u16*)(p.ws + OFF_DVT) + vt_off(b_all, hd, 4), nk, qf, ns * 32,
                       smem, tid, o, ls);
    float d1 = 0.f, d2 = 0.f;
    if (lane < 32) { d1 = p.in[I_LQ1][layer * 32 + lane] * p.in[I_LK1][layer * 32 + lane]; d2 = p.in[I_LQ2][layer * 32 + lane] * p.in[I_LK2][layer * 32 + lane]; }
    d1 = wave_sum(d1); d2 = wave_sum(d2);
    int ly_ = layer; asm volatile("" : "+s"(ly_));
    const float lam_init = ly_ == 0 ? 0.2f : (0.8f - 0.6f * 0.7408182206817179f);
    const float lam = expf(d1) - expf(d2) + lam_init;
    float* cmb = (float*)smem + qb * (64 * 33);
    if (ns == 1) {
      const float sc = lam / ls;
#pragma unroll
      for (int db = 0; db < 2; ++db)
#pragma unroll
        for (int r = 0; r < 16; ++r) cmb[(db * 32 + crow(r, hh)) * 33 + l32] = o[db][r] * sc;
    }
    __syncthreads();
    if (ns == 0) {
      const float i0 = 1.f / ls;
      float ss = 0.f;
#pragma unroll
      for (int db = 0; db < 2; ++db)
#pragma unroll
        for (int r = 0; r < 16; ++r) { float d = o[db][r] * i0 - cmb[(db * 32 + crow(r, hh)) * 33 + l32]; o[db][r] = d; ss += d * d; }
      ss += __shfl_xor(ss, 32);
      const float rr = rsqrtf(ss * (1.f / 64.f) + EPSF) * (1.f - lam_init);
      u16* dst = (u16*)(p.ws + OFF_MIXED) + (size_t)(q0 + l32) * 1024 + hd * 64;
#pragma unroll
      for (int db = 0; db < 2; ++db)
#pragma unroll
        for (int j = 0; j < 4; ++j) {
          const int dv = db * 32 + 8 * j + 4 * hh;
          f32x4 g = *(const f32x4*)(p.in[I_SUBLN] + layer * 64 + dv);
          f32x4 v = {o[db][4 * j] * rr * g[0], o[db][4 * j + 1] * rr * g[1], o[db][4 * j + 2] * rr * g[2], o[db][4 * j + 3] * rr * g[3]};
          *(u32x2*)(dst + dv) = pack4(v);
        }
    }
    __syncthreads();
  } else if (kind == 1) {
    const int q0 = tok0 + qblk * 256 + wave * 32;
    const u16* Q = (const u16*)(p.ws + OFF_GQ) + (size_t)(q0 + l32) * 256 + hd * 64 + hh * 8;
    bf16x8 qf[4];
#pragma unroll
    for (int s2 = 0; s2 < 4; ++s2) qf[s2] = *(const bf16x8*)(Q + s2 * 16);
    attn_block<64, 64>((const u16*)(p.ws + OFF_GKB) + (size_t)keyrow0 * 128 + (hd >> 1) * 64, 128, (const u16*)(p.ws + OFF_GVT) + vt_off(b_all, hd >> 1, 2), nk, qf, 0,
                       smem, tid, o, ls);
    store_o((u16*)(p.ws + OFF_MIXED) + (size_t)(q0 + l32) * 1024 + 256 + hd * 64, o, 1.f / ls, hh);
  } else {
    const int q0 = tok0 + qblk * 256 + wave * 32;
    const u16* Q = (const u16*)(p.ws + OFF_MQ) + (size_t)(q0 + l32) * 384 + hd * 96 + hh * 8;
    bf16x8 qf[6];
#pragma unroll
    for (int s2 = 0; s2 < 6; ++s2) qf[s2] = *(const bf16x8*)(Q + s2 * 16);
    attn_block<96, 96>((const u16*)(p.ws + OFF_MKB) + (size_t)keyrow0 * 384 + hd * 96, 384, (const u16*)(p.ws + OFF_MVT) + vt_off(b_all, hd, 4), nk, qf, 0,
                       smem, tid, o, ls);
    store_o((u16*)(p.ws + OFF_MIXED) + (size_t)(q0 + l32) * 1024 + 768 + hd * 64, o, 1.f / ls, hh);
  }
}

DI void phase_at(const P& p, int layer, char* smem) {
  EPI_IDX
  constexpr int N_ITEMS = 768;
  if (gridDim.x == 256) {
    const int b = blockIdx.x;
    attn_item(p, layer, b, smem, tid);
    __syncthreads();
    if (b < 128) {
      attn_item(p, layer, 256 + b, smem, tid); __syncthreads();
      attn_item(p, layer, 512 + b, smem, tid); __syncthreads();
      attn_item(p, layer, 640 + b, smem, tid); __syncthreads();
    } else if (b < 192) {
      attn_item(p, layer, 256 + 128 + 2 * (b - 128), smem, tid); __syncthreads();
      attn_item(p, layer, 256 + 128 + 2 * (b - 128) + 1, smem, tid); __syncthreads();
    }
  } else {
    for (int item = blockIdx.x; item < N_ITEMS; item += gridDim.x) {
      attn_item(p, layer, item, smem, tid);
      __syncthreads();
    }
  }
  {
    constexpr int T_GLU = (NT / 256) * 2;
    auto tile_at = [&](int t) { TD d; d.A = (const u16*)(p.ws + OFF_PROJ); d.lda = NP * 2; d.B = (const u16*)(p.ws + OFF_WGLU) + (size_t)layer * 512 * 256; d.ldb = 256; d.k0 = 0; d.nk = 4; d.m0 = (t >> 1) * 256; d.n0 = (t & 1) * 256; return d; };
    int buf = 0;
    const int t0 = (int)gridDim.x - 1 - (int)blockIdx.x;
    TD cur = tile_at(t0 < T_GLU ? t0 : 0);
    if (t0 < T_GLU) stage_td(cur, 0, smem, tid);
    for (int t = t0; t < T_GLU; t += gridDim.x) {
      const bool has_next = (t + (int)gridDim.x < T_GLU);
      const TD nxt = tile_at(has_next ? t + (int)gridDim.x : t);
      const int m0 = cur.m0, n0 = cur.n0;
      f32x16 acc[4][2];
      gemm_stream(cur, has_next, nxt, smem, buf, acc);
      cur = nxt;
      u16* mixed = (u16*)(p.ws + OFF_MIXED);
      const int q = (n0 + wn * 64) >> 6;
#pragma unroll
      for (int bi = 0; bi < 4; ++bi) {
        const int rb = m0 + wm * 128 + bi * 32;
#pragma unroll
        for (int r = 0; r < 16; ++r) {
          float z = acc[bi][0][r], g = acc[bi][1][r];
          mixed[(size_t)(rb + crow(r, hh)) * 1024 + 512 + q * 32 + l32] = f2bf(z * fsigmoid(g));
        }
      }
    }
  }
}

#define XB_TMO      128
#define XB_XCNT(j)  (256  + 64 * (j))
#define XB_XSUB(j)  (1280 + 64 * (j))
#define XB_XGEN(j)  (2304 + 64 * (j))
#define XB_TOP      3328
#define XB_TOPGEN   3392
#define XCD_BAR_WORDS 3456
#define XB_SPIN_CAP (1u << 22)
#define LAS __attribute__((address_space(3)))
DI unsigned xb_ld(unsigned* p) { return __hip_atomic_load(p, __ATOMIC_RELAXED, __HIP_MEMORY_SCOPE_AGENT); }
DI unsigned xb_add(unsigned* p, unsigned v) { return __hip_atomic_fetch_add(p, v, __ATOMIC_RELAXED, __HIP_MEMORY_SCOPE_AGENT); }
DI unsigned xb_xcc_id() { return (unsigned)__builtin_amdgcn_s_getreg((3 << 11) | 20) & 0xFu; }
#define XB_SPIN(cond, bar) do { unsigned _sp = 0; while (cond) { __builtin_amdgcn_s_sleep(1); \
    if ((++_sp & 255u) == 0u) { if (xb_ld(&(bar)[XB_TMO])) break; if (_sp > XB_SPIN_CAP) { atomicAdd(&(bar)[XB_TMO], 1u); break; } } } } while (0)
struct XcdBarrier { unsigned* bar; unsigned x; volatile LAS unsigned* st; };
DI XcdBarrier xcd_barrier_post(unsigned* bar, volatile LAS unsigned* st) {
  XcdBarrier b; b.bar = bar; b.x = xb_xcc_id(); b.st = st;
  if (threadIdx.x == 0) st[2] = xb_add(&bar[XB_XCNT(b.x)], 1u);
  return b;
}
DI void xcd_barrier_complete(unsigned* bar, unsigned x, unsigned& nloc, unsigned& nx) {
  const unsigned G = gridDim.x * gridDim.y * gridDim.z;
  unsigned sum, cnt, mine, sp = 0u;
  for (;;) {
    sum = 0u; cnt = 0u; mine = 0u;
#pragma unroll
    for (unsigned j = 0; j < 16; ++j) { const unsigned c = xb_ld(&bar[XB_XCNT(j)]); sum += c; cnt += (c > 0u) ? 1u : 0u; mine = (j == x) ? c : mine; }
    if (sum == G) break;
    __builtin_amdgcn_s_sleep(1);
    if ((++sp & 255u) == 0u) { if (xb_ld(&bar[XB_TMO])) break; if (sp > XB_SPIN_CAP) { atomicAdd(&bar[XB_TMO], 1u); break; } }
  }
  nloc = mine > 0u ? mine : 1u; nx = cnt > 0u ? cnt : 1u;
}
DI void xcd_barrier(const XcdBarrier& b) {
  asm volatile("s_waitcnt vmcnt(0)" ::: "memory");
  __syncthreads();
  if (threadIdx.x == 0) {
    unsigned* bar = b.bar;
    __builtin_amdgcn_s_waitcnt(0);
    unsigned nloc = b.st[0], nx = b.st[1];
    if (nloc == 0u) { xcd_barrier_complete(bar, b.x, nloc, nx); b.st[0] = nloc; b.st[1] = nx; }
    const unsigned old = xb_add(&bar[XB_XSUB(b.x)], 1u);
    const unsigned gen = old / nloc;
    if (old + 1u == (gen + 1u) * nloc) {
      __builtin_amdgcn_fence(__ATOMIC_RELEASE, "agent");
      asm volatile("s_waitcnt vmcnt(0)" ::: "memory");
      const unsigned og = xb_add(&bar[XB_TOP], 1u);
      const unsigned tg = og / nx;
      if (og + 1u == (tg + 1u) * nx) xb_add(&bar[XB_TOPGEN], 1u);
      else XB_SPIN(xb_ld(&bar[XB_TOPGEN]) == tg, bar);
      __builtin_amdgcn_fence(__ATOMIC_ACQUIRE, "agent");
      xb_add(&bar[XB_XGEN(b.x)], 1u);
      asm volatile("s_waitcnt vmcnt(0)" ::: "memory");
    } else {
      XB_SPIN(xb_ld(&bar[XB_XGEN(b.x)]) == gen, bar);
      __builtin_amdgcn_fence(__ATOMIC_ACQUIRE, "agent");
      asm volatile("s_waitcnt vmcnt(0)" ::: "memory");
    }
  }
  __syncthreads();
}

DI void run_phase(const P& p_, int ph, int layer, char* smem) {
  P p = p_;
  asm volatile("" : "+s"(p.ws), "+s"(p.out));
  switch (ph) {
    case 0: prologue(p, smem); break;
    case 1: norm_phase(p, layer, 0); break;
    case 2: phase_g1(p, layer, smem); break;
    case 3: phase_pp(p, layer, smem); break;
    case 4: phase_g2(p, layer, smem); break;
    case 5: phase_at(p, layer, smem); break;
    case 6: phase_resid(p, layer, smem, true); break;
    case 7: norm_phase(p, layer, 1); break;
    case 8: phase_g5(p, layer, smem); break;
    case 9: phase_resid(p, layer, smem, false); break;
    case 10: norm_phase(p, 0, 2); break;
  }
}

extern __shared__ __attribute__((aligned(16))) char dyn_smem[];

__global__ void __launch_bounds__(512) fwd_mega(P p) {
  if (p.ws == nullptr) { cg::grid_group grid = cg::this_grid(); grid.sync(); }
  volatile LAS unsigned* st = (volatile LAS unsigned*)(dyn_smem + LDS_BYTES);
  if (threadIdx.x == 0) { st[0] = 0u; st[1] = 0u; st[2] = 0u; st[3] = 0u; }
  __syncthreads();
  XcdBarrier xb = xcd_barrier_post((unsigned*)(p.ws + OFF_BAR), st);
  run_phase(p, 0, 0, dyn_smem);
  xcd_barrier(xb);
  if (threadIdx.x == 0) {
    unsigned* bar = (unsigned*)(p.ws + OFF_BAR);
    bool ok = (gridDim.x & 7u) == 0u;
    for (unsigned j = 0; j < 16; ++j) { const unsigned c = xb_ld(&bar[XB_XCNT(j)]); ok = ok && (c == (j < 8 ? gridDim.x >> 3 : 0u)); }
    if (ok) st[3] = xb.x; else { st[2] = blockIdx.x >> 3; st[3] = blockIdx.x & 7u; }
  }
  __syncthreads();
  for (int l = 0; l < 2; ++l) {
    for (int ph = 1; ph <= 9; ++ph) {
      run_phase(p, ph, l, dyn_smem);
      xcd_barrier(xb);
    }
  }
  run_phase(p, 10, 0, dyn_smem);
}

#if !MEGA
__global__ void __launch_bounds__(512) fwd_phase(P p, int ph, int layer) { run_phase(p, ph, layer, dyn_smem); }
#endif

extern "C" void kernel_launch(void* const* d_in, const int* in_sizes, int n_in, void* d_out, int out_size, void* d_ws, size_t ws_size,
                              hipStream_t stream) {
  static int grid_blocks = 0;
  if (!grid_blocks) {
    int dev = 0, cus = 0, per_cu = 0;
    (void)hipGetDevice(&dev);
    (void)hipDeviceGetAttribute(&cus, hipDeviceAttributeMultiprocessorCount, dev);
    (void)hipFuncSetAttribute((const void*)fwd_mega, hipFuncAttributeMaxDynamicSharedMemorySize, LDS_BYTES + 16);
#if !MEGA
    (void)hipFuncSetAttribute((const void*)fwd_phase, hipFuncAttributeMaxDynamicSharedMemorySize, LDS_BYTES);
#endif
    (void)hipOccupancyMaxActiveBlocksPerMultiprocessor(&per_cu, (const void*)fwd_mega, NTHR, LDS_BYTES + 16);
    if (per_cu < 1) per_cu = 1;
    if (per_cu > 1) per_cu = 1;
    grid_blocks = cus * per_cu;
    if (ws_size < WS_NEED) fprintf(stderr, "kernel_launch: workspace too small: %zu < %zu\n", ws_size, (size_t)WS_NEED);
  }
  P p{};
  for (int i = 0; i < N_IN; ++i) p.in[i] = (const float*)d_in[i];
  p.out = (float*)d_out;
  p.ws = (char*)d_ws;
#if MEGA
  (void)hipMemsetAsync((char*)d_ws + OFF_BAR, 0, XCD_BAR_WORDS * 4, stream);
  void* args[] = {&p};
  hipError_t e = hipLaunchCooperativeKernel((const void*)fwd_mega, dim3(grid_blocks), dim3(NTHR), args, LDS_BYTES + 16, stream);
  if (e != hipSuccess) fprintf(stderr, "cooperative launch failed: %s (grid %d)\n", hipGetErrorString(e), grid_blocks);
#else
  hipLaunchKernelGGL(fwd_phase, dim3(grid_blocks), dim3(NTHR), LDS_BYTES, stream, p, 0, 0);
  for (int l = 0; l < 2; ++l)
    for (int ph = 1; ph <= 9; ++ph) hipLaunchKernelGGL(fwd_phase, dim3(grid_blocks), dim3(NTHR), LDS_BYTES, stream, p, ph, l);
  hipLaunchKernelGGL(fwd_phase, dim3(grid_blocks), dim3(NTHR), LDS_BYTES, stream, p, 10, 0);
#endif
}
```

```cpp
#include <hip/hip_runtime.h>
#include <hip/hip_cooperative_groups.h>
#include <cstdio>
namespace cg = cooperative_groups;

#ifndef MEGA
#define MEGA 1
#endif

#define DI __device__ __forceinline__
typedef unsigned short u16;
typedef __attribute__((ext_vector_type(8))) short bf16x8;
typedef __attribute__((ext_vector_type(4))) short bf16x4;
typedef __attribute__((ext_vector_type(2))) __bf16 bf2_t;
typedef __attribute__((ext_vector_type(2))) float f32x2;
typedef __attribute__((ext_vector_type(4))) float f32x4;
typedef __attribute__((ext_vector_type(16))) float f32x16;
typedef __attribute__((ext_vector_type(4))) unsigned u32x4;
typedef __attribute__((ext_vector_type(2))) unsigned u32x2;

#define MFMA32(a, b, c) __builtin_amdgcn_mfma_f32_32x32x16_bf16((a), (b), (c), 0, 0, 0)
#define MFMA16(a, b, c) __builtin_amdgcn_mfma_f32_16x16x32_bf16((a), (b), (c), 0, 0, 0)

constexpr int NT = 12288;
constexpr int NCTX = 8192;
constexpr int NKR = 14336;
constexpr int NP = 1920;
constexpr float EPSF = 1e-6f;
constexpr float LOG2E = 1.4426950408889634f;

enum { I_XP = 0, I_XS, I_CDK, I_CDV, I_CGK, I_CGV, I_CCKV, I_CKR, I_SRE, I_SIM, I_C, I_CCTX, I_N1G, I_N2G, I_WADA, I_BADA,
       I_WIN, I_WOUT, I_LQ1, I_LK1, I_LQ2, I_LK2, I_SUBLN, I_QNG, I_KNG, I_ARE, I_AIM, I_LOGDT, I_BRE, I_BIM, I_CRE, I_CIM,
       I_SSMD, I_WGLU, I_MQNG, I_MKVNG, I_WUQ, I_WUKV, I_W1, I_W2, I_FNG, N_IN };

constexpr size_t O_Y = 0;
constexpr size_t O_DK = 12582912;
constexpr size_t O_DV = 16777216;
constexpr size_t O_GK = 20971520;
constexpr size_t O_GV = 23068672;
constexpr size_t O_CKV = 25165824;
constexpr size_t O_KR = 27262976;
constexpr size_t O_SRE = 27787264;
constexpr size_t O_SIM = 27918336;

constexpr size_t al256(size_t x) { return (x + 255) & ~(size_t)255; }
constexpr size_t OFF_MOD = 0;
constexpr size_t OFF_CTR = al256(OFF_MOD + 2 * 5 * 6144 * 4);
constexpr size_t OFF_BAR = al256(OFF_CTR + 256);
constexpr size_t OFF_ROPE = al256(OFF_BAR + 3456 * 4);
constexpr size_t OFF_ABAR = al256(OFF_ROPE + 2 * 64 * 16 * 8);
constexpr size_t OFF_ATAB = al256(OFF_ABAR + 64 * 64 * 8);
constexpr size_t OFF_CTAB = al256(OFF_ATAB + 64 * 128 * 16 * 2);
constexpr size_t OFF_WIN = al256(OFF_CTAB + 64 * 16 * 128 * 2);
constexpr size_t OFF_WOUT = al256(OFF_WIN + (size_t)2 * 1920 * 1024 * 2);
constexpr size_t OFF_W1 = al256(OFF_WOUT + (size_t)2 * 1024 * 1024 * 2);
constexpr size_t OFF_W2 = al256(OFF_W1 + (size_t)2 * 4096 * 1024 * 2);
constexpr size_t OFF_WUQ = al256(OFF_W2 + (size_t)2 * 4096 * 1024 * 2);
constexpr size_t OFF_WUKV = al256(OFF_WUQ + (size_t)2 * 384 * 192 * 2);
constexpr size_t OFF_WGLU = al256(OFF_WUKV + (size_t)2 * 512 * 128 * 2);
constexpr size_t OFF_H = al256(OFF_WGLU + (size_t)2 * 512 * 256 * 2);
constexpr size_t OFF_MIXED = OFF_H;
constexpr size_t OFF_BIG = al256(OFF_H + (size_t)NT * 1024 * 2);
constexpr size_t OFF_PROJ = OFF_BIG;
constexpr size_t OFF_DQ = al256(OFF_PROJ + (size_t)NT * NP * 4);
constexpr size_t OFF_DKB = al256(OFF_DQ + (size_t)NT * 256 * 2);
constexpr size_t OFF_DVT = al256(OFF_DKB + (size_t)NKR * 256 * 2);
constexpr size_t OFF_GQ = al256(OFF_DVT + (size_t)NKR * 256 * 2);
constexpr size_t OFF_GKB = al256(OFF_GQ + (size_t)NT * 256 * 2);
constexpr size_t OFF_GVT = al256(OFF_GKB + (size_t)NKR * 128 * 2);
constexpr size_t OFF_MQ = al256(OFF_GVT + (size_t)NKR * 128 * 2);
constexpr size_t OFF_MKB = al256(OFF_MQ + (size_t)NT * 384 * 2);
constexpr size_t OFF_MVT = al256(OFF_MKB + (size_t)NKR * 384 * 2);
constexpr size_t OFF_CQN = al256(OFF_MVT + (size_t)NKR * 256 * 2);
constexpr size_t OFF_CKVN = al256(OFF_CQN + (size_t)NT * 192 * 2);
constexpr size_t OFF_YBUF = al256(OFF_CKVN + (size_t)NKR * 128 * 2);
constexpr size_t OFF_END1 = al256(OFF_YBUF + (size_t)2 * NT * 256 * 4);
constexpr size_t OFF_A = OFF_BIG;
constexpr size_t OFF_END2 = al256(OFF_A + (size_t)NT * 4096 * 2);
constexpr size_t WS_NEED = OFF_END1 > OFF_END2 ? OFF_END1 : OFF_END2;
static_assert(WS_NEED <= (size_t)256 * 1024 * 1024, "workspace over 256 MiB");

constexpr int NTHR = 512;
constexpr int NWV = NTHR / 64;
constexpr int LDS_BYTES = 8 * 32 * 132 * 4;

struct P {
  const float* in[N_IN];
  float* out;
  char* ws;
};

DI unsigned pack2(float a, float b) { f32x2 v = {a, b}; return __builtin_bit_cast(unsigned, __builtin_convertvector(v, bf2_t)); }
DI u16 f2bf(float a) { return (u16)(pack2(a, 0.f) & 0xffffu); }
DI bf16x8 pack8(f32x4 a, f32x4 b) {
  u32x4 r = {pack2(a[0], a[1]), pack2(a[2], a[3]), pack2(b[0], b[1]), pack2(b[2], b[3])};
  return __builtin_bit_cast(bf16x8, r);
}
DI u32x2 pack4(f32x4 a) { u32x2 r = {pack2(a[0], a[1]), pack2(a[2], a[3])}; return r; }
DI int get_tid() { int t = threadIdx.x; asm volatile("" : "+v"(t)); return t; }
DI float fexp2(float x) { return __builtin_amdgcn_exp2f(x); }
DI float frcp(float x) { return __builtin_amdgcn_rcpf(x); }
DI float fsigmoid(float w) { return frcp(1.f + fexp2(-w * LOG2E)); }
DI float gelu_tanh(float x) { return x * fsigmoid(1.5957691216057308f * (x + 0.044715f * x * x * x)); }
DI float wave_sum(float v) {
#pragma unroll
  for (int o = 32; o >= 1; o >>= 1) v += __shfl_xor(v, o);
  return v;
}
DI void wave_lds_fence() {
  asm volatile("s_waitcnt lgkmcnt(0)" ::: "memory");
  __builtin_amdgcn_wave_barrier();
}
DI int fetch_item(int* ctr, int lane) {
  int v = 0;
  if (lane == 0) v = atomicAdd(ctr, 1);
  return __builtin_amdgcn_readfirstlane(v);
}
DI size_t vt_off(int b_all, int head, int H) {
  if (b_all < 32) return ((size_t)(b_all * H + head) * 64) * 256;
  return (size_t)32 * H * 64 * 256 + ((size_t)((b_all - 32) * H + head) * 64) * 1536;
}
DI int mod_index(int row) { return row < NCTX ? 0 : 1 + ((row - NCTX) >> 10); }

DI void prologue(const P& p, char* smem) {
  const int tid = get_tid();
  float* fs = (float*)smem;
  constexpr int N_ADA = 384, N_TAB = 64, N_MISC = 1, N_TR = 5700;
  constexpr int TOTAL = N_ADA + N_TAB + N_MISC;
  for (int it = blockIdx.x; it < TOTAL; it += gridDim.x) {
    if (it < N_ADA) {
      const int l = it / 192, ch = it % 192;
      float* sc = fs;
      float* red = fs + 5 * 1024;
      for (int i = tid; i < 5 * 1024; i += NTHR) {
        int m = i >> 10, k = i & 1023;
        float c = (m == 0) ? p.in[I_CCTX][k] : p.in[I_C][(m - 1) * 1024 + k];
        sc[i] = c * fsigmoid(c);
      }
      __syncthreads();
      const int col = tid & 31, kg = tid >> 5;
      const float* w = p.in[I_WADA] + ((size_t)l * 1024 + kg * 64) * 6144 + ch * 32 + col;
      float a0 = 0, a1 = 0, a2 = 0, a3 = 0, a4 = 0;
#pragma unroll 16
      for (int k = 0; k < 64; ++k) {
        float wv = w[(size_t)k * 6144];
        int kk = kg * 64 + k;
        a0 += sc[kk] * wv; a1 += sc[1024 + kk] * wv; a2 += sc[2048 + kk] * wv; a3 += sc[3072 + kk] * wv; a4 += sc[4096 + kk] * wv;
      }
      red[(kg * 5 + 0) * 32 + col] = a0; red[(kg * 5 + 1) * 32 + col] = a1; red[(kg * 5 + 2) * 32 + col] = a2;
      red[(kg * 5 + 3) * 32 + col] = a3; red[(kg * 5 + 4) * 32 + col] = a4;
      __syncthreads();
      if (tid < 160) {
        int m = tid >> 5, c2 = tid & 31;
        float s = 0;
#pragma unroll
        for (int g = 0; g < 16; ++g) s += red[(g * 5 + m) * 32 + c2];
        int n = ch * 32 + c2;
        s += p.in[I_BADA][l * 6144 + n];
        ((float*)(p.ws + OFF_MOD))[((size_t)l * 5 + m) * 6144 + n] = s;
      }
      __syncthreads();
    } else if (it < N_ADA + N_TAB) {
      const int idx = it - N_ADA;
      if (tid < 64) {
        const int pp = tid;
        float are = p.in[I_ARE][idx * 64 + pp], aim = p.in[I_AIM][idx * 64 + pp];
        float dt = expf(p.in[I_LOGDT][idx]);
        float zr = are * dt, zi = aim * dt;
        float e = expf(zr);
        float abr = e * cosf(zi), abi = e * sinf(zi);
        float d2 = are * are + aim * aim;
        float nr = abr - 1.f, ni = abi;
        float qr = (nr * are + ni * aim) / d2, qi = (ni * are - nr * aim) / d2;
        u16* at = (u16*)(p.ws + OFF_ATAB) + (size_t)idx * 128 * 16;
        u16* ct = (u16*)(p.ws + OFF_CTAB) + (size_t)idx * 16 * 128;
        for (int c = 0; c < 16; ++c) {
          float bre = p.in[I_BRE][((size_t)idx * 64 + pp) * 16 + c], bim = p.in[I_BIM][((size_t)idx * 64 + pp) * 16 + c];
          at[(2 * pp) * 16 + c] = f2bf(qr * bre - qi * bim);
          at[(2 * pp + 1) * 16 + c] = f2bf(qr * bim + qi * bre);
          float cre = p.in[I_CRE][((size_t)idx * 16 + c) * 64 + pp], cim = p.in[I_CIM][((size_t)idx * 16 + c) * 64 + pp];
          ct[c * 128 + 2 * pp] = f2bf(cre);
          ct[c * 128 + 2 * pp + 1] = f2bf(-cim);
        }
        float* ab = (float*)(p.ws + OFF_ABAR) + ((size_t)idx * 64 + pp) * 2;
        ab[0] = abr; ab[1] = abi;
      }
    } else if (it < N_ADA + N_TAB + N_MISC) {
      f32x2* tab = (f32x2*)(p.ws + OFF_ROPE);
      for (int i = tid; i < 2 * 64 * 16; i += NTHR) {
        int kind = i >> 10, pos = (i >> 4) & 63, fi = i & 15;
        int n = kind ? 16 : 8;
        float freq = expf(-(float)(fi % n) / (float)n * 9.210340371976184f);
        float ang = (float)pos * freq;
        f32x2 cs = {cosf(ang), sinf(ang)};
        tab[i] = cs;
      }
      if (tid < 64) ((int*)(p.ws + OFF_CTR))[tid] = 0;
    }
  }
  struct TrD { const float* src; u16* dst; int K, N, k0, n0; bool glu; };
  auto decode = [&](int tt) {
    TrD d; d.glu = false;
    const int l = tt / 2850;
    int r = tt % 2850; int kt, nt;
    if (r < 480) { d.src = p.in[I_WIN] + (size_t)l * 1024 * 1888; d.dst = (u16*)(p.ws + OFF_WIN) + (size_t)l * 1920 * 1024; d.K = 1024; d.N = 1888; kt = r / 30; nt = r % 30; }
    else if (r < 736) { r -= 480; d.src = p.in[I_WOUT] + (size_t)l * 1024 * 1024; d.dst = (u16*)(p.ws + OFF_WOUT) + (size_t)l * 1024 * 1024; d.K = 1024; d.N = 1024; kt = r / 16; nt = r % 16; }
    else if (r < 1760) { r -= 736; d.src = p.in[I_W1] + (size_t)l * 1024 * 4096; d.dst = (u16*)(p.ws + OFF_W1) + (size_t)l * 4096 * 1024; d.K = 1024; d.N = 4096; kt = r / 64; nt = r % 64; }
    else if (r < 2784) { r -= 1760; d.src = p.in[I_W2] + (size_t)l * 4096 * 1024; d.dst = (u16*)(p.ws + OFF_W2) + (size_t)l * 1024 * 4096; d.K = 4096; d.N = 1024; kt = r / 16; nt = r % 16; }
    else if (r < 2802) { r -= 2784; d.src = p.in[I_WUQ] + (size_t)l * 192 * 384; d.dst = (u16*)(p.ws + OFF_WUQ) + (size_t)l * 384 * 192; d.K = 192; d.N = 384; kt = r / 6; nt = r % 6; }
    else if (r < 2818) { r -= 2802; d.src = p.in[I_WUKV] + (size_t)l * 128 * 512; d.dst = (u16*)(p.ws + OFF_WUKV) + (size_t)l * 512 * 128; d.K = 128; d.N = 512; kt = r / 8; nt = r % 8; }
    else { r -= 2818; d.src = p.in[I_WGLU] + (size_t)l * 256 * 512; d.dst = (u16*)(p.ws + OFF_WGLU) + (size_t)l * 512 * 256; d.K = 256; d.N = 512; kt = r / 8; nt = r % 8; d.glu = true; }
    d.k0 = kt * 64; d.n0 = nt * 64;
    return d;
  };
  const int half = tid >> 8, t2 = tid & 255;
  float* ft = fs + half * (64 * 65);
  const int tx = t2 & 15, ty = t2 >> 4;
  auto tload = [&](const TrD& d, f32x4 (&v)[4]) {
#pragma unroll
    for (int i = 0; i < 4; ++i) {
      const int kk = ty + 16 * i, n = d.n0 + 4 * tx;
      f32x4 z = {0.f, 0.f, 0.f, 0.f};
      v[i] = (n < d.N) ? *(const f32x4*)(d.src + (size_t)(d.k0 + kk) * d.N + n) : z;
    }
  };
  const int nvb = 2 * (int)gridDim.x;
  const int tb = nvb - 1 - (2 * (int)blockIdx.x + half);
  const int nrounds = (N_TR + nvb - 1) / nvb;
  TrD cur = decode(tb < N_TR ? tb : 0);
  f32x4 cv[4];
  if (tb < N_TR) tload(cur, cv);
  for (int j = 0; j < nrounds; ++j) {
    const int tt = tb + j * nvb;
    const bool valid = tt < N_TR, more = tt + nvb < N_TR;
    TrD nxt = decode(more ? tt + nvb : 0);
    f32x4 nv[4];
    if (more) tload(nxt, nv);
    if (valid) {
#pragma unroll
      for (int i = 0; i < 4; ++i) {
        const int kk = ty + 16 * i;
        ft[kk * 65 + 4 * tx + 0] = cv[i][0]; ft[kk * 65 + 4 * tx + 1] = cv[i][1]; ft[kk * 65 + 4 * tx + 2] = cv[i][2]; ft[kk * 65 + 4 * tx + 3] = cv[i][3];
      }
    }
    __syncthreads();
    if (valid) {
#pragma unroll
      for (int i = 0; i < 2; ++i) {
        const int c = t2 + 256 * i, nn = c >> 3, kc = (c & 7) * 8;
        f32x4 a, b;
#pragma unroll
        for (int e = 0; e < 4; ++e) { a[e] = ft[(kc + e) * 65 + nn]; b[e] = ft[(kc + 4 + e) * 65 + nn]; }
        const int n = cur.n0 + nn;
        int drow = n;
        if (cur.glu) drow = (n < 256) ? ((n >> 5) * 64 + (n & 31)) : (((n - 256) >> 5) * 64 + 32 + (n & 31));
        *(bf16x8*)(cur.dst + (size_t)drow * cur.K + cur.k0 + kc) = pack8(a, b);
      }
    }
    __syncthreads();
    cur = nxt;
    if (more) {
#pragma unroll
      for (int i = 0; i < 4; ++i) cv[i] = nv[i];
    }
  }
}

DI const float* x_row_src(const P& p, int layer, int row) {
  if (layer == 0) return row < NCTX ? p.in[I_XP] + (size_t)row * 1024 : p.in[I_XS] + (size_t)(row - NCTX) * 1024;
  return p.out + (size_t)row * 1024;
}
DI void norm_phase(const P& p, int layer, int which) {
  const int tid_ = get_tid();
  const int lane = tid_ & 63;
  const int gw = blockIdx.x * NWV + (tid_ >> 6), nw = gridDim.x * NWV;
  auto src_of = [&](int row) { return (which == 0) ? x_row_src(p, layer, row) : (const float*)(p.out + (size_t)row * 1024); };
  f32x4 v[4];
  if (gw < NT) {
    const float* xs = src_of(gw);
#pragma unroll
    for (int i = 0; i < 4; ++i) v[i] = *(const f32x4*)(xs + (i * 64 + lane) * 4);
  }
  for (int row = gw; row < NT; row += nw) {
    f32x4 nv[4];
    const bool more = row + nw < NT;
    if (more) {
      const float* xs = src_of(row + nw);
#pragma unroll
      for (int i = 0; i < 4; ++i) nv[i] = *(const f32x4*)(xs + (i * 64 + lane) * 4);
    }
    float ss = 0;
#pragma unroll
    for (int i = 0; i < 4; ++i) ss += v[i][0] * v[i][0] + v[i][1] * v[i][1] + v[i][2] * v[i][2] + v[i][3] * v[i][3];
    ss = wave_sum(ss);
    const float r = rsqrtf(ss * (1.f / 1024.f) + EPSF);
    if (which == 2) {
      f32x4 g[4];
#pragma unroll
      for (int i = 0; i < 4; ++i) g[i] = *(const f32x4*)(p.in[I_FNG] + (i * 64 + lane) * 4);
#pragma unroll
      for (int i = 0; i < 4; ++i) {
        int e = (i * 64 + lane) * 4;
        f32x4 o = v[i] * r * g[i];
        *(f32x4*)(p.out + (size_t)row * 1024 + e) = o;
      }
    } else {
      const float* gn = p.in[which == 0 ? I_N1G : I_N2G] + layer * 1024;
      const float* md = (const float*)(p.ws + OFF_MOD) + ((size_t)layer * 5 + mod_index(row)) * 6144 + (which == 0 ? 0 : 3072);
      u16* h = (u16*)(p.ws + OFF_H) + (size_t)row * 1024;
      f32x4 g[4], sh[4], sc[4];
#pragma unroll
      for (int i = 0; i < 4; ++i) {
        int e = (i * 64 + lane) * 4;
        g[i] = *(const f32x4*)(gn + e);
        sh[i] = *(const f32x4*)(md + e);
        sc[i] = *(const f32x4*)(md + 1024 + e);
      }
      if (which == 0 && layer == 0) {
#pragma unroll
        for (int i = 0; i < 4; ++i) *(f32x4*)(p.out + (size_t)row * 1024 + (i * 64 + lane) * 4) = v[i];
      }
#pragma unroll
      for (int i = 0; i < 4; ++i) {
        int e = (i * 64 + lane) * 4;
        f32x4 o = v[i] * r * g[i] * (1.f + sc[i]) + sh[i];
        *(u32x2*)(h + e) = pack4(o);
      }
    }
    if (more) {
#pragma unroll
      for (int i = 0; i < 4; ++i) v[i] = nv[i];
    }
  }
}

#define LAS3 __attribute__((address_space(3)))
DI void stage_tile_dma(const u16* __restrict__ G, int ld, int row0, int k0, char* lds, int tid) {
#pragma unroll
  for (int i = 0; i < 4; ++i) {
    const int q = tid + NTHR * i, r = q >> 3, c = (q & 7) ^ ((r >> 1) & 7);
    __builtin_amdgcn_global_load_lds((const unsigned*)(G + (size_t)(row0 + r) * ld + k0 + c * 8), (LAS3 unsigned*)(lds + q * 16), 16, 0, 0);
  }
}
struct TD { const u16* A; const u16* B; int lda, ldb, k0, nk, m0, n0; };
DI void stage_td(const TD& d, int kt, char* stage_base, int tid) {
  stage_tile_dma(d.A, d.lda, d.m0, d.k0 + kt * 64, stage_base, tid);
  stage_tile_dma(d.B, d.ldb, d.n0, d.k0 + kt * 64, stage_base + 32768, tid);
}
DI void gemm_stream(const TD& cur, bool has_next, const TD& nxt, char* smem, int& buf, f32x16 (&acc)[4][2]) {
  const int tid = get_tid(), lane = tid & 63, wave = tid >> 6, wm = wave >> 2, wn = wave & 3, l32 = lane & 31, hh = lane >> 5;
#pragma unroll
  for (int bi = 0; bi < 4; ++bi)
#pragma unroll
    for (int bj = 0; bj < 2; ++bj)
#pragma unroll
      for (int r = 0; r < 16; ++r) acc[bi][bj][r] = 0.f;
  const int swz = (l32 >> 1) & 7;
  const int arow = (wm * 128 + l32) * 128, brow = (wn * 64 + l32) * 128;
  const int c0 = ((0 + hh) ^ swz) * 16, c1 = ((2 + hh) ^ swz) * 16, c2 = ((4 + hh) ^ swz) * 16, c3 = ((6 + hh) ^ swz) * 16;
  asm volatile("s_waitcnt vmcnt(0)" ::: "memory");
  __syncthreads();
  const int nk = cur.nk;
  for (int kt = 0; kt < nk; ++kt) {
    const bool early = wave < 4;
    if (early) {
      if (kt + 1 < nk) stage_td(cur, kt + 1, smem + (buf ^ 1) * 65536, tid);
      else if (has_next) stage_td(nxt, 0, smem + (buf ^ 1) * 65536, tid);
    }
    const char* as = smem + buf * 65536 + arow;
    const char* bs = smem + buf * 65536 + 32768 + brow;
#pragma unroll
    for (int ks = 0; ks < 4; ++ks) {
      const int co = (ks == 0) ? c0 : (ks == 1) ? c1 : (ks == 2) ? c2 : c3;
      bf16x8 fa[4], fb[2];
#pragma unroll
      for (int bi = 0; bi < 4; ++bi) fa[bi] = *(const bf16x8*)(as + bi * 4096 + co);
#pragma unroll
      for (int bj = 0; bj < 2; ++bj) fb[bj] = *(const bf16x8*)(bs + bj * 4096 + co);
      __builtin_amdgcn_s_setprio(1);
#pragma unroll
      for (int bi = 0; bi < 4; ++bi)
#pragma unroll
        for (int bj = 0; bj < 2; ++bj) acc[bi][bj] = MFMA32(fa[bi], fb[bj], acc[bi][bj]);
      __builtin_amdgcn_s_setprio(0);
      if (ks == 1 && !early) {
        if (kt + 1 < nk) stage_td(cur, kt + 1, smem + (buf ^ 1) * 65536, tid);
        else if (has_next) stage_td(nxt, 0, smem + (buf ^ 1) * 65536, tid);
      }
    }
    buf ^= 1;
    if (kt + 1 < nk) {
      asm volatile("s_waitcnt vmcnt(0)" ::: "memory");
      __syncthreads();
    }
  }
}

#if MEGA
#define XCD_ID()   ((int)((volatile int*)(smem + LDS_BYTES))[3])
#define XCD_RANK() ((int)((volatile int*)(smem + LDS_BYTES))[2])
#else
#define XCD_ID()   ((int)(blockIdx.x & 7))
#define XCD_RANK() ((int)(blockIdx.x >> 3))
#endif
#define EPI_IDX                                                                                        \
  const int tid = get_tid(), lane = tid & 63, wave = tid >> 6, wm = wave >> 2, wn = wave & 3, l32 = lane & 31, hh = lane >> 5; \
  (void)tid; (void)lane; (void)wave; (void)wm; (void)wn; (void)l32; (void)hh;
DI int crow(int r, int hh) { return (r & 3) + 8 * (r >> 2) + 4 * hh; }

DI void phase_g1(const P& p, int layer, char* smem) {
  EPI_IDX
  const u16* A = (const u16*)(p.ws + OFF_H);
  const u16* Bt = (const u16*)(p.ws + OFF_WIN) + (size_t)layer * 1920 * 1024;
  float* proj = (float*)(p.ws + OFF_PROJ);
  constexpr int MT = NT / 256, NTL = 8, MPX = MT / 8;
  const int xcd_ = XCD_ID(), xj_ = XCD_RANK(), xn_ = gridDim.x >> 3;
  auto tile_at = [&](int u) { TD d; d.A = A; d.B = Bt; d.lda = 1024; d.ldb = 1024; d.k0 = 0; d.nk = 16; d.m0 = (xcd_ * MPX + u % MPX) * 256; d.n0 = (u / MPX) * 256; return d; };
  int buf = 0;
  TD cur = tile_at(xj_ < MPX * NTL ? xj_ : 0);
  if (xj_ < MPX * NTL) stage_td(cur, 0, smem, tid);
  for (int u = xj_; u < MPX * NTL; u += xn_) {
    const bool has_next = (u + xn_ < MPX * NTL);
    const TD nxt = tile_at(has_next ? u + xn_ : u);
    const int m0 = cur.m0, n0 = cur.n0;
    f32x16 acc[4][2];
    gemm_stream(cur, has_next, nxt, smem, buf, acc);
    cur = nxt;
    const bool lat = m0 >= NCTX;
    const int b_all = lat ? 32 + ((m0 - NCTX) >> 10) : (m0 >> 8);
    const int nkk = lat ? 1536 : 256;
#pragma unroll
    for (int bi = 0; bi < 4; ++bi)
#pragma unroll
      for (int bj = 0; bj < 2; ++bj) {
        const int rb = m0 + wm * 128 + bi * 32;
        const int cb = n0 + wn * 64 + bj * 32;
        const int col = cb + l32;
        if (cb < NP) {
#pragma unroll
          for (int r = 0; r < 16; ++r) proj[(size_t)(rb + crow(r, hh)) * NP + col] = acc[bi][bj][r];
        }
        const bool isdv = (cb >= 512 && cb < 768), isgv = (cb >= 1152 && cb < 1280);
        if (isdv || isgv) {
          u16* vt; int f;
          if (isdv) { f = col - 512; vt = (u16*)(p.ws + OFF_DVT) + vt_off(b_all, f >> 6, 4); }
          else { f = col - 1152; vt = (u16*)(p.ws + OFF_GVT) + vt_off(b_all, f >> 6, 2); }
          vt += (size_t)(f & 63) * nkk;
#pragma unroll
          for (int j = 0; j < 4; ++j) {
            int row = rb + 16 * (j >> 1) + 8 * hh + 4 * (j & 1);
            int key = lat ? 512 + ((row - NCTX) & 1023) : (row & 255);
            f32x4 v = {acc[bi][bj][4 * j], acc[bi][bj][4 * j + 1], acc[bi][bj][4 * j + 2], acc[bi][bj][4 * j + 3]};
            *(u32x2*)(vt + key) = pack4(v);
          }
        }
      }
  }
}

DI void phase_g2(const P& p, int layer, char* smem) {
  EPI_IDX
  constexpr int T_MQ = (NT / 256) * 2, T_MKV = (NKR / 256) * 2;
  const f32x2* tab32 = (const f32x2*)(p.ws + OFF_ROPE);
  auto tile_at = [&](int t) {
    TD d; d.k0 = 0;
    if (t < T_MQ) { d.A = (const u16*)(p.ws + OFF_CQN); d.B = (const u16*)(p.ws + OFF_WUQ) + (size_t)layer * 384 * 192; d.lda = 192; d.ldb = 192; d.nk = 3; d.m0 = (t >> 1) * 256; d.n0 = (t & 1) * 256; }
    else { const int t2 = t - T_MQ; d.A = (const u16*)(p.ws + OFF_CKVN); d.B = (const u16*)(p.ws + OFF_WUKV) + (size_t)layer * 512 * 128; d.lda = 128; d.ldb = 128; d.nk = 2; d.m0 = (t2 >> 1) * 256; d.n0 = (t2 & 1) * 256; }
    return d;
  };
  int buf = 0;
  const int t_first = blockIdx.x;
  TD cur = tile_at(t_first < T_MQ + T_MKV ? t_first : 0);
  if (t_first < T_MQ + T_MKV) stage_td(cur, 0, smem, tid);
  for (int t = blockIdx.x; t < T_MQ + T_MKV; t += gridDim.x) {
    const bool has_next = (t + (int)gridDim.x < T_MQ + T_MKV);
    const TD nxt = tile_at(has_next ? t + (int)gridDim.x : t);
    f32x16 acc[4][2];
    const int m0 = cur.m0, n0 = cur.n0;
    gemm_stream(cur, has_next, nxt, smem, buf, acc);
    cur = nxt;
    if (t < T_MQ) {
      const bool lat = m0 >= NCTX;
      const float scl = 0.10206207261596575f * LOG2E;
      u16* mq = (u16*)(p.ws + OFF_MQ);
#pragma unroll
      for (int bi = 0; bi < 4; ++bi)
#pragma unroll
        for (int bj = 0; bj < 2; ++bj) {
          const int rb = m0 + wm * 128 + bi * 32;
          const int cb = n0 + wn * 64 + bj * 32;
          const int col = cb + l32;
          if (cb < 384) {
            const bool isrope = lat && ((cb % 96) == 64);
            const int e = l32, w2 = e & 15, fi = w2 & 7;
            const bool isx2 = w2 >= 8, half = e >= 16;
#pragma unroll
            for (int r = 0; r < 16; ++r) {
              float v = acc[bi][bj][r];
              const int row = rb + crow(r, hh);
              if (isrope) {
                const int tt = (row - NCTX) & 1023;
                const int pos = half ? (tt & 63) : (tt >> 6);
                const f32x2 cs = tab32[pos * 16 + fi];
                float pv = __shfl_xor(v, 8);
                v = v * cs[0] + (isx2 ? pv : -pv) * cs[1];
              }
              mq[(size_t)row * 384 + col] = f2bf(v * scl);
            }
          }
        }
    } else {
      const bool lat = m0 >= NCTX;
      const int b_all = lat ? 32 + (m0 - NCTX) / 1536 : (m0 >> 8);
      const int nkk = lat ? 1536 : 256;
      const int kbase = lat ? (m0 - NCTX) % 1536 : (m0 & 255);
      u16* mk = (u16*)(p.ws + OFF_MKB);
#pragma unroll
      for (int bi = 0; bi < 4; ++bi)
#pragma unroll
        for (int bj = 0; bj < 2; ++bj) {
          const int rloc = wm * 128 + bi * 32;
          const int cb = n0 + wn * 64 + bj * 32;
          const int head = cb >> 7, wc = (cb & 127) + l32;
          if ((cb & 127) < 64) {
#pragma unroll
            for (int r = 0; r < 16; ++r) mk[(size_t)(m0 + rloc + crow(r, hh)) * 384 + head * 96 + wc] = f2bf(acc[bi][bj][r]);
          } else {
            u16* vt = (u16*)(p.ws + OFF_MVT) + vt_off(b_all, head, 4) + (size_t)(wc - 64) * nkk + kbase + rloc;
#pragma unroll
            for (int j = 0; j < 4; ++j) {
              f32x4 v = {acc[bi][bj][4 * j], acc[bi][bj][4 * j + 1], acc[bi][bj][4 * j + 2], acc[bi][bj][4 * j + 3]};
              *(u32x2*)(vt + 16 * (j >> 1) + 8 * hh + 4 * (j & 1)) = pack4(v);
            }
          }
        }
    }
  }
  {
    const int gw = blockIdx.x * NWV + wave, nw = gridDim.x * NWV;
    const f32x4 dd = *(const f32x4*)(p.in[I_SSMD] + layer * 256 + lane * 4);
    for (int row = gw; row < NT; row += nw) {
      const float* y0 = (const float*)(p.ws + OFF_YBUF) + (size_t)row * 256 + lane * 4;
      float* prow = (float*)(p.ws + OFF_PROJ) + (size_t)row * NP;
      f32x4 a = *(const f32x4*)y0, b = *(const f32x4*)(y0 + (size_t)NT * 256), c = *(const f32x4*)(prow + 1280 + lane * 4);
      f32x4 sv = a + b + c * dd;
      f32x4 g = {gelu_tanh(sv[0]), gelu_tanh(sv[1]), gelu_tanh(sv[2]), gelu_tanh(sv[3])};
      *(u32x2*)((u16*)prow + lane * 4) = pack4(g);
    }
  }
}

DI void phase_resid(const P& p, int layer, char* smem, bool is_out) {
  EPI_IDX
  const u16* A = is_out ? (const u16*)(p.ws + OFF_MIXED) : (const u16*)(p.ws + OFF_A);
  const int K = is_out ? 1024 : 4096;
  const u16* Bt = is_out ? (const u16*)(p.ws + OFF_WOUT) + (size_t)layer * 1024 * 1024 : (const u16*)(p.ws + OFF_W2) + (size_t)layer * 1024 * 4096;
  constexpr int MT = NT / 256, NTL = 4, MPX = MT / 8, NU = MPX * NTL;
  const int xcd_ = XCD_ID(), xj_ = XCD_RANK(), xn_ = gridDim.x >> 3;
  auto tile_at = [&](int u) {
    TD d; d.A = A; d.B = Bt; d.lda = K; d.ldb = K; d.nk = K / 64; d.k0 = 0;
    d.n0 = (u % NTL) * 256;
    d.m0 = (xcd_ * MPX + u / NTL) * 256;
    return d;
  };
  int buf = 0;
  TD cur = tile_at(xj_ < NU ? xj_ : 0);
  if (xj_ < NU) stage_td(cur, 0, smem, tid);
  for (int u = xj_; u < NU; u += xn_) {
    const bool has_next = (u + xn_ < NU);
    const TD nxt = tile_at(has_next ? u + xn_ : u);
    const int m0 = cur.m0, n0 = cur.n0;
    f32x16 acc[4][2];
    gemm_stream(cur, has_next, nxt, smem, buf, acc);
    cur = nxt;
    const float* gate = (const float*)(p.ws + OFF_MOD) + ((size_t)layer * 5 + mod_index(m0)) * 6144 + (is_out ? 2048 : 5120);
#pragma unroll
    for (int bi = 0; bi < 4; ++bi)
#pragma unroll
      for (int bj = 0; bj < 2; ++bj) {
        const int rb = m0 + wm * 128 + bi * 32;
        const int col = n0 + wn * 64 + bj * 32 + l32;
        const float g = gate[col];
        float rv[16];
#pragma unroll
        for (int r = 0; r < 16; ++r) rv[r] = p.out[(size_t)(rb + crow(r, hh)) * 1024 + col];
#pragma unroll
        for (int r = 0; r < 16; ++r) p.out[(size_t)(rb + crow(r, hh)) * 1024 + col] = rv[r] + g * acc[bi][bj][r];
      }
  }
}

DI void phase_g5(const P& p, int layer, char* smem) {
  EPI_IDX
  const u16* A = (const u16*)(p.ws + OFF_H);
  const u16* Bt = (const u16*)(p.ws + OFF_W1) + (size_t)layer * 4096 * 1024;
  u16* a = (u16*)(p.ws + OFF_A);
  constexpr int MT = NT / 256, NTL = 16, MPX = MT / 8;
  const int xcd_ = XCD_ID(), xj_ = XCD_RANK(), xn_ = gridDim.x >> 3;
  auto tile_at = [&](int u) { TD d; d.A = A; d.B = Bt; d.lda = 1024; d.ldb = 1024; d.k0 = 0; d.nk = 16; d.m0 = (xcd_ * MPX + u % MPX) * 256; d.n0 = (u / MPX) * 256; return d; };
  int buf = 0;
  TD cur = tile_at(xj_ < MPX * NTL ? xj_ : 0);
  if (xj_ < MPX * NTL) stage_td(cur, 0, smem, tid);
  for (int u = xj_; u < MPX * NTL; u += xn_) {
    const bool has_next = (u + xn_ < MPX * NTL);
    const TD nxt = tile_at(has_next ? u + xn_ : u);
    const int m0 = cur.m0, n0 = cur.n0;
    f32x16 acc[4][2];
    gemm_stream(cur, has_next, nxt, smem, buf, acc);
    cur = nxt;
#pragma unroll
    for (int bi = 0; bi < 4; ++bi)
#pragma unroll
      for (int bj = 0; bj < 2; ++bj) {
        const int rb = m0 + wm * 128 + bi * 32;
        const int col = n0 + wn * 64 + bj * 32 + l32;
#pragma unroll
        for (int r = 0; r < 16; ++r) {
          float v = fmaxf(acc[bi][bj][r], 0.f);
          a[(size_t)(rb + crow(r, hh)) * 4096 + col] = f2bf(v * v);
        }
      }
  }
}

template <int R>
DI f32x4 rope4(f32x4 v, int lane, int t, const f32x2* tab) {
  constexpr int n = R / 4;
  const int e = (lane * 4) % R;
  const int half = e / (R / 2), w = e % (R / 2);
  const bool isx2 = w >= n;
  const int fi = w % n;
  const int pos = half ? (t & 63) : (t >> 6);
  f32x4 o;
#pragma unroll
  for (int i = 0; i < 4; ++i) {
    float pv = __shfl_xor(v[i], n / 4);
    f32x2 cs = tab[pos * 16 + fi + i];
    o[i] = v[i] * cs[0] + (isx2 ? pv : -pv) * cs[1];
  }
  return o;
}

DI void ssm_item(const P& p, int layer, int item, float* lds, int lane) {
  int b_all, r;
  if (item < 128) { b_all = 32 + item / 32; r = item % 32; } else { int it = item - 128; b_all = it / 32; r = it % 32; }
  const int dir = r >> 4, g = r & 15;
  const bool lat = b_all >= 32;
  const int T = lat ? 1024 : 256;
  const int row0 = lat ? NCTX + (b_all - 32) * 1024 : b_all * 256;
  const int tabidx = (layer * 2 + dir) * 16 + g;
  const int l32 = lane & 31, hh = lane >> 5, l16 = lane & 15, q4 = lane >> 4;
  const u16* atab = (const u16*)(p.ws + OFF_ATAB) + (size_t)tabidx * 128 * 16;
  const u16* ctab = (const u16*)(p.ws + OFF_CTAB) + (size_t)tabidx * 16 * 128;
  bf16x8 af[4], cf[4];
#pragma unroll
  for (int blk = 0; blk < 4; ++blk) af[blk] = *(const bf16x8*)(atab + (blk * 32 + l32) * 16 + hh * 8);
#pragma unroll
  for (int kk = 0; kk < 4; ++kk) cf[kk] = *(const bf16x8*)(ctab + l16 * 128 + kk * 32 + q4 * 8);
  const float* ab = (const float*)(p.ws + OFF_ABAR) + ((size_t)tabidx * 64 + lane) * 2;
  const float ar = ab[0], ai = ab[1];
  float hr = 0.f, hi = 0.f;
  if (lat) {
    size_t idx = ((size_t)((b_all - 32) * 2 + layer) * 2 + dir) * 1024 + g * 64 + lane;
    hr = p.in[I_SRE][idx]; hi = p.in[I_SIM][idx];
  }
  const float* proj = (const float*)(p.ws + OFF_PROJ);
  float* ybuf = (float*)(p.ws + OFF_YBUF) + (size_t)dir * NT * 256;
  f32x16 zero16;
#pragma unroll
  for (int i = 0; i < 16; ++i) zero16[i] = 0.f;
  f32x4 u0, u1;
  {
    const int t = dir ? (T - 1 - l32) : l32;
    const float* up = proj + (size_t)(row0 + t) * NP + 1280 + g * 16 + hh * 8;
    u0 = *(const f32x4*)up; u1 = *(const f32x4*)(up + 4);
  }
  for (int ch = 0; ch < T / 32; ++ch) {
    {
      bf16x8 uf = pack8(u0, u1);
      if (ch + 1 < T / 32) {
        const int n = (ch + 1) * 32 + l32;
        const int t = dir ? (T - 1 - n) : n;
        const float* up = proj + (size_t)(row0 + t) * NP + 1280 + g * 16 + hh * 8;
        u0 = *(const f32x4*)up; u1 = *(const f32x4*)(up + 4);
      }
#pragma unroll
      for (int blk = 0; blk < 4; ++blk) {
        f32x16 d = MFMA32(af[blk], uf, zero16);
#pragma unroll
        for (int j = 0; j < 4; ++j) {
          f32x4 v = {d[4 * j], d[4 * j + 1], d[4 * j + 2], d[4 * j + 3]};
          *(f32x4*)(lds + l32 * 132 + blk * 32 + 8 * j + 4 * hh) = v;
        }
      }
    }
    wave_lds_fence();
#pragma unroll
    for (int s = 0; s < 32; ++s) {
      f32x2 bu = *(const f32x2*)(lds + s * 132 + 2 * lane);
      float nr = ar * hr - ai * hi + bu[0];
      float ni = ar * hi + ai * hr + bu[1];
      hr = nr; hi = ni;
      f32x2 hv = {hr, hi};
      *(f32x2*)(lds + s * 132 + 2 * lane) = hv;
    }
    wave_lds_fence();
#pragma unroll
    for (int tb = 0; tb < 2; ++tb) {
      f32x4 y = {0.f, 0.f, 0.f, 0.f};
#pragma unroll
      for (int kk = 0; kk < 4; ++kk) {
        const float* hp = lds + (tb * 16 + l16) * 132 + kk * 32 + q4 * 8;
        f32x4 a0 = *(const f32x4*)hp, a1 = *(const f32x4*)(hp + 4);
        y = MFMA16(cf[kk], pack8(a0, a1), y);
      }
      const int n2 = ch * 32 + tb * 16 + l16;
      const int t2 = dir ? (T - 1 - n2) : n2;
      *(f32x4*)(ybuf + (size_t)(row0 + t2) * 256 + g * 16 + q4 * 4) = y;
    }
    wave_lds_fence();
  }
  if (!lat) {
    size_t idx = ((size_t)(b_all * 2 + layer) * 2 + dir) * 1024 + g * 64 + lane;
    p.out[O_SRE + idx] = hr;
    p.out[O_SIM + idx] = hi;
  }
}

DI void pp_row(const P& p, int layer, int row, int lane) {
  const float* pr = (const float*)(p.ws + OFF_PROJ) + (size_t)row * NP;
  const bool lat = row >= NCTX;
  int b, t, keyrow;
  if (!lat) { b = row >> 8; t = row & 255; keyrow = row; }
  else { int rr = row - NCTX; b = rr >> 10; t = rr & 1023; keyrow = NCTX + b * 1536 + 512 + t; }
  const f32x2* tab32 = (const f32x2*)(p.ws + OFF_ROPE);
  const f32x2* tab64 = tab32 + 64 * 16;
  const size_t orow = (size_t)(b * 2 + layer) * 256 + t;
  const f32x4 z4 = {0.f, 0.f, 0.f, 0.f};
  f32x4 v_dq = *(const f32x4*)(pr + lane * 4);
  f32x4 v_dk = *(const f32x4*)(pr + 256 + lane * 4);
  f32x4 v_dv = *(const f32x4*)(pr + 512 + lane * 4);
  f32x4 v_gq = *(const f32x4*)(pr + 768 + lane * 4);
  f32x4 v_gk = lane < 32 ? *(const f32x4*)(pr + 1024 + lane * 4) : z4;
  f32x4 v_gv = lane < 32 ? *(const f32x4*)(pr + 1152 + lane * 4) : z4;
  f32x4 v_cq = lane < 48 ? *(const f32x4*)(pr + 1536 + lane * 4) : z4;
  f32x4 v_ckv = lane < 32 ? *(const f32x4*)(pr + 1728 + lane * 4) : z4;
  f32x4 v_kr = lane < 8 ? *(const f32x4*)(pr + 1856 + lane * 4) : z4;
  const f32x4 g_q = *(const f32x4*)(p.in[I_QNG] + layer * 64 + (lane & 15) * 4);
  const f32x4 g_k = *(const f32x4*)(p.in[I_KNG] + layer * 64 + (lane & 15) * 4);
  const f32x4 g_cq = lane < 48 ? *(const f32x4*)(p.in[I_MQNG] + layer * 192 + lane * 4) : z4;
  const f32x4 g_ckv = lane < 32 ? *(const f32x4*)(p.in[I_MKVNG] + layer * 128 + lane * 4) : z4;
  f32x2 cs32[4], cs64[4];
  {
    const int e32 = (lane * 4) & 31, w32 = e32 & 15, p32 = (e32 >> 4) ? (t & 63) : (t >> 6), f32i = w32 & 7;
    const int e64 = (lane * 4) & 63, w64 = e64 & 31, p64 = (e64 >> 5) ? (t & 63) : (t >> 6), f64i = w64 & 15;
    const f32x2 one = {1.f, 0.f};
#pragma unroll
    for (int i = 0; i < 4; ++i) {
      cs32[i] = lat ? tab32[p32 * 16 + f32i + i] : one;
      cs64[i] = lat ? tab64[p64 * 16 + f64i + i] : one;
    }
  }
  const bool x2_32 = ((lane * 4) & 15) >= 8, x2_64 = ((lane * 4) & 31) >= 16;
  auto rope32 = [&](f32x4 v) {
    f32x4 o;
#pragma unroll
    for (int i = 0; i < 4; ++i) { float pv = __shfl_xor(v[i], 2); o[i] = v[i] * cs32[i][0] + (x2_32 ? pv : -pv) * cs32[i][1]; }
    return o;
  };
  auto rope64 = [&](f32x4 v) {
    f32x4 o;
#pragma unroll
    for (int i = 0; i < 4; ++i) { float pv = __shfl_xor(v[i], 4); o[i] = v[i] * cs64[i][0] + (x2_64 ? pv : -pv) * cs64[i][1]; }
    return o;
  };
  if (!lat) {
    *(f32x4*)(p.out + O_DK + orow * 256 + lane * 4) = v_dk;
    *(f32x4*)(p.out + O_DV + orow * 256 + lane * 4) = v_dv;
    if (lane < 32) *(f32x4*)(p.out + O_GV + orow * 128 + lane * 4) = v_gv;
    if (lane < 8) *(f32x4*)(p.out + O_KR + orow * 32 + lane * 4) = v_kr;
  }
  {
    f32x4 v = v_dq;
    if (lat) v = rope32(v);
    v = v * (0.17677669529663687f * LOG2E);
    *(u32x2*)((u16*)(p.ws + OFF_DQ) + (size_t)row * 256 + lane * 4) = pack4(v);
  }
  {
    f32x4 v = v_dk;
    if (lat) v = rope32(v);
    *(u32x2*)((u16*)(p.ws + OFF_DKB) + (size_t)keyrow * 256 + lane * 4) = pack4(v);
  }
  {
    f32x4 v = v_gq;
    float ss = v[0] * v[0] + v[1] * v[1] + v[2] * v[2] + v[3] * v[3];
    ss += __shfl_xor(ss, 1); ss += __shfl_xor(ss, 2); ss += __shfl_xor(ss, 4); ss += __shfl_xor(ss, 8);
    float r = rsqrtf(ss * (1.f / 64.f) + EPSF);
    v = v * r * g_q;
    if (lat) v = rope64(v);
    v = v * (0.125f * LOG2E);
    *(u32x2*)((u16*)(p.ws + OFF_GQ) + (size_t)row * 256 + lane * 4) = pack4(v);
  }
  {
    f32x4 v = v_gk;
    float ss = v[0] * v[0] + v[1] * v[1] + v[2] * v[2] + v[3] * v[3];
    ss += __shfl_xor(ss, 1); ss += __shfl_xor(ss, 2); ss += __shfl_xor(ss, 4); ss += __shfl_xor(ss, 8);
    float r = rsqrtf(ss * (1.f / 64.f) + EPSF);
    v = v * r * g_k;
    if (!lat) { if (lane < 32) *(f32x4*)(p.out + O_GK + orow * 128 + lane * 4) = v; }
    else v = rope64(v);
    if (lane < 32) *(u32x2*)((u16*)(p.ws + OFF_GKB) + (size_t)keyrow * 128 + lane * 4) = pack4(v);
  }
  {
    f32x4 v = v_cq;
    float ss = wave_sum(v[0] * v[0] + v[1] * v[1] + v[2] * v[2] + v[3] * v[3]);
    float r = rsqrtf(ss * (1.f / 192.f) + EPSF);
    v = v * r * g_cq;
    if (lane < 48) *(u32x2*)((u16*)(p.ws + OFF_CQN) + (size_t)row * 192 + lane * 4) = pack4(v);
  }
  {
    f32x4 v = v_ckv;
    float ss = wave_sum(v[0] * v[0] + v[1] * v[1] + v[2] * v[2] + v[3] * v[3]);
    float r = rsqrtf(ss * (1.f / 128.f) + EPSF);
    v = v * r * g_ckv;
    if (lane < 32) {
      if (!lat) *(f32x4*)(p.out + O_CKV + orow * 128 + lane * 4) = v;
      *(u32x2*)((u16*)(p.ws + OFF_CKVN) + (size_t)keyrow * 128 + lane * 4) = pack4(v);
    }
  }
  {
    f32x4 v = v_kr;
    if (lat) v = rope32(v);
    if (lane < 8) {
      u32x2 pk = pack4(v);
      u16* mk = (u16*)(p.ws + OFF_MKB) + (size_t)keyrow * 384 + 64 + lane * 4;
#pragma unroll
      for (int hd = 0; hd < 4; ++hd) *(u32x2*)(mk + hd * 96) = pk;
    }
  }
}

DI void pp_cached(const P& p, int layer, int crow_, int lane) {
  const int b = crow_ >> 9, j = crow_ & 511;
  const int keyrow = NCTX + b * 1536 + j;
  const size_t src = (size_t)(b * 2 + layer) * 512 + j;
  const int jp = (j & ~15) | (((j >> 2) & 1) << 3) | (((j >> 3) & 1) << 2) | (j & 3);
  const f32x4 z4 = {0.f, 0.f, 0.f, 0.f};
  const int l31 = lane & 31, l7 = lane & 7;
  f32x4 v_dk = *(const f32x4*)(p.in[I_CDK] + src * 256 + lane * 4);
  f32x4 v_dv = *(const f32x4*)(p.in[I_CDV] + src * 256 + lane * 4);
  f32x4 v_gk = *(const f32x4*)(p.in[I_CGK] + src * 128 + l31 * 4);
  f32x4 v_gv = *(const f32x4*)(p.in[I_CGV] + src * 128 + l31 * 4);
  f32x4 v_ckv = *(const f32x4*)(p.in[I_CCKV] + src * 128 + l31 * 4);
  f32x4 v_kr = *(const f32x4*)(p.in[I_CKR] + src * 32 + l7 * 4);
  (void)z4;
  *(u32x2*)((u16*)(p.ws + OFF_DKB) + (size_t)keyrow * 256 + lane * 4) = pack4(v_dk);
  {
    u16* vt = (u16*)(p.ws + OFF_DVT) + vt_off(32 + b, lane >> 4, 4) + (size_t)((lane & 15) * 4) * 1536 + jp;
#pragma unroll
    for (int i = 0; i < 4; ++i) vt[(size_t)i * 1536] = f2bf(v_dv[i]);
  }
  if (lane < 32) {
    *(u32x2*)((u16*)(p.ws + OFF_GKB) + (size_t)keyrow * 128 + lane * 4) = pack4(v_gk);
    u16* vt = (u16*)(p.ws + OFF_GVT) + vt_off(32 + b, lane >> 4, 2) + (size_t)((lane & 15) * 4) * 1536 + jp;
#pragma unroll
    for (int i = 0; i < 4; ++i) vt[(size_t)i * 1536] = f2bf(v_gv[i]);
    *(u32x2*)((u16*)(p.ws + OFF_CKVN) + (size_t)keyrow * 128 + lane * 4) = pack4(v_ckv);
  }
  if (lane < 8) {
    u32x2 pk = pack4(v_kr);
    u16* mk = (u16*)(p.ws + OFF_MKB) + (size_t)keyrow * 384 + 64 + lane * 4;
#pragma unroll
    for (int hd = 0; hd < 4; ++hd) *(u32x2*)(mk + hd * 96) = pk;
  }
}

DI void phase_pp(const P& p, int layer, char* smem) {
  const int tid_ = get_tid();
  const int lane = tid_ & 63, wave = tid_ >> 6;
  float* lds = (float*)smem + wave * (32 * 132);
  const int gw = blockIdx.x * NWV + wave, nw = gridDim.x * NWV;
  constexpr int N_SSM = 1152, N_ROWS = NT + 2048;
  for (int item = gw; item < N_SSM; item += nw) ssm_item(p, layer, item, lds, lane);
  const int rw0 = (nw > 256) ? 128 : 0;
  if (gw >= rw0) {
    for (int row = gw - rw0; row < N_ROWS; row += nw - rw0) {
      if (row < NT) pp_row(p, layer, row, lane);
      else pp_cached(p, layer, row - NT, lane);
    }
  }
}

template <int KW, int DK>
DI void attn_block(const u16* __restrict__ Kg, int ldk, const u16* __restrict__ Vt, int nk, const bf16x8 (&qf)[DK / 16], int kcol, char* smem,
                   int tid, f32x16 (&o)[2], float& lsum) {
  constexpr int KST = KW + 8, KS = DK / 16, KCH = KW / 8, KTOT = 64 * KCH, NKC = (KTOT + NTHR - 1) / NTHR;
  const int lane = tid & 63, l32 = lane & 31, hh = lane >> 5;
  u16* Ks = (u16*)smem;
  u16* Vs = Ks + 2 * 64 * KST;
  float m = -1e30f;
  lsum = 0.f;
#pragma unroll
  for (int db = 0; db < 2; ++db)
#pragma unroll
    for (int r = 0; r < 16; ++r) o[db][r] = 0.f;
  u32x4 rk[NKC], rv[1];
  const int nt = nk / 64;
#pragma unroll
  for (int i = 0; i < NKC; ++i) { int c = tid + NTHR * i, r = c / KCH, kc = (c % KCH) * 8; if (c < KTOT) rk[i] = *(const u32x4*)(Kg + (size_t)r * ldk + kc); }
  { int r = tid >> 3, kc = (tid & 7) * 8; rv[0] = *(const u32x4*)(Vt + (size_t)r * nk + kc); }
#pragma unroll
  for (int i = 0; i < NKC; ++i) { int c = tid + NTHR * i, r = c / KCH, kc = (c % KCH) * 8; if (c < KTOT) *(u32x4*)(Ks + r * KST + kc) = rk[i]; }
  { int r = tid >> 3, kc = (tid & 7) * 8; *(u32x4*)(Vs + r * 72 + kc) = rv[0]; }
  __syncthreads();
  for (int t = 0; t < nt; ++t) {
    const int buf = t & 1;
    const bool more = (t + 1 < nt);
    if (more) {
      const int kt = (t + 1) * 64;
#pragma unroll
      for (int i = 0; i < NKC; ++i) { int c = tid + NTHR * i, r = c / KCH, kc = (c % KCH) * 8; if (c < KTOT) rk[i] = *(const u32x4*)(Kg + (size_t)(kt + r) * ldk + kc); }
      { int r = tid >> 3, kc = (tid & 7) * 8; rv[0] = *(const u32x4*)(Vt + (size_t)r * nk + kt + kc); }
    }
    const u16* ks = Ks + buf * 64 * KST + l32 * KST + kcol + hh * 8;
    const u16* vs = Vs + buf * 64 * 72 + l32 * 72 + hh * 8;
    f32x16 sa[2];
#pragma unroll
    for (int kb = 0; kb < 2; ++kb) {
#pragma unroll
      for (int r = 0; r < 16; ++r) sa[kb][r] = 0.f;
#pragma unroll
      for (int s2 = 0; s2 < KS; ++s2) {
        bf16x8 kf = *(const bf16x8*)(ks + kb * 32 * KST + s2 * 16);
        sa[kb] = MFMA32(kf, qf[s2], sa[kb]);
      }
      __builtin_amdgcn_sched_barrier(0);
    }
    float mx = sa[0][0];
#pragma unroll
    for (int r = 1; r < 16; ++r) mx = fmaxf(mx, sa[0][r]);
#pragma unroll
    for (int r = 0; r < 16; ++r) mx = fmaxf(mx, sa[1][r]);
    mx = fmaxf(mx, __shfl_xor(mx, 32));
    const float mn = fmaxf(m, mx);
    const float alpha = fexp2(m - mn);
    m = mn;
    float ps = 0.f;
#pragma unroll
    for (int kb = 0; kb < 2; ++kb)
#pragma unroll
      for (int r = 0; r < 16; ++r) { float e = fexp2(sa[kb][r] - mn); sa[kb][r] = e; ps += e; }
    lsum = lsum * alpha + ps;
#pragma unroll
    for (int db = 0; db < 2; ++db)
#pragma unroll
      for (int r = 0; r < 16; ++r) o[db][r] *= alpha;
#pragma unroll
    for (int s2 = 0; s2 < 4; ++s2) {
      const int kb = s2 >> 1, rb = 8 * (s2 & 1);
      f32x4 p0 = {sa[kb][rb], sa[kb][rb + 1], sa[kb][rb + 2], sa[kb][rb + 3]};
      f32x4 p1 = {sa[kb][rb + 4], sa[kb][rb + 5], sa[kb][rb + 6], sa[kb][rb + 7]};
      bf16x8 pf = pack8(p0, p1);
      bf16x8 v0 = *(const bf16x8*)(vs + s2 * 16);
      bf16x8 v1 = *(const bf16x8*)(vs + 32 * 72 + s2 * 16);
      o[0] = MFMA32(v0, pf, o[0]);
      o[1] = MFMA32(v1, pf, o[1]);
      if (s2 == 1) __builtin_amdgcn_sched_barrier(0);
    }
    if (more) {
      const int nb = buf ^ 1;
#pragma unroll
      for (int i = 0; i < NKC; ++i) { int c = tid + NTHR * i, r = c / KCH, kc = (c % KCH) * 8; if (c < KTOT) *(u32x4*)(Ks + nb * 64 * KST + r * KST + kc) = rk[i]; }
      { int r = tid >> 3, kc = (tid & 7) * 8; *(u32x4*)(Vs + nb * 64 * 72 + r * 72 + kc) = rv[0]; }
    }
    __syncthreads();
  }
  lsum += __shfl_xor(lsum, 32);
}

DI void store_o(u16* dst  , const f32x16 (&o)[2], float scale, int hh) {
#pragma unroll
  for (int db = 0; db < 2; ++db)
#pragma unroll
    for (int j = 0; j < 4; ++j) {
      const int dv = db * 32 + 8 * j + 4 * hh;
      f32x4 v = {o[db][4 * j] * scale, o[db][4 * j + 1] * scale, o[db][4 * j + 2] * scale, o[db][4 * j + 3] * scale};
      *(u32x2*)(dst + dv) = pack4(v);
    }
}

DI void attn_item(const P& p, int layer, int item, char* smem, int tid) {
  const int lane = tid & 63, wave = tid >> 6, l32 = lane & 31, hh = lane >> 5;
  bool lat; int kind, b, hd, qblk;
  if (item < 256) {
    lat = true;
    if (item < 128) { kind = 0; b = item >> 5; hd = (item >> 3) & 3; qblk = item & 7; }
    else { int it = item - 128; kind = 1 + (it >> 6); it &= 63; b = it >> 4; hd = (it >> 2) & 3; qblk = it & 3; }
  } else {
    lat = false;
    int it = item - 256;
    if (it < 256) { kind = 0; b = it >> 3; hd = (it >> 1) & 3; qblk = it & 1; }
    else { it -= 256; kind = 1 + (it >> 7); it &= 127; b = it >> 2; hd = it & 3; qblk = 0; }
  }
  const int nk = lat ? 1536 : 256;
  const int b_all = lat ? 32 + b : b;
  const int keyrow0 = lat ? NCTX + b * 1536 : b * 256;
  const int tok0 = lat ? NCTX + b * 1024 : b * 256;
  f32x16 o[2]; float ls;
  if (kind == 0) {
    const int ns = wave & 1, qb = wave >> 1;
    const int q0 = tok0 + qblk * 128 + qb * 32;
    const u16* Q = (const u16*)(p.ws + OFF_DQ) + (size_t)(q0 + l32) * 256 + hd * 64 + ns * 32 + hh * 8;
    bf16x8 qf[2];
    qf[0] = *(const bf16x8*)Q; qf[1] = *(const bf16x8*)(Q + 16);
    attn_block<64, 32>((const u16*)(p.ws + OFF_DKB) + (size_t)keyrow0 * 256 + hd * 64, 256, (const u16*)(p.ws + OFF_DVT) + vt_off(b_all, hd, 4), nk, qf, ns * 32,
                       smem, tid, o, ls);
    float d1 = 0.f, d2 = 0.f;
    if (lane < 32) { d1 = p.in[I_LQ1][layer * 32 + lane] * p.in[I_LK1][layer * 32 + lane]; d2 = p.in[I_LQ2][layer * 32 + lane] * p.in[I_LK2][layer * 32 + lane]; }
    d1 = wave_sum(d1); d2 = wave_sum(d2);
    int ly_ = layer; asm volatile("" : "+s"(ly_));
    const float lam_init = ly_ == 0 ? 0.2f : (0.8f - 0.6f * 0.7408182206817179f);
    const float lam = expf(d1) - expf(d2) + lam_init;
    float* cmb = (float*)smem + qb * (64 * 33);
    if (ns == 1) {
      const float sc = lam / ls;
#pragma unroll
      for (int db = 0; db < 2; ++db)
#pragma unroll
        for (int r = 0; r < 16; ++r) cmb[(db * 32 + crow(r, hh)) * 33 + l32] = o[db][r] * sc;
    }
    __syncthreads();
    if (ns == 0) {
      const float i0 = 1.f / ls;
      float ss = 0.f;
#pragma unroll
      for (int db = 0; db < 2; ++db)
#pragma unroll
        for (int r = 0; r < 16; ++r) { float d = o[db][r] * i0 - cmb[(db * 32 + crow(r, hh)) * 33 + l32]; o[db][r] = d; ss += d * d; }
      ss += __shfl_xor(ss, 32);
      const float rr = rsqrtf(ss * (1.f / 64.f) + EPSF) * (1.f - lam_init);
      u16* dst = (u16*)(p.ws + OFF_MIXED) + (size_t)(q0 + l32) * 1024 + hd * 64;
#pragma unroll
      for (int db = 0; db < 2; ++db)
#pragma unroll
        for (int j = 0; j < 4; ++j) {
          const int dv = db * 32 + 8 * j + 4 * hh;
          f32x4 g = *(const f32x4*)(p.in[I_SUBLN] + layer * 64 + dv);
          f32x4 v = {o[db][4 * j] * rr * g[0], o[db][4 * j + 1] * rr * g[1], o[db][4 * j + 2] * rr * g[2], o[db][4 * j + 3] * rr * g[3]};
          *(u32x2*)(dst + dv) = pack4(v);
        }
    }
    __syncthreads();
  } else if (kind == 1) {
    const int q0 = tok0 + qblk * 256 + wave * 32;
    const u16* Q = (const u16*)(p.ws + OFF_GQ) + (size_t)(q0 + l32) * 256 + hd * 64 + hh * 8;
    bf16x8 qf[4];
#pragma unroll
    for (int s2 = 0; s2 < 4; ++s2) qf[s2] = *(const bf16x8*)(Q + s2 * 16);
    attn_block<64, 64>((const u16*)(p.ws + OFF_GKB) + (size_t)keyrow0 * 128 + (hd >> 1) * 64, 128, (const u16*)(p.ws + OFF_GVT) + vt_off(b_all, hd >> 1, 2), nk, qf, 0,
                       smem, tid, o, ls);
    store_o((u16*)(p.ws + OFF_MIXED) + (size_t)(q0 + l32) * 1024 + 256 + hd * 64, o, 1.f / ls, hh);
  } else {
    const int q0 = tok0 + qblk * 256 + wave * 32;
    const u16* Q = (const u16*)(p.ws + OFF_MQ) + (size_t)(q0 + l32) * 384 + hd * 96 + hh * 8;
    bf16x8 qf[6];
#pragma unroll
    for (int s2 = 0; s2 < 6; ++s2) qf[s2] = *(const bf16x8*)(Q + s2 * 16);
    attn_block<96, 96>((const u16*)(p.ws + OFF_MKB) + (size_t)keyrow0 * 384 + hd * 96, 384, (const u16*)(p.ws + OFF_MVT) + vt_off(b_all, hd, 4), nk, qf, 0,
                       smem, tid, o, ls);
    store_o((u16*)(p.ws + OFF_MIXED) + (size_t)(q0 + l32) * 1024 + 768 + hd * 64, o, 1.f / ls, hh);
  }
}

DI void phase_at(const P& p, int layer, char* smem) {
  EPI_IDX
  constexpr int N_ITEMS = 768;
  if (gridDim.x == 256) {
    const int b = blockIdx.x;
    attn_item(p, layer, b, smem, tid);
    __syncthreads();
    if (b < 128) {
      attn_item(p, layer, 256 + b, smem, tid); __syncthreads();
      attn_item(p, layer, 512 + b, smem, tid); __syncthreads();
      attn_item(p, layer, 640 + b, smem, tid); __syncthreads();
    } else if (b < 192) {
      attn_item(p, layer, 256 + 128 + 2 * (b - 128), smem, tid); __syncthreads();
      attn_item(p, layer, 256 + 128 + 2 * (b - 128) + 1, smem, tid); __syncthreads();
    }
  } else {
    for (int item = blockIdx.x; item < N_ITEMS; item += gridDim.x) {
      attn_item(p, layer, item, smem, tid);
      __syncthreads();
    }
  }
  {
    constexpr int T_GLU = (NT / 256) * 2;
    auto tile_at = [&](int t) { TD d; d.A = (const u16*)(p.ws + OFF_PROJ); d.lda = NP * 2; d.B = (const u16*)(p.ws + OFF_WGLU) + (size_t)layer * 512 * 256; d.ldb = 256; d.k0 = 0; d.nk = 4; d.m0 = (t >> 1) * 256; d.n0 = (t & 1) * 256; return d; };
    int buf = 0;
    const int t0 = (int)gridDim.x - 1 - (int)blockIdx.x;
    TD cur = tile_at(t0 < T_GLU ? t0 : 0);
    if (t0 < T_GLU) stage_td(cur, 0, smem, tid);
    for (int t = t0; t < T_GLU; t += gridDim.x) {
      const bool has_next = (t + (int)gridDim.x < T_GLU);
      const TD nxt = tile_at(has_next ? t + (int)gridDim.x : t);
      const int m0 = cur.m0, n0 = cur.n0;
      f32x16 acc[4][2];
      gemm_stream(cur, has_next, nxt, smem, buf, acc);
      cur = nxt;
      u16* mixed = (u16*)(p.ws + OFF_MIXED);
      const int q = (n0 + wn * 64) >> 6;
#pragma unroll
      for (int bi = 0; bi < 4; ++bi) {
        const int rb = m0 + wm * 128 + bi * 32;
#pragma unroll
        for (int r = 0; r < 16; ++r) {
          float z = acc[bi][0][r], g = acc[bi][1][r];
          mixed[(size_t)(rb + crow(r, hh)) * 1024 + 512 + q * 32 + l32] = f2bf(z * fsigmoid(g));
        }
      }
    }
  }
}

#define XB_TMO      128
#define XB_XCNT(j)  (256  + 64 * (j))
#define XB_XSUB(j)  (1280 + 64 * (j))
#define XB_XGEN(j)  (2304 + 64 * (j))
#define XB_TOP      3328
#define XB_TOPGEN   3392
#define XCD_BAR_WORDS 3456
#define XB_SPIN_CAP (1u << 22)
#define LAS __attribute__((address_space(3)))
DI unsigned xb_ld(unsigned* p) { return __hip_atomic_load(p, __ATOMIC_RELAXED, __HIP_MEMORY_SCOPE_AGENT); }
DI unsigned xb_add(unsigned* p, unsigned v) { return __hip_atomic_fetch_add(p, v, __ATOMIC_RELAXED, __HIP_MEMORY_SCOPE_AGENT); }
DI unsigned xb_xcc_id() { return (unsigned)__builtin_amdgcn_s_getreg((3 << 11) | 20) & 0xFu; }
#define XB_SPIN(cond, bar) do { unsigned _sp = 0; while (cond) { __builtin_amdgcn_s_sleep(1); \
    if ((++_sp & 255u) == 0u) { if (xb_ld(&(bar)[XB_TMO])) break; if (_sp > XB_SPIN_CAP) { atomicAdd(&(bar)[XB_TMO], 1u); break; } } } } while (0)
struct XcdBarrier { unsigned* bar; unsigned x; volatile LAS unsigned* st; };
DI XcdBarrier xcd_barrier_post(unsigned* bar, volatile LAS unsigned* st) {
  XcdBarrier b; b.bar = bar; b.x = xb_xcc_id(); b.st = st;
  if (threadIdx.x == 0) st[2] = xb_add(&bar[XB_XCNT(b.x)], 1u);
  return b;
}
DI void xcd_barrier_complete(unsigned* bar, unsigned x, unsigned& nloc, unsigned& nx) {
  const unsigned G = gridDim.x * gridDim.y * gridDim.z;
  unsigned sum, cnt, mine, sp = 0u;
  for (;;) {
    sum = 0u; cnt = 0u; mine = 0u;
#pragma unroll
    for (unsigned j = 0; j < 16; ++j) { const unsigned c = xb_ld(&bar[XB_XCNT(j)]); sum += c; cnt += (c > 0u) ? 1u : 0u; mine = (j == x) ? c : mine; }
    if (sum == G) break;
    __builtin_amdgcn_s_sleep(1);
    if ((++sp & 255u) == 0u) { if (xb_ld(&bar[XB_TMO])) break; if (sp > XB_SPIN_CAP) { atomicAdd(&bar[XB_TMO], 1u); break; } }
  }
  nloc = mine > 0u ? mine : 1u; nx = cnt > 0u ? cnt : 1u;
}
DI void xcd_barrier(const XcdBarrier& b) {
  asm volatile("s_waitcnt vmcnt(0)" ::: "memory");
  __syncthreads();
  if (threadIdx.x == 0) {
    unsigned* bar = b.bar;
    __builtin_amdgcn_s_waitcnt(0);
    unsigned nloc = b.st[0], nx = b.st[1];
    if (nloc == 0u) { xcd_barrier_complete(bar, b.x, nloc, nx); b.st[0] = nloc; b.st[1] = nx; }
    const unsigned old = xb_add(&bar[XB_XSUB(b.x)], 1u);
    const unsigned gen = old / nloc;
    if (old + 1u == (gen + 1u) * nloc) {
      __builtin_amdgcn_fence(__ATOMIC_RELEASE, "agent");
      asm volatile("s_waitcnt vmcnt(0)" ::: "memory");
      const unsigned og = xb_add(&bar[XB_TOP], 1u);
      const unsigned tg = og / nx;
      if (og + 1u == (tg + 1u) * nx) xb_add(&bar[XB_TOPGEN], 1u);
      else XB_SPIN(xb_ld(&bar[XB_TOPGEN]) == tg, bar);
      __builtin_amdgcn_fence(__ATOMIC_ACQUIRE, "agent");
      xb_add(&bar[XB_XGEN(b.x)], 1u);
      asm volatile("s_waitcnt vmcnt(0)" ::: "memory");
    } else {
      XB_SPIN(xb_ld(&bar[XB_XGEN(b.x)]) == gen, bar);
      __builtin_amdgcn_fence(__ATOMIC_ACQUIRE, "agent");
      asm volatile("s_waitcnt vmcnt(0)" ::: "memory");
    }
  }
  __syncthreads();
}

DI void run_phase(const P& p_, int ph, int layer, char* smem) {
  P p = p_;
  asm volatile("" : "+s"(p.ws), "+s"(p.out));
  switch (ph) {
    case 0: prologue(p, smem); break;
    case 1: norm_phase(p, layer, 0); break;
    case 2: phase_g1(p, layer, smem); break;
    case 3: phase_pp(p, layer, smem); break;
    case 4: phase_g2(p, layer, smem); break;
    case 5: phase_at(p, layer, smem); break;
    case 6: phase_resid(p, layer, smem, true); break;
    case 7: norm_phase(p, layer, 1); break;
    case 8: phase_g5(p, layer, smem); break;
    case 9: phase_resid(p, layer, smem, false); break;
    case 10: norm_phase(p, 0, 2); break;
  }
}

extern __shared__ __attribute__((aligned(16))) char dyn_smem[];

__global__ void __launch_bounds__(512) fwd_mega(P p) {
  if (p.ws == nullptr) { cg::grid_group grid = cg::this_grid(); grid.sync(); }
  volatile LAS unsigned* st = (volatile LAS unsigned*)(dyn_smem + LDS_BYTES);
  if (threadIdx.x == 0) { st[0] = 0u; st[1] = 0u; st[2] = 0u; st[3] = 0u; }
  __syncthreads();
  XcdBarrier xb = xcd_barrier_post((unsigned*)(p.ws + OFF_BAR), st);
  run_phase(p, 0, 0, dyn_smem);
  xcd_barrier(xb);
  if (threadIdx.x == 0) {
    unsigned* bar = (unsigned*)(p.ws + OFF_BAR);
    bool ok = (gridDim.x & 7u) == 0u;
    for (unsigned j = 0; j < 16; ++j) { const unsigned c = xb_ld(&bar[XB_XCNT(j)]); ok = ok && (c == (j < 8 ? gridDim.x >> 3 : 0u)); }
    if (ok) st[3] = xb.x; else { st[2] = blockIdx.x >> 3; st[3] = blockIdx.x & 7u; }
  }
  __syncthreads();
  for (int l = 0; l < 2; ++l) {
    for (int ph = 1; ph <= 9; ++ph) {
      run_phase(p, ph, l, dyn_smem);
      xcd_barrier(xb);
    }
  }
  run_phase(p, 10, 0, dyn_smem);
}

#if !MEGA
__global__ void __launch_bounds__(512) fwd_phase(P p, int ph, int layer) { run_phase(p, ph, layer, dyn_smem); }
#endif

extern "C" void kernel_launch(void* const* d_in, const int* in_sizes, int n_in, void* d_out, int out_size, void* d_ws, size_t ws_size,
                              hipStream_t stream) {
  static int grid_blocks = 0;
  if (!grid_blocks) {
    int dev = 0, cus = 0, per_cu = 0;
    (void)hipGetDevice(&dev);
    (void)hipDeviceGetAttribute(&cus, hipDeviceAttributeMultiprocessorCount, dev);
    (void)hipFuncSetAttribute((const void*)fwd_mega, hipFuncAttributeMaxDynamicSharedMemorySize, LDS_BYTES + 16);
#if !MEGA
    (void)hipFuncSetAttribute((const void*)fwd_phase, hipFuncAttributeMaxDynamicSharedMemorySize, LDS_BYTES);
#endif
    (void)hipOccupancyMaxActiveBlocksPerMultiprocessor(&per_cu, (const void*)fwd_mega, NTHR, LDS_BYTES + 16);
    if (per_cu < 1) per_cu = 1;
    if (per_cu > 1) per_cu = 1;
    grid_blocks = cus * per_cu;
    if (ws_size < WS_NEED) fprintf(stderr, "kernel_launch: workspace too small: %zu < %zu\n", ws_size, (size_t)WS_NEED);
  }
  P p{};
  for (int i = 0; i < N_IN; ++i) p.in[i] = (const float*)d_in[i];
  p.out = (float*)d_out;
  p.ws = (char*)d_ws;
#if MEGA
  (void)hipMemsetAsync((char*)d_ws + OFF_BAR, 0, XCD_BAR_WORDS * 4, stream);
  void* args[] = {&p};
  hipError_t e = hipLaunchCooperativeKernel((const void*)fwd_mega, dim3(grid_blocks), dim3(NTHR), args, LDS_BYTES + 16, stream);
  if (e != hipSuccess) fprintf(stderr, "cooperative launch failed: %s (grid %d)\n", hipGetErrorString(e), grid_blocks);
#else
  hipLaunchKernelGGL(fwd_phase, dim3(grid_blocks), dim3(NTHR), LDS_BYTES, stream, p, 0, 0);
  for (int l = 0; l < 2; ++l)
    for (int ph = 1; ph <= 9; ++ph) hipLaunchKernelGGL(fwd_phase, dim3(grid_blocks), dim3(NTHR), LDS_BYTES, stream, p, ph, l);
  hipLaunchKernelGGL(fwd_phase, dim3(grid_blocks), dim3(NTHR), LDS_BYTES, stream, p, 10, 0);
#endif
}
```

```cpp
#include <hip/hip_runtime.h>
#include <hip/hip_cooperative_groups.h>
#include <cstdio>
namespace cg = cooperative_groups;

#ifndef MEGA
#define MEGA 1
#endif

#define DI __device__ __forceinline__
typedef unsigned short u16;
typedef __attribute__((ext_vector_type(8))) short bf16x8;
typedef __attribute__((ext_vector_type(4))) short bf16x4;
typedef __attribute__((ext_vector_type(2))) __bf16 bf2_t;
typedef __attribute__((ext_vector_type(2))) float f32x2;
typedef __attribute__((ext_vector_type(4))) float f32x4;
typedef __attribute__((ext_vector_type(16))) float f32x16;
typedef __attribute__((ext_vector_type(4))) unsigned u32x4;
typedef __attribute__((ext_vector_type(2))) unsigned u32x2;

#define MFMA32(a, b, c) __builtin_amdgcn_mfma_f32_32x32x16_bf16((a), (b), (c), 0, 0, 0)
#define MFMA16(a, b, c) __builtin_amdgcn_mfma_f32_16x16x32_bf16((a), (b), (c), 0, 0, 0)

constexpr int NT = 12288;
constexpr int NCTX = 8192;
constexpr int NKR = 14336;
constexpr int NP = 1920;
constexpr float EPSF = 1e-6f;
constexpr float LOG2E = 1.4426950408889634f;

enum { I_XP = 0, I_XS, I_CDK, I_CDV, I_CGK, I_CGV, I_CCKV, I_CKR, I_SRE, I_SIM, I_C, I_CCTX, I_N1G, I_N2G, I_WADA, I_BADA,
       I_WIN, I_WOUT, I_LQ1, I_LK1, I_LQ2, I_LK2, I_SUBLN, I_QNG, I_KNG, I_ARE, I_AIM, I_LOGDT, I_BRE, I_BIM, I_CRE, I_CIM,
       I_SSMD, I_WGLU, I_MQNG, I_MKVNG, I_WUQ, I_WUKV, I_W1, I_W2, I_FNG, N_IN };

constexpr size_t O_Y = 0;
constexpr size_t O_DK = 12582912;
constexpr size_t O_DV = 16777216;
constexpr size_t O_GK = 20971520;
constexpr size_t O_GV = 23068672;
constexpr size_t O_CKV = 25165824;
constexpr size_t O_KR = 27262976;
constexpr size_t O_SRE = 27787264;
constexpr size_t O_SIM = 27918336;

constexpr size_t al256(size_t x) { return (x + 255) & ~(size_t)255; }
constexpr size_t OFF_MOD = 0;
constexpr size_t OFF_CTR = al256(OFF_MOD + 2 * 5 * 6144 * 4);
constexpr size_t OFF_BAR = al256(OFF_CTR + 256);
constexpr size_t OFF_ROPE = al256(OFF_BAR + 3456 * 4);
constexpr size_t OFF_ABAR = al256(OFF_ROPE + 2 * 64 * 16 * 8);
constexpr size_t OFF_ATAB = al256(OFF_ABAR + 64 * 64 * 8);
constexpr size_t OFF_CTAB = al256(OFF_ATAB + 64 * 128 * 16 * 2);
constexpr size_t OFF_WIN = al256(OFF_CTAB + 64 * 16 * 128 * 2);
constexpr size_t OFF_WOUT = al256(OFF_WIN + (size_t)2 * 1920 * 1024 * 2);
constexpr size_t OFF_W1 = al256(OFF_WOUT + (size_t)2 * 1024 * 1024 * 2);
constexpr size_t OFF_W2 = al256(OFF_W1 + (size_t)2 * 4096 * 1024 * 2);
constexpr size_t OFF_WUQ = al256(OFF_W2 + (size_t)2 * 4096 * 1024 * 2);
constexpr size_t OFF_WUKV = al256(OFF_WUQ + (size_t)2 * 384 * 192 * 2);
constexpr size_t OFF_WGLU = al256(OFF_WUKV + (size_t)2 * 512 * 128 * 2);
constexpr size_t OFF_H = al256(OFF_WGLU + (size_t)2 * 512 * 256 * 2);
constexpr size_t OFF_MIXED = OFF_H;
constexpr size_t OFF_BIG = al256(OFF_H + (size_t)NT * 1024 * 2);
constexpr size_t OFF_PROJ = OFF_BIG;
constexpr size_t OFF_DQ = al256(OFF_PROJ + (size_t)NT * NP * 4);
constexpr size_t OFF_DKB = al256(OFF_DQ + (size_t)NT * 256 * 2);
constexpr size_t OFF_DVT = al256(OFF_DKB + (size_t)NKR * 256 * 2);
constexpr size_t OFF_GQ = al256(OFF_DVT + (size_t)NKR * 256 * 2);
constexpr size_t OFF_GKB = al256(OFF_GQ + (size_t)NT * 256 * 2);
constexpr size_t OFF_GVT = al256(OFF_GKB + (size_t)NKR * 128 * 2);
constexpr size_t OFF_MQ = al256(OFF_GVT + (size_t)NKR * 128 * 2);
constexpr size_t OFF_MKB = al256(OFF_MQ + (size_t)NT * 384 * 2);
constexpr size_t OFF_MVT = al256(OFF_MKB + (size_t)NKR * 384 * 2);
constexpr size_t OFF_CQN = al256(OFF_MVT + (size_t)NKR * 256 * 2);
constexpr size_t OFF_CKVN = al256(OFF_CQN + (size_t)NT * 192 * 2);
constexpr size_t OFF_YBUF = al256(OFF_CKVN + (size_t)NKR * 128 * 2);
constexpr size_t OFF_END1 = al256(OFF_YBUF + (size_t)2 * NT * 256 * 4);
constexpr size_t OFF_A = OFF_BIG;
constexpr size_t OFF_END2 = al256(OFF_A + (size_t)NT * 4096 * 2);
constexpr size_t WS_NEED = OFF_END1 > OFF_END2 ? OFF_END1 : OFF_END2;
static_assert(WS_NEED <= (size_t)256 * 1024 * 1024, "workspace over 256 MiB");

constexpr int NTHR = 512;
constexpr int NWV = NTHR / 64;
constexpr int LDS_BYTES = 8 * 32 * 132 * 4;

struct P {
  const float* in[N_IN];
  float* out;
  char* ws;
};

DI unsigned pack2(float a, float b) { f32x2 v = {a, b}; return __builtin_bit_cast(unsigned, __builtin_convertvector(v, bf2_t)); }
DI u16 f2bf(float a) { return (u16)(pack2(a, 0.f) & 0xffffu); }
DI bf16x8 pack8(f32x4 a, f32x4 b) {
  u32x4 r = {pack2(a[0], a[1]), pack2(a[2], a[3]), pack2(b[0], b[1]), pack2(b[2], b[3])};
  return __builtin_bit_cast(bf16x8, r);
}
DI f32x4 ld4bf(const u16* p) {
  const u32x2 w = *(const u32x2*)p;
  f32x4 r = {__uint_as_float(w[0] << 16), __uint_as_float(w[0] & 0xffff0000u), __uint_as_float(w[1] << 16), __uint_as_float(w[1] & 0xffff0000u)};
  return r;
}
DI u32x2 pack4(f32x4 a) { u32x2 r = {pack2(a[0], a[1]), pack2(a[2], a[3])}; return r; }
DI int get_tid() { int t = threadIdx.x; asm volatile("" : "+v"(t)); return t; }
DI float fexp2(float x) { return __builtin_amdgcn_exp2f(x); }
DI float frcp(float x) { return __builtin_amdgcn_rcpf(x); }
DI float fsigmoid(float w) { return frcp(1.f + fexp2(-w * LOG2E)); }
DI float gelu_tanh(float x) { return x * fsigmoid(1.5957691216057308f * (x + 0.044715f * x * x * x)); }
DI float wave_sum(float v) {
#pragma unroll
  for (int o = 32; o >= 1; o >>= 1) v += __shfl_xor(v, o);
  return v;
}
DI void wave_lds_fence() {
  asm volatile("s_waitcnt lgkmcnt(0)" ::: "memory");
  __builtin_amdgcn_wave_barrier();
}
DI int fetch_item(int* ctr, int lane) {
  int v = 0;
  if (lane == 0) v = atomicAdd(ctr, 1);
  return __builtin_amdgcn_readfirstlane(v);
}
DI size_t vt_off(int b_all, int head, int H) {
  if (b_all < 32) return ((size_t)(b_all * H + head) * 64) * 256;
  return (size_t)32 * H * 64 * 256 + ((size_t)((b_all - 32) * H + head) * 64) * 1536;
}
DI int mod_index(int row) { return row < NCTX ? 0 : 1 + ((row - NCTX) >> 10); }

DI void prologue(const P& p, char* smem) {
  const int tid = get_tid();
  float* fs = (float*)smem;
  constexpr int N_ADA = 384, N_TAB = 64, N_MISC = 1, N_TR = 5700;
  constexpr int TOTAL = N_ADA + N_TAB + N_MISC;
  for (int it = blockIdx.x; it < TOTAL; it += gridDim.x) {
    if (it < N_ADA) {
      const int l = it / 192, ch = it % 192;
      float* sc = fs;
      float* red = fs + 5 * 1024;
      for (int i = tid; i < 5 * 1024; i += NTHR) {
        int m = i >> 10, k = i & 1023;
        float c = (m == 0) ? p.in[I_CCTX][k] : p.in[I_C][(m - 1) * 1024 + k];
        sc[i] = c * fsigmoid(c);
      }
      __syncthreads();
      const int col = tid & 31, kg = tid >> 5;
      const float* w = p.in[I_WADA] + ((size_t)l * 1024 + kg * 64) * 6144 + ch * 32 + col;
      float a0 = 0, a1 = 0, a2 = 0, a3 = 0, a4 = 0;
#pragma unroll 16
      for (int k = 0; k < 64; ++k) {
        float wv = w[(size_t)k * 6144];
        int kk = kg * 64 + k;
        a0 += sc[kk] * wv; a1 += sc[1024 + kk] * wv; a2 += sc[2048 + kk] * wv; a3 += sc[3072 + kk] * wv; a4 += sc[4096 + kk] * wv;
      }
      red[(kg * 5 + 0) * 32 + col] = a0; red[(kg * 5 + 1) * 32 + col] = a1; red[(kg * 5 + 2) * 32 + col] = a2;
      red[(kg * 5 + 3) * 32 + col] = a3; red[(kg * 5 + 4) * 32 + col] = a4;
      __syncthreads();
      if (tid < 160) {
        int m = tid >> 5, c2 = tid & 31;
        float s = 0;
#pragma unroll
        for (int g = 0; g < 16; ++g) s += red[(g * 5 + m) * 32 + c2];
        int n = ch * 32 + c2;
        s += p.in[I_BADA][l * 6144 + n];
        ((float*)(p.ws + OFF_MOD))[((size_t)l * 5 + m) * 6144 + n] = s;
      }
      __syncthreads();
    } else if (it < N_ADA + N_TAB) {
      const int idx = it - N_ADA;
      if (tid < 64) {
        const int pp = tid;
        float are = p.in[I_ARE][idx * 64 + pp], aim = p.in[I_AIM][idx * 64 + pp];
        float dt = expf(p.in[I_LOGDT][idx]);
        float zr = are * dt, zi = aim * dt;
        float e = expf(zr);
        float abr = e * cosf(zi), abi = e * sinf(zi);
        float d2 = are * are + aim * aim;
        float nr = abr - 1.f, ni = abi;
        float qr = (nr * are + ni * aim) / d2, qi = (ni * are - nr * aim) / d2;
        u16* at = (u16*)(p.ws + OFF_ATAB) + (size_t)idx * 128 * 16;
        u16* ct = (u16*)(p.ws + OFF_CTAB) + (size_t)idx * 16 * 128;
        for (int c = 0; c < 16; ++c) {
          float bre = p.in[I_BRE][((size_t)idx * 64 + pp) * 16 + c], bim = p.in[I_BIM][((size_t)idx * 64 + pp) * 16 + c];
          at[(2 * pp) * 16 + c] = f2bf(qr * bre - qi * bim);
          at[(2 * pp + 1) * 16 + c] = f2bf(qr * bim + qi * bre);
          float cre = p.in[I_CRE][((size_t)idx * 16 + c) * 64 + pp], cim = p.in[I_CIM][((size_t)idx * 16 + c) * 64 + pp];
          ct[c * 128 + 2 * pp] = f2bf(cre);
          ct[c * 128 + 2 * pp + 1] = f2bf(-cim);
        }
        float* ab = (float*)(p.ws + OFF_ABAR) + ((size_t)idx * 64 + pp) * 2;
        ab[0] = abr; ab[1] = abi;
      }
    } else if (it < N_ADA + N_TAB + N_MISC) {
      f32x2* tab = (f32x2*)(p.ws + OFF_ROPE);
      for (int i = tid; i < 2 * 64 * 16; i += NTHR) {
        int kind = i >> 10, pos = (i >> 4) & 63, fi = i & 15;
        int n = kind ? 16 : 8;
        float freq = expf(-(float)(fi % n) / (float)n * 9.210340371976184f);
        float ang = (float)pos * freq;
        f32x2 cs = {cosf(ang), sinf(ang)};
        tab[i] = cs;
      }
      if (tid < 64) ((int*)(p.ws + OFF_CTR))[tid] = 0;
    }
  }
  struct TrD { const float* src; u16* dst; int K, N, k0, n0; bool glu; };
  auto decode = [&](int tt) {
    TrD d; d.glu = false;
    const int l = tt / 2850;
    int r = tt % 2850; int kt, nt;
    if (r < 480) { d.src = p.in[I_WIN] + (size_t)l * 1024 * 1888; d.dst = (u16*)(p.ws + OFF_WIN) + (size_t)l * 1920 * 1024; d.K = 1024; d.N = 1888; kt = r / 30; nt = r % 30; }
    else if (r < 736) { r -= 480; d.src = p.in[I_WOUT] + (size_t)l * 1024 * 1024; d.dst = (u16*)(p.ws + OFF_WOUT) + (size_t)l * 1024 * 1024; d.K = 1024; d.N = 1024; kt = r / 16; nt = r % 16; }
    else if (r < 1760) { r -= 736; d.src = p.in[I_W1] + (size_t)l * 1024 * 4096; d.dst = (u16*)(p.ws + OFF_W1) + (size_t)l * 4096 * 1024; d.K = 1024; d.N = 4096; kt = r / 64; nt = r % 64; }
    else if (r < 2784) { r -= 1760; d.src = p.in[I_W2] + (size_t)l * 4096 * 1024; d.dst = (u16*)(p.ws + OFF_W2) + (size_t)l * 1024 * 4096; d.K = 4096; d.N = 1024; kt = r / 16; nt = r % 16; }
    else if (r < 2802) { r -= 2784; d.src = p.in[I_WUQ] + (size_t)l * 192 * 384; d.dst = (u16*)(p.ws + OFF_WUQ) + (size_t)l * 384 * 192; d.K = 192; d.N = 384; kt = r / 6; nt = r % 6; }
    else if (r < 2818) { r -= 2802; d.src = p.in[I_WUKV] + (size_t)l * 128 * 512; d.dst = (u16*)(p.ws + OFF_WUKV) + (size_t)l * 512 * 128; d.K = 128; d.N = 512; kt = r / 8; nt = r % 8; }
    else { r -= 2818; d.src = p.in[I_WGLU] + (size_t)l * 256 * 512; d.dst = (u16*)(p.ws + OFF_WGLU) + (size_t)l * 512 * 256; d.K = 256; d.N = 512; kt = r / 8; nt = r % 8; d.glu = true; }
    d.k0 = kt * 64; d.n0 = nt * 64;
    return d;
  };
  const int half = tid >> 8, t2 = tid & 255;
  float* ft = fs + half * (64 * 65);
  const int tx = t2 & 15, ty = t2 >> 4;
  auto tload = [&](const TrD& d, f32x4 (&v)[4]) {
#pragma unroll
    for (int i = 0; i < 4; ++i) {
      const int kk = ty + 16 * i, n = d.n0 + 4 * tx;
      f32x4 z = {0.f, 0.f, 0.f, 0.f};
      v[i] = (n < d.N) ? *(const f32x4*)(d.src + (size_t)(d.k0 + kk) * d.N + n) : z;
    }
  };
  const int nvb = 2 * (int)gridDim.x;
  const int tb = nvb - 1 - (2 * (int)blockIdx.x + half);
  const int nrounds = (N_TR + nvb - 1) / nvb;
  TrD cur = decode(tb < N_TR ? tb : 0);
  f32x4 cv[4];
  if (tb < N_TR) tload(cur, cv);
  for (int j = 0; j < nrounds; ++j) {
    const int tt = tb + j * nvb;
    const bool valid = tt < N_TR, more = tt + nvb < N_TR;
    TrD nxt = decode(more ? tt + nvb : 0);
    f32x4 nv[4];
    if (more) tload(nxt, nv);
    if (valid) {
#pragma unroll
      for (int i = 0; i < 4; ++i) {
        const int kk = ty + 16 * i;
        ft[kk * 65 + 4 * tx + 0] = cv[i][0]; ft[kk * 65 + 4 * tx + 1] = cv[i][1]; ft[kk * 65 + 4 * tx + 2] = cv[i][2]; ft[kk * 65 + 4 * tx + 3] = cv[i][3];
      }
    }
    __syncthreads();
    if (valid) {
#pragma unroll
      for (int i = 0; i < 2; ++i) {
        const int c = t2 + 256 * i, nn = c >> 3, kc = (c & 7) * 8;
        f32x4 a, b;
#pragma unroll
        for (int e = 0; e < 4; ++e) { a[e] = ft[(kc + e) * 65 + nn]; b[e] = ft[(kc + 4 + e) * 65 + nn]; }
        const int n = cur.n0 + nn;
        int drow = n;
        if (cur.glu) drow = (n < 256) ? ((n >> 5) * 64 + (n & 31)) : (((n - 256) >> 5) * 64 + 32 + (n & 31));
        *(bf16x8*)(cur.dst + (size_t)drow * cur.K + cur.k0 + kc) = pack8(a, b);
      }
    }
    __syncthreads();
    cur = nxt;
    if (more) {
#pragma unroll
      for (int i = 0; i < 4; ++i) cv[i] = nv[i];
    }
  }
}

DI const float* x_row_src(const P& p, int layer, int row) {
  if (layer == 0) return row < NCTX ? p.in[I_XP] + (size_t)row * 1024 : p.in[I_XS] + (size_t)(row - NCTX) * 1024;
  return p.out + (size_t)row * 1024;
}
DI void norm_phase(const P& p, int layer, int which) {
  const int tid_ = get_tid();
  const int lane = tid_ & 63;
  const int gw = blockIdx.x * NWV + (tid_ >> 6), nw = gridDim.x * NWV;
  auto src_of = [&](int row) { return (which == 0) ? x_row_src(p, layer, row) : (const float*)(p.out + (size_t)row * 1024); };
  f32x4 v[4];
  if (gw < NT) {
    const float* xs = src_of(gw);
#pragma unroll
    for (int i = 0; i < 4; ++i) v[i] = *(const f32x4*)(xs + (i * 64 + lane) * 4);
  }
  for (int row = gw; row < NT; row += nw) {
    f32x4 nv[4];
    const bool more = row + nw < NT;
    if (more) {
      const float* xs = src_of(row + nw);
#pragma unroll
      for (int i = 0; i < 4; ++i) nv[i] = *(const f32x4*)(xs + (i * 64 + lane) * 4);
    }
    float ss = 0;
#pragma unroll
    for (int i = 0; i < 4; ++i) ss += v[i][0] * v[i][0] + v[i][1] * v[i][1] + v[i][2] * v[i][2] + v[i][3] * v[i][3];
    ss = wave_sum(ss);
    const float r = rsqrtf(ss * (1.f / 1024.f) + EPSF);
    if (which == 2) {
      f32x4 g[4];
#pragma unroll
      for (int i = 0; i < 4; ++i) g[i] = *(const f32x4*)(p.in[I_FNG] + (i * 64 + lane) * 4);
#pragma unroll
      for (int i = 0; i < 4; ++i) {
        int e = (i * 64 + lane) * 4;
        f32x4 o = v[i] * r * g[i];
        *(f32x4*)(p.out + (size_t)row * 1024 + e) = o;
      }
    } else {
      const float* gn = p.in[which == 0 ? I_N1G : I_N2G] + layer * 1024;
      const float* md = (const float*)(p.ws + OFF_MOD) + ((size_t)layer * 5 + mod_index(row)) * 6144 + (which == 0 ? 0 : 3072);
      u16* h = (u16*)(p.ws + OFF_H) + (size_t)row * 1024;
      f32x4 g[4], sh[4], sc[4];
#pragma unroll
      for (int i = 0; i < 4; ++i) {
        int e = (i * 64 + lane) * 4;
        g[i] = *(const f32x4*)(gn + e);
        sh[i] = *(const f32x4*)(md + e);
        sc[i] = *(const f32x4*)(md + 1024 + e);
      }
      if (which == 0 && layer == 0) {
#pragma unroll
        for (int i = 0; i < 4; ++i) *(f32x4*)(p.out + (size_t)row * 1024 + (i * 64 + lane) * 4) = v[i];
      }
#pragma unroll
      for (int i = 0; i < 4; ++i) {
        int e = (i * 64 + lane) * 4;
        f32x4 o = v[i] * r * g[i] * (1.f + sc[i]) + sh[i];
        *(u32x2*)(h + e) = pack4(o);
      }
    }
    if (more) {
#pragma unroll
      for (int i = 0; i < 4; ++i) v[i] = nv[i];
    }
  }
}

#define LAS3 __attribute__((address_space(3)))
DI void stage_tile_dma(const u16* __restrict__ G, int ld, int row0, int k0, char* lds, int tid) {
#pragma unroll
  for (int i = 0; i < 4; ++i) {
    const int q = tid + NTHR * i, r = q >> 3, c = (q & 7) ^ ((r >> 1) & 7);
    __builtin_amdgcn_global_load_lds((const unsigned*)(G + (size_t)(row0 + r) * ld + k0 + c * 8), (LAS3 unsigned*)(lds + q * 16), 16, 0, 0);
  }
}
struct TD { const u16* A; const u16* B; int lda, ldb, k0, nk, m0, n0; };
DI void stage_td(const TD& d, int kt, char* stage_base, int tid) {
  stage_tile_dma(d.A, d.lda, d.m0, d.k0 + kt * 64, stage_base, tid);
  stage_tile_dma(d.B, d.ldb, d.n0, d.k0 + kt * 64, stage_base + 32768, tid);
}
DI void gemm_stream(const TD& cur, bool has_next, const TD& nxt, char* smem, int& buf, f32x16 (&acc)[4][2]) {
  const int tid = get_tid(), lane = tid & 63, wave = tid >> 6, wm = wave >> 2, wn = wave & 3, l32 = lane & 31, hh = lane >> 5;
#pragma unroll
  for (int bi = 0; bi < 4; ++bi)
#pragma unroll
    for (int bj = 0; bj < 2; ++bj)
#pragma unroll
      for (int r = 0; r < 16; ++r) acc[bi][bj][r] = 0.f;
  const int swz = (l32 >> 1) & 7;
  const int arow = (wm * 128 + l32) * 128, brow = (wn * 64 + l32) * 128;
  const int c0 = ((0 + hh) ^ swz) * 16, c1 = ((2 + hh) ^ swz) * 16, c2 = ((4 + hh) ^ swz) * 16, c3 = ((6 + hh) ^ swz) * 16;
  asm volatile("s_waitcnt vmcnt(0)" ::: "memory");
  __syncthreads();
  const int nk = cur.nk;
  for (int kt = 0; kt < nk; ++kt) {
    const bool early = wave < 4;
    if (early) {
      if (kt + 1 < nk) stage_td(cur, kt + 1, smem + (buf ^ 1) * 65536, tid);
      else if (has_next) stage_td(nxt, 0, smem + (buf ^ 1) * 65536, tid);
    }
    const char* as = smem + buf * 65536 + arow;
    const char* bs = smem + buf * 65536 + 32768 + brow;
#pragma unroll
    for (int ks = 0; ks < 4; ++ks) {
      const int co = (ks == 0) ? c0 : (ks == 1) ? c1 : (ks == 2) ? c2 : c3;
      bf16x8 fa[4], fb[2];
#pragma unroll
      for (int bi = 0; bi < 4; ++bi) fa[bi] = *(const bf16x8*)(as + bi * 4096 + co);
#pragma unroll
      for (int bj = 0; bj < 2; ++bj) fb[bj] = *(const bf16x8*)(bs + bj * 4096 + co);
      __builtin_amdgcn_s_setprio(1);
#pragma unroll
      for (int bi = 0; bi < 4; ++bi)
#pragma unroll
        for (int bj = 0; bj < 2; ++bj) acc[bi][bj] = MFMA32(fa[bi], fb[bj], acc[bi][bj]);
      __builtin_amdgcn_s_setprio(0);
      if (ks == 1 && !early) {
        if (kt + 1 < nk) stage_td(cur, kt + 1, smem + (buf ^ 1) * 65536, tid);
        else if (has_next) stage_td(nxt, 0, smem + (buf ^ 1) * 65536, tid);
      }
    }
    buf ^= 1;
    if (kt + 1 < nk) {
      asm volatile("s_waitcnt vmcnt(0)" ::: "memory");
      __syncthreads();
    }
  }
}

#if MEGA
#define XCD_ID()   ((int)((volatile int*)(smem + LDS_BYTES))[3])
#define XCD_RANK() ((int)((volatile int*)(smem + LDS_BYTES))[2])
#else
#define XCD_ID()   ((int)(blockIdx.x & 7))
#define XCD_RANK() ((int)(blockIdx.x >> 3))
#endif
#define EPI_IDX                                                                                        \
  const int tid = get_tid(), lane = tid & 63, wave = tid >> 6, wm = wave >> 2, wn = wave & 3, l32 = lane & 31, hh = lane >> 5; \
  (void)tid; (void)lane; (void)wave; (void)wm; (void)wn; (void)l32; (void)hh;
DI int crow(int r, int hh) { return (r & 3) + 8 * (r >> 2) + 4 * hh; }

DI void phase_g1(const P& p, int layer, char* smem) {
  EPI_IDX
  const u16* A = (const u16*)(p.ws + OFF_H);
  const u16* Bt = (const u16*)(p.ws + OFF_WIN) + (size_t)layer * 1920 * 1024;
  u16* proj = (u16*)(p.ws + OFF_PROJ);
  constexpr int MT = NT / 256, NTL = 8, MPX = MT / 8;
  const int xcd_ = XCD_ID(), xj_ = XCD_RANK(), xn_ = gridDim.x >> 3;
  auto tile_at = [&](int u) { TD d; d.A = A; d.B = Bt; d.lda = 1024; d.ldb = 1024; d.k0 = 0; d.nk = 16; d.m0 = (xcd_ * MPX + u % MPX) * 256; d.n0 = (u / MPX) * 256; return d; };
  int buf = 0;
  TD cur = tile_at(xj_ < MPX * NTL ? xj_ : 0);
  if (xj_ < MPX * NTL) stage_td(cur, 0, smem, tid);
  for (int u = xj_; u < MPX * NTL; u += xn_) {
    const bool has_next = (u + xn_ < MPX * NTL);
    const TD nxt = tile_at(has_next ? u + xn_ : u);
    const int m0 = cur.m0, n0 = cur.n0;
    f32x16 acc[4][2];
    gemm_stream(cur, has_next, nxt, smem, buf, acc);
    cur = nxt;
    const bool lat = m0 >= NCTX;
    const int b_all = lat ? 32 + ((m0 - NCTX) >> 10) : (m0 >> 8);
    const int nkk = lat ? 1536 : 256;
#pragma unroll
    for (int bi = 0; bi < 4; ++bi)
#pragma unroll
      for (int bj = 0; bj < 2; ++bj) {
        const int rb = m0 + wm * 128 + bi * 32;
        const int cb = n0 + wn * 64 + bj * 32;
        const int col = cb + l32;
        if (cb < NP) {
#pragma unroll
          for (int r = 0; r < 16; ++r) proj[(size_t)(rb + crow(r, hh)) * NP + col] = f2bf(acc[bi][bj][r]);
        }
        const bool isdv = (cb >= 512 && cb < 768), isgv = (cb >= 1152 && cb < 1280);
        if (isdv || isgv) {
          u16* vt; int f;
          if (isdv) { f = col - 512; vt = (u16*)(p.ws + OFF_DVT) + vt_off(b_all, f >> 6, 4); }
          else { f = col - 1152; vt = (u16*)(p.ws + OFF_GVT) + vt_off(b_all, f >> 6, 2); }
          vt += (size_t)(f & 63) * nkk;
#pragma unroll
          for (int j = 0; j < 4; ++j) {
            int row = rb + 16 * (j >> 1) + 8 * hh + 4 * (j & 1);
            int key = lat ? 512 + ((row - NCTX) & 1023) : (row & 255);
            f32x4 v = {acc[bi][bj][4 * j], acc[bi][bj][4 * j + 1], acc[bi][bj][4 * j + 2], acc[bi][bj][4 * j + 3]};
            *(u32x2*)(vt + key) = pack4(v);
          }
        }
      }
  }
}

DI void phase_g2(const P& p, int layer, char* smem) {
  EPI_IDX
  constexpr int T_MQ = (NT / 256) * 2, T_MKV = (NKR / 256) * 2;
  const f32x2* tab32 = (const f32x2*)(p.ws + OFF_ROPE);
  auto tile_at = [&](int t) {
    TD d; d.k0 = 0;
    if (t < T_MQ) { d.A = (const u16*)(p.ws + OFF_CQN); d.B = (const u16*)(p.ws + OFF_WUQ) + (size_t)layer * 384 * 192; d.lda = 192; d.ldb = 192; d.nk = 3; d.m0 = (t >> 1) * 256; d.n0 = (t & 1) * 256; }
    else { const int t2 = t - T_MQ; d.A = (const u16*)(p.ws + OFF_CKVN); d.B = (const u16*)(p.ws + OFF_WUKV) + (size_t)layer * 512 * 128; d.lda = 128; d.ldb = 128; d.nk = 2; d.m0 = (t2 >> 1) * 256; d.n0 = (t2 & 1) * 256; }
    return d;
  };
  int buf = 0;
  const int t_first = blockIdx.x;
  TD cur = tile_at(t_first < T_MQ + T_MKV ? t_first : 0);
  if (t_first < T_MQ + T_MKV) stage_td(cur, 0, smem, tid);
  for (int t = blockIdx.x; t < T_MQ + T_MKV; t += gridDim.x) {
    const bool has_next = (t + (int)gridDim.x < T_MQ + T_MKV);
    const TD nxt = tile_at(has_next ? t + (int)gridDim.x : t);
    f32x16 acc[4][2];
    const int m0 = cur.m0, n0 = cur.n0;
    gemm_stream(cur, has_next, nxt, smem, buf, acc);
    cur = nxt;
    if (t < T_MQ) {
      const bool lat = m0 >= NCTX;
      const float scl = 0.10206207261596575f * LOG2E;
      u16* mq = (u16*)(p.ws + OFF_MQ);
#pragma unroll
      for (int bi = 0; bi < 4; ++bi)
#pragma unroll
        for (int bj = 0; bj < 2; ++bj) {
          const int rb = m0 + wm * 128 + bi * 32;
          const int cb = n0 + wn * 64 + bj * 32;
          const int col = cb + l32;
          if (cb < 384) {
            const bool isrope = lat && ((cb % 96) == 64);
            const int e = l32, w2 = e & 15, fi = w2 & 7;
            const bool isx2 = w2 >= 8, half = e >= 16;
#pragma unroll
            for (int r = 0; r < 16; ++r) {
              float v = acc[bi][bj][r];
              const int row = rb + crow(r, hh);
              if (isrope) {
                const int tt = (row - NCTX) & 1023;
                const int pos = half ? (tt & 63) : (tt >> 6);
                const f32x2 cs = tab32[pos * 16 + fi];
                float pv = __shfl_xor(v, 8);
                v = v * cs[0] + (isx2 ? pv : -pv) * cs[1];
              }
              mq[(size_t)row * 384 + col] = f2bf(v * scl);
            }
          }
        }
    } else {
      const bool lat = m0 >= NCTX;
      const int b_all = lat ? 32 + (m0 - NCTX) / 1536 : (m0 >> 8);
      const int nkk = lat ? 1536 : 256;
      const int kbase = lat ? (m0 - NCTX) % 1536 : (m0 & 255);
      u16* mk = (u16*)(p.ws + OFF_MKB);
#pragma unroll
      for (int bi = 0; bi < 4; ++bi)
#pragma unroll
        for (int bj = 0; bj < 2; ++bj) {
          const int rloc = wm * 128 + bi * 32;
          const int cb = n0 + wn * 64 + bj * 32;
          const int head = cb >> 7, wc = (cb & 127) + l32;
          if ((cb & 127) < 64) {
#pragma unroll
            for (int r = 0; r < 16; ++r) mk[(size_t)(m0 + rloc + crow(r, hh)) * 384 + head * 96 + wc] = f2bf(acc[bi][bj][r]);
          } else {
            u16* vt = (u16*)(p.ws + OFF_MVT) + vt_off(b_all, head, 4) + (size_t)(wc - 64) * nkk + kbase + rloc;
#pragma unroll
            for (int j = 0; j < 4; ++j) {
              f32x4 v = {acc[bi][bj][4 * j], acc[bi][bj][4 * j + 1], acc[bi][bj][4 * j + 2], acc[bi][bj][4 * j + 3]};
              *(u32x2*)(vt + 16 * (j >> 1) + 8 * hh + 4 * (j & 1)) = pack4(v);
            }
          }
        }
    }
  }
  {
    const int gw = blockIdx.x * NWV + wave, nw = gridDim.x * NWV;
    const f32x4 dd = *(const f32x4*)(p.in[I_SSMD] + layer * 256 + lane * 4);
    for (int row = gw; row < NT; row += nw) {
      const float* y0 = (const float*)(p.ws + OFF_YBUF) + (size_t)row * 256 + lane * 4;
      u16* prow = (u16*)(p.ws + OFF_PROJ) + (size_t)row * NP;
      f32x4 a = *(const f32x4*)y0, b = *(const f32x4*)(y0 + (size_t)NT * 256), c = ld4bf(prow + 1280 + lane * 4);
      f32x4 sv = a + b + c * dd;
      f32x4 g = {gelu_tanh(sv[0]), gelu_tanh(sv[1]), gelu_tanh(sv[2]), gelu_tanh(sv[3])};
      *(u32x2*)(prow + lane * 4) = pack4(g);
    }
  }
}

DI void phase_resid(const P& p, int layer, char* smem, bool is_out) {
  EPI_IDX
  const u16* A = is_out ? (const u16*)(p.ws + OFF_MIXED) : (const u16*)(p.ws + OFF_A);
  const int K = is_out ? 1024 : 4096;
  const u16* Bt = is_out ? (const u16*)(p.ws + OFF_WOUT) + (size_t)layer * 1024 * 1024 : (const u16*)(p.ws + OFF_W2) + (size_t)layer * 1024 * 4096;
  constexpr int MT = NT / 256, NTL = 4, MPX = MT / 8, NU = MPX * NTL;
  const int xcd_ = XCD_ID(), xj_ = XCD_RANK(), xn_ = gridDim.x >> 3;
  auto tile_at = [&](int u) {
    TD d; d.A = A; d.B = Bt; d.lda = K; d.ldb = K; d.nk = K / 64; d.k0 = 0;
    d.n0 = (u % NTL) * 256;
    d.m0 = (xcd_ * MPX + u / NTL) * 256;
    return d;
  };
  int buf = 0;
  TD cur = tile_at(xj_ < NU ? xj_ : 0);
  if (xj_ < NU) stage_td(cur, 0, smem, tid);
  for (int u = xj_; u < NU; u += xn_) {
    const bool has_next = (u + xn_ < NU);
    const TD nxt = tile_at(has_next ? u + xn_ : u);
    const int m0 = cur.m0, n0 = cur.n0;
    f32x16 acc[4][2];
    gemm_stream(cur, has_next, nxt, smem, buf, acc);
    cur = nxt;
    const float* gate = (const float*)(p.ws + OFF_MOD) + ((size_t)layer * 5 + mod_index(m0)) * 6144 + (is_out ? 2048 : 5120);
#pragma unroll
    for (int bi = 0; bi < 4; ++bi)
#pragma unroll
      for (int bj = 0; bj < 2; ++bj) {
        const int rb = m0 + wm * 128 + bi * 32;
        const int col = n0 + wn * 64 + bj * 32 + l32;
        const float g = gate[col];
        float rv[16];
#pragma unroll
        for (int r = 0; r < 16; ++r) rv[r] = p.out[(size_t)(rb + crow(r, hh)) * 1024 + col];
#pragma unroll
        for (int r = 0; r < 16; ++r) p.out[(size_t)(rb + crow(r, hh)) * 1024 + col] = rv[r] + g * acc[bi][bj][r];
      }
  }
}

DI void phase_g5(const P& p, int layer, char* smem) {
  EPI_IDX
  const u16* A = (const u16*)(p.ws + OFF_H);
  const u16* Bt = (const u16*)(p.ws + OFF_W1) + (size_t)layer * 4096 * 1024;
  u16* a = (u16*)(p.ws + OFF_A);
  constexpr int MT = NT / 256, NTL = 16, MPX = MT / 8;
  const int xcd_ = XCD_ID(), xj_ = XCD_RANK(), xn_ = gridDim.x >> 3;
  auto tile_at = [&](int u) { TD d; d.A = A; d.B = Bt; d.lda = 1024; d.ldb = 1024; d.k0 = 0; d.nk = 16; d.m0 = (xcd_ * MPX + u % MPX) * 256; d.n0 = (u / MPX) * 256; return d; };
  int buf = 0;
  TD cur = tile_at(xj_ < MPX * NTL ? xj_ : 0);
  if (xj_ < MPX * NTL) stage_td(cur, 0, smem, tid);
  for (int u = xj_; u < MPX * NTL; u += xn_) {
    const bool has_next = (u + xn_ < MPX * NTL);
    const TD nxt = tile_at(has_next ? u + xn_ : u);
    const int m0 = cur.m0, n0 = cur.n0;
    f32x16 acc[4][2];
    gemm_stream(cur, has_next, nxt, smem, buf, acc);
    cur = nxt;
#pragma unroll
    for (int bi = 0; bi < 4; ++bi)
#pragma unroll
      for (int bj = 0; bj < 2; ++bj) {
        const int rb = m0 + wm * 128 + bi * 32;
        const int col = n0 + wn * 64 + bj * 32 + l32;
#pragma unroll
        for (int r = 0; r < 16; ++r) {
          float v = fmaxf(acc[bi][bj][r], 0.f);
          a[(size_t)(rb + crow(r, hh)) * 4096 + col] = f2bf(v * v);
        }
      }
  }
}

template <int R>
DI f32x4 rope4(f32x4 v, int lane, int t, const f32x2* tab) {
  constexpr int n = R / 4;
  const int e = (lane * 4) % R;
  const int half = e / (R / 2), w = e % (R / 2);
  const bool isx2 = w >= n;
  const int fi = w % n;
  const int pos = half ? (t & 63) : (t >> 6);
  f32x4 o;
#pragma unroll
  for (int i = 0; i < 4; ++i) {
    float pv = __shfl_xor(v[i], n / 4);
    f32x2 cs = tab[pos * 16 + fi + i];
    o[i] = v[i] * cs[0] + (isx2 ? pv : -pv) * cs[1];
  }
  return o;
}

DI void ssm_item(const P& p, int layer, int item, float* lds, int lane) {
  int b_all, r;
  if (item < 128) { b_all = 32 + item / 32; r = item % 32; } else { int it = item - 128; b_all = it / 32; r = it % 32; }
  const int dir = r >> 4, g = r & 15;
  const bool lat = b_all >= 32;
  const int T = lat ? 1024 : 256;
  const int row0 = lat ? NCTX + (b_all - 32) * 1024 : b_all * 256;
  const int tabidx = (layer * 2 + dir) * 16 + g;
  const int l32 = lane & 31, hh = lane >> 5, l16 = lane & 15, q4 = lane >> 4;
  const u16* atab = (const u16*)(p.ws + OFF_ATAB) + (size_t)tabidx * 128 * 16;
  const u16* ctab = (const u16*)(p.ws + OFF_CTAB) + (size_t)tabidx * 16 * 128;
  bf16x8 af[4], cf[4];
#pragma unroll
  for (int blk = 0; blk < 4; ++blk) af[blk] = *(const bf16x8*)(atab + (blk * 32 + l32) * 16 + hh * 8);
#pragma unroll
  for (int kk = 0; kk < 4; ++kk) cf[kk] = *(const bf16x8*)(ctab + l16 * 128 + kk * 32 + q4 * 8);
  const float* ab = (const float*)(p.ws + OFF_ABAR) + ((size_t)tabidx * 64 + lane) * 2;
  const float ar = ab[0], ai = ab[1];
  float hr = 0.f, hi = 0.f;
  if (lat) {
    size_t idx = ((size_t)((b_all - 32) * 2 + layer) * 2 + dir) * 1024 + g * 64 + lane;
    hr = p.in[I_SRE][idx]; hi = p.in[I_SIM][idx];
  }
  const u16* proj = (const u16*)(p.ws + OFF_PROJ);
  float* ybuf = (float*)(p.ws + OFF_YBUF) + (size_t)dir * NT * 256;
  f32x16 zero16;
#pragma unroll
  for (int i = 0; i < 16; ++i) zero16[i] = 0.f;
  bf16x8 un;
  {
    const int t = dir ? (T - 1 - l32) : l32;
    un = *(const bf16x8*)(proj + (size_t)(row0 + t) * NP + 1280 + g * 16 + hh * 8);
  }
  for (int ch = 0; ch < T / 32; ++ch) {
    {
      bf16x8 uf = un;
      if (ch + 1 < T / 32) {
        const int n = (ch + 1) * 32 + l32;
        const int t = dir ? (T - 1 - n) : n;
        un = *(const bf16x8*)(proj + (size_t)(row0 + t) * NP + 1280 + g * 16 + hh * 8);
      }
#pragma unroll
      for (int blk = 0; blk < 4; ++blk) {
        f32x16 d = MFMA32(af[blk], uf, zero16);
#pragma unroll
        for (int j = 0; j < 4; ++j) {
          f32x4 v = {d[4 * j], d[4 * j + 1], d[4 * j + 2], d[4 * j + 3]};
          *(f32x4*)(lds + l32 * 132 + blk * 32 + 8 * j + 4 * hh) = v;
        }
      }
    }
    wave_lds_fence();
    {
      f32x2 bu[32];
#pragma unroll
      for (int s = 0; s < 32; ++s) bu[s] = *(const f32x2*)(lds + s * 132 + 2 * lane);
#pragma unroll
      for (int s = 0; s < 32; ++s) {
        const float nr = __builtin_fmaf(ar, hr, __builtin_fmaf(-ai, hi, bu[s][0]));
        const float ni = __builtin_fmaf(ar, hi, __builtin_fmaf(ai, hr, bu[s][1]));
        hr = nr; hi = ni;
        f32x2 hv = {hr, hi};
        *(f32x2*)(lds + s * 132 + 2 * lane) = hv;
      }
    }
    wave_lds_fence();
#pragma unroll
    for (int tb = 0; tb < 2; ++tb) {
      f32x4 y = {0.f, 0.f, 0.f, 0.f};
#pragma unroll
      for (int kk = 0; kk < 4; ++kk) {
        const float* hp = lds + (tb * 16 + l16) * 132 + kk * 32 + q4 * 8;
        f32x4 a0 = *(const f32x4*)hp, a1 = *(const f32x4*)(hp + 4);
        y = MFMA16(cf[kk], pack8(a0, a1), y);
      }
      const int n2 = ch * 32 + tb * 16 + l16;
      const int t2 = dir ? (T - 1 - n2) : n2;
      *(f32x4*)(ybuf + (size_t)(row0 + t2) * 256 + g * 16 + q4 * 4) = y;
    }
    wave_lds_fence();
  }
  if (!lat) {
    size_t idx = ((size_t)(b_all * 2 + layer) * 2 + dir) * 1024 + g * 64 + lane;
    p.out[O_SRE + idx] = hr;
    p.out[O_SIM + idx] = hi;
  }
}

DI void pp_row(const P& p, int layer, int row, int lane) {
  const u16* pr = (const u16*)(p.ws + OFF_PROJ) + (size_t)row * NP;
  const bool lat = row >= NCTX;
  int b, t, keyrow;
  if (!lat) { b = row >> 8; t = row & 255; keyrow = row; }
  else { int rr = row - NCTX; b = rr >> 10; t = rr & 1023; keyrow = NCTX + b * 1536 + 512 + t; }
  const f32x2* tab32 = (const f32x2*)(p.ws + OFF_ROPE);
  const f32x2* tab64 = tab32 + 64 * 16;
  const size_t orow = (size_t)(b * 2 + layer) * 256 + t;
  const f32x4 z4 = {0.f, 0.f, 0.f, 0.f};
  f32x4 v_dq = ld4bf(pr + lane * 4);
  f32x4 v_dk = ld4bf(pr + 256 + lane * 4);
  f32x4 v_dv = ld4bf(pr + 512 + lane * 4);
  f32x4 v_gq = ld4bf(pr + 768 + lane * 4);
  f32x4 v_gk = lane < 32 ? ld4bf(pr + 1024 + lane * 4) : z4;
  f32x4 v_gv = lane < 32 ? ld4bf(pr + 1152 + lane * 4) : z4;
  f32x4 v_cq = lane < 48 ? ld4bf(pr + 1536 + lane * 4) : z4;
  f32x4 v_ckv = lane < 32 ? ld4bf(pr + 1728 + lane * 4) : z4;
  f32x4 v_kr = lane < 8 ? ld4bf(pr + 1856 + lane * 4) : z4;
  const f32x4 g_q = *(const f32x4*)(p.in[I_QNG] + layer * 64 + (lane & 15) * 4);
  const f32x4 g_k = *(const f32x4*)(p.in[I_KNG] + layer * 64 + (lane & 15) * 4);
  const f32x4 g_cq = lane < 48 ? *(const f32x4*)(p.in[I_MQNG] + layer * 192 + lane * 4) : z4;
  const f32x4 g_ckv = lane < 32 ? *(const f32x4*)(p.in[I_MKVNG] + layer * 128 + lane * 4) : z4;
  f32x2 cs32[4], cs64[4];
  {
    const int e32 = (lane * 4) & 31, w32 = e32 & 15, p32 = (e32 >> 4) ? (t & 63) : (t >> 6), f32i = w32 & 7;
    const int e64 = (lane * 4) & 63, w64 = e64 & 31, p64 = (e64 >> 5) ? (t & 63) : (t >> 6), f64i = w64 & 15;
    const f32x2 one = {1.f, 0.f};
#pragma unroll
    for (int i = 0; i < 4; ++i) {
      cs32[i] = lat ? tab32[p32 * 16 + f32i + i] : one;
      cs64[i] = lat ? tab64[p64 * 16 + f64i + i] : one;
    }
  }
  const bool x2_32 = ((lane * 4) & 15) >= 8, x2_64 = ((lane * 4) & 31) >= 16;
  auto rope32 = [&](f32x4 v) {
    f32x4 o;
#pragma unroll
    for (int i = 0; i < 4; ++i) { float pv = __shfl_xor(v[i], 2); o[i] = v[i] * cs32[i][0] + (x2_32 ? pv : -pv) * cs32[i][1]; }
    return o;
  };
  auto rope64 = [&](f32x4 v) {
    f32x4 o;
#pragma unroll
    for (int i = 0; i < 4; ++i) { float pv = __shfl_xor(v[i], 4); o[i] = v[i] * cs64[i][0] + (x2_64 ? pv : -pv) * cs64[i][1]; }
    return o;
  };
  if (!lat) {
    *(f32x4*)(p.out + O_DK + orow * 256 + lane * 4) = v_dk;
    *(f32x4*)(p.out + O_DV + orow * 256 + lane * 4) = v_dv;
    if (lane < 32) *(f32x4*)(p.out + O_GV + orow * 128 + lane * 4) = v_gv;
    if (lane < 8) *(f32x4*)(p.out + O_KR + orow * 32 + lane * 4) = v_kr;
  }
  {
    f32x4 v = v_dq;
    if (lat) v = rope32(v);
    v = v * (0.17677669529663687f * LOG2E);
    *(u32x2*)((u16*)(p.ws + OFF_DQ) + (size_t)row * 256 + lane * 4) = pack4(v);
  }
  {
    f32x4 v = v_dk;
    if (lat) v = rope32(v);
    *(u32x2*)((u16*)(p.ws + OFF_DKB) + (size_t)keyrow * 256 + lane * 4) = pack4(v);
  }
  {
    f32x4 v = v_gq;
    float ss = v[0] * v[0] + v[1] * v[1] + v[2] * v[2] + v[3] * v[3];
    ss += __shfl_xor(ss, 1); ss += __shfl_xor(ss, 2); ss += __shfl_xor(ss, 4); ss += __shfl_xor(ss, 8);
    float r = rsqrtf(ss * (1.f / 64.f) + EPSF);
    v = v * r * g_q;
    if (lat) v = rope64(v);
    v = v * (0.125f * LOG2E);
    *(u32x2*)((u16*)(p.ws + OFF_GQ) + (size_t)row * 256 + lane * 4) = pack4(v);
  }
  {
    f32x4 v = v_gk;
    float ss = v[0] * v[0] + v[1] * v[1] + v[2] * v[2] + v[3] * v[3];
    ss += __shfl_xor(ss, 1); ss += __shfl_xor(ss, 2); ss += __shfl_xor(ss, 4); ss += __shfl_xor(ss, 8);
    float r = rsqrtf(ss * (1.f / 64.f) + EPSF);
    v = v * r * g_k;
    if (!lat) { if (lane < 32) *(f32x4*)(p.out + O_GK + orow * 128 + lane * 4) = v; }
    else v = rope64(v);
    if (lane < 32) *(u32x2*)((u16*)(p.ws + OFF_GKB) + (size_t)keyrow * 128 + lane * 4) = pack4(v);
  }
  {
    f32x4 v = v_cq;
    float ss = wave_sum(v[0] * v[0] + v[1] * v[1] + v[2] * v[2] + v[3] * v[3]);
    float r = rsqrtf(ss * (1.f / 192.f) + EPSF);
    v = v * r * g_cq;
    if (lane < 48) *(u32x2*)((u16*)(p.ws + OFF_CQN) + (size_t)row * 192 + lane * 4) = pack4(v);
  }
  {
    f32x4 v = v_ckv;
    float ss = wave_sum(v[0] * v[0] + v[1] * v[1] + v[2] * v[2] + v[3] * v[3]);
    float r = rsqrtf(ss * (1.f / 128.f) + EPSF);
    v = v * r * g_ckv;
    if (lane < 32) {
      if (!lat) *(f32x4*)(p.out + O_CKV + orow * 128 + lane * 4) = v;
      *(u32x2*)((u16*)(p.ws + OFF_CKVN) + (size_t)keyrow * 128 + lane * 4) = pack4(v);
    }
  }
  {
    f32x4 v = v_kr;
    if (lat) v = rope32(v);
    if (lane < 8) {
      u32x2 pk = pack4(v);
      u16* mk = (u16*)(p.ws + OFF_MKB) + (size_t)keyrow * 384 + 64 + lane * 4;
#pragma unroll
      for (int hd = 0; hd < 4; ++hd) *(u32x2*)(mk + hd * 96) = pk;
    }
  }
}

DI void pp_cached(const P& p, int layer, int crow_, int lane) {
  const int b = crow_ >> 9, j = crow_ & 511;
  const int keyrow = NCTX + b * 1536 + j;
  const size_t src = (size_t)(b * 2 + layer) * 512 + j;
  const int jp = (j & ~15) | (((j >> 2) & 1) << 3) | (((j >> 3) & 1) << 2) | (j & 3);
  const f32x4 z4 = {0.f, 0.f, 0.f, 0.f};
  const int l31 = lane & 31, l7 = lane & 7;
  f32x4 v_dk = *(const f32x4*)(p.in[I_CDK] + src * 256 + lane * 4);
  f32x4 v_dv = *(const f32x4*)(p.in[I_CDV] + src * 256 + lane * 4);
  f32x4 v_gk = *(const f32x4*)(p.in[I_CGK] + src * 128 + l31 * 4);
  f32x4 v_gv = *(const f32x4*)(p.in[I_CGV] + src * 128 + l31 * 4);
  f32x4 v_ckv = *(const f32x4*)(p.in[I_CCKV] + src * 128 + l31 * 4);
  f32x4 v_kr = *(const f32x4*)(p.in[I_CKR] + src * 32 + l7 * 4);
  (void)z4;
  *(u32x2*)((u16*)(p.ws + OFF_DKB) + (size_t)keyrow * 256 + lane * 4) = pack4(v_dk);
  {
    u16* vt = (u16*)(p.ws + OFF_DVT) + vt_off(32 + b, lane >> 4, 4) + (size_t)((lane & 15) * 4) * 1536 + jp;
#pragma unroll
    for (int i = 0; i < 4; ++i) vt[(size_t)i * 1536] = f2bf(v_dv[i]);
  }
  if (lane < 32) {
    *(u32x2*)((u16*)(p.ws + OFF_GKB) + (size_t)keyrow * 128 + lane * 4) = pack4(v_gk);
    u16* vt = (u16*)(p.ws + OFF_GVT) + vt_off(32 + b, lane >> 4, 2) + (size_t)((lane & 15) * 4) * 1536 + jp;
#pragma unroll
    for (int i = 0; i < 4; ++i) vt[(size_t)i * 1536] = f2bf(v_gv[i]);
    *(u32x2*)((u16*)(p.ws + OFF_CKVN) + (size_t)keyrow * 128 + lane * 4) = pack4(v_ckv);
  }
  if (lane < 8) {
    u32x2 pk = pack4(v_kr);
    u16* mk = (u16*)(p.ws + OFF_MKB) + (size_t)keyrow * 384 + 64 + lane * 4;
#pragma unroll
    for (int hd = 0; hd < 4; ++hd) *(u32x2*)(mk + hd * 96) = pk;
  }
}

DI void phase_pp(const P& p, int layer, char* smem) {
  const int tid_ = get_tid();
  const int lane = tid_ & 63, wave = tid_ >> 6;
  float* lds = (float*)smem + wave * (32 * 132);
  const int gw = blockIdx.x * NWV + wave, nw = gridDim.x * NWV;
  constexpr int N_SSM = 1152, N_ROWS = NT + 2048;
  for (int item = gw; item < N_SSM; item += nw) ssm_item(p, layer, item, lds, lane);
  const int rw0 = (nw > 256) ? 128 : 0;
  if (gw >= rw0) {
    for (int row = gw - rw0; row < N_ROWS; row += nw - rw0) {
      if (row < NT) pp_row(p, layer, row, lane);
      else pp_cached(p, layer, row - NT, lane);
    }
  }
}

template <int KW, int DK>
DI void attn_block(const u16* __restrict__ Kg, int ldk, const u16* __restrict__ Vt, int nk, const bf16x8 (&qf)[DK / 16], int kcol, char* smem,
                   int tid, f32x16 (&o)[2], float& lsum) {
  constexpr int KST = KW + 8, KS = DK / 16, KCH = KW / 8, KTOT = 64 * KCH, NKC = (KTOT + NTHR - 1) / NTHR;
  const int lane = tid & 63, l32 = lane & 31, hh = lane >> 5;
  u16* Ks = (u16*)smem;
  u16* Vs = Ks + 2 * 64 * KST;
  float m = -1e30f;
  lsum = 0.f;
#pragma unroll
  for (int db = 0; db < 2; ++db)
#pragma unroll
    for (int r = 0; r < 16; ++r) o[db][r] = 0.f;
  u32x4 rk[NKC], rv[1];
  const int nt = nk / 64;
#pragma unroll
  for (int i = 0; i < NKC; ++i) { int c = tid + NTHR * i, r = c / KCH, kc = (c % KCH) * 8; if (c < KTOT) rk[i] = *(const u32x4*)(Kg + (size_t)r * ldk + kc); }
  { int r = tid >> 3, kc = (tid & 7) * 8; rv[0] = *(const u32x4*)(Vt + (size_t)r * nk + kc); }
#pragma unroll
  for (int i = 0; i < NKC; ++i) { int c = tid + NTHR * i, r = c / KCH, kc = (c % KCH) * 8; if (c < KTOT) *(u32x4*)(Ks + r * KST + kc) = rk[i]; }
  { int r = tid >> 3, kc = (tid & 7) * 8; *(u32x4*)(Vs + r * 72 + kc) = rv[0]; }
  __syncthreads();
  for (int t = 0; t < nt; ++t) {
    const int buf = t & 1;
    const bool more = (t + 1 < nt);
    if (more) {
      const int kt = (t + 1) * 64;
#pragma unroll
      for (int i = 0; i < NKC; ++i) { int c = tid + NTHR * i, r = c / KCH, kc = (c % KCH) * 8; if (c < KTOT) rk[i] = *(const u32x4*)(Kg + (size_t)(kt + r) * ldk + kc); }
      { int r = tid >> 3, kc = (tid & 7) * 8; rv[0] = *(const u32x4*)(Vt + (size_t)r * nk + kt + kc); }
    }
    const u16* ks = Ks + buf * 64 * KST + l32 * KST + kcol + hh * 8;
    const u16* vs = Vs + buf * 64 * 72 + l32 * 72 + hh * 8;
    f32x16 sa[2];
#pragma unroll
    for (int kb = 0; kb < 2; ++kb) {
#pragma unroll
      for (int r = 0; r < 16; ++r) sa[kb][r] = 0.f;
#pragma unroll
      for (int s2 = 0; s2 < KS; ++s2) {
        bf16x8 kf = *(const bf16x8*)(ks + kb * 32 * KST + s2 * 16);
        sa[kb] = MFMA32(kf, qf[s2], sa[kb]);
      }
      __builtin_amdgcn_sched_barrier(0);
    }
    float mx = sa[0][0];
#pragma unroll
    for (int r = 1; r < 16; ++r) mx = fmaxf(mx, sa[0][r]);
#pragma unroll
    for (int r = 0; r < 16; ++r) mx = fmaxf(mx, sa[1][r]);
    mx = fmaxf(mx, __shfl_xor(mx, 32));
    const float mn = fmaxf(m, mx);
    const float alpha = fexp2(m - mn);
    m = mn;
    float ps = 0.f;
#pragma unroll
    for (int kb = 0; kb < 2; ++kb)
#pragma unroll
      for (int r = 0; r < 16; ++r) { float e = fexp2(sa[kb][r] - mn); sa[kb][r] = e; ps += e; }
    lsum = lsum * alpha + ps;
#pragma unroll
    for (int db = 0; db < 2; ++db)
#pragma unroll
      for (int r = 0; r < 16; ++r) o[db][r] *= alpha;
#pragma unroll
    for (int s2 = 0; s2 < 4; ++s2) {
      const int kb = s2 >> 1, rb = 8 * (s2 & 1);
      f32x4 p0 = {sa[kb][rb], sa[kb][rb + 1], sa[kb][rb + 2], sa[kb][rb + 3]};
      f32x4 p1 = {sa[kb][rb + 4], sa[kb][rb + 5], sa[kb][rb + 6], sa[kb][rb + 7]};
      bf16x8 pf = pack8(p0, p1);
      bf16x8 v0 = *(const bf16x8*)(vs + s2 * 16);
      bf16x8 v1 = *(const bf16x8*)(vs + 32 * 72 + s2 * 16);
      o[0] = MFMA32(v0, pf, o[0]);
      o[1] = MFMA32(v1, pf, o[1]);
      if (s2 == 1) __builtin_amdgcn_sched_barrier(0);
    }
    if (more) {
      const int nb = buf ^ 1;
#pragma unroll
      for (int i = 0; i < NKC; ++i) { int c = tid + NTHR * i, r = c / KCH, kc = (c % KCH) * 8; if (c < KTOT) *(u32x4*)(Ks + nb * 64 * KST + r * KST + kc) = rk[i]; }
      { int r = tid >> 3, kc = (tid & 7) * 8; *(u32x4*)(Vs + nb * 64 * 72 + r * 72 + kc) = rv[0]; }
    }
    __syncthreads();
  }
  lsum += __shfl_xor(lsum, 32);
}

DI void store_o(u16* dst  , const f32x16 (&o)[2], float scale, int hh) {
#pragma unroll
  for (int db = 0; db < 2; ++db)
#pragma unroll
    for (int j = 0; j < 4; ++j) {
      const int dv = db * 32 + 8 * j + 4 * hh;
      f32x4 v = {o[db][4 * j] * scale, o[db][4 * j + 1] * scale, o[db][4 * j + 2] * scale, o[db][4 * j + 3] * scale};
      *(u32x2*)(dst + dv) = pack4(v);
    }
}

DI void attn_item(const P& p, int layer, int item, char* smem, int tid) {
  const int lane = tid & 63, wave = tid >> 6, l32 = lane & 31, hh = lane >> 5;
  bool lat; int kind, b, hd, qblk;
  if (item < 256) {
    lat = true;
    if (item < 128) { kind = 0; b = item >> 5; hd = (item >> 3) & 3; qblk = item & 7; }
    else { int it = item - 128; kind = 1 + (it >> 6); it &= 63; b = it >> 4; hd = (it >> 2) & 3; qblk = it & 3; }
  } else {
    lat = false;
    int it = item - 256;
    if (it < 256) { kind = 0; b = it >> 3; hd = (it >> 1) & 3; qblk = it & 1; }
    else { it -= 256; kind = 1 + (it >> 7); it &= 127; b = it >> 2; hd = it & 3; qblk = 0; }
  }
  const int nk = lat ? 1536 : 256;
  const int b_all = lat ? 32 + b : b;
  const int keyrow0 = lat ? NCTX + b * 1536 : b * 256;
  const int tok0 = lat ? NCTX + b * 1024 : b * 256;
  f32x16 o[2]; float ls;
  if (kind == 0) {
    const int ns = wave & 1, qb = wave >> 1;
    const int q0 = tok0 + qblk * 128 + qb * 32;
    const u16* Q = (const u16*)(p.ws + OFF_DQ) + (size_t)(q0 + l32) * 256 + hd * 64 + ns * 32 + hh * 8;
    bf16x8 qf[2];
    qf[0] = *(const bf16x8*)Q; qf[1] = *(const bf16x8*)(Q + 16);
    attn_block<64, 32>((const u16*)(p.ws + OFF_DKB) + (size_t)keyrow0 * 256 + hd * 64, 256, (const u16*)(p.ws + OFF_DVT) + vt_off(b_all, hd, 4), nk, qf, ns * 32,
                       smem, tid, o, ls);
    float d1 = 0.f, d2 = 0.f;
    if (lane < 32) { d1 = p.in[I_LQ1][layer * 32 + lane] * p.in[I_LK1][layer * 32 + lane]; d2 = p.in[I_LQ2][layer * 32 + lane] * p.in[I_LK2][layer * 32 + lane]; }
    d1 = wave_sum(d1); d2 = wave_sum(d2);
    int ly_ = layer; asm volatile("" : "+s"(ly_));
    const float lam_init = ly_ == 0 ? 0.2f : (0.8f - 0.6f * 0.7408182206817179f);
    const float lam = expf(d1) - expf(d2) + lam_init;
    float* cmb = (float*)smem + qb * (64 * 33);
    if (ns == 1) {
      const float sc = lam / ls;
#pragma unroll
      for (int db = 0; db < 2; ++db)
#pragma unroll
        for (int r = 0; r < 16; ++r) cmb[(db * 32 + crow(r, hh)) * 33 + l32] = o[db][r] * sc;
    }
    __syncthreads();
    if (ns == 0) {
      const float i0 = 1.f / ls;
      float ss = 0.f;
#pragma unroll
      for (int db = 0; db < 2; ++db)
#pragma unroll
        for (int r = 0; r < 16; ++r) { float d = o[db][r] * i0 - cmb[(db * 32 + crow(r, hh)) * 33 + l32]; o[db][r] = d; ss += d * d; }
      ss += __shfl_xor(ss, 32);
      const float rr = rsqrtf(ss * (1.f / 64.f) + EPSF) * (1.f - lam_init);
      u16* dst = (u16*)(p.ws + OFF_MIXED) + (size_t)(q0 + l32) * 1024 + hd * 64;
#pragma unroll
      for (int db = 0; db < 2; ++db)
#pragma unroll
        for (int j = 0; j < 4; ++j) {
          const int dv = db * 32 + 8 * j + 4 * hh;
          f32x4 g = *(const f32x4*)(p.in[I_SUBLN] + layer * 64 + dv);
          f32x4 v = {o[db][4 * j] * rr * g[0], o[db][4 * j + 1] * rr * g[1], o[db][4 * j + 2] * rr * g[2], o[db][4 * j + 3] * rr * g[3]};
          *(u32x2*)(dst + dv) = pack4(v);
        }
    }
    __syncthreads();
  } else if (kind == 1) {
    const int q0 = tok0 + qblk * 256 + wave * 32;
    const u16* Q = (const u16*)(p.ws + OFF_GQ) + (size_t)(q0 + l32) * 256 + hd * 64 + hh * 8;
    bf16x8 qf[4];
#pragma unroll
    for (int s2 = 0; s2 < 4; ++s2) qf[s2] = *(const bf16x8*)(Q + s2 * 16);
    attn_block<64, 64>((const u16*)(p.ws + OFF_GKB) + (size_t)keyrow0 * 128 + (hd >> 1) * 64, 128, (const u16*)(p.ws + OFF_GVT) + vt_off(b_all, hd >> 1, 2), nk, qf, 0,
                       smem, tid, o, ls);
    store_o((u16*)(p.ws + OFF_MIXED) + (size_t)(q0 + l32) * 1024 + 256 + hd * 64, o, 1.f / ls, hh);
  } else {
    const int q0 = tok0 + qblk * 256 + wave * 32;
    const u16* Q = (const u16*)(p.ws + OFF_MQ) + (size_t)(q0 + l32) * 384 + hd * 96 + hh * 8;
    bf16x8 qf[6];
#pragma unroll
    for (int s2 = 0; s2 < 6; ++s2) qf[s2] = *(const bf16x8*)(Q + s2 * 16);
    attn_block<96, 96>((const u16*)(p.ws + OFF_MKB) + (size_t)keyrow0 * 384 + hd * 96, 384, (const u16*)(p.ws + OFF_MVT) + vt_off(b_all, hd, 4), nk, qf, 0,
                       smem, tid, o, ls);
    store_o((u16*)(p.ws + OFF_MIXED) + (size_t)(q0 + l32) * 1024 + 768 + hd * 64, o, 1.f / ls, hh);
  }
}

DI void phase_at(const P& p, int layer, char* smem) {
  EPI_IDX
  constexpr int N_ITEMS = 768;
  if (gridDim.x == 256) {
    const int b = blockIdx.x;
    attn_item(p, layer, b, smem, tid);
    __syncthreads();
    if (b < 128) {
      attn_item(p, layer, 256 + b, smem, tid); __syncthreads();
      attn_item(p, layer, 512 + b, smem, tid); __syncthreads();
      attn_item(p, layer, 640 + b, smem, tid); __syncthreads();
    } else if (b < 192) {
      attn_item(p, layer, 256 + 128 + 2 * (b - 128), smem, tid); __syncthreads();
      attn_item(p, layer, 256 + 128 + 2 * (b - 128) + 1, smem, tid); __syncthreads();
    }
  } else {
    for (int item = blockIdx.x; item < N_ITEMS; item += gridDim.x) {
      attn_item(p, layer, item, smem, tid);
      __syncthreads();
    }
  }
  {
    constexpr int T_GLU = (NT / 256) * 2;
    auto tile_at = [&](int t) { TD d; d.A = (const u16*)(p.ws + OFF_PROJ); d.lda = NP; d.B = (const u16*)(p.ws + OFF_WGLU) + (size_t)layer * 512 * 256; d.ldb = 256; d.k0 = 0; d.nk = 4; d.m0 = (t >> 1) * 256; d.n0 = (t & 1) * 256; return d; };
    int buf = 0;
    const int t0 = (int)gridDim.x - 1 - (int)blockIdx.x;
    TD cur = tile_at(t0 < T_GLU ? t0 : 0);
    if (t0 < T_GLU) stage_td(cur, 0, smem, tid);
    for (int t = t0; t < T_GLU; t += gridDim.x) {
      const bool has_next = (t + (int)gridDim.x < T_GLU);
      const TD nxt = tile_at(has_next ? t + (int)gridDim.x : t);
      const int m0 = cur.m0, n0 = cur.n0;
      f32x16 acc[4][2];
      gemm_stream(cur, has_next, nxt, smem, buf, acc);
      cur = nxt;
      u16* mixed = (u16*)(p.ws + OFF_MIXED);
      const int q = (n0 + wn * 64) >> 6;
#pragma unroll
      for (int bi = 0; bi < 4; ++bi) {
        const int rb = m0 + wm * 128 + bi * 32;
#pragma unroll
        for (int r = 0; r < 16; ++r) {
          float z = acc[bi][0][r], g = acc[bi][1][r];
          mixed[(size_t)(rb + crow(r, hh)) * 1024 + 512 + q * 32 + l32] = f2bf(z * fsigmoid(g));
        }
      }
    }
  }
}

#define XB_TMO      128
#define XB_XCNT(j)  (256  + 64 * (j))
#define XB_XSUB(j)  (1280 + 64 * (j))
#define XB_XGEN(j)  (2304 + 64 * (j))
#define XB_TOP      3328
#define XB_TOPGEN   3392
#define XCD_BAR_WORDS 3456
#define XB_SPIN_CAP (1u << 22)
#define LAS __attribute__((address_space(3)))
DI unsigned xb_ld(unsigned* p) { return __hip_atomic_load(p, __ATOMIC_RELAXED, __HIP_MEMORY_SCOPE_AGENT); }
DI unsigned xb_add(unsigned* p, unsigned v) { return __hip_atomic_fetch_add(p, v, __ATOMIC_RELAXED, __HIP_MEMORY_SCOPE_AGENT); }
DI unsigned xb_xcc_id() { return (unsigned)__builtin_amdgcn_s_getreg((3 << 11) | 20) & 0xFu; }
#define XB_SPIN(cond, bar) do { unsigned _sp = 0; while (cond) { __builtin_amdgcn_s_sleep(1); \
    if ((++_sp & 255u) == 0u) { if (xb_ld(&(bar)[XB_TMO])) break; if (_sp > XB_SPIN_CAP) { atomicAdd(&(bar)[XB_TMO], 1u); break; } } } } while (0)
struct XcdBarrier { unsigned* bar; unsigned x; volatile LAS unsigned* st; };
DI XcdBarrier xcd_barrier_post(unsigned* bar, volatile LAS unsigned* st) {
  XcdBarrier b; b.bar = bar; b.x = xb_xcc_id(); b.st = st;
  if (threadIdx.x == 0) st[2] = xb_add(&bar[XB_XCNT(b.x)], 1u);
  return b;
}
DI void xcd_barrier_complete(unsigned* bar, unsigned x, unsigned& nloc, unsigned& nx) {
  const unsigned G = gridDim.x * gridDim.y * gridDim.z;
  unsigned sum, cnt, mine, sp = 0u;
  for (;;) {
    sum = 0u; cnt = 0u; mine = 0u;
#pragma unroll
    for (unsigned j = 0; j < 16; ++j) { const unsigned c = xb_ld(&bar[XB_XCNT(j)]); sum += c; cnt += (c > 0u) ? 1u : 0u; mine = (j == x) ? c : mine; }
    if (sum == G) break;
    __builtin_amdgcn_s_sleep(1);
    if ((++sp & 255u) == 0u) { if (xb_ld(&bar[XB_TMO])) break; if (sp > XB_SPIN_CAP) { atomicAdd(&bar[XB_TMO], 1u); break; } }
  }
  nloc = mine > 0u ? mine : 1u; nx = cnt > 0u ? cnt : 1u;
}
DI void xcd_barrier(const XcdBarrier& b) {
  asm volatile("s_waitcnt vmcnt(0)" ::: "memory");
  __syncthreads();
  if (threadIdx.x == 0) {
    unsigned* bar = b.bar;
    __builtin_amdgcn_s_waitcnt(0);
    unsigned nloc = b.st[0], nx = b.st[1];
    if (nloc == 0u) { xcd_barrier_complete(bar, b.x, nloc, nx); b.st[0] = nloc; b.st[1] = nx; }
    const unsigned old = xb_add(&bar[XB_XSUB(b.x)], 1u);
    const unsigned gen = old / nloc;
    if (old + 1u == (gen + 1u) * nloc) {
      __builtin_amdgcn_fence(__ATOMIC_RELEASE, "agent");
      asm volatile("s_waitcnt vmcnt(0)" ::: "memory");
      const unsigned og = xb_add(&bar[XB_TOP], 1u);
      const unsigned tg = og / nx;
      if (og + 1u == (tg + 1u) * nx) xb_add(&bar[XB_TOPGEN], 1u);
      else XB_SPIN(xb_ld(&bar[XB_TOPGEN]) == tg, bar);
      __builtin_amdgcn_fence(__ATOMIC_ACQUIRE, "agent");
      xb_add(&bar[XB_XGEN(b.x)], 1u);
      asm volatile("s_waitcnt vmcnt(0)" ::: "memory");
    } else {
      XB_SPIN(xb_ld(&bar[XB_XGEN(b.x)]) == gen, bar);
      __builtin_amdgcn_fence(__ATOMIC_ACQUIRE, "agent");
      asm volatile("s_waitcnt vmcnt(0)" ::: "memory");
    }
  }
  __syncthreads();
}

DI void run_phase(const P& p_, int ph, int layer, char* smem) {
  P p = p_;
  size_t zoff = 0;
  asm volatile("" : "+s"(zoff));
  p.ws = p_.ws + zoff;
  p.out = p_.out + zoff;
  switch (ph) {
    case 0: prologue(p, smem); break;
    case 1: norm_phase(p, layer, 0); break;
    case 2: phase_g1(p, layer, smem); break;
    case 3: phase_pp(p, layer, smem); break;
    case 4: phase_g2(p, layer, smem); break;
    case 5: phase_at(p, layer, smem); break;
    case 6: phase_resid(p, layer, smem, true); break;
    case 7: norm_phase(p, layer, 1); break;
    case 8: phase_g5(p, layer, smem); break;
    case 9: phase_resid(p, layer, smem, false); break;
    case 10: norm_phase(p, 0, 2); break;
  }
}

extern __shared__ __attribute__((aligned(16))) char dyn_smem[];

__global__ void __launch_bounds__(512) fwd_mega(P p) {
  if (p.ws == nullptr) { cg::grid_group grid = cg::this_grid(); grid.sync(); }
  volatile LAS unsigned* st = (volatile LAS unsigned*)(dyn_smem + LDS_BYTES);
  if (threadIdx.x == 0) { st[0] = 0u; st[1] = 0u; st[2] = 0u; st[3] = 0u; }
  __syncthreads();
  XcdBarrier xb = xcd_barrier_post((unsigned*)(p.ws + OFF_BAR), st);
  run_phase(p, 0, 0, dyn_smem);
  xcd_barrier(xb);
  if (threadIdx.x == 0) {
    unsigned* bar = (unsigned*)(p.ws + OFF_BAR);
    bool ok = (gridDim.x & 7u) == 0u;
    for (unsigned j = 0; j < 16; ++j) { const unsigned c = xb_ld(&bar[XB_XCNT(j)]); ok = ok && (c == (j < 8 ? gridDim.x >> 3 : 0u)); }
    if (ok) st[3] = xb.x; else { st[2] = blockIdx.x >> 3; st[3] = blockIdx.x & 7u; }
  }
  __syncthreads();
  for (int l = 0; l < 2; ++l) {
    for (int ph = 1; ph <= 9; ++ph) {
      run_phase(p, ph, l, dyn_smem);
      xcd_barrier(xb);
    }
  }
  run_phase(p, 10, 0, dyn_smem);
}

#if !MEGA
__global__ void __launch_bounds__(512) fwd_phase(P p, int ph, int layer) { run_phase(p, ph, layer, dyn_smem); }
#endif

extern "C" void kernel_launch(void* const* d_in, const int* in_sizes, int n_in, void* d_out, int out_size, void* d_ws, size_t ws_size,
                              hipStream_t stream) {
  static int grid_blocks = 0;
  if (!grid_blocks) {
    int dev = 0, cus = 0, per_cu = 0;
    (void)hipGetDevice(&dev);
    (void)hipDeviceGetAttribute(&cus, hipDeviceAttributeMultiprocessorCount, dev);
    (void)hipFuncSetAttribute((const void*)fwd_mega, hipFuncAttributeMaxDynamicSharedMemorySize, LDS_BYTES + 16);
#if !MEGA
    (void)hipFuncSetAttribute((const void*)fwd_phase, hipFuncAttributeMaxDynamicSharedMemorySize, LDS_BYTES);
#endif
    (void)hipOccupancyMaxActiveBlocksPerMultiprocessor(&per_cu, (const void*)fwd_mega, NTHR, LDS_BYTES + 16);
    if (per_cu < 1) per_cu = 1;
    if (per_cu > 1) per_cu = 1;
    grid_blocks = cus * per_cu;
    if (ws_size < WS_NEED) fprintf(stderr, "kernel_launch: workspace too small: %zu < %zu\n", ws_size, (size_t)WS_NEED);
  }
  P p{};
  for (int i = 0; i < N_IN; ++i) p.in[i] = (const float*)d_in[i];
  p.out = (float*)d_out;
  p.ws = (char*)d_ws;
#if MEGA
  (void)hipMemsetAsync((char*)d_ws + OFF_BAR, 0, XCD_BAR_WORDS * 4, stream);
  void* args[] = {&p};
  hipError_t e = hipLaunchCooperativeKernel((const void*)fwd_mega, dim3(grid_blocks), dim3(NTHR), args, LDS_BYTES + 16, stream);
  if (e != hipSuccess) fprintf(stderr, "cooperative launch failed: %s (grid %d)\n", hipGetErrorString(e), grid_blocks);
#else
  hipLaunchKernelGGL(fwd_phase, dim3(grid_blocks), dim3(NTHR), LDS_BYTES, stream, p, 0, 0);
  for (int l = 0; l < 2; ++l)
    for (int ph = 1; ph <= 9; ++ph) hipLaunchKernelGGL(fwd_phase, dim3(grid_blocks), dim3(NTHR), LDS_BYTES, stream, p, ph, l);
  hipLaunchKernelGGL(fwd_phase, dim3(grid_blocks), dim3(NTHR), LDS_BYTES, stream, p, 10, 0);
#endif
}
```

```cpp
#include <hip/hip_runtime.h>
#include <hip/hip_cooperative_groups.h>
#include <cstdio>
namespace cg = cooperative_groups;

#ifndef MEGA
#define MEGA 1
#endif

#define DI __device__ __forceinline__
typedef unsigned short u16;
typedef __attribute__((ext_vector_type(8))) short bf16x8;
typedef __attribute__((ext_vector_type(4))) short bf16x4;
typedef __attribute__((ext_vector_type(2))) __bf16 bf2_t;
typedef __attribute__((ext_vector_type(2))) float f32x2;
typedef __attribute__((ext_vector_type(4))) float f32x4;
typedef __attribute__((ext_vector_type(16))) float f32x16;
typedef __attribute__((ext_vector_type(4))) unsigned u32x4;
typedef __attribute__((ext_vector_type(2))) unsigned u32x2;

#define MFMA32(a, b, c) __builtin_amdgcn_mfma_f32_32x32x16_bf16((a), (b), (c), 0, 0, 0)
#define MFMA16(a, b, c) __builtin_amdgcn_mfma_f32_16x16x32_bf16((a), (b), (c), 0, 0, 0)

constexpr int NT = 12288;
constexpr int NCTX = 8192;
constexpr int NKR = 14336;
constexpr int NP = 1920;
constexpr float EPSF = 1e-6f;
constexpr float LOG2E = 1.4426950408889634f;

enum { I_XP = 0, I_XS, I_CDK, I_CDV, I_CGK, I_CGV, I_CCKV, I_CKR, I_SRE, I_SIM, I_C, I_CCTX, I_N1G, I_N2G, I_WADA, I_BADA,
       I_WIN, I_WOUT, I_LQ1, I_LK1, I_LQ2, I_LK2, I_SUBLN, I_QNG, I_KNG, I_ARE, I_AIM, I_LOGDT, I_BRE, I_BIM, I_CRE, I_CIM,
       I_SSMD, I_WGLU, I_MQNG, I_MKVNG, I_WUQ, I_WUKV, I_W1, I_W2, I_FNG, N_IN };

constexpr size_t O_Y = 0;
constexpr size_t O_DK = 12582912;
constexpr size_t O_DV = 16777216;
constexpr size_t O_GK = 20971520;
constexpr size_t O_GV = 23068672;
constexpr size_t O_CKV = 25165824;
constexpr size_t O_KR = 27262976;
constexpr size_t O_SRE = 27787264;
constexpr size_t O_SIM = 27918336;

constexpr size_t al256(size_t x) { return (x + 255) & ~(size_t)255; }
constexpr size_t OFF_MOD = 0;
constexpr size_t OFF_CTR = al256(OFF_MOD + 2 * 5 * 6144 * 4);
constexpr size_t OFF_BAR = al256(OFF_CTR + 256);
constexpr size_t OFF_ROPE = al256(OFF_BAR + 3456 * 4);
constexpr size_t OFF_ABAR = al256(OFF_ROPE + 2 * 64 * 16 * 8);
constexpr size_t OFF_ATAB = al256(OFF_ABAR + 64 * 64 * 8);
constexpr size_t OFF_CTAB = al256(OFF_ATAB + 64 * 128 * 16 * 2);
constexpr size_t OFF_WIN = al256(OFF_CTAB + 64 * 16 * 128 * 2);
constexpr size_t OFF_WOUT = al256(OFF_WIN + (size_t)2 * 1920 * 1024 * 2);
constexpr size_t OFF_W1 = al256(OFF_WOUT + (size_t)2 * 1024 * 1024 * 2);
constexpr size_t OFF_W2 = al256(OFF_W1 + (size_t)2 * 4096 * 1024 * 2);
constexpr size_t OFF_WUQ = al256(OFF_W2 + (size_t)2 * 4096 * 1024 * 2);
constexpr size_t OFF_WUKV = al256(OFF_WUQ + (size_t)2 * 384 * 192 * 2);
constexpr size_t OFF_WGLU = al256(OFF_WUKV + (size_t)2 * 512 * 128 * 2);
constexpr size_t OFF_H = al256(OFF_WGLU + (size_t)2 * 512 * 256 * 2);
constexpr size_t OFF_MIXED = OFF_H;
constexpr size_t OFF_BIG = al256(OFF_H + (size_t)NT * 1024 * 2);
constexpr size_t OFF_PROJ = OFF_BIG;
constexpr size_t OFF_DQ = al256(OFF_PROJ + (size_t)NT * NP * 4);
constexpr size_t OFF_DKB = al256(OFF_DQ + (size_t)NT * 256 * 2);
constexpr size_t OFF_DVT = al256(OFF_DKB + (size_t)NKR * 256 * 2);
constexpr size_t OFF_GQ = al256(OFF_DVT + (size_t)NKR * 256 * 2);
constexpr size_t OFF_GKB = al256(OFF_GQ + (size_t)NT * 256 * 2);
constexpr size_t OFF_GVT = al256(OFF_GKB + (size_t)NKR * 128 * 2);
constexpr size_t OFF_MQ = al256(OFF_GVT + (size_t)NKR * 128 * 2);
constexpr size_t OFF_MKB = al256(OFF_MQ + (size_t)NT * 384 * 2);
constexpr size_t OFF_MVT = al256(OFF_MKB + (size_t)NKR * 384 * 2);
constexpr size_t OFF_CQN = al256(OFF_MVT + (size_t)NKR * 256 * 2);
constexpr size_t OFF_CKVN = al256(OFF_CQN + (size_t)NT * 192 * 2);
constexpr size_t OFF_YBUF = al256(OFF_CKVN + (size_t)NKR * 128 * 2);
constexpr size_t OFF_END1 = al256(OFF_YBUF + (size_t)2 * NT * 256 * 4);
constexpr size_t OFF_A = OFF_BIG;
constexpr size_t OFF_END2 = al256(OFF_A + (size_t)NT * 4096 * 2);
constexpr size_t WS_NEED = OFF_END1 > OFF_END2 ? OFF_END1 : OFF_END2;
static_assert(WS_NEED <= (size_t)256 * 1024 * 1024, "workspace over 256 MiB");

constexpr int NTHR = 512;
constexpr int NWV = NTHR / 64;
constexpr int LDS_BYTES = 8 * 32 * 132 * 4;

struct P {
  const float* in[N_IN];
  float* out;
  char* ws;
};

DI unsigned pack2(float a, float b) { f32x2 v = {a, b}; return __builtin_bit_cast(unsigned, __builtin_convertvector(v, bf2_t)); }
DI u16 f2bf(float a) { return (u16)(pack2(a, 0.f) & 0xffffu); }
DI bf16x8 pack8(f32x4 a, f32x4 b) {
  u32x4 r = {pack2(a[0], a[1]), pack2(a[2], a[3]), pack2(b[0], b[1]), pack2(b[2], b[3])};
  return __builtin_bit_cast(bf16x8, r);
}
DI f32x4 ld4bf(const u16* p) {
  const u32x2 w = *(const u32x2*)p;
  f32x4 r = {__uint_as_float(w[0] << 16), __uint_as_float(w[0] & 0xffff0000u), __uint_as_float(w[1] << 16), __uint_as_float(w[1] & 0xffff0000u)};
  return r;
}
DI u32x2 pack4(f32x4 a) { u32x2 r = {pack2(a[0], a[1]), pack2(a[2], a[3])}; return r; }
DI int get_tid() { int t = threadIdx.x; asm volatile("" : "+v"(t)); return t; }
DI float fexp2(float x) { return __builtin_amdgcn_exp2f(x); }
DI float frcp(float x) { return __builtin_amdgcn_rcpf(x); }
DI float fsigmoid(float w) { return frcp(1.f + fexp2(-w * LOG2E)); }
DI float gelu_tanh(float x) { return x * fsigmoid(1.5957691216057308f * (x + 0.044715f * x * x * x)); }
DI float wave_sum(float v) {
#pragma unroll
  for (int o = 32; o >= 1; o >>= 1) v += __shfl_xor(v, o);
  return v;
}
DI void wave_lds_fence() {
  asm volatile("s_waitcnt lgkmcnt(0)" ::: "memory");
  __builtin_amdgcn_wave_barrier();
}
DI int fetch_item(int* ctr, int lane) {
  int v = 0;
  if (lane == 0) v = atomicAdd(ctr, 1);
  return __builtin_amdgcn_readfirstlane(v);
}
DI size_t vt_off(int b_all, int head, int H) {
  if (b_all < 32) return ((size_t)(b_all * H + head) * 64) * 256;
  return (size_t)32 * H * 64 * 256 + ((size_t)((b_all - 32) * H + head) * 64) * 1536;
}
DI int mod_index(int row) { return row < NCTX ? 0 : 1 + ((row - NCTX) >> 10); }

DI void prologue(const P& p, char* smem) {
  const int tid = get_tid();
  float* fs = (float*)smem;
  constexpr int N_ADA = 384, N_TAB = 64, N_MISC = 1, N_TR = 5700;
  constexpr int TOTAL = N_ADA + N_TAB + N_MISC;
  for (int it = blockIdx.x; it < TOTAL; it += gridDim.x) {
    if (it < N_ADA) {
      const int l = it / 192, ch = it % 192;
      float* sc = fs;
      float* red = fs + 5 * 1024;
      for (int i = tid; i < 5 * 1024; i += NTHR) {
        int m = i >> 10, k = i & 1023;
        float c = (m == 0) ? p.in[I_CCTX][k] : p.in[I_C][(m - 1) * 1024 + k];
        sc[i] = c * fsigmoid(c);
      }
      __syncthreads();
      const int col = tid & 31, kg = tid >> 5;
      const float* w = p.in[I_WADA] + ((size_t)l * 1024 + kg * 64) * 6144 + ch * 32 + col;
      float a0 = 0, a1 = 0, a2 = 0, a3 = 0, a4 = 0;
#pragma unroll 16
      for (int k = 0; k < 64; ++k) {
        float wv = w[(size_t)k * 6144];
        int kk = kg * 64 + k;
        a0 += sc[kk] * wv; a1 += sc[1024 + kk] * wv; a2 += sc[2048 + kk] * wv; a3 += sc[3072 + kk] * wv; a4 += sc[4096 + kk] * wv;
      }
      red[(kg * 5 + 0) * 32 + col] = a0; red[(kg * 5 + 1) * 32 + col] = a1; red[(kg * 5 + 2) * 32 + col] = a2;
      red[(kg * 5 + 3) * 32 + col] = a3; red[(kg * 5 + 4) * 32 + col] = a4;
      __syncthreads();
      if (tid < 160) {
        int m = tid >> 5, c2 = tid & 31;
        float s = 0;
#pragma unroll
        for (int g = 0; g < 16; ++g) s += red[(g * 5 + m) * 32 + c2];
        int n = ch * 32 + c2;
        s += p.in[I_BADA][l * 6144 + n];
        ((float*)(p.ws + OFF_MOD))[((size_t)l * 5 + m) * 6144 + n] = s;
      }
      __syncthreads();
    } else if (it < N_ADA + N_TAB) {
      const int idx = it - N_ADA;
      if (tid < 64) {
        const int pp = tid;
        float are = p.in[I_ARE][idx * 64 + pp], aim = p.in[I_AIM][idx * 64 + pp];
        float dt = expf(p.in[I_LOGDT][idx]);
        float zr = are * dt, zi = aim * dt;
        float e = expf(zr);
        float abr = e * cosf(zi), abi = e * sinf(zi);
        float d2 = are * are + aim * aim;
        float nr = abr - 1.f, ni = abi;
        float qr = (nr * are + ni * aim) / d2, qi = (ni * are - nr * aim) / d2;
        u16* at = (u16*)(p.ws + OFF_ATAB) + (size_t)idx * 128 * 16;
        u16* ct = (u16*)(p.ws + OFF_CTAB) + (size_t)idx * 16 * 128;
        for (int c = 0; c < 16; ++c) {
          float bre = p.in[I_BRE][((size_t)idx * 64 + pp) * 16 + c], bim = p.in[I_BIM][((size_t)idx * 64 + pp) * 16 + c];
          at[(2 * pp) * 16 + c] = f2bf(qr * bre - qi * bim);
          at[(2 * pp + 1) * 16 + c] = f2bf(qr * bim + qi * bre);
          float cre = p.in[I_CRE][((size_t)idx * 16 + c) * 64 + pp], cim = p.in[I_CIM][((size_t)idx * 16 + c) * 64 + pp];
          ct[c * 128 + 2 * pp] = f2bf(cre);
          ct[c * 128 + 2 * pp + 1] = f2bf(-cim);
        }
        float* ab = (float*)(p.ws + OFF_ABAR) + ((size_t)idx * 64 + pp) * 2;
        ab[0] = abr; ab[1] = abi;
      }
    } else if (it < N_ADA + N_TAB + N_MISC) {
      f32x2* tab = (f32x2*)(p.ws + OFF_ROPE);
      for (int i = tid; i < 2 * 64 * 16; i += NTHR) {
        int kind = i >> 10, pos = (i >> 4) & 63, fi = i & 15;
        int n = kind ? 16 : 8;
        float freq = expf(-(float)(fi % n) / (float)n * 9.210340371976184f);
        float ang = (float)pos * freq;
        f32x2 cs = {cosf(ang), sinf(ang)};
        tab[i] = cs;
      }
      if (tid < 64) ((int*)(p.ws + OFF_CTR))[tid] = 0;
    }
  }
  struct TrD { const float* src; u16* dst; int K, N, k0, n0; bool glu; };
  auto decode = [&](int tt) {
    TrD d; d.glu = false;
    const int l = tt / 2850;
    int r = tt % 2850; int kt, nt;
    if (r < 480) { d.src = p.in[I_WIN] + (size_t)l * 1024 * 1888; d.dst = (u16*)(p.ws + OFF_WIN) + (size_t)l * 1920 * 1024; d.K = 1024; d.N = 1888; kt = r / 30; nt = r % 30; }
    else if (r < 736) { r -= 480; d.src = p.in[I_WOUT] + (size_t)l * 1024 * 1024; d.dst = (u16*)(p.ws + OFF_WOUT) + (size_t)l * 1024 * 1024; d.K = 1024; d.N = 1024; kt = r / 16; nt = r % 16; }
    else if (r < 1760) { r -= 736; d.src = p.in[I_W1] + (size_t)l * 1024 * 4096; d.dst = (u16*)(p.ws + OFF_W1) + (size_t)l * 4096 * 1024; d.K = 1024; d.N = 4096; kt = r / 64; nt = r % 64; }
    else if (r < 2784) { r -= 1760; d.src = p.in[I_W2] + (size_t)l * 4096 * 1024; d.dst = (u16*)(p.ws + OFF_W2) + (size_t)l * 1024 * 4096; d.K = 4096; d.N = 1024; kt = r / 16; nt = r % 16; }
    else if (r < 2802) { r -= 2784; d.src = p.in[I_WUQ] + (size_t)l * 192 * 384; d.dst = (u16*)(p.ws + OFF_WUQ) + (size_t)l * 384 * 192; d.K = 192; d.N = 384; kt = r / 6; nt = r % 6; }
    else if (r < 2818) { r -= 2802; d.src = p.in[I_WUKV] + (size_t)l * 128 * 512; d.dst = (u16*)(p.ws + OFF_WUKV) + (size_t)l * 512 * 128; d.K = 128; d.N = 512; kt = r / 8; nt = r % 8; }
    else { r -= 2818; d.src = p.in[I_WGLU] + (size_t)l * 256 * 512; d.dst = (u16*)(p.ws + OFF_WGLU) + (size_t)l * 512 * 256; d.K = 256; d.N = 512; kt = r / 8; nt = r % 8; d.glu = true; }
    d.k0 = kt * 64; d.n0 = nt * 64;
    return d;
  };
  const int half = tid >> 8, t2 = tid & 255;
  float* ft = fs + half * (64 * 65);
  const int tx = t2 & 15, ty = t2 >> 4;
  auto tload = [&](const TrD& d, f32x4 (&v)[4]) {
#pragma unroll
    for (int i = 0; i < 4; ++i) {
      const int kk = ty + 16 * i, n = d.n0 + 4 * tx;
      f32x4 z = {0.f, 0.f, 0.f, 0.f};
      v[i] = (n < d.N) ? *(const f32x4*)(d.src + (size_t)(d.k0 + kk) * d.N + n) : z;
    }
  };
  const int nvb = 2 * (int)gridDim.x;
  const int tb = nvb - 1 - (2 * (int)blockIdx.x + half);
  const int nrounds = (N_TR + nvb - 1) / nvb;
  TrD cur = decode(tb < N_TR ? tb : 0);
  f32x4 cv[4];
  if (tb < N_TR) tload(cur, cv);
  for (int j = 0; j < nrounds; ++j) {
    const int tt = tb + j * nvb;
    const bool valid = tt < N_TR, more = tt + nvb < N_TR;
    TrD nxt = decode(more ? tt + nvb : 0);
    f32x4 nv[4];
    if (more) tload(nxt, nv);
    if (valid) {
#pragma unroll
      for (int i = 0; i < 4; ++i) {
        const int kk = ty + 16 * i;
        ft[kk * 65 + 4 * tx + 0] = cv[i][0]; ft[kk * 65 + 4 * tx + 1] = cv[i][1]; ft[kk * 65 + 4 * tx + 2] = cv[i][2]; ft[kk * 65 + 4 * tx + 3] = cv[i][3];
      }
    }
    __syncthreads();
    if (valid) {
#pragma unroll
      for (int i = 0; i < 2; ++i) {
        const int c = t2 + 256 * i, nn = c >> 3, kc = (c & 7) * 8;
        f32x4 a, b;
#pragma unroll
        for (int e = 0; e < 4; ++e) { a[e] = ft[(kc + e) * 65 + nn]; b[e] = ft[(kc + 4 + e) * 65 + nn]; }
        const int n = cur.n0 + nn;
        int drow = n;
        if (cur.glu) drow = (n < 256) ? ((n >> 5) * 64 + (n & 31)) : (((n - 256) >> 5) * 64 + 32 + (n & 31));
        *(bf16x8*)(cur.dst + (size_t)drow * cur.K + cur.k0 + kc) = pack8(a, b);
      }
    }
    __syncthreads();
    cur = nxt;
    if (more) {
#pragma unroll
      for (int i = 0; i < 4; ++i) cv[i] = nv[i];
    }
  }
}

DI const float* x_row_src(const P& p, int layer, int row) {
  if (layer == 0) return row < NCTX ? p.in[I_XP] + (size_t)row * 1024 : p.in[I_XS] + (size_t)(row - NCTX) * 1024;
  return p.out + (size_t)row * 1024;
}
DI void norm_phase(const P& p, int layer, int which) {
  const int tid_ = get_tid();
  const int lane = tid_ & 63;
  const int gw = blockIdx.x * NWV + (tid_ >> 6), nw = gridDim.x * NWV;
  auto src_of = [&](int row) { return (which == 0) ? x_row_src(p, layer, row) : (const float*)(p.out + (size_t)row * 1024); };
  f32x4 v[4];
  if (gw < NT) {
    const float* xs = src_of(gw);
#pragma unroll
    for (int i = 0; i < 4; ++i) v[i] = *(const f32x4*)(xs + (i * 64 + lane) * 4);
  }
  for (int row = gw; row < NT; row += nw) {
    f32x4 nv[4];
    const bool more = row + nw < NT;
    if (more) {
      const float* xs = src_of(row + nw);
#pragma unroll
      for (int i = 0; i < 4; ++i) nv[i] = *(const f32x4*)(xs + (i * 64 + lane) * 4);
    }
    float ss = 0;
#pragma unroll
    for (int i = 0; i < 4; ++i) ss += v[i][0] * v[i][0] + v[i][1] * v[i][1] + v[i][2] * v[i][2] + v[i][3] * v[i][3];
    ss = wave_sum(ss);
    const float r = rsqrtf(ss * (1.f / 1024.f) + EPSF);
    if (which == 2) {
      f32x4 g[4];
#pragma unroll
      for (int i = 0; i < 4; ++i) g[i] = *(const f32x4*)(p.in[I_FNG] + (i * 64 + lane) * 4);
#pragma unroll
      for (int i = 0; i < 4; ++i) {
        int e = (i * 64 + lane) * 4;
        f32x4 o = v[i] * r * g[i];
        *(f32x4*)(p.out + (size_t)row * 1024 + e) = o;
      }
    } else {
      const float* gn = p.in[which == 0 ? I_N1G : I_N2G] + layer * 1024;
      const float* md = (const float*)(p.ws + OFF_MOD) + ((size_t)layer * 5 + mod_index(row)) * 6144 + (which == 0 ? 0 : 3072);
      u16* h = (u16*)(p.ws + OFF_H) + (size_t)row * 1024;
      f32x4 g[4], sh[4], sc[4];
#pragma unroll
      for (int i = 0; i < 4; ++i) {
        int e = (i * 64 + lane) * 4;
        g[i] = *(const f32x4*)(gn + e);
        sh[i] = *(const f32x4*)(md + e);
        sc[i] = *(const f32x4*)(md + 1024 + e);
      }
      if (which == 0 && layer == 0) {
#pragma unroll
        for (int i = 0; i < 4; ++i) *(f32x4*)(p.out + (size_t)row * 1024 + (i * 64 + lane) * 4) = v[i];
      }
#pragma unroll
      for (int i = 0; i < 4; ++i) {
        int e = (i * 64 + lane) * 4;
        f32x4 o = v[i] * r * g[i] * (1.f + sc[i]) + sh[i];
        *(u32x2*)(h + e) = pack4(o);
      }
    }
    if (more) {
#pragma unroll
      for (int i = 0; i < 4; ++i) v[i] = nv[i];
    }
  }
}

#define LAS3 __attribute__((address_space(3)))
DI void stage_tile_dma(const u16* __restrict__ G, int ld, int row0, int k0, char* lds, int tid) {
#pragma unroll
  for (int i = 0; i < 4; ++i) {
    const int q = tid + NTHR * i, r = q >> 3, c = (q & 7) ^ ((r >> 1) & 7);
    __builtin_amdgcn_global_load_lds((const unsigned*)(G + (size_t)(row0 + r) * ld + k0 + c * 8), (LAS3 unsigned*)(lds + q * 16), 16, 0, 0);
  }
}
struct TD { const u16* A; const u16* B; int lda, ldb, k0, nk, m0, n0; };
DI void stage_td(const TD& d, int kt, char* stage_base, int tid) {
  stage_tile_dma(d.A, d.lda, d.m0, d.k0 + kt * 64, stage_base, tid);
  stage_tile_dma(d.B, d.ldb, d.n0, d.k0 + kt * 64, stage_base + 32768, tid);
}
DI void gemm_stream(const TD& cur, bool has_next, const TD& nxt, char* smem, int& buf, f32x16 (&acc)[4][2]) {
  const int tid = get_tid(), lane = tid & 63, wave = tid >> 6, wm = wave >> 2, wn = wave & 3, l32 = lane & 31, hh = lane >> 5;
#pragma unroll
  for (int bi = 0; bi < 4; ++bi)
#pragma unroll
    for (int bj = 0; bj < 2; ++bj)
#pragma unroll
      for (int r = 0; r < 16; ++r) acc[bi][bj][r] = 0.f;
  const int swz = (l32 >> 1) & 7;
  const int arow = (wm * 128 + l32) * 128, brow = (wn * 64 + l32) * 128;
  const int c0 = ((0 + hh) ^ swz) * 16, c1 = ((2 + hh) ^ swz) * 16, c2 = ((4 + hh) ^ swz) * 16, c3 = ((6 + hh) ^ swz) * 16;
  asm volatile("s_waitcnt vmcnt(0)" ::: "memory");
  __syncthreads();
  const int nk = cur.nk;
  for (int kt = 0; kt < nk; ++kt) {
    const bool early = wave < 4;
    if (early) {
      if (kt + 1 < nk) stage_td(cur, kt + 1, smem + (buf ^ 1) * 65536, tid);
      else if (has_next) stage_td(nxt, 0, smem + (buf ^ 1) * 65536, tid);
    }
    const char* as = smem + buf * 65536 + arow;
    const char* bs = smem + buf * 65536 + 32768 + brow;
#pragma unroll
    for (int ks = 0; ks < 4; ++ks) {
      const int co = (ks == 0) ? c0 : (ks == 1) ? c1 : (ks == 2) ? c2 : c3;
      bf16x8 fa[4], fb[2];
#pragma unroll
      for (int bi = 0; bi < 4; ++bi) fa[bi] = *(const bf16x8*)(as + bi * 4096 + co);
#pragma unroll
      for (int bj = 0; bj < 2; ++bj) fb[bj] = *(const bf16x8*)(bs + bj * 4096 + co);
      __builtin_amdgcn_s_setprio(1);
#pragma unroll
      for (int bi = 0; bi < 4; ++bi)
#pragma unroll
        for (int bj = 0; bj < 2; ++bj) acc[bi][bj] = MFMA32(fa[bi], fb[bj], acc[bi][bj]);
      __builtin_amdgcn_s_setprio(0);
      if (ks == 1 && !early) {
        if (kt + 1 < nk) stage_td(cur, kt + 1, smem + (buf ^ 1) * 65536, tid);
        else if (has_next) stage_td(nxt, 0, smem + (buf ^ 1) * 65536, tid);
      }
    }
    buf ^= 1;
    if (kt + 1 < nk) {
      asm volatile("s_waitcnt vmcnt(0)" ::: "memory");
      __syncthreads();
    }
  }
}

#if MEGA
#define XCD_ID()   ((int)((volatile int*)(smem + LDS_BYTES))[3])
#define XCD_RANK() ((int)((volatile int*)(smem + LDS_BYTES))[2])
#else
#define XCD_ID()   ((int)(blockIdx.x & 7))
#define XCD_RANK() ((int)(blockIdx.x >> 3))
#endif
#define EPI_IDX                                                                                        \
  const int tid = get_tid(), lane = tid & 63, wave = tid >> 6, wm = wave >> 2, wn = wave & 3, l32 = lane & 31, hh = lane >> 5; \
  (void)tid; (void)lane; (void)wave; (void)wm; (void)wn; (void)l32; (void)hh;
DI int crow(int r, int hh) { return (r & 3) + 8 * (r >> 2) + 4 * hh; }

DI void phase_g1(const P& p, int layer, char* smem) {
  EPI_IDX
  const u16* A = (const u16*)(p.ws + OFF_H);
  const u16* Bt = (const u16*)(p.ws + OFF_WIN) + (size_t)layer * 1920 * 1024;
  u16* proj = (u16*)(p.ws + OFF_PROJ);
  constexpr int MT = NT / 256, NTL = 8, MPX = MT / 8;
  const int xcd_ = XCD_ID(), xj_ = XCD_RANK(), xn_ = gridDim.x >> 3;
  auto tile_at = [&](int u) { TD d; d.A = A; d.B = Bt; d.lda = 1024; d.ldb = 1024; d.k0 = 0; d.nk = 16; d.m0 = (xcd_ * MPX + u % MPX) * 256; d.n0 = (u / MPX) * 256; return d; };
  int buf = 0;
  TD cur = tile_at(xj_ < MPX * NTL ? xj_ : 0);
  if (xj_ < MPX * NTL) stage_td(cur, 0, smem, tid);
  for (int u = xj_; u < MPX * NTL; u += xn_) {
    const bool has_next = (u + xn_ < MPX * NTL);
    const TD nxt = tile_at(has_next ? u + xn_ : u);
    const int m0 = cur.m0, n0 = cur.n0;
    f32x16 acc[4][2];
    gemm_stream(cur, has_next, nxt, smem, buf, acc);
    cur = nxt;
    const bool lat = m0 >= NCTX;
    const int b_all = lat ? 32 + ((m0 - NCTX) >> 10) : (m0 >> 8);
    const int nkk = lat ? 1536 : 256;
#pragma unroll
    for (int bi = 0; bi < 4; ++bi)
#pragma unroll
      for (int bj = 0; bj < 2; ++bj) {
        const int rb = m0 + wm * 128 + bi * 32;
        const int cb = n0 + wn * 64 + bj * 32;
        const int col = cb + l32;
        if (cb < NP) {
#pragma unroll
          for (int r = 0; r < 16; ++r) proj[(size_t)(rb + crow(r, hh)) * NP + col] = f2bf(acc[bi][bj][r]);
        }
        const bool isdv = (cb >= 512 && cb < 768), isgv = (cb >= 1152 && cb < 1280);
        if (isdv || isgv) {
          u16* vt; int f;
          if (isdv) { f = col - 512; vt = (u16*)(p.ws + OFF_DVT) + vt_off(b_all, f >> 6, 4); }
          else { f = col - 1152; vt = (u16*)(p.ws + OFF_GVT) + vt_off(b_all, f >> 6, 2); }
          vt += (size_t)(f & 63) * nkk;
#pragma unroll
          for (int j = 0; j < 4; ++j) {
            int row = rb + 16 * (j >> 1) + 8 * hh + 4 * (j & 1);
            int key = lat ? 512 + ((row - NCTX) & 1023) : (row & 255);
            f32x4 v = {acc[bi][bj][4 * j], acc[bi][bj][4 * j + 1], acc[bi][bj][4 * j + 2], acc[bi][bj][4 * j + 3]};
            *(u32x2*)(vt + key) = pack4(v);
          }
        }
      }
  }
}

DI void phase_g2(const P& p, int layer, char* smem) {
  EPI_IDX
  constexpr int T_MQ = (NT / 256) * 2, T_MKV = (NKR / 256) * 2;
  const f32x2* tab32 = (const f32x2*)(p.ws + OFF_ROPE);
  auto tile_at = [&](int t) {
    TD d; d.k0 = 0;
    if (t < T_MQ) { d.A = (const u16*)(p.ws + OFF_CQN); d.B = (const u16*)(p.ws + OFF_WUQ) + (size_t)layer * 384 * 192; d.lda = 192; d.ldb = 192; d.nk = 3; d.m0 = (t >> 1) * 256; d.n0 = (t & 1) * 256; }
    else { const int t2 = t - T_MQ; d.A = (const u16*)(p.ws + OFF_CKVN); d.B = (const u16*)(p.ws + OFF_WUKV) + (size_t)layer * 512 * 128; d.lda = 128; d.ldb = 128; d.nk = 2; d.m0 = (t2 >> 1) * 256; d.n0 = (t2 & 1) * 256; }
    return d;
  };
  int buf = 0;
  const int t_first = blockIdx.x;
  TD cur = tile_at(t_first < T_MQ + T_MKV ? t_first : 0);
  if (t_first < T_MQ + T_MKV) stage_td(cur, 0, smem, tid);
  for (int t = blockIdx.x; t < T_MQ + T_MKV; t += gridDim.x) {
    const bool has_next = (t + (int)gridDim.x < T_MQ + T_MKV);
    const TD nxt = tile_at(has_next ? t + (int)gridDim.x : t);
    f32x16 acc[4][2];
    const int m0 = cur.m0, n0 = cur.n0;
    gemm_stream(cur, has_next, nxt, smem, buf, acc);
    cur = nxt;
    if (t < T_MQ) {
      const bool lat = m0 >= NCTX;
      const float scl = 0.10206207261596575f * LOG2E;
      u16* mq = (u16*)(p.ws + OFF_MQ);
#pragma unroll
      for (int bi = 0; bi < 4; ++bi)
#pragma unroll
        for (int bj = 0; bj < 2; ++bj) {
          const int rb = m0 + wm * 128 + bi * 32;
          const int cb = n0 + wn * 64 + bj * 32;
          const int col = cb + l32;
          if (cb < 384) {
            const bool isrope = lat && ((cb % 96) == 64);
            const int e = l32, w2 = e & 15, fi = w2 & 7;
            const bool isx2 = w2 >= 8, half = e >= 16;
#pragma unroll
            for (int r = 0; r < 16; ++r) {
              float v = acc[bi][bj][r];
              const int row = rb + crow(r, hh);
              if (isrope) {
                const int tt = (row - NCTX) & 1023;
                const int pos = half ? (tt & 63) : (tt >> 6);
                const f32x2 cs = tab32[pos * 16 + fi];
                float pv = __shfl_xor(v, 8);
                v = v * cs[0] + (isx2 ? pv : -pv) * cs[1];
              }
              mq[(size_t)row * 384 + col] = f2bf(v * scl);
            }
          }
        }
    } else {
      const bool lat = m0 >= NCTX;
      const int b_all = lat ? 32 + (m0 - NCTX) / 1536 : (m0 >> 8);
      const int nkk = lat ? 1536 : 256;
      const int kbase = lat ? (m0 - NCTX) % 1536 : (m0 & 255);
      u16* mk = (u16*)(p.ws + OFF_MKB);
#pragma unroll
      for (int bi = 0; bi < 4; ++bi)
#pragma unroll
        for (int bj = 0; bj < 2; ++bj) {
          const int rloc = wm * 128 + bi * 32;
          const int cb = n0 + wn * 64 + bj * 32;
          const int head = cb >> 7, wc = (cb & 127) + l32;
          if ((cb & 127) < 64) {
#pragma unroll
            for (int r = 0; r < 16; ++r) mk[(size_t)(m0 + rloc + crow(r, hh)) * 384 + head * 96 + wc] = f2bf(acc[bi][bj][r]);
          } else {
            u16* vt = (u16*)(p.ws + OFF_MVT) + vt_off(b_all, head, 4) + (size_t)(wc - 64) * nkk + kbase + rloc;
#pragma unroll
            for (int j = 0; j < 4; ++j) {
              f32x4 v = {acc[bi][bj][4 * j], acc[bi][bj][4 * j + 1], acc[bi][bj][4 * j + 2], acc[bi][bj][4 * j + 3]};
              *(u32x2*)(vt + 16 * (j >> 1) + 8 * hh + 4 * (j & 1)) = pack4(v);
            }
          }
        }
    }
  }
  {
    const int gw = blockIdx.x * NWV + wave, nw = gridDim.x * NWV;
    const f32x4 dd = *(const f32x4*)(p.in[I_SSMD] + layer * 256 + lane * 4);
    for (int row = gw; row < NT; row += nw) {
      const float* y0 = (const float*)(p.ws + OFF_YBUF) + (size_t)row * 256 + lane * 4;
      u16* prow = (u16*)(p.ws + OFF_PROJ) + (size_t)row * NP;
      f32x4 a = *(const f32x4*)y0, b = *(const f32x4*)(y0 + (size_t)NT * 256), c = ld4bf(prow + 1280 + lane * 4);
      f32x4 sv = a + b + c * dd;
      f32x4 g = {gelu_tanh(sv[0]), gelu_tanh(sv[1]), gelu_tanh(sv[2]), gelu_tanh(sv[3])};
      *(u32x2*)(prow + lane * 4) = pack4(g);
    }
  }
}

DI void phase_resid(const P& p, int layer, char* smem, bool is_out) {
  EPI_IDX
  const u16* A = is_out ? (const u16*)(p.ws + OFF_MIXED) : (const u16*)(p.ws + OFF_A);
  const int K = is_out ? 1024 : 4096;
  const u16* Bt = is_out ? (const u16*)(p.ws + OFF_WOUT) + (size_t)layer * 1024 * 1024 : (const u16*)(p.ws + OFF_W2) + (size_t)layer * 1024 * 4096;
  constexpr int MT = NT / 256, NTL = 4, MPX = MT / 8, NU = MPX * NTL;
  const int xcd_ = XCD_ID(), xj_ = XCD_RANK(), xn_ = gridDim.x >> 3;
  auto tile_at = [&](int u) {
    TD d; d.A = A; d.B = Bt; d.lda = K; d.ldb = K; d.nk = K / 64; d.k0 = 0;
    d.n0 = (u % NTL) * 256;
    d.m0 = (xcd_ * MPX + u / NTL) * 256;
    return d;
  };
  int buf = 0;
  TD cur = tile_at(xj_ < NU ? xj_ : 0);
  if (xj_ < NU) stage_td(cur, 0, smem, tid);
  for (int u = xj_; u < NU; u += xn_) {
    const bool has_next = (u + xn_ < NU);
    const TD nxt = tile_at(has_next ? u + xn_ : u);
    const int m0 = cur.m0, n0 = cur.n0;
    f32x16 acc[4][2];
    gemm_stream(cur, has_next, nxt, smem, buf, acc);
    cur = nxt;
    const float* gate = (const float*)(p.ws + OFF_MOD) + ((size_t)layer * 5 + mod_index(m0)) * 6144 + (is_out ? 2048 : 5120);
#pragma unroll
    for (int bi = 0; bi < 4; ++bi)
#pragma unroll
      for (int bj = 0; bj < 2; ++bj) {
        const int rb = m0 + wm * 128 + bi * 32;
        const int col = n0 + wn * 64 + bj * 32 + l32;
        const float g = gate[col];
        float rv[16];
#pragma unroll
        for (int r = 0; r < 16; ++r) rv[r] = p.out[(size_t)(rb + crow(r, hh)) * 1024 + col];
#pragma unroll
        for (int r = 0; r < 16; ++r) p.out[(size_t)(rb + crow(r, hh)) * 1024 + col] = rv[r] + g * acc[bi][bj][r];
      }
  }
}

DI void phase_g5(const P& p, int layer, char* smem) {
  EPI_IDX
  const u16* A = (const u16*)(p.ws + OFF_H);
  const u16* Bt = (const u16*)(p.ws + OFF_W1) + (size_t)layer * 4096 * 1024;
  u16* a = (u16*)(p.ws + OFF_A);
  constexpr int MT = NT / 256, NTL = 16, MPX = MT / 8;
  const int xcd_ = XCD_ID(), xj_ = XCD_RANK(), xn_ = gridDim.x >> 3;
  auto tile_at = [&](int u) { TD d; d.A = A; d.B = Bt; d.lda = 1024; d.ldb = 1024; d.k0 = 0; d.nk = 16; d.m0 = (xcd_ * MPX + u % MPX) * 256; d.n0 = (u / MPX) * 256; return d; };
  int buf = 0;
  TD cur = tile_at(xj_ < MPX * NTL ? xj_ : 0);
  if (xj_ < MPX * NTL) stage_td(cur, 0, smem, tid);
  for (int u = xj_; u < MPX * NTL; u += xn_) {
    const bool has_next = (u + xn_ < MPX * NTL);
    const TD nxt = tile_at(has_next ? u + xn_ : u);
    const int m0 = cur.m0, n0 = cur.n0;
    f32x16 acc[4][2];
    gemm_stream(cur, has_next, nxt, smem, buf, acc);
    cur = nxt;
#pragma unroll
    for (int bi = 0; bi < 4; ++bi)
#pragma unroll
      for (int bj = 0; bj < 2; ++bj) {
        const int rb = m0 + wm * 128 + bi * 32;
        const int col = n0 + wn * 64 + bj * 32 + l32;
#pragma unroll
        for (int r = 0; r < 16; ++r) {
          float v = fmaxf(acc[bi][bj][r], 0.f);
          a[(size_t)(rb + crow(r, hh)) * 4096 + col] = f2bf(v * v);
        }
      }
  }
}

template <int R>
DI f32x4 rope4(f32x4 v, int lane, int t, const f32x2* tab) {
  constexpr int n = R / 4;
  const int e = (lane * 4) % R;
  const int half = e / (R / 2), w = e % (R / 2);
  const bool isx2 = w >= n;
  const int fi = w % n;
  const int pos = half ? (t & 63) : (t >> 6);
  f32x4 o;
#pragma unroll
  for (int i = 0; i < 4; ++i) {
    float pv = __shfl_xor(v[i], n / 4);
    f32x2 cs = tab[pos * 16 + fi + i];
    o[i] = v[i] * cs[0] + (isx2 ? pv : -pv) * cs[1];
  }
  return o;
}

DI void ssm_item(const P& p, int layer, int item, float* lds, int lane) {
  int b_all, r;
  if (item < 128) { b_all = 32 + item / 32; r = item % 32; } else { int it = item - 128; b_all = it / 32; r = it % 32; }
  const int dir = r >> 4, g = r & 15;
  const bool lat = b_all >= 32;
  const int T = lat ? 1024 : 256;
  const int row0 = lat ? NCTX + (b_all - 32) * 1024 : b_all * 256;
  const int tabidx = (layer * 2 + dir) * 16 + g;
  const int l32 = lane & 31, hh = lane >> 5, l16 = lane & 15, q4 = lane >> 4;
  const u16* atab = (const u16*)(p.ws + OFF_ATAB) + (size_t)tabidx * 128 * 16;
  const u16* ctab = (const u16*)(p.ws + OFF_CTAB) + (size_t)tabidx * 16 * 128;
  bf16x8 af[4], cf[4];
#pragma unroll
  for (int blk = 0; blk < 4; ++blk) af[blk] = *(const bf16x8*)(atab + (blk * 32 + l32) * 16 + hh * 8);
#pragma unroll
  for (int kk = 0; kk < 4; ++kk) cf[kk] = *(const bf16x8*)(ctab + l16 * 128 + kk * 32 + q4 * 8);
  const float* ab = (const float*)(p.ws + OFF_ABAR) + ((size_t)tabidx * 64 + lane) * 2;
  const float ar = ab[0], ai = ab[1];
  float hr = 0.f, hi = 0.f;
  if (lat) {
    size_t idx = ((size_t)((b_all - 32) * 2 + layer) * 2 + dir) * 1024 + g * 64 + lane;
    hr = p.in[I_SRE][idx]; hi = p.in[I_SIM][idx];
  }
  const u16* proj = (const u16*)(p.ws + OFF_PROJ);
  float* ybuf = (float*)(p.ws + OFF_YBUF) + (size_t)dir * NT * 256;
  f32x16 zero16;
#pragma unroll
  for (int i = 0; i < 16; ++i) zero16[i] = 0.f;
  bf16x8 un;
  {
    const int t = dir ? (T - 1 - l32) : l32;
    un = *(const bf16x8*)(proj + (size_t)(row0 + t) * NP + 1280 + g * 16 + hh * 8);
  }
  for (int ch = 0; ch < T / 32; ++ch) {
    {
      bf16x8 uf = un;
      if (ch + 1 < T / 32) {
        const int n = (ch + 1) * 32 + l32;
        const int t = dir ? (T - 1 - n) : n;
        un = *(const bf16x8*)(proj + (size_t)(row0 + t) * NP + 1280 + g * 16 + hh * 8);
      }
#pragma unroll
      for (int blk = 0; blk < 4; ++blk) {
        f32x16 d = MFMA32(af[blk], uf, zero16);
#pragma unroll
        for (int j = 0; j < 4; ++j) {
          f32x4 v = {d[4 * j], d[4 * j + 1], d[4 * j + 2], d[4 * j + 3]};
          *(f32x4*)(lds + l32 * 132 + blk * 32 + 8 * j + 4 * hh) = v;
        }
      }
    }
    wave_lds_fence();
    {
      f32x2 bu[32];
#pragma unroll
      for (int s = 0; s < 32; ++s) bu[s] = *(const f32x2*)(lds + s * 132 + 2 * lane);
#pragma unroll
      for (int s = 0; s < 32; ++s) {
        const float nr = __builtin_fmaf(ar, hr, __builtin_fmaf(-ai, hi, bu[s][0]));
        const float ni = __builtin_fmaf(ar, hi, __builtin_fmaf(ai, hr, bu[s][1]));
        hr = nr; hi = ni;
        f32x2 hv = {hr, hi};
        *(f32x2*)(lds + s * 132 + 2 * lane) = hv;
      }
    }
    wave_lds_fence();
#pragma unroll
    for (int tb = 0; tb < 2; ++tb) {
      f32x4 y = {0.f, 0.f, 0.f, 0.f};
#pragma unroll
      for (int kk = 0; kk < 4; ++kk) {
        const float* hp = lds + (tb * 16 + l16) * 132 + kk * 32 + q4 * 8;
        f32x4 a0 = *(const f32x4*)hp, a1 = *(const f32x4*)(hp + 4);
        y = MFMA16(cf[kk], pack8(a0, a1), y);
      }
      const int n2 = ch * 32 + tb * 16 + l16;
      const int t2 = dir ? (T - 1 - n2) : n2;
      *(f32x4*)(ybuf + (size_t)(row0 + t2) * 256 + g * 16 + q4 * 4) = y;
    }
    wave_lds_fence();
  }
  if (!lat) {
    size_t idx = ((size_t)(b_all * 2 + layer) * 2 + dir) * 1024 + g * 64 + lane;
    p.out[O_SRE + idx] = hr;
    p.out[O_SIM + idx] = hi;
  }
}

DI void pp_row(const P& p, int layer, int row, int lane) {
  const u16* pr = (const u16*)(p.ws + OFF_PROJ) + (size_t)row * NP;
  const bool lat = row >= NCTX;
  int b, t, keyrow;
  if (!lat) { b = row >> 8; t = row & 255; keyrow = row; }
  else { int rr = row - NCTX; b = rr >> 10; t = rr & 1023; keyrow = NCTX + b * 1536 + 512 + t; }
  const f32x2* tab32 = (const f32x2*)(p.ws + OFF_ROPE);
  const f32x2* tab64 = tab32 + 64 * 16;
  const size_t orow = (size_t)(b * 2 + layer) * 256 + t;
  const f32x4 z4 = {0.f, 0.f, 0.f, 0.f};
  f32x4 v_dq = ld4bf(pr + lane * 4);
  f32x4 v_dk = ld4bf(pr + 256 + lane * 4);
  f32x4 v_dv = ld4bf(pr + 512 + lane * 4);
  f32x4 v_gq = ld4bf(pr + 768 + lane * 4);
  f32x4 v_gk = lane < 32 ? ld4bf(pr + 1024 + lane * 4) : z4;
  f32x4 v_gv = lane < 32 ? ld4bf(pr + 1152 + lane * 4) : z4;
  f32x4 v_cq = lane < 48 ? ld4bf(pr + 1536 + lane * 4) : z4;
  f32x4 v_ckv = lane < 32 ? ld4bf(pr + 1728 + lane * 4) : z4;
  f32x4 v_kr = lane < 8 ? ld4bf(pr + 1856 + lane * 4) : z4;
  const f32x4 g_q = *(const f32x4*)(p.in[I_QNG] + layer * 64 + (lane & 15) * 4);
  const f32x4 g_k = *(const f32x4*)(p.in[I_KNG] + layer * 64 + (lane & 15) * 4);
  const f32x4 g_cq = lane < 48 ? *(const f32x4*)(p.in[I_MQNG] + layer * 192 + lane * 4) : z4;
  const f32x4 g_ckv = lane < 32 ? *(const f32x4*)(p.in[I_MKVNG] + layer * 128 + lane * 4) : z4;
  f32x2 cs32[4], cs64[4];
  {
    const int e32 = (lane * 4) & 31, w32 = e32 & 15, p32 = (e32 >> 4) ? (t & 63) : (t >> 6), f32i = w32 & 7;
    const int e64 = (lane * 4) & 63, w64 = e64 & 31, p64 = (e64 >> 5) ? (t & 63) : (t >> 6), f64i = w64 & 15;
    const f32x2 one = {1.f, 0.f};
#pragma unroll
    for (int i = 0; i < 4; ++i) {
      cs32[i] = lat ? tab32[p32 * 16 + f32i + i] : one;
      cs64[i] = lat ? tab64[p64 * 16 + f64i + i] : one;
    }
  }
  const bool x2_32 = ((lane * 4) & 15) >= 8, x2_64 = ((lane * 4) & 31) >= 16;
  auto rope32 = [&](f32x4 v) {
    f32x4 o;
#pragma unroll
    for (int i = 0; i < 4; ++i) { float pv = __shfl_xor(v[i], 2); o[i] = v[i] * cs32[i][0] + (x2_32 ? pv : -pv) * cs32[i][1]; }
    return o;
  };
  auto rope64 = [&](f32x4 v) {
    f32x4 o;
#pragma unroll
    for (int i = 0; i < 4; ++i) { float pv = __shfl_xor(v[i], 4); o[i] = v[i] * cs64[i][0] + (x2_64 ? pv : -pv) * cs64[i][1]; }
    return o;
  };
  if (!lat) {
    *(f32x4*)(p.out + O_DK + orow * 256 + lane * 4) = v_dk;
    *(f32x4*)(p.out + O_DV + orow * 256 + lane * 4) = v_dv;
    if (lane < 32) *(f32x4*)(p.out + O_GV + orow * 128 + lane * 4) = v_gv;
    if (lane < 8) *(f32x4*)(p.out + O_KR + orow * 32 + lane * 4) = v_kr;
  }
  {
    f32x4 v = v_dq;
    if (lat) v = rope32(v);
    v = v * (0.17677669529663687f * LOG2E);
    *(u32x2*)((u16*)(p.ws + OFF_DQ) + (size_t)row * 256 + lane * 4) = pack4(v);
  }
  {
    f32x4 v = v_dk;
    if (lat) v = rope32(v);
    *(u32x2*)((u16*)(p.ws + OFF_DKB) + (size_t)keyrow * 256 + lane * 4) = pack4(v);
  }
  {
    f32x4 v = v_gq;
    float ss = v[0] * v[0] + v[1] * v[1] + v[2] * v[2] + v[3] * v[3];
    ss += __shfl_xor(ss, 1); ss += __shfl_xor(ss, 2); ss += __shfl_xor(ss, 4); ss += __shfl_xor(ss, 8);
    float r = rsqrtf(ss * (1.f / 64.f) + EPSF);
    v = v * r * g_q;
    if (lat) v = rope64(v);
    v = v * (0.125f * LOG2E);
    *(u32x2*)((u16*)(p.ws + OFF_GQ) + (size_t)row * 256 + lane * 4) = pack4(v);
  }
  {
    f32x4 v = v_gk;
    float ss = v[0] * v[0] + v[1] * v[1] + v[2] * v[2] + v[3] * v[3];
    ss += __shfl_xor(ss, 1); ss += __shfl_xor(ss, 2); ss += __shfl_xor(ss, 4); ss += __shfl_xor(ss, 8);
    float r = rsqrtf(ss * (1.f / 64.f) + EPSF);
    v = v * r * g_k;
    if (!lat) { if (lane < 32) *(f32x4*)(p.out + O_GK + orow * 128 + lane * 4) = v; }
    else v = rope64(v);
    if (lane < 32) *(u32x2*)((u16*)(p.ws + OFF_GKB) + (size_t)keyrow * 128 + lane * 4) = pack4(v);
  }
  {
    f32x4 v = v_cq;
    float ss = wave_sum(v[0] * v[0] + v[1] * v[1] + v[2] * v[2] + v[3] * v[3]);
    float r = rsqrtf(ss * (1.f / 192.f) + EPSF);
    v = v * r * g_cq;
    if (lane < 48) *(u32x2*)((u16*)(p.ws + OFF_CQN) + (size_t)row * 192 + lane * 4) = pack4(v);
  }
  {
    f32x4 v = v_ckv;
    float ss = wave_sum(v[0] * v[0] + v[1] * v[1] + v[2] * v[2] + v[3] * v[3]);
    float r = rsqrtf(ss * (1.f / 128.f) + EPSF);
    v = v * r * g_ckv;
    if (lane < 32) {
      if (!lat) *(f32x4*)(p.out + O_CKV + orow * 128 + lane * 4) = v;
      *(u32x2*)((u16*)(p.ws + OFF_CKVN) + (size_t)keyrow * 128 + lane * 4) = pack4(v);
    }
  }
  {
    f32x4 v = v_kr;
    if (lat) v = rope32(v);
    if (lane < 8) {
      u32x2 pk = pack4(v);
      u16* mk = (u16*)(p.ws + OFF_MKB) + (size_t)keyrow * 384 + 64 + lane * 4;
#pragma unroll
      for (int hd = 0; hd < 4; ++hd) *(u32x2*)(mk + hd * 96) = pk;
    }
  }
}

DI void pp_cached(const P& p, int layer, int crow_, int lane) {
  const int b = crow_ >> 9, j = crow_ & 511;
  const int keyrow = NCTX + b * 1536 + j;
  const size_t src = (size_t)(b * 2 + layer) * 512 + j;
  const int jp = (j & ~15) | (((j >> 2) & 1) << 3) | (((j >> 3) & 1) << 2) | (j & 3);
  const f32x4 z4 = {0.f, 0.f, 0.f, 0.f};
  const int l31 = lane & 31, l7 = lane & 7;
  f32x4 v_dk = *(const f32x4*)(p.in[I_CDK] + src * 256 + lane * 4);
  f32x4 v_dv = *(const f32x4*)(p.in[I_CDV] + src * 256 + lane * 4);
  f32x4 v_gk = *(const f32x4*)(p.in[I_CGK] + src * 128 + l31 * 4);
  f32x4 v_gv = *(const f32x4*)(p.in[I_CGV] + src * 128 + l31 * 4);
  f32x4 v_ckv = *(const f32x4*)(p.in[I_CCKV] + src * 128 + l31 * 4);
  f32x4 v_kr = *(const f32x4*)(p.in[I_CKR] + src * 32 + l7 * 4);
  (void)z4;
  *(u32x2*)((u16*)(p.ws + OFF_DKB) + (size_t)keyrow * 256 + lane * 4) = pack4(v_dk);
  {
    u16* vt = (u16*)(p.ws + OFF_DVT) + vt_off(32 + b, lane >> 4, 4) + (size_t)((lane & 15) * 4) * 1536 + jp;
#pragma unroll
    for (int i = 0; i < 4; ++i) vt[(size_t)i * 1536] = f2bf(v_dv[i]);
  }
  if (lane < 32) {
    *(u32x2*)((u16*)(p.ws + OFF_GKB) + (size_t)keyrow * 128 + lane * 4) = pack4(v_gk);
    u16* vt = (u16*)(p.ws + OFF_GVT) + vt_off(32 + b, lane >> 4, 2) + (size_t)((lane & 15) * 4) * 1536 + jp;
#pragma unroll
    for (int i = 0; i < 4; ++i) vt[(size_t)i * 1536] = f2bf(v_gv[i]);
    *(u32x2*)((u16*)(p.ws + OFF_CKVN) + (size_t)keyrow * 128 + lane * 4) = pack4(v_ckv);
  }
  if (lane < 8) {
    u32x2 pk = pack4(v_kr);
    u16* mk = (u16*)(p.ws + OFF_MKB) + (size_t)keyrow * 384 + 64 + lane * 4;
#pragma unroll
    for (int hd = 0; hd < 4; ++hd) *(u32x2*)(mk + hd * 96) = pk;
  }
}

DI void phase_pp(const P& p, int layer, char* smem) {
  const int tid_ = get_tid();
  const int lane = tid_ & 63, wave = tid_ >> 6;
  float* lds = (float*)smem + wave * (32 * 132);
  const int gw = wave * (int)gridDim.x + (int)blockIdx.x, nw = gridDim.x * NWV;
  constexpr int N_SSM = 1152, N_ROWS = NT + 2048;
  for (int item = gw; item < N_SSM; item += nw) ssm_item(p, layer, item, lds, lane);
  const int rw0 = (nw > 256) ? 128 : 0;
  if (gw >= rw0) {
    for (int row = gw - rw0; row < N_ROWS; row += nw - rw0) {
      if (row < NT) pp_row(p, layer, row, lane);
      else pp_cached(p, layer, row - NT, lane);
    }
  }
}

template <int KW, int DK>
DI void attn_block(const u16* __restrict__ Kg, int ldk, const u16* __restrict__ Vt, int nk, const bf16x8 (&qf)[DK / 16], int kcol, char* smem,
                   int tid, f32x16 (&o)[2], float& lsum) {
  constexpr int KST = KW + 8, KS = DK / 16, KCH = KW / 8, KTOT = 64 * KCH, NKC = (KTOT + NTHR - 1) / NTHR;
  const int lane = tid & 63, l32 = lane & 31, hh = lane >> 5;
  u16* Ks = (u16*)smem;
  u16* Vs = Ks + 2 * 64 * KST;
  float m = -1e30f;
  lsum = 0.f;
#pragma unroll
  for (int db = 0; db < 2; ++db)
#pragma unroll
    for (int r = 0; r < 16; ++r) o[db][r] = 0.f;
  u32x4 rk[NKC], rv[1];
  const int nt = nk / 64;
#pragma unroll
  for (int i = 0; i < NKC; ++i) { int c = tid + NTHR * i, r = c / KCH, kc = (c % KCH) * 8; if (c < KTOT) rk[i] = *(const u32x4*)(Kg + (size_t)r * ldk + kc); }
  { int r = tid >> 3, kc = (tid & 7) * 8; rv[0] = *(const u32x4*)(Vt + (size_t)r * nk + kc); }
#pragma unroll
  for (int i = 0; i < NKC; ++i) { int c = tid + NTHR * i, r = c / KCH, kc = (c % KCH) * 8; if (c < KTOT) *(u32x4*)(Ks + r * KST + kc) = rk[i]; }
  { int r = tid >> 3, kc = (tid & 7) * 8; *(u32x4*)(Vs + r * 72 + kc) = rv[0]; }
  __syncthreads();
  for (int t = 0; t < nt; ++t) {
    const int buf = t & 1;
    const bool more = (t + 1 < nt);
    if (more) {
      const int kt = (t + 1) * 64;
#pragma unroll
      for (int i = 0; i < NKC; ++i) { int c = tid + NTHR * i, r = c / KCH, kc = (c % KCH) * 8; if (c < KTOT) rk[i] = *(const u32x4*)(Kg + (size_t)(kt + r) * ldk + kc); }
      { int r = tid >> 3, kc = (tid & 7) * 8; rv[0] = *(const u32x4*)(Vt + (size_t)r * nk + kt + kc); }
    }
    const u16* ks = Ks + buf * 64 * KST + l32 * KST + kcol + hh * 8;
    const u16* vs = Vs + buf * 64 * 72 + l32 * 72 + hh * 8;
    f32x16 sa[2];
#pragma unroll
    for (int kb = 0; kb < 2; ++kb) {
#pragma unroll
      for (int r = 0; r < 16; ++r) sa[kb][r] = 0.f;
      bf16x8 kf[KS];
#pragma unroll
      for (int s2 = 0; s2 < KS; ++s2) kf[s2] = *(const bf16x8*)(ks + kb * 32 * KST + s2 * 16);
#pragma unroll
      for (int s2 = 0; s2 < KS; ++s2) sa[kb] = MFMA32(kf[s2], qf[s2], sa[kb]);
    }
    float mx = sa[0][0];
#pragma unroll
    for (int r = 1; r < 16; ++r) mx = fmaxf(mx, sa[0][r]);
#pragma unroll
    for (int r = 0; r < 16; ++r) mx = fmaxf(mx, sa[1][r]);
    mx = fmaxf(mx, __shfl_xor(mx, 32));
    const float mn = fmaxf(m, mx);
    const float alpha = fexp2(m - mn);
    m = mn;
    float ps = 0.f;
#pragma unroll
    for (int kb = 0; kb < 2; ++kb)
#pragma unroll
      for (int r = 0; r < 16; ++r) { float e = fexp2(sa[kb][r] - mn); sa[kb][r] = e; ps += e; }
    lsum = lsum * alpha + ps;
#pragma unroll
    for (int db = 0; db < 2; ++db)
#pragma unroll
      for (int r = 0; r < 16; ++r) o[db][r] *= alpha;
#pragma unroll
    for (int s2 = 0; s2 < 4; ++s2) {
      const int kb = s2 >> 1, rb = 8 * (s2 & 1);
      f32x4 p0 = {sa[kb][rb], sa[kb][rb + 1], sa[kb][rb + 2], sa[kb][rb + 3]};
      f32x4 p1 = {sa[kb][rb + 4], sa[kb][rb + 5], sa[kb][rb + 6], sa[kb][rb + 7]};
      bf16x8 pf = pack8(p0, p1);
      bf16x8 v0 = *(const bf16x8*)(vs + s2 * 16);
      bf16x8 v1 = *(const bf16x8*)(vs + 32 * 72 + s2 * 16);
      o[0] = MFMA32(v0, pf, o[0]);
      o[1] = MFMA32(v1, pf, o[1]);
    }
    if (more) {
      const int nb = buf ^ 1;
#pragma unroll
      for (int i = 0; i < NKC; ++i) { int c = tid + NTHR * i, r = c / KCH, kc = (c % KCH) * 8; if (c < KTOT) *(u32x4*)(Ks + nb * 64 * KST + r * KST + kc) = rk[i]; }
      { int r = tid >> 3, kc = (tid & 7) * 8; *(u32x4*)(Vs + nb * 64 * 72 + r * 72 + kc) = rv[0]; }
    }
    __syncthreads();
  }
  lsum += __shfl_xor(lsum, 32);
}

DI void store_o(u16* dst  , const f32x16 (&o)[2], float scale, int hh) {
#pragma unroll
  for (int db = 0; db < 2; ++db)
#pragma unroll
    for (int j = 0; j < 4; ++j) {
      const int dv = db * 32 + 8 * j + 4 * hh;
      f32x4 v = {o[db][4 * j] * scale, o[db][4 * j + 1] * scale, o[db][4 * j + 2] * scale, o[db][4 * j + 3] * scale};
      *(u32x2*)(dst + dv) = pack4(v);
    }
}

DI void attn_item(const P& p, int layer, int item, char* smem, int tid) {
  const int lane = tid & 63, wave = tid >> 6, l32 = lane & 31, hh = lane >> 5;
  bool lat; int kind, b, hd, qblk;
  if (item < 256) {
    lat = true;
    if (item < 128) { kind = 0; b = item >> 5; hd = (item >> 3) & 3; qblk = item & 7; }
    else { int it = item - 128; kind = 1 + (it >> 6); it &= 63; b = it >> 4; hd = (it >> 2) & 3; qblk = it & 3; }
  } else {
    lat = false;
    int it = item - 256;
    if (it < 256) { kind = 0; b = it >> 3; hd = (it >> 1) & 3; qblk = it & 1; }
    else { it -= 256; kind = 1 + (it >> 7); it &= 127; b = it >> 2; hd = it & 3; qblk = 0; }
  }
  const int nk = lat ? 1536 : 256;
  const int b_all = lat ? 32 + b : b;
  const int keyrow0 = lat ? NCTX + b * 1536 : b * 256;
  const int tok0 = lat ? NCTX + b * 1024 : b * 256;
  f32x16 o[2]; float ls;
  if (kind == 0) {
    const int ns = wave & 1, qb = wave >> 1;
    const int q0 = tok0 + qblk * 128 + qb * 32;
    const u16* Q = (const u16*)(p.ws + OFF_DQ) + (size_t)(q0 + l32) * 256 + hd * 64 + ns * 32 + hh * 8;
    bf16x8 qf[2];
    qf[0] = *(const bf16x8*)Q; qf[1] = *(const bf16x8*)(Q + 16);
    attn_block<64, 32>((const u16*)(p.ws + OFF_DKB) + (size_t)keyrow0 * 256 + hd * 64, 256, (const u16*)(p.ws + OFF_DVT) + vt_off(b_all, hd, 4), nk, qf, ns * 32,
                       smem, tid, o, ls);
    float d1 = 0.f, d2 = 0.f;
    if (lane < 32) { d1 = p.in[I_LQ1][layer * 32 + lane] * p.in[I_LK1][layer * 32 + lane]; d2 = p.in[I_LQ2][layer * 32 + lane] * p.in[I_LK2][layer * 32 + lane]; }
    d1 = wave_sum(d1); d2 = wave_sum(d2);
    int ly_ = layer; asm volatile("" : "+s"(ly_));
    const float lam_init = ly_ == 0 ? 0.2f : (0.8f - 0.6f * 0.7408182206817179f);
    const float lam = expf(d1) - expf(d2) + lam_init;
    float* cmb = (float*)smem + qb * (64 * 33);
    if (ns == 1) {
      const float sc = lam / ls;
#pragma unroll
      for (int db = 0; db < 2; ++db)
#pragma unroll
        for (int r = 0; r < 16; ++r) cmb[(db * 32 + crow(r, hh)) * 33 + l32] = o[db][r] * sc;
    }
    __syncthreads();
    if (ns == 0) {
      const float i0 = 1.f / ls;
      float ss = 0.f;
#pragma unroll
      for (int db = 0; db < 2; ++db)
#pragma unroll
        for (int r = 0; r < 16; ++r) { float d = o[db][r] * i0 - cmb[(db * 32 + crow(r, hh)) * 33 + l32]; o[db][r] = d; ss += d * d; }
      ss += __shfl_xor(ss, 32);
      const float rr = rsqrtf(ss * (1.f / 64.f) + EPSF) * (1.f - lam_init);
      u16* dst = (u16*)(p.ws + OFF_MIXED) + (size_t)(q0 + l32) * 1024 + hd * 64;
#pragma unroll
      for (int db = 0; db < 2; ++db)
#pragma unroll
        for (int j = 0; j < 4; ++j) {
          const int dv = db * 32 + 8 * j + 4 * hh;
          f32x4 g = *(const f32x4*)(p.in[I_SUBLN] + layer * 64 + dv);
          f32x4 v = {o[db][4 * j] * rr * g[0], o[db][4 * j + 1] * rr * g[1], o[db][4 * j + 2] * rr * g[2], o[db][4 * j + 3] * rr * g[3]};
          *(u32x2*)(dst + dv) = pack4(v);
        }
    }
    __syncthreads();
  } else if (kind == 1) {
    const int q0 = tok0 + qblk * 256 + wave * 32;
    const u16* Q = (const u16*)(p.ws + OFF_GQ) + (size_t)(q0 + l32) * 256 + hd * 64 + hh * 8;
    bf16x8 qf[4];
#pragma unroll
    for (int s2 = 0; s2 < 4; ++s2) qf[s2] = *(const bf16x8*)(Q + s2 * 16);
    attn_block<64, 64>((const u16*)(p.ws + OFF_GKB) + (size_t)keyrow0 * 128 + (hd >> 1) * 64, 128, (const u16*)(p.ws + OFF_GVT) + vt_off(b_all, hd >> 1, 2), nk, qf, 0,
                       smem, tid, o, ls);
    store_o((u16*)(p.ws + OFF_MIXED) + (size_t)(q0 + l32) * 1024 + 256 + hd * 64, o, 1.f / ls, hh);
  } else {
    const int q0 = tok0 + qblk * 256 + wave * 32;
    const u16* Q = (const u16*)(p.ws + OFF_MQ) + (size_t)(q0 + l32) * 384 + hd * 96 + hh * 8;
    bf16x8 qf[6];
#pragma unroll
    for (int s2 = 0; s2 < 6; ++s2) qf[s2] = *(const bf16x8*)(Q + s2 * 16);
    attn_block<96, 96>((const u16*)(p.ws + OFF_MKB) + (size_t)keyrow0 * 384 + hd * 96, 384, (const u16*)(p.ws + OFF_MVT) + vt_off(b_all, hd, 4), nk, qf, 0,
                       smem, tid, o, ls);
    store_o((u16*)(p.ws + OFF_MIXED) + (size_t)(q0 + l32) * 1024 + 768 + hd * 64, o, 1.f / ls, hh);
  }
}

DI void phase_at(const P& p, int layer, char* smem) {
  EPI_IDX
  constexpr int N_ITEMS = 768;
  if (gridDim.x == 256) {
    const int b = blockIdx.x;
    attn_item(p, layer, b, smem, tid);
    __syncthreads();
    if (b < 128) {
      attn_item(p, layer, 256 + b, smem, tid); __syncthreads();
      attn_item(p, layer, 512 + b, smem, tid); __syncthreads();
      attn_item(p, layer, 640 + b, smem, tid); __syncthreads();
    } else if (b < 192) {
      attn_item(p, layer, 256 + 128 + 2 * (b - 128), smem, tid); __syncthreads();
      attn_item(p, layer, 256 + 128 + 2 * (b - 128) + 1, smem, tid); __syncthreads();
    }
  } else {
    for (int item = blockIdx.x; item < N_ITEMS; item += gridDim.x) {
      attn_item(p, layer, item, smem, tid);
      __syncthreads();
    }
  }
  {
    constexpr int T_GLU = (NT / 256) * 2;
    auto tile_at = [&](int t) { TD d; d.A = (const u16*)(p.ws + OFF_PROJ); d.lda = NP; d.B = (const u16*)(p.ws + OFF_WGLU) + (size_t)layer * 512 * 256; d.ldb = 256; d.k0 = 0; d.nk = 4; d.m0 = (t >> 1) * 256; d.n0 = (t & 1) * 256; return d; };
    int buf = 0;
    const int t0 = (int)gridDim.x - 1 - (int)blockIdx.x;
    TD cur = tile_at(t0 < T_GLU ? t0 : 0);
    if (t0 < T_GLU) stage_td(cur, 0, smem, tid);
    for (int t = t0; t < T_GLU; t += gridDim.x) {
      const bool has_next = (t + (int)gridDim.x < T_GLU);
      const TD nxt = tile_at(has_next ? t + (int)gridDim.x : t);
      const int m0 = cur.m0, n0 = cur.n0;
      f32x16 acc[4][2];
      gemm_stream(cur, has_next, nxt, smem, buf, acc);
      cur = nxt;
      u16* mixed = (u16*)(p.ws + OFF_MIXED);
      const int q = (n0 + wn * 64) >> 6;
#pragma unroll
      for (int bi = 0; bi < 4; ++bi) {
        const int rb = m0 + wm * 128 + bi * 32;
#pragma unroll
        for (int r = 0; r < 16; ++r) {
          float z = acc[bi][0][r], g = acc[bi][1][r];
          mixed[(size_t)(rb + crow(r, hh)) * 1024 + 512 + q * 32 + l32] = f2bf(z * fsigmoid(g));
        }
      }
    }
  }
}

#define XB_TMO      128
#define XB_XCNT(j)  (256  + 64 * (j))
#define XB_XSUB(j)  (1280 + 64 * (j))
#define XB_XGEN(j)  (2304 + 64 * (j))
#define XB_TOP      3328
#define XB_TOPGEN   3392
#define XCD_BAR_WORDS 3456
#define XB_SPIN_CAP (1u << 22)
#define LAS __attribute__((address_space(3)))
DI unsigned xb_ld(unsigned* p) { return __hip_atomic_load(p, __ATOMIC_RELAXED, __HIP_MEMORY_SCOPE_AGENT); }
DI unsigned xb_add(unsigned* p, unsigned v) { return __hip_atomic_fetch_add(p, v, __ATOMIC_RELAXED, __HIP_MEMORY_SCOPE_AGENT); }
DI unsigned xb_xcc_id() { return (unsigned)__builtin_amdgcn_s_getreg((3 << 11) | 20) & 0xFu; }
#define XB_SPIN(cond, bar) do { unsigned _sp = 0; while (cond) { __builtin_amdgcn_s_sleep(1); \
    if ((++_sp & 255u) == 0u) { if (xb_ld(&(bar)[XB_TMO])) break; if (_sp > XB_SPIN_CAP) { atomicAdd(&(bar)[XB_TMO], 1u); break; } } } } while (0)
struct XcdBarrier { unsigned* bar; unsigned x; volatile LAS unsigned* st; };
DI XcdBarrier xcd_barrier_post(unsigned* bar, volatile LAS unsigned* st) {
  XcdBarrier b; b.bar = bar; b.x = xb_xcc_id(); b.st = st;
  if (threadIdx.x == 0) st[2] = xb_add(&bar[XB_XCNT(b.x)], 1u);
  return b;
}
DI void xcd_barrier_complete(unsigned* bar, unsigned x, unsigned& nloc, unsigned& nx) {
  const unsigned G = gridDim.x * gridDim.y * gridDim.z;
  unsigned sum, cnt, mine, sp = 0u;
  for (;;) {
    sum = 0u; cnt = 0u; mine = 0u;
#pragma unroll
    for (unsigned j = 0; j < 16; ++j) { const unsigned c = xb_ld(&bar[XB_XCNT(j)]); sum += c; cnt += (c > 0u) ? 1u : 0u; mine = (j == x) ? c : mine; }
    if (sum == G) break;
    __builtin_amdgcn_s_sleep(1);
    if ((++sp & 255u) == 0u) { if (xb_ld(&bar[XB_TMO])) break; if (sp > XB_SPIN_CAP) { atomicAdd(&bar[XB_TMO], 1u); break; } }
  }
  nloc = mine > 0u ? mine : 1u; nx = cnt > 0u ? cnt : 1u;
}
DI void xcd_barrier(const XcdBarrier& b) {
  asm volatile("s_waitcnt vmcnt(0)" ::: "memory");
  __syncthreads();
  if (threadIdx.x == 0) {
    unsigned* bar = b.bar;
    __builtin_amdgcn_s_waitcnt(0);
    unsigned nloc = b.st[0], nx = b.st[1];
    if (nloc == 0u) { xcd_barrier_complete(bar, b.x, nloc, nx); b.st[0] = nloc; b.st[1] = nx; }
    const unsigned old = xb_add(&bar[XB_XSUB(b.x)], 1u);
    const unsigned gen = old / nloc;
    if (old + 1u == (gen + 1u) * nloc) {
      __builtin_amdgcn_fence(__ATOMIC_RELEASE, "agent");
      asm volatile("s_waitcnt vmcnt(0)" ::: "memory");
      const unsigned og = xb_add(&bar[XB_TOP], 1u);
      const unsigned tg = og / nx;
      if (og + 1u == (tg + 1u) * nx) xb_add(&bar[XB_TOPGEN], 1u);
      else XB_SPIN(xb_ld(&bar[XB_TOPGEN]) == tg, bar);
      __builtin_amdgcn_fence(__ATOMIC_ACQUIRE, "agent");
      xb_add(&bar[XB_XGEN(b.x)], 1u);
      asm volatile("s_waitcnt vmcnt(0)" ::: "memory");
    } else {
      XB_SPIN(xb_ld(&bar[XB_XGEN(b.x)]) == gen, bar);
      __builtin_amdgcn_fence(__ATOMIC_ACQUIRE, "agent");
      asm volatile("s_waitcnt vmcnt(0)" ::: "memory");
    }
  }
  __syncthreads();
}

DI void run_phase(const P& p_, int ph, int layer, char* smem) {
  P p = p_;
  size_t zoff = 0;
  asm volatile("" : "+s"(zoff));
  p.ws = p_.ws + zoff;
  p.out = p_.out + zoff;
  switch (ph) {
    case 0: prologue(p, smem); break;
    case 1: norm_phase(p, layer, 0); break;
    case 2: phase_g1(p, layer, smem); break;
    case 3: phase_pp(p, layer, smem); break;
    case 4: phase_g2(p, layer, smem); break;
    case 5: phase_at(p, layer, smem); break;
    case 6: phase_resid(p, layer, smem, true); break;
    case 7: norm_phase(p, layer, 1); break;
    case 8: phase_g5(p, layer, smem); break;
    case 9: phase_resid(p, layer, smem, false); break;
    case 10: norm_phase(p, 0, 2); break;
  }
}

extern __shared__ __attribute__((aligned(16))) char dyn_smem[];

__global__ void __launch_bounds__(512) fwd_mega(P p) {
  if (p.ws == nullptr) { cg::grid_group grid = cg::this_grid(); grid.sync(); }
  volatile LAS unsigned* st = (volatile LAS unsigned*)(dyn_smem + LDS_BYTES);
  if (threadIdx.x == 0) { st[0] = 0u; st[1] = 0u; st[2] = 0u; st[3] = 0u; }
  __syncthreads();
  XcdBarrier xb = xcd_barrier_post((unsigned*)(p.ws + OFF_BAR), st);
  run_phase(p, 0, 0, dyn_smem);
  xcd_barrier(xb);
  if (threadIdx.x == 0) {
    unsigned* bar = (unsigned*)(p.ws + OFF_BAR);
    bool ok = (gridDim.x & 7u) == 0u;
    for (unsigned j = 0; j < 16; ++j) { const unsigned c = xb_ld(&bar[XB_XCNT(j)]); ok = ok && (c == (j < 8 ? gridDim.x >> 3 : 0u)); }
    if (ok) st[3] = xb.x; else { st[2] = blockIdx.x >> 3; st[3] = blockIdx.x & 7u; }
  }
  __syncthreads();
  for (int l = 0; l < 2; ++l) {
    for (int ph = 1; ph <= 9; ++ph) {
      run_phase(p, ph, l, dyn_smem);
      xcd_barrier(xb);
    }
  }
  run_phase(p, 10, 0, dyn_smem);
}

#if !MEGA
__global__ void __launch_bounds__(512) fwd_phase(P p, int ph, int layer) { run_phase(p, ph, layer, dyn_smem); }
#endif

extern "C" void kernel_launch(void* const* d_in, const int* in_sizes, int n_in, void* d_out, int out_size, void* d_ws, size_t ws_size,
                              hipStream_t stream) {
  static int grid_blocks = 0;
  if (!grid_blocks) {
    int dev = 0, cus = 0, per_cu = 0;
    (void)hipGetDevice(&dev);
    (void)hipDeviceGetAttribute(&cus, hipDeviceAttributeMultiprocessorCount, dev);
    (void)hipFuncSetAttribute((const void*)fwd_mega, hipFuncAttributeMaxDynamicSharedMemorySize, LDS_BYTES + 16);
#if !MEGA
    (void)hipFuncSetAttribute((const void*)fwd_phase, hipFuncAttributeMaxDynamicSharedMemorySize, LDS_BYTES);
#endif
    (void)hipOccupancyMaxActiveBlocksPerMultiprocessor(&per_cu, (const void*)fwd_mega, NTHR, LDS_BYTES + 16);
    if (per_cu < 1) per_cu = 1;
    if (per_cu > 1) per_cu = 1;
    grid_blocks = cus * per_cu;
    if (ws_size < WS_NEED) fprintf(stderr, "kernel_launch: workspace too small: %zu < %zu\n", ws_size, (size_t)WS_NEED);
  }
  P p{};
  for (int i = 0; i < N_IN; ++i) p.in[i] = (const float*)d_in[i];
  p.out = (float*)d_out;
  p.ws = (char*)d_ws;
#if MEGA
  (void)hipMemsetAsync((char*)d_ws + OFF_BAR, 0, XCD_BAR_WORDS * 4, stream);
  void* args[] = {&p};
  hipError_t e = hipLaunchCooperativeKernel((const void*)fwd_mega, dim3(grid_blocks), dim3(NTHR), args, LDS_BYTES + 16, stream);
  if (e != hipSuccess) fprintf(stderr, "cooperative launch failed: %s (grid %d)\n", hipGetErrorString(e), grid_blocks);
#else
  hipLaunchKernelGGL(fwd_phase, dim3(grid_blocks), dim3(NTHR), LDS_BYTES, stream, p, 0, 0);
  for (int l = 0; l < 2; ++l)
    for (int ph = 1; ph <= 9; ++ph) hipLaunchKernelGGL(fwd_phase, dim3(grid_blocks), dim3(NTHR), LDS_BYTES, stream, p, ph, l);
  hipLaunchKernelGGL(fwd_phase, dim3(grid_blocks), dim3(NTHR), LDS_BYTES, stream, p, 10, 0);
#endif
}
```

```cpp
#include <hip/hip_runtime.h>
#include <hip/hip_cooperative_groups.h>
#include <cstdio>
namespace cg = cooperative_groups;

#ifndef MEGA
#define MEGA 1
#endif

#define DI __device__ __forceinline__
typedef unsigned short u16;
typedef __attribute__((ext_vector_type(8))) short bf16x8;
typedef __attribute__((ext_vector_type(4))) short bf16x4;
typedef __attribute__((ext_vector_type(2))) __bf16 bf2_t;
typedef __attribute__((ext_vector_type(2))) float f32x2;
typedef __attribute__((ext_vector_type(4))) float f32x4;
typedef __attribute__((ext_vector_type(16))) float f32x16;
typedef __attribute__((ext_vector_type(4))) unsigned u32x4;
typedef __attribute__((ext_vector_type(2))) unsigned u32x2;

#define MFMA32(a, b, c) __builtin_amdgcn_mfma_f32_32x32x16_bf16((a), (b), (c), 0, 0, 0)
#define MFMA16(a, b, c) __builtin_amdgcn_mfma_f32_16x16x32_bf16((a), (b), (c), 0, 0, 0)

constexpr int NT = 12288;
constexpr int NCTX = 8192;
constexpr int NKR = 14336;
constexpr int NP = 1920;
constexpr float EPSF = 1e-6f;
constexpr float LOG2E = 1.4426950408889634f;

enum { I_XP = 0, I_XS, I_CDK, I_CDV, I_CGK, I_CGV, I_CCKV, I_CKR, I_SRE, I_SIM, I_C, I_CCTX, I_N1G, I_N2G, I_WADA, I_BADA,
       I_WIN, I_WOUT, I_LQ1, I_LK1, I_LQ2, I_LK2, I_SUBLN, I_QNG, I_KNG, I_ARE, I_AIM, I_LOGDT, I_BRE, I_BIM, I_CRE, I_CIM,
       I_SSMD, I_WGLU, I_MQNG, I_MKVNG, I_WUQ, I_WUKV, I_W1, I_W2, I_FNG, N_IN };

constexpr size_t O_Y = 0;
constexpr size_t O_DK = 12582912;
constexpr size_t O_DV = 16777216;
constexpr size_t O_GK = 20971520;
constexpr size_t O_GV = 23068672;
constexpr size_t O_CKV = 25165824;
constexpr size_t O_KR = 27262976;
constexpr size_t O_SRE = 27787264;
constexpr size_t O_SIM = 27918336;

constexpr size_t al256(size_t x) { return (x + 255) & ~(size_t)255; }
constexpr size_t OFF_MOD = 0;
constexpr size_t OFF_CTR = al256(OFF_MOD + 2 * 5 * 6144 * 4);
constexpr size_t OFF_BAR = al256(OFF_CTR + 256);
constexpr size_t OFF_ROPE = al256(OFF_BAR + 3456 * 4);
constexpr size_t OFF_ABAR = al256(OFF_ROPE + 2 * 64 * 16 * 8);
constexpr size_t OFF_ATAB = al256(OFF_ABAR + 64 * 64 * 8);
constexpr size_t OFF_CTAB = al256(OFF_ATAB + 64 * 128 * 16 * 2);
constexpr size_t OFF_WIN = al256(OFF_CTAB + 64 * 16 * 128 * 2);
constexpr size_t OFF_WOUT = al256(OFF_WIN + (size_t)2 * 1920 * 1024 * 2);
constexpr size_t OFF_W1 = al256(OFF_WOUT + (size_t)2 * 1024 * 1024 * 2);
constexpr size_t OFF_W2 = al256(OFF_W1 + (size_t)2 * 4096 * 1024 * 2);
constexpr size_t OFF_WUQ = al256(OFF_W2 + (size_t)2 * 4096 * 1024 * 2);
constexpr size_t OFF_WUKV = al256(OFF_WUQ + (size_t)2 * 384 * 192 * 2);
constexpr size_t OFF_WGLU = al256(OFF_WUKV + (size_t)2 * 512 * 128 * 2);
constexpr size_t OFF_H = al256(OFF_WGLU + (size_t)2 * 512 * 256 * 2);
constexpr size_t OFF_MIXED = OFF_H;
constexpr size_t OFF_BIG = al256(OFF_H + (size_t)NT * 1024 * 2);
constexpr size_t OFF_PROJ = OFF_BIG;
constexpr size_t OFF_DQ = al256(OFF_PROJ + (size_t)NT * NP * 4);
constexpr size_t OFF_DKB = al256(OFF_DQ + (size_t)NT * 256 * 2);
constexpr size_t OFF_DVT = al256(OFF_DKB + (size_t)NKR * 256 * 2);
constexpr size_t OFF_GQ = al256(OFF_DVT + (size_t)NKR * 256 * 2);
constexpr size_t OFF_GKB = al256(OFF_GQ + (size_t)NT * 256 * 2);
constexpr size_t OFF_GVT = al256(OFF_GKB + (size_t)NKR * 128 * 2);
constexpr size_t OFF_MQ = al256(OFF_GVT + (size_t)NKR * 128 * 2);
constexpr size_t OFF_MKB = al256(OFF_MQ + (size_t)NT * 384 * 2);
constexpr size_t OFF_MVT = al256(OFF_MKB + (size_t)NKR * 384 * 2);
constexpr size_t OFF_CQN = al256(OFF_MVT + (size_t)NKR * 256 * 2);
constexpr size_t OFF_CKVN = al256(OFF_CQN + (size_t)NT * 192 * 2);
constexpr size_t OFF_YBUF = al256(OFF_CKVN + (size_t)NKR * 128 * 2);
constexpr size_t OFF_END1 = al256(OFF_YBUF + (size_t)2 * NT * 256 * 4);
constexpr size_t OFF_A = OFF_BIG;
constexpr size_t OFF_END2 = al256(OFF_A + (size_t)NT * 4096 * 2);
constexpr size_t WS_NEED = OFF_END1 > OFF_END2 ? OFF_END1 : OFF_END2;
static_assert(WS_NEED <= (size_t)256 * 1024 * 1024, "workspace over 256 MiB");

constexpr int NTHR = 512;
constexpr int NWV = NTHR / 64;
constexpr int LDS_BYTES = 8 * 32 * 132 * 4;

struct P {
  const float* in[N_IN];
  float* out;
  char* ws;
};

DI unsigned pack2(float a, float b) { f32x2 v = {a, b}; return __builtin_bit_cast(unsigned, __builtin_convertvector(v, bf2_t)); }
DI u16 f2bf(float a) { return (u16)(pack2(a, 0.f) & 0xffffu); }
DI bf16x8 pack8(f32x4 a, f32x4 b) {
  u32x4 r = {pack2(a[0], a[1]), pack2(a[2], a[3]), pack2(b[0], b[1]), pack2(b[2], b[3])};
  return __builtin_bit_cast(bf16x8, r);
}
DI f32x4 ld4bf(const u16* p) {
  const u32x2 w = *(const u32x2*)p;
  f32x4 r = {__uint_as_float(w[0] << 16), __uint_as_float(w[0] & 0xffff0000u), __uint_as_float(w[1] << 16), __uint_as_float(w[1] & 0xffff0000u)};
  return r;
}
DI u32x2 pack4(f32x4 a) { u32x2 r = {pack2(a[0], a[1]), pack2(a[2], a[3])}; return r; }
DI int get_tid() { int t = threadIdx.x; asm volatile("" : "+v"(t)); return t; }
DI float fexp2(float x) { return __builtin_amdgcn_exp2f(x); }
DI float frcp(float x) { return __builtin_amdgcn_rcpf(x); }
DI float fsigmoid(float w) { return frcp(1.f + fexp2(-w * LOG2E)); }
DI float gelu_tanh(float x) { return x * fsigmoid(1.5957691216057308f * (x + 0.044715f * x * x * x)); }
DI float wave_sum(float v) {
#pragma unroll
  for (int o = 32; o >= 1; o >>= 1) v += __shfl_xor(v, o);
  return v;
}
DI void wave_lds_fence() {
  asm volatile("s_waitcnt lgkmcnt(0)" ::: "memory");
  __builtin_amdgcn_wave_barrier();
}
DI int fetch_item(int* ctr, int lane) {
  int v = 0;
  if (lane == 0) v = atomicAdd(ctr, 1);
  return __builtin_amdgcn_readfirstlane(v);
}
DI size_t vt_off(int b_all, int head, int H) {
  if (b_all < 32) return ((size_t)(b_all * H + head) * 64) * 256;
  return (size_t)32 * H * 64 * 256 + ((size_t)((b_all - 32) * H + head) * 64) * 1536;
}
DI int mod_index(int row) { return row < NCTX ? 0 : 1 + ((row - NCTX) >> 10); }

DI void prologue(const P& p, char* smem) {
  const int tid = get_tid();
  float* fs = (float*)smem;
  constexpr int N_ADA = 384, N_TAB = 64, N_MISC = 1, N_TR = 5700;
  constexpr int TOTAL = N_ADA + N_TAB + N_MISC;
  for (int it = blockIdx.x; it < TOTAL; it += gridDim.x) {
    if (it < N_ADA) {
      const int l = it / 192, ch = it % 192;
      float* sc = fs;
      float* red = fs + 5 * 1024;
      for (int i = tid; i < 5 * 1024; i += NTHR) {
        int m = i >> 10, k = i & 1023;
        float c = (m == 0) ? p.in[I_CCTX][k] : p.in[I_C][(m - 1) * 1024 + k];
        sc[i] = c * fsigmoid(c);
      }
      __syncthreads();
      const int col = tid & 31, kg = tid >> 5;
      const float* w = p.in[I_WADA] + ((size_t)l * 1024 + kg * 64) * 6144 + ch * 32 + col;
      float a0 = 0, a1 = 0, a2 = 0, a3 = 0, a4 = 0;
#pragma unroll 16
      for (int k = 0; k < 64; ++k) {
        float wv = w[(size_t)k * 6144];
        int kk = kg * 64 + k;
        a0 += sc[kk] * wv; a1 += sc[1024 + kk] * wv; a2 += sc[2048 + kk] * wv; a3 += sc[3072 + kk] * wv; a4 += sc[4096 + kk] * wv;
      }
      red[(kg * 5 + 0) * 32 + col] = a0; red[(kg * 5 + 1) * 32 + col] = a1; red[(kg * 5 + 2) * 32 + col] = a2;
      red[(kg * 5 + 3) * 32 + col] = a3; red[(kg * 5 + 4) * 32 + col] = a4;
      __syncthreads();
      if (tid < 160) {
        int m = tid >> 5, c2 = tid & 31;
        float s = 0;
#pragma unroll
        for (int g = 0; g < 16; ++g) s += red[(g * 5 + m) * 32 + c2];
        int n = ch * 32 + c2;
        s += p.in[I_BADA][l * 6144 + n];
        ((float*)(p.ws + OFF_MOD))[((size_t)l * 5 + m) * 6144 + n] = s;
      }
      __syncthreads();
    } else if (it < N_ADA + N_TAB) {
      const int idx = it - N_ADA;
      if (tid < 64) {
        const int pp = tid;
        float are = p.in[I_ARE][idx * 64 + pp], aim = p.in[I_AIM][idx * 64 + pp];
        float dt = expf(p.in[I_LOGDT][idx]);
        float zr = are * dt, zi = aim * dt;
        float e = expf(zr);
        float abr = e * cosf(zi), abi = e * sinf(zi);
        float d2 = are * are + aim * aim;
        float nr = abr - 1.f, ni = abi;
        float qr = (nr * are + ni * aim) / d2, qi = (ni * are - nr * aim) / d2;
        u16* at = (u16*)(p.ws + OFF_ATAB) + (size_t)idx * 128 * 16;
        u16* ct = (u16*)(p.ws + OFF_CTAB) + (size_t)idx * 16 * 128;
        for (int c = 0; c < 16; ++c) {
          float bre = p.in[I_BRE][((size_t)idx * 64 + pp) * 16 + c], bim = p.in[I_BIM][((size_t)idx * 64 + pp) * 16 + c];
          at[(2 * pp) * 16 + c] = f2bf(qr * bre - qi * bim);
          at[(2 * pp + 1) * 16 + c] = f2bf(qr * bim + qi * bre);
          float cre = p.in[I_CRE][((size_t)idx * 16 + c) * 64 + pp], cim = p.in[I_CIM][((size_t)idx * 16 + c) * 64 + pp];
          ct[c * 128 + 2 * pp] = f2bf(cre);
          ct[c * 128 + 2 * pp + 1] = f2bf(-cim);
        }
        float* ab = (float*)(p.ws + OFF_ABAR) + ((size_t)idx * 64 + pp) * 2;
        ab[0] = abr; ab[1] = abi;
      }
    } else if (it < N_ADA + N_TAB + N_MISC) {
      f32x2* tab = (f32x2*)(p.ws + OFF_ROPE);
      for (int i = tid; i < 2 * 64 * 16; i += NTHR) {
        int kind = i >> 10, pos = (i >> 4) & 63, fi = i & 15;
        int n = kind ? 16 : 8;
        float freq = expf(-(float)(fi % n) / (float)n * 9.210340371976184f);
        float ang = (float)pos * freq;
        f32x2 cs = {cosf(ang), sinf(ang)};
        tab[i] = cs;
      }
      if (tid < 64) ((int*)(p.ws + OFF_CTR))[tid] = 0;
    }
  }
  struct TrD { const float* src; u16* dst; int K, N, k0, n0; bool glu; };
  auto decode = [&](int tt) {
    TrD d; d.glu = false;
    const int l = tt / 2850;
    int r = tt % 2850; int kt, nt;
    if (r < 480) { d.src = p.in[I_WIN] + (size_t)l * 1024 * 1888; d.dst = (u16*)(p.ws + OFF_WIN) + (size_t)l * 1920 * 1024; d.K = 1024; d.N = 1888; kt = r / 30; nt = r % 30; }
    else if (r < 736) { r -= 480; d.src = p.in[I_WOUT] + (size_t)l * 1024 * 1024; d.dst = (u16*)(p.ws + OFF_WOUT) + (size_t)l * 1024 * 1024; d.K = 1024; d.N = 1024; kt = r / 16; nt = r % 16; }
    else if (r < 1760) { r -= 736; d.src = p.in[I_W1] + (size_t)l * 1024 * 4096; d.dst = (u16*)(p.ws + OFF_W1) + (size_t)l * 4096 * 1024; d.K = 1024; d.N = 4096; kt = r / 64; nt = r % 64; }
    else if (r < 2784) { r -= 1760; d.src = p.in[I_W2] + (size_t)l * 4096 * 1024; d.dst = (u16*)(p.ws + OFF_W2) + (size_t)l * 1024 * 4096; d.K = 4096; d.N = 1024; kt = r / 16; nt = r % 16; }
    else if (r < 2802) { r -= 2784; d.src = p.in[I_WUQ] + (size_t)l * 192 * 384; d.dst = (u16*)(p.ws + OFF_WUQ) + (size_t)l * 384 * 192; d.K = 192; d.N = 384; kt = r / 6; nt = r % 6; }
    else if (r < 2818) { r -= 2802; d.src = p.in[I_WUKV] + (size_t)l * 128 * 512; d.dst = (u16*)(p.ws + OFF_WUKV) + (size_t)l * 512 * 128; d.K = 128; d.N = 512; kt = r / 8; nt = r % 8; }
    else { r -= 2818; d.src = p.in[I_WGLU] + (size_t)l * 256 * 512; d.dst = (u16*)(p.ws + OFF_WGLU) + (size_t)l * 512 * 256; d.K = 256; d.N = 512; kt = r / 8; nt = r % 8; d.glu = true; }
    d.k0 = kt * 64; d.n0 = nt * 64;
    return d;
  };
  const int half = tid >> 8, t2 = tid & 255;
  float* ft = fs + half * (64 * 65);
  const int tx = t2 & 15, ty = t2 >> 4;
  auto tload = [&](const TrD& d, f32x4 (&v)[4]) {
#pragma unroll
    for (int i = 0; i < 4; ++i) {
      const int kk = ty + 16 * i, n = d.n0 + 4 * tx;
      f32x4 z = {0.f, 0.f, 0.f, 0.f};
      v[i] = (n < d.N) ? *(const f32x4*)(d.src + (size_t)(d.k0 + kk) * d.N + n) : z;
    }
  };
  const int nvb = 2 * (int)gridDim.x;
  const int tb = nvb - 1 - (2 * (int)blockIdx.x + half);
  const int nrounds = (N_TR + nvb - 1) / nvb;
  TrD cur = decode(tb < N_TR ? tb : 0);
  f32x4 cv[4];
  if (tb < N_TR) tload(cur, cv);
  for (int j = 0; j < nrounds; ++j) {
    const int tt = tb + j * nvb;
    const bool valid = tt < N_TR, more = tt + nvb < N_TR;
    TrD nxt = decode(more ? tt + nvb : 0);
    f32x4 nv[4];
    if (more) tload(nxt, nv);
    if (valid) {
#pragma unroll
      for (int i = 0; i < 4; ++i) {
        const int kk = ty + 16 * i;
        ft[kk * 65 + 4 * tx + 0] = cv[i][0]; ft[kk * 65 + 4 * tx + 1] = cv[i][1]; ft[kk * 65 + 4 * tx + 2] = cv[i][2]; ft[kk * 65 + 4 * tx + 3] = cv[i][3];
      }
    }
    __syncthreads();
    if (valid) {
#pragma unroll
      for (int i = 0; i < 2; ++i) {
        const int c = t2 + 256 * i, nn = c >> 3, kc = (c & 7) * 8;
        f32x4 a, b;
#pragma unroll
        for (int e = 0; e < 4; ++e) { a[e] = ft[(kc + e) * 65 + nn]; b[e] = ft[(kc + 4 + e) * 65 + nn]; }
        const int n = cur.n0 + nn;
        int drow = n;
        if (cur.glu) drow = (n < 256) ? ((n >> 5) * 64 + (n & 31)) : (((n - 256) >> 5) * 64 + 32 + (n & 31));
        *(bf16x8*)(cur.dst + (size_t)drow * cur.K + cur.k0 + kc) = pack8(a, b);
      }
    }
    __syncthreads();
    cur = nxt;
    if (more) {
#pragma unroll
      for (int i = 0; i < 4; ++i) cv[i] = nv[i];
    }
  }
}

DI const float* x_row_src(const P& p, int layer, int row) {
  if (layer == 0) return row < NCTX ? p.in[I_XP] + (size_t)row * 1024 : p.in[I_XS] + (size_t)(row - NCTX) * 1024;
  return p.out + (size_t)row * 1024;
}
DI void norm_phase(const P& p, int layer, int which) {
  const int tid_ = get_tid();
  const int lane = tid_ & 63;
  const int gw = blockIdx.x * NWV + (tid_ >> 6), nw = gridDim.x * NWV;
  auto src_of = [&](int row) { return (which == 0) ? x_row_src(p, layer, row) : (const float*)(p.out + (size_t)row * 1024); };
  f32x4 v[4];
  if (gw < NT) {
    const float* xs = src_of(gw);
#pragma unroll
    for (int i = 0; i < 4; ++i) v[i] = *(const f32x4*)(xs + (i * 64 + lane) * 4);
  }
  for (int row = gw; row < NT; row += nw) {
    f32x4 nv[4];
    const bool more = row + nw < NT;
    if (more) {
      const float* xs = src_of(row + nw);
#pragma unroll
      for (int i = 0; i < 4; ++i) nv[i] = *(const f32x4*)(xs + (i * 64 + lane) * 4);
    }
    float ss = 0;
#pragma unroll
    for (int i = 0; i < 4; ++i) ss += v[i][0] * v[i][0] + v[i][1] * v[i][1] + v[i][2] * v[i][2] + v[i][3] * v[i][3];
    ss = wave_sum(ss);
    const float r = rsqrtf(ss * (1.f / 1024.f) + EPSF);
    if (which == 2) {
      f32x4 g[4];
#pragma unroll
      for (int i = 0; i < 4; ++i) g[i] = *(const f32x4*)(p.in[I_FNG] + (i * 64 + lane) * 4);
#pragma unroll
      for (int i = 0; i < 4; ++i) {
        int e = (i * 64 + lane) * 4;
        f32x4 o = v[i] * r * g[i];
        *(f32x4*)(p.out + (size_t)row * 1024 + e) = o;
      }
    } else {
      const float* gn = p.in[which == 0 ? I_N1G : I_N2G] + layer * 1024;
      const float* md = (const float*)(p.ws + OFF_MOD) + ((size_t)layer * 5 + mod_index(row)) * 6144 + (which == 0 ? 0 : 3072);
      u16* h = (u16*)(p.ws + OFF_H) + (size_t)row * 1024;
      f32x4 g[4], sh[4], sc[4];
#pragma unroll
      for (int i = 0; i < 4; ++i) {
        int e = (i * 64 + lane) * 4;
        g[i] = *(const f32x4*)(gn + e);
        sh[i] = *(const f32x4*)(md + e);
        sc[i] = *(const f32x4*)(md + 1024 + e);
      }
#pragma unroll
      for (int i = 0; i < 4; ++i) {
        int e = (i * 64 + lane) * 4;
        f32x4 o = v[i] * r * g[i] * (1.f + sc[i]) + sh[i];
        *(u32x2*)(h + e) = pack4(o);
      }
    }
    if (more) {
#pragma unroll
      for (int i = 0; i < 4; ++i) v[i] = nv[i];
    }
  }
}

#define LAS3 __attribute__((address_space(3)))
template <int NI>
DI void stage_tile_dma(const u16* __restrict__ G, int ld, int row0, int k0, char* lds, int tid) {
#pragma unroll
  for (int i = 0; i < NI; ++i) {
    const int q = tid + NTHR * i, r = q >> 3, c = (q & 7) ^ ((r >> 1) & 7);
    __builtin_amdgcn_global_load_lds((const unsigned*)(G + (size_t)(row0 + r) * ld + k0 + c * 8), (LAS3 unsigned*)(lds + q * 16), 16, 0, 0);
  }
}
struct TD { const u16* A; const u16* B; int lda, ldb, k0, nk, m0, n0; };
template <int NB>
DI void stage_td(const TD& d, int kt, char* stage_base, int tid) {
  stage_tile_dma<4>(d.A, d.lda, d.m0, d.k0 + kt * 64, stage_base, tid);
  stage_tile_dma<2 * NB>(d.B, d.ldb, d.n0, d.k0 + kt * 64, stage_base + 32768, tid);
}
template <int NB>
DI void gemm_stream(const TD& cur, bool has_next, const TD& nxt, char* smem, int& buf, f32x16 (&acc)[4][NB]) {
  const int tid = get_tid(), lane = tid & 63, wave = tid >> 6, wm = wave >> 2, wn = wave & 3, l32 = lane & 31, hh = lane >> 5;
#pragma unroll
  for (int bi = 0; bi < 4; ++bi)
#pragma unroll
    for (int bj = 0; bj < NB; ++bj)
#pragma unroll
      for (int r = 0; r < 16; ++r) acc[bi][bj][r] = 0.f;
  const int swz = (l32 >> 1) & 7;
  const int arow = (wm * 128 + l32) * 128, brow = (wn * (NB * 32) + l32) * 128;
  const int c0 = ((0 + hh) ^ swz) * 16, c1 = ((2 + hh) ^ swz) * 16, c2 = ((4 + hh) ^ swz) * 16, c3 = ((6 + hh) ^ swz) * 16;
  asm volatile("s_waitcnt vmcnt(0)" ::: "memory");
  __syncthreads();
  const int nk = cur.nk;
  for (int kt = 0; kt < nk; ++kt) {
    const bool early = wave < 4;
    if (early) {
      if (kt + 1 < nk) stage_td<NB>(cur, kt + 1, smem + (buf ^ 1) * 65536, tid);
      else if (has_next) stage_td<NB>(nxt, 0, smem + (buf ^ 1) * 65536, tid);
    }
    const char* as = smem + buf * 65536 + arow;
    const char* bs = smem + buf * 65536 + 32768 + brow;
#pragma unroll
    for (int ks = 0; ks < 4; ++ks) {
      const int co = (ks == 0) ? c0 : (ks == 1) ? c1 : (ks == 2) ? c2 : c3;
      bf16x8 fa[4], fb[NB];
#pragma unroll
      for (int bi = 0; bi < 4; ++bi) fa[bi] = *(const bf16x8*)(as + bi * 4096 + co);
#pragma unroll
      for (int bj = 0; bj < NB; ++bj) fb[bj] = *(const bf16x8*)(bs + bj * 4096 + co);
      __builtin_amdgcn_s_setprio(1);
#pragma unroll
      for (int bi = 0; bi < 4; ++bi)
#pragma unroll
        for (int bj = 0; bj < NB; ++bj) acc[bi][bj] = MFMA32(fa[bi], fb[bj], acc[bi][bj]);
      __builtin_amdgcn_s_setprio(0);
      if (ks == 1 && !early) {
        if (kt + 1 < nk) stage_td<NB>(cur, kt + 1, smem + (buf ^ 1) * 65536, tid);
        else if (has_next) stage_td<NB>(nxt, 0, smem + (buf ^ 1) * 65536, tid);
      }
    }
    buf ^= 1;
    if (kt + 1 < nk) {
      asm volatile("s_waitcnt vmcnt(0)" ::: "memory");
      __syncthreads();
    }
  }
}

#if MEGA
#define XCD_ID()   ((int)((volatile int*)(smem + LDS_BYTES))[3])
#define XCD_RANK() ((int)((volatile int*)(smem + LDS_BYTES))[2])
#else
#define XCD_ID()   ((int)(blockIdx.x & 7))
#define XCD_RANK() ((int)(blockIdx.x >> 3))
#endif
#define EPI_IDX                                                                                        \
  const int tid = get_tid(), lane = tid & 63, wave = tid >> 6, wm = wave >> 2, wn = wave & 3, l32 = lane & 31, hh = lane >> 5; \
  (void)tid; (void)lane; (void)wave; (void)wm; (void)wn; (void)l32; (void)hh;
DI int crow(int r, int hh) { return (r & 3) + 8 * (r >> 2) + 4 * hh; }

DI void phase_g1(const P& p, int layer, char* smem) {
  EPI_IDX
  const u16* A = (const u16*)(p.ws + OFF_H);
  const u16* Bt = (const u16*)(p.ws + OFF_WIN) + (size_t)layer * 1920 * 1024;
  u16* proj = (u16*)(p.ws + OFF_PROJ);
  constexpr int MT = NT / 256, NTL = NP / 128, MPX = MT / 8;
  const int xcd_ = XCD_ID(), xj_ = XCD_RANK(), xn_ = gridDim.x >> 3;
  auto tile_at = [&](int u) { TD d; d.A = A; d.B = Bt; d.lda = 1024; d.ldb = 1024; d.k0 = 0; d.nk = 16; d.m0 = (xcd_ * MPX + u % MPX) * 256; d.n0 = (u / MPX) * 128; return d; };
  int buf = 0;
  TD cur = tile_at(xj_ < MPX * NTL ? xj_ : 0);
  if (xj_ < MPX * NTL) stage_td<1>(cur, 0, smem, tid);
  for (int u = xj_; u < MPX * NTL; u += xn_) {
    const bool has_next = (u + xn_ < MPX * NTL);
    const TD nxt = tile_at(has_next ? u + xn_ : u);
    const int m0 = cur.m0, n0 = cur.n0;
    f32x16 acc[4][1];
    gemm_stream<1>(cur, has_next, nxt, smem, buf, acc);
    cur = nxt;
    const bool lat = m0 >= NCTX;
    const int b_all = lat ? 32 + ((m0 - NCTX) >> 10) : (m0 >> 8);
    const int nkk = lat ? 1536 : 256;
#pragma unroll
    for (int bi = 0; bi < 4; ++bi)
#pragma unroll
      for (int bj = 0; bj < 1; ++bj) {
        const int rb = m0 + wm * 128 + bi * 32;
        const int cb = n0 + wn * 32 + bj * 32;
        const int col = cb + l32;
        if (cb < NP) {
#pragma unroll
          for (int r = 0; r < 16; ++r) proj[(size_t)(rb + crow(r, hh)) * NP + col] = f2bf(acc[bi][bj][r]);
        }
        const bool isdv = (cb >= 512 && cb < 768), isgv = (cb >= 1152 && cb < 1280);
        if (isdv || isgv) {
          u16* vt; int f;
          if (isdv) { f = col - 512; vt = (u16*)(p.ws + OFF_DVT) + vt_off(b_all, f >> 6, 4); }
          else { f = col - 1152; vt = (u16*)(p.ws + OFF_GVT) + vt_off(b_all, f >> 6, 2); }
          vt += (size_t)(f & 63) * nkk;
#pragma unroll
          for (int j = 0; j < 4; ++j) {
            int row = rb + 16 * (j >> 1) + 8 * hh + 4 * (j & 1);
            int key = lat ? 512 + ((row - NCTX) & 1023) : (row & 255);
            f32x4 v = {acc[bi][bj][4 * j], acc[bi][bj][4 * j + 1], acc[bi][bj][4 * j + 2], acc[bi][bj][4 * j + 3]};
            *(u32x2*)(vt + key) = pack4(v);
          }
        }
      }
  }
}

DI void phase_g2(const P& p, int layer, char* smem) {
  EPI_IDX
  constexpr int T_MQ = (NT / 256) * 2, T_MKV = (NKR / 256) * 2;
  const f32x2* tab32 = (const f32x2*)(p.ws + OFF_ROPE);
  auto tile_at = [&](int t) {
    TD d; d.k0 = 0;
    if (t < T_MQ) { d.A = (const u16*)(p.ws + OFF_CQN); d.B = (const u16*)(p.ws + OFF_WUQ) + (size_t)layer * 384 * 192; d.lda = 192; d.ldb = 192; d.nk = 3; d.m0 = (t >> 1) * 256; d.n0 = (t & 1) * 256; }
    else { const int t2 = t - T_MQ; d.A = (const u16*)(p.ws + OFF_CKVN); d.B = (const u16*)(p.ws + OFF_WUKV) + (size_t)layer * 512 * 128; d.lda = 128; d.ldb = 128; d.nk = 2; d.m0 = (t2 >> 1) * 256; d.n0 = (t2 & 1) * 256; }
    return d;
  };
  int buf = 0;
  const int t_first = blockIdx.x;
  TD cur = tile_at(t_first < T_MQ + T_MKV ? t_first : 0);
  if (t_first < T_MQ + T_MKV) stage_td<2>(cur, 0, smem, tid);
  for (int t = blockIdx.x; t < T_MQ + T_MKV; t += gridDim.x) {
    const bool has_next = (t + (int)gridDim.x < T_MQ + T_MKV);
    const TD nxt = tile_at(has_next ? t + (int)gridDim.x : t);
    f32x16 acc[4][2];
    const int m0 = cur.m0, n0 = cur.n0;
    gemm_stream<2>(cur, has_next, nxt, smem, buf, acc);
    cur = nxt;
    if (t < T_MQ) {
      const bool lat = m0 >= NCTX;
      const float scl = 0.10206207261596575f * LOG2E;
      u16* mq = (u16*)(p.ws + OFF_MQ);
#pragma unroll
      for (int bi = 0; bi < 4; ++bi)
#pragma unroll
        for (int bj = 0; bj < 2; ++bj) {
          const int rb = m0 + wm * 128 + bi * 32;
          const int cb = n0 + wn * 64 + bj * 32;
          const int col = cb + l32;
          if (cb < 384) {
            const bool isrope = lat && ((cb % 96) == 64);
            const int e = l32, w2 = e & 15, fi = w2 & 7;
            const bool isx2 = w2 >= 8, half = e >= 16;
#pragma unroll
            for (int r = 0; r < 16; ++r) {
              float v = acc[bi][bj][r];
              const int row = rb + crow(r, hh);
              if (isrope) {
                const int tt = (row - NCTX) & 1023;
                const int pos = half ? (tt & 63) : (tt >> 6);
                const f32x2 cs = tab32[pos * 16 + fi];
                float pv = __shfl_xor(v, 8);
                v = v * cs[0] + (isx2 ? pv : -pv) * cs[1];
              }
              mq[(size_t)row * 384 + col] = f2bf(v * scl);
            }
          }
        }
    } else {
      const bool lat = m0 >= NCTX;
      const int b_all = lat ? 32 + (m0 - NCTX) / 1536 : (m0 >> 8);
      const int nkk = lat ? 1536 : 256;
      const int kbase = lat ? (m0 - NCTX) % 1536 : (m0 & 255);
      u16* mk = (u16*)(p.ws + OFF_MKB);
#pragma unroll
      for (int bi = 0; bi < 4; ++bi)
#pragma unroll
        for (int bj = 0; bj < 2; ++bj) {
          const int rloc = wm * 128 + bi * 32;
          const int cb = n0 + wn * 64 + bj * 32;
          const int head = cb >> 7, wc = (cb & 127) + l32;
          if ((cb & 127) < 64) {
#pragma unroll
            for (int r = 0; r < 16; ++r) mk[(size_t)(m0 + rloc + crow(r, hh)) * 384 + head * 96 + wc] = f2bf(acc[bi][bj][r]);
          } else {
            u16* vt = (u16*)(p.ws + OFF_MVT) + vt_off(b_all, head, 4) + (size_t)(wc - 64) * nkk + kbase + rloc;
#pragma unroll
            for (int j = 0; j < 4; ++j) {
              f32x4 v = {acc[bi][bj][4 * j], acc[bi][bj][4 * j + 1], acc[bi][bj][4 * j + 2], acc[bi][bj][4 * j + 3]};
              *(u32x2*)(vt + 16 * (j >> 1) + 8 * hh + 4 * (j & 1)) = pack4(v);
            }
          }
        }
    }
  }
  {
    const int gw = blockIdx.x * NWV + wave, nw = gridDim.x * NWV;
    const f32x4 dd = *(const f32x4*)(p.in[I_SSMD] + layer * 256 + lane * 4);
    for (int row = gw; row < NT; row += nw) {
      const float* y0 = (const float*)(p.ws + OFF_YBUF) + (size_t)row * 256 + lane * 4;
      u16* prow = (u16*)(p.ws + OFF_PROJ) + (size_t)row * NP;
      f32x4 a = *(const f32x4*)y0, b = *(const f32x4*)(y0 + (size_t)NT * 256), c = ld4bf(prow + 1280 + lane * 4);
      f32x4 sv = a + b + c * dd;
      f32x4 g = {gelu_tanh(sv[0]), gelu_tanh(sv[1]), gelu_tanh(sv[2]), gelu_tanh(sv[3])};
      *(u32x2*)(prow + lane * 4) = pack4(g);
    }
  }
}

DI void phase_resid(const P& p, int layer, char* smem, bool is_out) {
  EPI_IDX
  const u16* A = is_out ? (const u16*)(p.ws + OFF_MIXED) : (const u16*)(p.ws + OFF_A);
  const int K = is_out ? 1024 : 4096;
  const u16* Bt = is_out ? (const u16*)(p.ws + OFF_WOUT) + (size_t)layer * 1024 * 1024 : (const u16*)(p.ws + OFF_W2) + (size_t)layer * 1024 * 4096;
  constexpr int MT = NT / 256, NTL = 4, MPX = MT / 8, NU = MPX * NTL;
  const int xcd_ = XCD_ID(), xj_ = XCD_RANK(), xn_ = gridDim.x >> 3;
  auto tile_at = [&](int u) {
    TD d; d.A = A; d.B = Bt; d.lda = K; d.ldb = K; d.nk = K / 64; d.k0 = 0;
    d.n0 = (u % NTL) * 256;
    d.m0 = (xcd_ * MPX + u / NTL) * 256;
    return d;
  };
  int buf = 0;
  TD cur = tile_at(xj_ < NU ? xj_ : 0);
  if (xj_ < NU) stage_td<2>(cur, 0, smem, tid);
  for (int u = xj_; u < NU; u += xn_) {
    const bool has_next = (u + xn_ < NU);
    const TD nxt = tile_at(has_next ? u + xn_ : u);
    const int m0 = cur.m0, n0 = cur.n0;
    f32x16 acc[4][2];
    gemm_stream<2>(cur, has_next, nxt, smem, buf, acc);
    cur = nxt;
    const float* gate = (const float*)(p.ws + OFF_MOD) + ((size_t)layer * 5 + mod_index(m0)) * 6144 + (is_out ? 2048 : 5120);
#pragma unroll
    for (int bi = 0; bi < 4; ++bi)
#pragma unroll
      for (int bj = 0; bj < 2; ++bj) {
        const int rb = m0 + wm * 128 + bi * 32;
        const int col = n0 + wn * 64 + bj * 32 + l32;
        const float g = gate[col];
        float rv[16];
#pragma unroll
        for (int r = 0; r < 16; ++r) {
          const int row = rb + crow(r, hh);
          rv[r] = (is_out && layer == 0) ? x_row_src(p, 0, row)[col] : p.out[(size_t)row * 1024 + col];
        }
#pragma unroll
        for (int r = 0; r < 16; ++r) p.out[(size_t)(rb + crow(r, hh)) * 1024 + col] = rv[r] + g * acc[bi][bj][r];
      }
  }
}

DI void phase_g5(const P& p, int layer, char* smem) {
  EPI_IDX
  const u16* A = (const u16*)(p.ws + OFF_H);
  const u16* Bt = (const u16*)(p.ws + OFF_W1) + (size_t)layer * 4096 * 1024;
  u16* a = (u16*)(p.ws + OFF_A);
  constexpr int MT = NT / 256, NTL = 16, MPX = MT / 8;
  const int xcd_ = XCD_ID(), xj_ = XCD_RANK(), xn_ = gridDim.x >> 3;
  auto tile_at = [&](int u) { TD d; d.A = A; d.B = Bt; d.lda = 1024; d.ldb = 1024; d.k0 = 0; d.nk = 16; d.m0 = (xcd_ * MPX + u % MPX) * 256; d.n0 = (u / MPX) * 256; return d; };
  int buf = 0;
  TD cur = tile_at(xj_ < MPX * NTL ? xj_ : 0);
  if (xj_ < MPX * NTL) stage_td<2>(cur, 0, smem, tid);
  for (int u = xj_; u < MPX * NTL; u += xn_) {
    const bool has_next = (u + xn_ < MPX * NTL);
    const TD nxt = tile_at(has_next ? u + xn_ : u);
    const int m0 = cur.m0, n0 = cur.n0;
    f32x16 acc[4][2];
    gemm_stream<2>(cur, has_next, nxt, smem, buf, acc);
    cur = nxt;
#pragma unroll
    for (int bi = 0; bi < 4; ++bi)
#pragma unroll
      for (int bj = 0; bj < 2; ++bj) {
        const int rb = m0 + wm * 128 + bi * 32;
        const int col = n0 + wn * 64 + bj * 32 + l32;
#pragma unroll
        for (int r = 0; r < 16; ++r) {
          float v = fmaxf(acc[bi][bj][r], 0.f);
          a[(size_t)(rb + crow(r, hh)) * 4096 + col] = f2bf(v * v);
        }
      }
  }
}

template <int R>
DI f32x4 rope4(f32x4 v, int lane, int t, const f32x2* tab) {
  constexpr int n = R / 4;
  const int e = (lane * 4) % R;
  const int half = e / (R / 2), w = e % (R / 2);
  const bool isx2 = w >= n;
  const int fi = w % n;
  const int pos = half ? (t & 63) : (t >> 6);
  f32x4 o;
#pragma unroll
  for (int i = 0; i < 4; ++i) {
    float pv = __shfl_xor(v[i], n / 4);
    f32x2 cs = tab[pos * 16 + fi + i];
    o[i] = v[i] * cs[0] + (isx2 ? pv : -pv) * cs[1];
  }
  return o;
}

DI void ssm_item(const P& p, int layer, int item, float* lds, int lane) {
  int b_all, r;
  if (item < 128) { b_all = 32 + item / 32; r = item % 32; } else { int it = item - 128; b_all = it / 32; r = it % 32; }
  const int dir = r >> 4, g = r & 15;
  const bool lat = b_all >= 32;
  const int T = lat ? 1024 : 256;
  const int row0 = lat ? NCTX + (b_all - 32) * 1024 : b_all * 256;
  const int tabidx = (layer * 2 + dir) * 16 + g;
  const int l32 = lane & 31, hh = lane >> 5, l16 = lane & 15, q4 = lane >> 4;
  const u16* atab = (const u16*)(p.ws + OFF_ATAB) + (size_t)tabidx * 128 * 16;
  const u16* ctab = (const u16*)(p.ws + OFF_CTAB) + (size_t)tabidx * 16 * 128;
  bf16x8 af[4], cf[4];
#pragma unroll
  for (int blk = 0; blk < 4; ++blk) af[blk] = *(const bf16x8*)(atab + (blk * 32 + l32) * 16 + hh * 8);
#pragma unroll
  for (int kk = 0; kk < 4; ++kk) cf[kk] = *(const bf16x8*)(ctab + l16 * 128 + kk * 32 + q4 * 8);
  const float* ab = (const float*)(p.ws + OFF_ABAR) + ((size_t)tabidx * 64 + lane) * 2;
  const float ar = ab[0], ai = ab[1];
  float hr = 0.f, hi = 0.f;
  if (lat) {
    size_t idx = ((size_t)((b_all - 32) * 2 + layer) * 2 + dir) * 1024 + g * 64 + lane;
    hr = p.in[I_SRE][idx]; hi = p.in[I_SIM][idx];
  }
  const u16* proj = (const u16*)(p.ws + OFF_PROJ);
  float* ybuf = (float*)(p.ws + OFF_YBUF) + (size_t)dir * NT * 256;
  f32x16 zero16;
#pragma unroll
  for (int i = 0; i < 16; ++i) zero16[i] = 0.f;
  bf16x8 un;
  {
    const int t = dir ? (T - 1 - l32) : l32;
    un = *(const bf16x8*)(proj + (size_t)(row0 + t) * NP + 1280 + g * 16 + hh * 8);
  }
  for (int ch = 0; ch < T / 32; ++ch) {
    {
      bf16x8 uf = un;
      if (ch + 1 < T / 32) {
        const int n = (ch + 1) * 32 + l32;
        const int t = dir ? (T - 1 - n) : n;
        un = *(const bf16x8*)(proj + (size_t)(row0 + t) * NP + 1280 + g * 16 + hh * 8);
      }
#pragma unroll
      for (int blk = 0; blk < 4; ++blk) {
        f32x16 d = MFMA32(af[blk], uf, zero16);
#pragma unroll
        for (int j = 0; j < 4; ++j) {
          f32x4 v = {d[4 * j], d[4 * j + 1], d[4 * j + 2], d[4 * j + 3]};
          *(f32x4*)(lds + l32 * 132 + blk * 32 + 8 * j + 4 * hh) = v;
        }
      }
    }
    wave_lds_fence();
    {
      f32x2 bu[32];
#pragma unroll
      for (int s = 0; s < 32; ++s) bu[s] = *(const f32x2*)(lds + s * 132 + 2 * lane);
#pragma unroll
      for (int s = 0; s < 32; ++s) {
        const float nr = __builtin_fmaf(ar, hr, __builtin_fmaf(-ai, hi, bu[s][0]));
        const float ni = __builtin_fmaf(ar, hi, __builtin_fmaf(ai, hr, bu[s][1]));
        hr = nr; hi = ni;
        f32x2 hv = {hr, hi};
        *(f32x2*)(lds + s * 132 + 2 * lane) = hv;
      }
    }
    wave_lds_fence();
#pragma unroll
    for (int tb = 0; tb < 2; ++tb) {
      f32x4 y = {0.f, 0.f, 0.f, 0.f};
#pragma unroll
      for (int kk = 0; kk < 4; ++kk) {
        const float* hp = lds + (tb * 16 + l16) * 132 + kk * 32 + q4 * 8;
        f32x4 a0 = *(const f32x4*)hp, a1 = *(const f32x4*)(hp + 4);
        y = MFMA16(cf[kk], pack8(a0, a1), y);
      }
      const int n2 = ch * 32 + tb * 16 + l16;
      const int t2 = dir ? (T - 1 - n2) : n2;
      *(f32x4*)(ybuf + (size_t)(row0 + t2) * 256 + g * 16 + q4 * 4) = y;
    }
    wave_lds_fence();
  }
  if (!lat) {
    size_t idx = ((size_t)(b_all * 2 + layer) * 2 + dir) * 1024 + g * 64 + lane;
    p.out[O_SRE + idx] = hr;
    p.out[O_SIM + idx] = hi;
  }
}

DI void pp_row(const P& p, int layer, int row, int lane) {
  const u16* pr = (const u16*)(p.ws + OFF_PROJ) + (size_t)row * NP;
  const bool lat = row >= NCTX;
  int b, t, keyrow;
  if (!lat) { b = row >> 8; t = row & 255; keyrow = row; }
  else { int rr = row - NCTX; b = rr >> 10; t = rr & 1023; keyrow = NCTX + b * 1536 + 512 + t; }
  const f32x2* tab32 = (const f32x2*)(p.ws + OFF_ROPE);
  const f32x2* tab64 = tab32 + 64 * 16;
  const size_t orow = (size_t)(b * 2 + layer) * 256 + t;
  const f32x4 z4 = {0.f, 0.f, 0.f, 0.f};
  f32x4 v_dq = ld4bf(pr + lane * 4);
  f32x4 v_dk = ld4bf(pr + 256 + lane * 4);
  f32x4 v_dv = ld4bf(pr + 512 + lane * 4);
  f32x4 v_gq = ld4bf(pr + 768 + lane * 4);
  f32x4 v_gk = lane < 32 ? ld4bf(pr + 1024 + lane * 4) : z4;
  f32x4 v_gv = lane < 32 ? ld4bf(pr + 1152 + lane * 4) : z4;
  f32x4 v_cq = lane < 48 ? ld4bf(pr + 1536 + lane * 4) : z4;
  f32x4 v_ckv = lane < 32 ? ld4bf(pr + 1728 + lane * 4) : z4;
  f32x4 v_kr = lane < 8 ? ld4bf(pr + 1856 + lane * 4) : z4;
  const f32x4 g_q = *(const f32x4*)(p.in[I_QNG] + layer * 64 + (lane & 15) * 4);
  const f32x4 g_k = *(const f32x4*)(p.in[I_KNG] + layer * 64 + (lane & 15) * 4);
  const f32x4 g_cq = lane < 48 ? *(const f32x4*)(p.in[I_MQNG] + layer * 192 + lane * 4) : z4;
  const f32x4 g_ckv = lane < 32 ? *(const f32x4*)(p.in[I_MKVNG] + layer * 128 + lane * 4) : z4;
  f32x2 cs32[4], cs64[4];
  {
    const int e32 = (lane * 4) & 31, w32 = e32 & 15, p32 = (e32 >> 4) ? (t & 63) : (t >> 6), f32i = w32 & 7;
    const int e64 = (lane * 4) & 63, w64 = e64 & 31, p64 = (e64 >> 5) ? (t & 63) : (t >> 6), f64i = w64 & 15;
    const f32x2 one = {1.f, 0.f};
#pragma unroll
    for (int i = 0; i < 4; ++i) {
      cs32[i] = lat ? tab32[p32 * 16 + f32i + i] : one;
      cs64[i] = lat ? tab64[p64 * 16 + f64i + i] : one;
    }
  }
  const bool x2_32 = ((lane * 4) & 15) >= 8, x2_64 = ((lane * 4) & 31) >= 16;
  auto rope32 = [&](f32x4 v) {
    f32x4 o;
#pragma unroll
    for (int i = 0; i < 4; ++i) { float pv = __shfl_xor(v[i], 2); o[i] = v[i] * cs32[i][0] + (x2_32 ? pv : -pv) * cs32[i][1]; }
    return o;
  };
  auto rope64 = [&](f32x4 v) {
    f32x4 o;
#pragma unroll
    for (int i = 0; i < 4; ++i) { float pv = __shfl_xor(v[i], 4); o[i] = v[i] * cs64[i][0] + (x2_64 ? pv : -pv) * cs64[i][1]; }
    return o;
  };
  if (!lat) {
    *(f32x4*)(p.out + O_DK + orow * 256 + lane * 4) = v_dk;
    *(f32x4*)(p.out + O_DV + orow * 256 + lane * 4) = v_dv;
    if (lane < 32) *(f32x4*)(p.out + O_GV + orow * 128 + lane * 4) = v_gv;
    if (lane < 8) *(f32x4*)(p.out + O_KR + orow * 32 + lane * 4) = v_kr;
  }
  {
    f32x4 v = v_dq;
    if (lat) v = rope32(v);
    v = v * (0.17677669529663687f * LOG2E);
    *(u32x2*)((u16*)(p.ws + OFF_DQ) + (size_t)row * 256 + lane * 4) = pack4(v);
  }
  {
    f32x4 v = v_dk;
    if (lat) v = rope32(v);
    *(u32x2*)((u16*)(p.ws + OFF_DKB) + (size_t)keyrow * 256 + lane * 4) = pack4(v);
  }
  {
    f32x4 v = v_gq;
    float ss = v[0] * v[0] + v[1] * v[1] + v[2] * v[2] + v[3] * v[3];
    ss += __shfl_xor(ss, 1); ss += __shfl_xor(ss, 2); ss += __shfl_xor(ss, 4); ss += __shfl_xor(ss, 8);
    float r = rsqrtf(ss * (1.f / 64.f) + EPSF);
    v = v * r * g_q;
    if (lat) v = rope64(v);
    v = v * (0.125f * LOG2E);
    *(u32x2*)((u16*)(p.ws + OFF_GQ) + (size_t)row * 256 + lane * 4) = pack4(v);
  }
  {
    f32x4 v = v_gk;
    float ss = v[0] * v[0] + v[1] * v[1] + v[2] * v[2] + v[3] * v[3];
    ss += __shfl_xor(ss, 1); ss += __shfl_xor(ss, 2); ss += __shfl_xor(ss, 4); ss += __shfl_xor(ss, 8);
    float r = rsqrtf(ss * (1.f / 64.f) + EPSF);
    v = v * r * g_k;
    if (!lat) { if (lane < 32) *(f32x4*)(p.out + O_GK + orow * 128 + lane * 4) = v; }
    else v = rope64(v);
    if (lane < 32) *(u32x2*)((u16*)(p.ws + OFF_GKB) + (size_t)keyrow * 128 + lane * 4) = pack4(v);
  }
  {
    f32x4 v = v_cq;
    float ss = wave_sum(v[0] * v[0] + v[1] * v[1] + v[2] * v[2] + v[3] * v[3]);
    float r = rsqrtf(ss * (1.f / 192.f) + EPSF);
    v = v * r * g_cq;
    if (lane < 48) *(u32x2*)((u16*)(p.ws + OFF_CQN) + (size_t)row * 192 + lane * 4) = pack4(v);
  }
  {
    f32x4 v = v_ckv;
    float ss = wave_sum(v[0] * v[0] + v[1] * v[1] + v[2] * v[2] + v[3] * v[3]);
    float r = rsqrtf(ss * (1.f / 128.f) + EPSF);
    v = v * r * g_ckv;
    if (lane < 32) {
      if (!lat) *(f32x4*)(p.out + O_CKV + orow * 128 + lane * 4) = v;
      *(u32x2*)((u16*)(p.ws + OFF_CKVN) + (size_t)keyrow * 128 + lane * 4) = pack4(v);
    }
  }
  {
    f32x4 v = v_kr;
    if (lat) v = rope32(v);
    if (lane < 8) {
      u32x2 pk = pack4(v);
      u16* mk = (u16*)(p.ws + OFF_MKB) + (size_t)keyrow * 384 + 64 + lane * 4;
#pragma unroll
      for (int hd = 0; hd < 4; ++hd) *(u32x2*)(mk + hd * 96) = pk;
    }
  }
}

DI void pp_cached(const P& p, int layer, int crow_, int lane) {
  const int b = crow_ >> 9, j = crow_ & 511;
  const int keyrow = NCTX + b * 1536 + j;
  const size_t src = (size_t)(b * 2 + layer) * 512 + j;
  const int jp = (j & ~15) | (((j >> 2) & 1) << 3) | (((j >> 3) & 1) << 2) | (j & 3);
  const f32x4 z4 = {0.f, 0.f, 0.f, 0.f};
  const int l31 = lane & 31, l7 = lane & 7;
  f32x4 v_dk = *(const f32x4*)(p.in[I_CDK] + src * 256 + lane * 4);
  f32x4 v_dv = *(const f32x4*)(p.in[I_CDV] + src * 256 + lane * 4);
  f32x4 v_gk = *(const f32x4*)(p.in[I_CGK] + src * 128 + l31 * 4);
  f32x4 v_gv = *(const f32x4*)(p.in[I_CGV] + src * 128 + l31 * 4);
  f32x4 v_ckv = *(const f32x4*)(p.in[I_CCKV] + src * 128 + l31 * 4);
  f32x4 v_kr = *(const f32x4*)(p.in[I_CKR] + src * 32 + l7 * 4);
  (void)z4;
  *(u32x2*)((u16*)(p.ws + OFF_DKB) + (size_t)keyrow * 256 + lane * 4) = pack4(v_dk);
  {
    u16* vt = (u16*)(p.ws + OFF_DVT) + vt_off(32 + b, lane >> 4, 4) + (size_t)((lane & 15) * 4) * 1536 + jp;
#pragma unroll
    for (int i = 0; i < 4; ++i) vt[(size_t)i * 1536] = f2bf(v_dv[i]);
  }
  if (lane < 32) {
    *(u32x2*)((u16*)(p.ws + OFF_GKB) + (size_t)keyrow * 128 + lane * 4) = pack4(v_gk);
    u16* vt = (u16*)(p.ws + OFF_GVT) + vt_off(32 + b, lane >> 4, 2) + (size_t)((lane & 15) * 4) * 1536 + jp;
#pragma unroll
    for (int i = 0; i < 4; ++i) vt[(size_t)i * 1536] = f2bf(v_gv[i]);
    *(u32x2*)((u16*)(p.ws + OFF_CKVN) + (size_t)keyrow * 128 + lane * 4) = pack4(v_ckv);
  }
  if (lane < 8) {
    u32x2 pk = pack4(v_kr);
    u16* mk = (u16*)(p.ws + OFF_MKB) + (size_t)keyrow * 384 + 64 + lane * 4;
#pragma unroll
    for (int hd = 0; hd < 4; ++hd) *(u32x2*)(mk + hd * 96) = pk;
  }
}

DI void phase_pp(const P& p, int layer, char* smem) {
  const int tid_ = get_tid();
  const int lane = tid_ & 63, wave = tid_ >> 6;
  float* lds = (float*)smem + wave * (32 * 132);
  const int gw = wave * (int)gridDim.x + (int)blockIdx.x, nw = gridDim.x * NWV;
  constexpr int N_SSM = 1152, N_ROWS = NT + 2048;
  for (int item = gw; item < N_SSM; item += nw) ssm_item(p, layer, item, lds, lane);
  const int rw0 = (nw > 256) ? 128 : 0;
  if (gw >= rw0) {
    for (int row = gw - rw0; row < N_ROWS; row += nw - rw0) {
      if (row < NT) pp_row(p, layer, row, lane);
      else pp_cached(p, layer, row - NT, lane);
    }
  }
}

template <int KW, int DK>
DI void attn_block(const u16* __restrict__ Kg, int ldk, const u16* __restrict__ Vt, int nk, const bf16x8 (&qf)[DK / 16], int kcol, char* smem,
                   int tid, f32x16 (&o)[2], float& lsum) {
  constexpr int KST = KW + 8, KS = DK / 16, KCH = KW / 8, KTOT = 64 * KCH, NKC = (KTOT + NTHR - 1) / NTHR;
  const int lane = tid & 63, l32 = lane & 31, hh = lane >> 5;
  u16* Ks = (u16*)smem;
  u16* Vs = Ks + 2 * 64 * KST;
  float m = -1e30f;
  lsum = 0.f;
#pragma unroll
  for (int db = 0; db < 2; ++db)
#pragma unroll
    for (int r = 0; r < 16; ++r) o[db][r] = 0.f;
  u32x4 rk[NKC], rv[1];
  const int nt = nk / 64;
#pragma unroll
  for (int i = 0; i < NKC; ++i) { int c = tid + NTHR * i, r = c / KCH, kc = (c % KCH) * 8; if (c < KTOT) rk[i] = *(const u32x4*)(Kg + (size_t)r * ldk + kc); }
  { int r = tid >> 3, kc = (tid & 7) * 8; rv[0] = *(const u32x4*)(Vt + (size_t)r * nk + kc); }
#pragma unroll
  for (int i = 0; i < NKC; ++i) { int c = tid + NTHR * i, r = c / KCH, kc = (c % KCH) * 8; if (c < KTOT) *(u32x4*)(Ks + r * KST + kc) = rk[i]; }
  { int r = tid >> 3, kc = (tid & 7) * 8; *(u32x4*)(Vs + r * 72 + kc) = rv[0]; }
  __syncthreads();
  for (int t = 0; t < nt; ++t) {
    const int buf = t & 1;
    const bool more = (t + 1 < nt);
    if (more) {
      const int kt = (t + 1) * 64;
#pragma unroll
      for (int i = 0; i < NKC; ++i) { int c = tid + NTHR * i, r = c / KCH, kc = (c % KCH) * 8; if (c < KTOT) rk[i] = *(const u32x4*)(Kg + (size_t)(kt + r) * ldk + kc); }
      { int r = tid >> 3, kc = (tid & 7) * 8; rv[0] = *(const u32x4*)(Vt + (size_t)r * nk + kt + kc); }
    }
    const u16* ks = Ks + buf * 64 * KST + l32 * KST + kcol + hh * 8;
    const u16* vs = Vs + buf * 64 * 72 + l32 * 72 + hh * 8;
    f32x16 sa[2];
#pragma unroll
    for (int kb = 0; kb < 2; ++kb) {
#pragma unroll
      for (int r = 0; r < 16; ++r) sa[kb][r] = 0.f;
      bf16x8 kf[KS];
#pragma unroll
      for (int s2 = 0; s2 < KS; ++s2) kf[s2] = *(const bf16x8*)(ks + kb * 32 * KST + s2 * 16);
#pragma unroll
      for (int s2 = 0; s2 < KS; ++s2) sa[kb] = MFMA32(kf[s2], qf[s2], sa[kb]);
    }
    float mx = sa[0][0];
#pragma unroll
    for (int r = 1; r < 16; ++r) mx = fmaxf(mx, sa[0][r]);
#pragma unroll
    for (int r = 0; r < 16; ++r) mx = fmaxf(mx, sa[1][r]);
    mx = fmaxf(mx, __shfl_xor(mx, 32));
    const float mn = fmaxf(m, mx);
    const float alpha = fexp2(m - mn);
    m = mn;
    float ps = 0.f;
#pragma unroll
    for (int kb = 0; kb < 2; ++kb)
#pragma unroll
      for (int r = 0; r < 16; ++r) { float e = fexp2(sa[kb][r] - mn); sa[kb][r] = e; ps += e; }
    lsum = lsum * alpha + ps;
#pragma unroll
    for (int db = 0; db < 2; ++db)
#pragma unroll
      for (int r = 0; r < 16; ++r) o[db][r] *= alpha;
#pragma unroll
    for (int s2 = 0; s2 < 4; ++s2) {
      const int kb = s2 >> 1, rb = 8 * (s2 & 1);
      f32x4 p0 = {sa[kb][rb], sa[kb][rb + 1], sa[kb][rb + 2], sa[kb][rb + 3]};
      f32x4 p1 = {sa[kb][rb + 4], sa[kb][rb + 5], sa[kb][rb + 6], sa[kb][rb + 7]};
      bf16x8 pf = pack8(p0, p1);
      bf16x8 v0 = *(const bf16x8*)(vs + s2 * 16);
      bf16x8 v1 = *(const bf16x8*)(vs + 32 * 72 + s2 * 16);
      o[0] = MFMA32(v0, pf, o[0]);
      o[1] = MFMA32(v1, pf, o[1]);
    }
    if (more) {
      const int nb = buf ^ 1;
#pragma unroll
      for (int i = 0; i < NKC; ++i) { int c = tid + NTHR * i, r = c / KCH, kc = (c % KCH) * 8; if (c < KTOT) *(u32x4*)(Ks + nb * 64 * KST + r * KST + kc) = rk[i]; }
      { int r = tid >> 3, kc = (tid & 7) * 8; *(u32x4*)(Vs + nb * 64 * 72 + r * 72 + kc) = rv[0]; }
    }
    __syncthreads();
  }
  lsum += __shfl_xor(lsum, 32);
}

DI void store_o(u16* dst  , const f32x16 (&o)[2], float scale, int hh) {
#pragma unroll
  for (int db = 0; db < 2; ++db)
#pragma unroll
    for (int j = 0; j < 4; ++j) {
      const int dv = db * 32 + 8 * j + 4 * hh;
      f32x4 v = {o[db][4 * j] * scale, o[db][4 * j + 1] * scale, o[db][4 * j + 2] * scale, o[db][4 * j + 3] * scale};
      *(u32x2*)(dst + dv) = pack4(v);
    }
}

DI void attn_item(const P& p, int layer, int item, char* smem, int tid) {
  const int lane = tid & 63, wave = tid >> 6, l32 = lane & 31, hh = lane >> 5;
  bool lat; int kind, b, hd, qblk;
  if (item < 256) {
    lat = true;
    if (item < 128) { kind = 0; b = item >> 5; hd = (item >> 3) & 3; qblk = item & 7; }
    else { int it = item - 128; kind = 1 + (it >> 6); it &= 63; b = it >> 4; hd = (it >> 2) & 3; qblk = it & 3; }
  } else {
    lat = false;
    int it = item - 256;
    if (it < 256) { kind = 0; b = it >> 3; hd = (it >> 1) & 3; qblk = it & 1; }
    else { it -= 256; kind = 1 + (it >> 7); it &= 127; b = it >> 2; hd = it & 3; qblk = 0; }
  }
  const int nk = lat ? 1536 : 256;
  const int b_all = lat ? 32 + b : b;
  const int keyrow0 = lat ? NCTX + b * 1536 : b * 256;
  const int tok0 = lat ? NCTX + b * 1024 : b * 256;
  f32x16 o[2]; float ls;
  if (kind == 0) {
    const int ns = wave & 1, qb = wave >> 1;
    const int q0 = tok0 + qblk * 128 + qb * 32;
    const u16* Q = (const u16*)(p.ws + OFF_DQ) + (size_t)(q0 + l32) * 256 + hd * 64 + ns * 32 + hh * 8;
    bf16x8 qf[2];
    qf[0] = *(const bf16x8*)Q; qf[1] = *(const bf16x8*)(Q + 16);
    attn_block<64, 32>((const u16*)(p.ws + OFF_DKB) + (size_t)keyrow0 * 256 + hd * 64, 256, (const u16*)(p.ws + OFF_DVT) + vt_off(b_all, hd, 4), nk, qf, ns * 32,
                       smem, tid, o, ls);
    float d1 = 0.f, d2 = 0.f;
    if (lane < 32) { d1 = p.in[I_LQ1][layer * 32 + lane] * p.in[I_LK1][layer * 32 + lane]; d2 = p.in[I_LQ2][layer * 32 + lane] * p.in[I_LK2][layer * 32 + lane]; }
    d1 = wave_sum(d1); d2 = wave_sum(d2);
    int ly_ = layer; asm volatile("" : "+s"(ly_));
    const float lam_init = ly_ == 0 ? 0.2f : (0.8f - 0.6f * 0.7408182206817179f);
    const float lam = expf(d1) - expf(d2) + lam_init;
    float* cmb = (float*)smem + qb * (64 * 33);
    if (ns == 1) {
      const float sc = lam / ls;
#pragma unroll
      for (int db = 0; db < 2; ++db)
#pragma unroll
        for (int r = 0; r < 16; ++r) cmb[(db * 32 + crow(r, hh)) * 33 + l32] = o[db][r] * sc;
    }
    __syncthreads();
    if (ns == 0) {
      const float i0 = 1.f / ls;
      float ss = 0.f;
#pragma unroll
      for (int db = 0; db < 2; ++db)
#pragma unroll
        for (int r = 0; r < 16; ++r) { float d = o[db][r] * i0 - cmb[(db * 32 + crow(r, hh)) * 33 + l32]; o[db][r] = d; ss += d * d; }
      ss += __shfl_xor(ss, 32);
      const float rr = rsqrtf(ss * (1.f / 64.f) + EPSF) * (1.f - lam_init);
      u16* dst = (u16*)(p.ws + OFF_MIXED) + (size_t)(q0 + l32) * 1024 + hd * 64;
#pragma unroll
      for (int db = 0; db < 2; ++db)
#pragma unroll
        for (int j = 0; j < 4; ++j) {
          const int dv = db * 32 + 8 * j + 4 * hh;
          f32x4 g = *(const f32x4*)(p.in[I_SUBLN] + layer * 64 + dv);
          f32x4 v = {o[db][4 * j] * rr * g[0], o[db][4 * j + 1] * rr * g[1], o[db][4 * j + 2] * rr * g[2], o[db][4 * j + 3] * rr * g[3]};
          *(u32x2*)(dst + dv) = pack4(v);
        }
    }
    __syncthreads();
  } else if (kind == 1) {
    const int q0 = tok0 + qblk * 256 + wave * 32;
    const u16* Q = (const u16*)(p.ws + OFF_GQ) + (size_t)(q0 + l32) * 256 + hd * 64 + hh * 8;
    bf16x8 qf[4];
#pragma unroll
    for (int s2 = 0; s2 < 4; ++s2) qf[s2] = *(const bf16x8*)(Q + s2 * 16);
    attn_block<64, 64>((const u16*)(p.ws + OFF_GKB) + (size_t)keyrow0 * 128 + (hd >> 1) * 64, 128, (const u16*)(p.ws + OFF_GVT) + vt_off(b_all, hd >> 1, 2), nk, qf, 0,
                       smem, tid, o, ls);
    store_o((u16*)(p.ws + OFF_MIXED) + (size_t)(q0 + l32) * 1024 + 256 + hd * 64, o, 1.f / ls, hh);
  } else {
    const int q0 = tok0 + qblk * 256 + wave * 32;
    const u16* Q = (const u16*)(p.ws + OFF_MQ) + (size_t)(q0 + l32) * 384 + hd * 96 + hh * 8;
    bf16x8 qf[6];
#pragma unroll
    for (int s2 = 0; s2 < 6; ++s2) qf[s2] = *(const bf16x8*)(Q + s2 * 16);
    attn_block<96, 96>((const u16*)(p.ws + OFF_MKB) + (size_t)keyrow0 * 384 + hd * 96, 384, (const u16*)(p.ws + OFF_MVT) + vt_off(b_all, hd, 4), nk, qf, 0,
                       smem, tid, o, ls);
    store_o((u16*)(p.ws + OFF_MIXED) + (size_t)(q0 + l32) * 1024 + 768 + hd * 64, o, 1.f / ls, hh);
  }
}

DI void phase_at(const P& p, int layer, char* smem) {
  EPI_IDX
  constexpr int N_ITEMS = 768;
  if (gridDim.x == 256) {
    const int b = blockIdx.x;
    attn_item(p, layer, b, smem, tid);
    __syncthreads();
    if (b < 128) {
      attn_item(p, layer, 256 + b, smem, tid); __syncthreads();
      attn_item(p, layer, 512 + b, smem, tid); __syncthreads();
      attn_item(p, layer, 640 + b, smem, tid); __syncthreads();
    } else if (b < 192) {
      attn_item(p, layer, 256 + 128 + 2 * (b - 128), smem, tid); __syncthreads();
      attn_item(p, layer, 256 + 128 + 2 * (b - 128) + 1, smem, tid); __syncthreads();
    }
  } else {
    for (int item = blockIdx.x; item < N_ITEMS; item += gridDim.x) {
      attn_item(p, layer, item, smem, tid);
      __syncthreads();
    }
  }
  {
    constexpr int T_GLU = (NT / 256) * 2;
    auto tile_at = [&](int t) { TD d; d.A = (const u16*)(p.ws + OFF_PROJ); d.lda = NP; d.B = (const u16*)(p.ws + OFF_WGLU) + (size_t)layer * 512 * 256; d.ldb = 256; d.k0 = 0; d.nk = 4; d.m0 = (t >> 1) * 256; d.n0 = (t & 1) * 256; return d; };
    int buf = 0;
    const int t0 = (int)gridDim.x - 1 - (int)blockIdx.x;
    TD cur = tile_at(t0 < T_GLU ? t0 : 0);
    if (t0 < T_GLU) stage_td<2>(cur, 0, smem, tid);
    for (int t = t0; t < T_GLU; t += gridDim.x) {
      const bool has_next = (t + (int)gridDim.x < T_GLU);
      const TD nxt = tile_at(has_next ? t + (int)gridDim.x : t);
      const int m0 = cur.m0, n0 = cur.n0;
      f32x16 acc[4][2];
      gemm_stream<2>(cur, has_next, nxt, smem, buf, acc);
      cur = nxt;
      u16* mixed = (u16*)(p.ws + OFF_MIXED);
      const int q = (n0 + wn * 64) >> 6;
#pragma unroll
      for (int bi = 0; bi < 4; ++bi) {
        const int rb = m0 + wm * 128 + bi * 32;
#pragma unroll
        for (int r = 0; r < 16; ++r) {
          float z = acc[bi][0][r], g = acc[bi][1][r];
          mixed[(size_t)(rb + crow(r, hh)) * 1024 + 512 + q * 32 + l32] = f2bf(z * fsigmoid(g));
        }
      }
    }
  }
}

#define XB_TMO      128
#define XB_XCNT(j)  (256  + 64 * (j))
#define XB_XSUB(j)  (1280 + 64 * (j))
#define XB_XGEN(j)  (2304 + 64 * (j))
#define XB_TOP      3328
#define XB_TOPGEN   3392
#define XCD_BAR_WORDS 3456
#define XB_SPIN_CAP (1u << 22)
#define LAS __attribute__((address_space(3)))
DI unsigned xb_ld(unsigned* p) { return __hip_atomic_load(p, __ATOMIC_RELAXED, __HIP_MEMORY_SCOPE_AGENT); }
DI unsigned xb_add(unsigned* p, unsigned v) { return __hip_atomic_fetch_add(p, v, __ATOMIC_RELAXED, __HIP_MEMORY_SCOPE_AGENT); }
DI unsigned xb_xcc_id() { return (unsigned)__builtin_amdgcn_s_getreg((3 << 11) | 20) & 0xFu; }
#define XB_SPIN(cond, bar) do { unsigned _sp = 0; while (cond) { __builtin_amdgcn_s_sleep(1); \
    if ((++_sp & 255u) == 0u) { if (xb_ld(&(bar)[XB_TMO])) break; if (_sp > XB_SPIN_CAP) { atomicAdd(&(bar)[XB_TMO], 1u); break; } } } } while (0)
struct XcdBarrier { unsigned* bar; unsigned x; volatile LAS unsigned* st; };
DI XcdBarrier xcd_barrier_post(unsigned* bar, volatile LAS unsigned* st) {
  XcdBarrier b; b.bar = bar; b.x = xb_xcc_id(); b.st = st;
  if (threadIdx.x == 0) st[2] = xb_add(&bar[XB_XCNT(b.x)], 1u);
  return b;
}
DI void xcd_barrier_complete(unsigned* bar, unsigned x, unsigned& nloc, unsigned& nx) {
  const unsigned G = gridDim.x * gridDim.y * gridDim.z;
  unsigned sum, cnt, mine, sp = 0u;
  for (;;) {
    sum = 0u; cnt = 0u; mine = 0u;
#pragma unroll
    for (unsigned j = 0; j < 16; ++j) { const unsigned c = xb_ld(&bar[XB_XCNT(j)]); sum += c; cnt += (c > 0u) ? 1u : 0u; mine = (j == x) ? c : mine; }
    if (sum == G) break;
    __builtin_amdgcn_s_sleep(1);
    if ((++sp & 255u) == 0u) { if (xb_ld(&bar[XB_TMO])) break; if (sp > XB_SPIN_CAP) { atomicAdd(&bar[XB_TMO], 1u); break; } }
  }
  nloc = mine > 0u ? mine : 1u; nx = cnt > 0u ? cnt : 1u;
}
DI void xcd_barrier(const XcdBarrier& b) {
  asm volatile("s_waitcnt vmcnt(0)" ::: "memory");
  __syncthreads();
  if (threadIdx.x == 0) {
    unsigned* bar = b.bar;
    __builtin_amdgcn_s_waitcnt(0);
    unsigned nloc = b.st[0], nx = b.st[1];
    if (nloc == 0u) { xcd_barrier_complete(bar, b.x, nloc, nx); b.st[0] = nloc; b.st[1] = nx; }
    const unsigned old = xb_add(&bar[XB_XSUB(b.x)], 1u);
    const unsigned gen = old / nloc;
    if (old + 1u == (gen + 1u) * nloc) {
      __builtin_amdgcn_fence(__ATOMIC_RELEASE, "agent");
      asm volatile("s_waitcnt vmcnt(0)" ::: "memory");
      const unsigned og = xb_add(&bar[XB_TOP], 1u);
      const unsigned tg = og / nx;
      if (og + 1u == (tg + 1u) * nx) xb_add(&bar[XB_TOPGEN], 1u);
      else XB_SPIN(xb_ld(&bar[XB_TOPGEN]) == tg, bar);
      __builtin_amdgcn_fence(__ATOMIC_ACQUIRE, "agent");
      xb_add(&bar[XB_XGEN(b.x)], 1u);
      asm volatile("s_waitcnt vmcnt(0)" ::: "memory");
    } else {
      XB_SPIN(xb_ld(&bar[XB_XGEN(b.x)]) == gen, bar);
      __builtin_amdgcn_fence(__ATOMIC_ACQUIRE, "agent");
      asm volatile("s_waitcnt vmcnt(0)" ::: "memory");
    }
  }
  __syncthreads();
}

DI void run_phase(const P& p_, int ph, int layer, char* smem) {
  P p = p_;
  size_t zoff = 0;
  asm volatile("" : "+s"(zoff));
  p.ws = p_.ws + zoff;
  p.out = p_.out + zoff;
  switch (ph) {
    case 0: prologue(p, smem); break;
    case 1: norm_phase(p, layer, 0); break;
    case 2: phase_g1(p, layer, smem); break;
    case 3: phase_pp(p, layer, smem); break;
    case 4: phase_g2(p, layer, smem); break;
    case 5: phase_at(p, layer, smem); break;
    case 6: phase_resid(p, layer, smem, true); break;
    case 7: norm_phase(p, layer, 1); break;
    case 8: phase_g5(p, layer, smem); break;
    case 9: phase_resid(p, layer, smem, false); break;
    case 10: norm_phase(p, 0, 2); break;
  }
}

extern __shared__ __attribute__((aligned(16))) char dyn_smem[];

__global__ void __launch_bounds__(512) fwd_mega(P p) {
  if (p.ws == nullptr) { cg::grid_group grid = cg::this_grid(); grid.sync(); }
  volatile LAS unsigned* st = (volatile LAS unsigned*)(dyn_smem + LDS_BYTES);
  if (threadIdx.x == 0) { st[0] = 0u; st[1] = 0u; st[2] = 0u; st[3] = 0u; }
  __syncthreads();
  XcdBarrier xb = xcd_barrier_post((unsigned*)(p.ws + OFF_BAR), st);
  run_phase(p, 0, 0, dyn_smem);
  xcd_barrier(xb);
  if (threadIdx.x == 0) {
    unsigned* bar = (unsigned*)(p.ws + OFF_BAR);
    bool ok = (gridDim.x & 7u) == 0u;
    for (unsigned j = 0; j < 16; ++j) { const unsigned c = xb_ld(&bar[XB_XCNT(j)]); ok = ok && (c == (j < 8 ? gridDim.x >> 3 : 0u)); }
    if (ok) st[3] = xb.x; else { st[2] = blockIdx.x >> 3; st[3] = blockIdx.x & 7u; }
  }
  __syncthreads();
  for (int l = 0; l < 2; ++l) {
    for (int ph = 1; ph <= 9; ++ph) {
      run_phase(p, ph, l, dyn_smem);
      xcd_barrier(xb);
    }
  }
  run_phase(p, 10, 0, dyn_smem);
}

#if !MEGA
__global__ void __launch_bounds__(512) fwd_phase(P p, int ph, int layer) { run_phase(p, ph, layer, dyn_smem); }
#endif

extern "C" void kernel_launch(void* const* d_in, const int* in_sizes, int n_in, void* d_out, int out_size, void* d_ws, size_t ws_size,
                              hipStream_t stream) {
  static int grid_blocks = 0;
  if (!grid_blocks) {
    int dev = 0, cus = 0, per_cu = 0;
    (void)hipGetDevice(&dev);
    (void)hipDeviceGetAttribute(&cus, hipDeviceAttributeMultiprocessorCount, dev);
    (void)hipFuncSetAttribute((const void*)fwd_mega, hipFuncAttributeMaxDynamicSharedMemorySize, LDS_BYTES + 16);
#if !MEGA
    (void)hipFuncSetAttribute((const void*)fwd_phase, hipFuncAttributeMaxDynamicSharedMemorySize, LDS_BYTES);
#endif
    (void)hipOccupancyMaxActiveBlocksPerMultiprocessor(&per_cu, (const void*)fwd_mega, NTHR, LDS_BYTES + 16);
    if (per_cu < 1) per_cu = 1;
    if (per_cu > 1) per_cu = 1;
    grid_blocks = cus * per_cu;
    if (ws_size < WS_NEED) fprintf(stderr, "kernel_launch: workspace too small: %zu < %zu\n", ws_size, (size_t)WS_NEED);
  }
  P p{};
  for (int i = 0; i < N_IN; ++i) p.in[i] = (const float*)d_in[i];
  p.out = (float*)d_out;
  p.ws = (char*)d_ws;
#if MEGA
  (void)hipMemsetAsync((char*)d_ws + OFF_BAR, 0, XCD_BAR_WORDS * 4, stream);
  void* args[] = {&p};
  hipError_t e = hipLaunchCooperativeKernel((const void*)fwd_mega, dim3(grid_blocks), dim3(NTHR), args, LDS_BYTES + 16, stream);
  if (e != hipSuccess) fprintf(stderr, "cooperative launch failed: %s (grid %d)\n", hipGetErrorString(e), grid_blocks);
#else
  hipLaunchKernelGGL(fwd_phase, dim3(grid_blocks), dim3(NTHR), LDS_BYTES, stream, p, 0, 0);
  for (int l = 0; l < 2; ++l)
    for (int ph = 1; ph <= 9; ++ph) hipLaunchKernelGGL(fwd_phase, dim3(grid_blocks), dim3(NTHR), LDS_BYTES, stream, p, ph, l);
  hipLaunchKernelGGL(fwd_phase, dim3(grid_blocks), dim3(NTHR), LDS_BYTES, stream, p, 10, 0);
#endif
}
```

```cpp
#include <hip/hip_runtime.h>
#include <hip/hip_cooperative_groups.h>
#include <cstdio>
namespace cg = cooperative_groups;

#ifndef MEGA
#define MEGA 1
#endif

#define DI __device__ __forceinline__
typedef unsigned short u16;
typedef __attribute__((ext_vector_type(8))) short bf16x8;
typedef __attribute__((ext_vector_type(4))) short bf16x4;
typedef __attribute__((ext_vector_type(2))) __bf16 bf2_t;
typedef __attribute__((ext_vector_type(2))) float f32x2;
typedef __attribute__((ext_vector_type(4))) float f32x4;
typedef __attribute__((ext_vector_type(16))) float f32x16;
typedef __attribute__((ext_vector_type(4))) unsigned u32x4;
typedef __attribute__((ext_vector_type(2))) unsigned u32x2;

#define MFMA32(a, b, c) __builtin_amdgcn_mfma_f32_32x32x16_bf16((a), (b), (c), 0, 0, 0)
#define MFMA16(a, b, c) __builtin_amdgcn_mfma_f32_16x16x32_bf16((a), (b), (c), 0, 0, 0)

constexpr int NT = 12288;
constexpr int NCTX = 8192;
constexpr int NKR = 14336;
constexpr int NP = 1920;
constexpr float EPSF = 1e-6f;
constexpr float LOG2E = 1.4426950408889634f;

enum { I_XP = 0, I_XS, I_CDK, I_CDV, I_CGK, I_CGV, I_CCKV, I_CKR, I_SRE, I_SIM, I_C, I_CCTX, I_N1G, I_N2G, I_WADA, I_BADA,
       I_WIN, I_WOUT, I_LQ1, I_LK1, I_LQ2, I_LK2, I_SUBLN, I_QNG, I_KNG, I_ARE, I_AIM, I_LOGDT, I_BRE, I_BIM, I_CRE, I_CIM,
       I_SSMD, I_WGLU, I_MQNG, I_MKVNG, I_WUQ, I_WUKV, I_W1, I_W2, I_FNG, N_IN };

constexpr size_t O_Y = 0;
constexpr size_t O_DK = 12582912;
constexpr size_t O_DV = 16777216;
constexpr size_t O_GK = 20971520;
constexpr size_t O_GV = 23068672;
constexpr size_t O_CKV = 25165824;
constexpr size_t O_KR = 27262976;
constexpr size_t O_SRE = 27787264;
constexpr size_t O_SIM = 27918336;

constexpr size_t al256(size_t x) { return (x + 255) & ~(size_t)255; }
constexpr size_t OFF_MOD = 0;
constexpr size_t OFF_CTR = al256(OFF_MOD + 2 * 5 * 6144 * 4);
constexpr size_t OFF_BAR = al256(OFF_CTR + 256);
constexpr size_t OFF_ROPE = al256(OFF_BAR + 3456 * 4);
constexpr size_t OFF_ABAR = al256(OFF_ROPE + 2 * 64 * 16 * 8);
constexpr size_t OFF_ATAB = al256(OFF_ABAR + 64 * 64 * 8);
constexpr size_t OFF_CTAB = al256(OFF_ATAB + 64 * 128 * 16 * 2);
constexpr size_t OFF_WIN = al256(OFF_CTAB + 64 * 16 * 128 * 2);
constexpr size_t OFF_WOUT = al256(OFF_WIN + (size_t)2 * 1920 * 1024 * 2);
constexpr size_t OFF_W1 = al256(OFF_WOUT + (size_t)2 * 1024 * 1024 * 2);
constexpr size_t OFF_W2 = al256(OFF_W1 + (size_t)2 * 4096 * 1024 * 2);
constexpr size_t OFF_WUQ = al256(OFF_W2 + (size_t)2 * 4096 * 1024 * 2);
constexpr size_t OFF_WUKV = al256(OFF_WUQ + (size_t)2 * 384 * 192 * 2);
constexpr size_t OFF_WGLU = al256(OFF_WUKV + (size_t)2 * 512 * 128 * 2);
constexpr size_t OFF_H = al256(OFF_WGLU + (size_t)2 * 512 * 256 * 2);
constexpr size_t OFF_MIXED = OFF_H;
constexpr size_t OFF_BIG = al256(OFF_H + (size_t)NT * 1024 * 2);
constexpr size_t OFF_PROJ = OFF_BIG;
constexpr size_t OFF_DQ = al256(OFF_PROJ + (size_t)NT * NP * 4);
constexpr size_t OFF_DKB = al256(OFF_DQ + (size_t)NT * 256 * 2);
constexpr size_t OFF_DVT = al256(OFF_DKB + (size_t)NKR * 256 * 2);
constexpr size_t OFF_GQ = al256(OFF_DVT + (size_t)NKR * 256 * 2);
constexpr size_t OFF_GKB = al256(OFF_GQ + (size_t)NT * 256 * 2);
constexpr size_t OFF_GVT = al256(OFF_GKB + (size_t)NKR * 128 * 2);
constexpr size_t OFF_MQ = al256(OFF_GVT + (size_t)NKR * 128 * 2);
constexpr size_t OFF_MKB = al256(OFF_MQ + (size_t)NT * 384 * 2);
constexpr size_t OFF_MVT = al256(OFF_MKB + (size_t)NKR * 384 * 2);
constexpr size_t OFF_CQN = al256(OFF_MVT + (size_t)NKR * 256 * 2);
constexpr size_t OFF_CKVN = al256(OFF_CQN + (size_t)NT * 192 * 2);
constexpr size_t OFF_YBUF = al256(OFF_CKVN + (size_t)NKR * 128 * 2);
constexpr size_t OFF_END1 = al256(OFF_YBUF + (size_t)2 * NT * 256 * 4);
constexpr size_t OFF_A = OFF_BIG;
constexpr size_t OFF_END2 = al256(OFF_A + (size_t)NT * 4096 * 2);
constexpr size_t WS_NEED = OFF_END1 > OFF_END2 ? OFF_END1 : OFF_END2;
static_assert(WS_NEED <= (size_t)256 * 1024 * 1024, "workspace over 256 MiB");

constexpr int NTHR = 512;
constexpr int NWV = NTHR / 64;
constexpr int LDS_BYTES = 8 * 32 * 132 * 4;

struct P {
  const float* in[N_IN];
  float* out;
  char* ws;
};

DI unsigned pack2(float a, float b) { f32x2 v = {a, b}; return __builtin_bit_cast(unsigned, __builtin_convertvector(v, bf2_t)); }
DI u16 f2bf(float a) { return (u16)(pack2(a, 0.f) & 0xffffu); }
DI bf16x8 pack8(f32x4 a, f32x4 b) {
  u32x4 r = {pack2(a[0], a[1]), pack2(a[2], a[3]), pack2(b[0], b[1]), pack2(b[2], b[3])};
  return __builtin_bit_cast(bf16x8, r);
}
DI f32x4 ld4bf(const u16* p) {
  const u32x2 w = *(const u32x2*)p;
  f32x4 r = {__uint_as_float(w[0] << 16), __uint_as_float(w[0] & 0xffff0000u), __uint_as_float(w[1] << 16), __uint_as_float(w[1] & 0xffff0000u)};
  return r;
}
DI u32x2 pack4(f32x4 a) { u32x2 r = {pack2(a[0], a[1]), pack2(a[2], a[3])}; return r; }
DI int get_tid() { int t = threadIdx.x; asm volatile("" : "+v"(t)); return t; }
DI float fexp2(float x) { return __builtin_amdgcn_exp2f(x); }
DI float frcp(float x) { return __builtin_amdgcn_rcpf(x); }
DI float fsigmoid(float w) { return frcp(1.f + fexp2(-w * LOG2E)); }
DI float gelu_tanh(float x) { return x * fsigmoid(1.5957691216057308f * (x + 0.044715f * x * x * x)); }
DI float wave_sum(float v) {
#pragma unroll
  for (int o = 32; o >= 1; o >>= 1) v += __shfl_xor(v, o);
  return v;
}
DI void wave_lds_fence() {
  asm volatile("s_waitcnt lgkmcnt(0)" ::: "memory");
  __builtin_amdgcn_wave_barrier();
}
DI int fetch_item(int* ctr, int lane) {
  int v = 0;
  if (lane == 0) v = atomicAdd(ctr, 1);
  return __builtin_amdgcn_readfirstlane(v);
}
DI size_t vt_off(int b_all, int head, int H) {
  if (b_all < 32) return ((size_t)(b_all * H + head) * 64) * 256;
  return (size_t)32 * H * 64 * 256 + ((size_t)((b_all - 32) * H + head) * 64) * 1536;
}
DI int mod_index(int row) { return row < NCTX ? 0 : 1 + ((row - NCTX) >> 10); }

DI void prologue(const P& p, char* smem) {
  const int tid = get_tid();
  float* fs = (float*)smem;
  constexpr int N_ADA = 384, N_TAB = 64, N_MISC = 1, N_TR = 5700;
  constexpr int TOTAL = N_ADA + N_TAB + N_MISC;
  for (int it = blockIdx.x; it < TOTAL; it += gridDim.x) {
    if (it < N_ADA) {
      const int l = it / 192, ch = it % 192;
      float* sc = fs;
      float* red = fs + 5 * 1024;
      for (int i = tid; i < 5 * 1024; i += NTHR) {
        int m = i >> 10, k = i & 1023;
        float c = (m == 0) ? p.in[I_CCTX][k] : p.in[I_C][(m - 1) * 1024 + k];
        sc[i] = c * fsigmoid(c);
      }
      __syncthreads();
      const int col = tid & 31, kg = tid >> 5;
      const float* w = p.in[I_WADA] + ((size_t)l * 1024 + kg * 64) * 6144 + ch * 32 + col;
      float a0 = 0, a1 = 0, a2 = 0, a3 = 0, a4 = 0;
#pragma unroll 16
      for (int k = 0; k < 64; ++k) {
        float wv = __builtin_nontemporal_load(w + (size_t)k * 6144);
        int kk = kg * 64 + k;
        a0 += sc[kk] * wv; a1 += sc[1024 + kk] * wv; a2 += sc[2048 + kk] * wv; a3 += sc[3072 + kk] * wv; a4 += sc[4096 + kk] * wv;
      }
      red[(kg * 5 + 0) * 32 + col] = a0; red[(kg * 5 + 1) * 32 + col] = a1; red[(kg * 5 + 2) * 32 + col] = a2;
      red[(kg * 5 + 3) * 32 + col] = a3; red[(kg * 5 + 4) * 32 + col] = a4;
      __syncthreads();
      if (tid < 160) {
        int m = tid >> 5, c2 = tid & 31;
        float s = 0;
#pragma unroll
        for (int g = 0; g < 16; ++g) s += red[(g * 5 + m) * 32 + c2];
        int n = ch * 32 + c2;
        s += p.in[I_BADA][l * 6144 + n];
        ((float*)(p.ws + OFF_MOD))[((size_t)l * 5 + m) * 6144 + n] = s;
      }
      __syncthreads();
    } else if (it < N_ADA + N_TAB) {
      const int idx = it - N_ADA;
      if (tid < 64) {
        const int pp = tid;
        float are = p.in[I_ARE][idx * 64 + pp], aim = p.in[I_AIM][idx * 64 + pp];
        float dt = expf(p.in[I_LOGDT][idx]);
        float zr = are * dt, zi = aim * dt;
        float e = expf(zr);
        float abr = e * cosf(zi), abi = e * sinf(zi);
        float d2 = are * are + aim * aim;
        float nr = abr - 1.f, ni = abi;
        float qr = (nr * are + ni * aim) / d2, qi = (ni * are - nr * aim) / d2;
        u16* at = (u16*)(p.ws + OFF_ATAB) + (size_t)idx * 128 * 16;
        u16* ct = (u16*)(p.ws + OFF_CTAB) + (size_t)idx * 16 * 128;
        for (int c = 0; c < 16; ++c) {
          float bre = p.in[I_BRE][((size_t)idx * 64 + pp) * 16 + c], bim = p.in[I_BIM][((size_t)idx * 64 + pp) * 16 + c];
          at[(2 * pp) * 16 + c] = f2bf(qr * bre - qi * bim);
          at[(2 * pp + 1) * 16 + c] = f2bf(qr * bim + qi * bre);
          float cre = p.in[I_CRE][((size_t)idx * 16 + c) * 64 + pp], cim = p.in[I_CIM][((size_t)idx * 16 + c) * 64 + pp];
          ct[c * 128 + 2 * pp] = f2bf(cre);
          ct[c * 128 + 2 * pp + 1] = f2bf(-cim);
        }
        float* ab = (float*)(p.ws + OFF_ABAR) + ((size_t)idx * 64 + pp) * 2;
        ab[0] = abr; ab[1] = abi;
      }
    } else if (it < N_ADA + N_TAB + N_MISC) {
      f32x2* tab = (f32x2*)(p.ws + OFF_ROPE);
      for (int i = tid; i < 2 * 64 * 16; i += NTHR) {
        int kind = i >> 10, pos = (i >> 4) & 63, fi = i & 15;
        int n = kind ? 16 : 8;
        float freq = expf(-(float)(fi % n) / (float)n * 9.210340371976184f);
        float ang = (float)pos * freq;
        f32x2 cs = {cosf(ang), sinf(ang)};
        tab[i] = cs;
      }
      if (tid < 64) ((int*)(p.ws + OFF_CTR))[tid] = 0;
    }
  }
  struct TrD { const float* src; u16* dst; int K, N, k0, n0; bool glu; };
  auto decode = [&](int tt) {
    TrD d; d.glu = false;
    const int l = tt / 2850;
    int r = tt % 2850; int kt, nt;
    if (r < 480) { d.src = p.in[I_WIN] + (size_t)l * 1024 * 1888; d.dst = (u16*)(p.ws + OFF_WIN) + (size_t)l * 1920 * 1024; d.K = 1024; d.N = 1888; kt = r / 30; nt = r % 30; }
    else if (r < 736) { r -= 480; d.src = p.in[I_WOUT] + (size_t)l * 1024 * 1024; d.dst = (u16*)(p.ws + OFF_WOUT) + (size_t)l * 1024 * 1024; d.K = 1024; d.N = 1024; kt = r / 16; nt = r % 16; }
    else if (r < 1760) { r -= 736; d.src = p.in[I_W1] + (size_t)l * 1024 * 4096; d.dst = (u16*)(p.ws + OFF_W1) + (size_t)l * 4096 * 1024; d.K = 1024; d.N = 4096; kt = r / 64; nt = r % 64; }
    else if (r < 2784) { r -= 1760; d.src = p.in[I_W2] + (size_t)l * 4096 * 1024; d.dst = (u16*)(p.ws + OFF_W2) + (size_t)l * 1024 * 4096; d.K = 4096; d.N = 1024; kt = r / 16; nt = r % 16; }
    else if (r < 2802) { r -= 2784; d.src = p.in[I_WUQ] + (size_t)l * 192 * 384; d.dst = (u16*)(p.ws + OFF_WUQ) + (size_t)l * 384 * 192; d.K = 192; d.N = 384; kt = r / 6; nt = r % 6; }
    else if (r < 2818) { r -= 2802; d.src = p.in[I_WUKV] + (size_t)l * 128 * 512; d.dst = (u16*)(p.ws + OFF_WUKV) + (size_t)l * 512 * 128; d.K = 128; d.N = 512; kt = r / 8; nt = r % 8; }
    else { r -= 2818; d.src = p.in[I_WGLU] + (size_t)l * 256 * 512; d.dst = (u16*)(p.ws + OFF_WGLU) + (size_t)l * 512 * 256; d.K = 256; d.N = 512; kt = r / 8; nt = r % 8; d.glu = true; }
    d.k0 = kt * 64; d.n0 = nt * 64;
    return d;
  };
  const int half = tid >> 8, t2 = tid & 255;
  float* ft = fs + half * (64 * 65);
  const int tx = t2 & 15, ty = t2 >> 4;
  auto tload = [&](const TrD& d, f32x4 (&v)[4]) {
#pragma unroll
    for (int i = 0; i < 4; ++i) {
      const int kk = ty + 16 * i, n = d.n0 + 4 * tx;
      f32x4 z = {0.f, 0.f, 0.f, 0.f};
      v[i] = (n < d.N) ? __builtin_nontemporal_load((const f32x4*)(d.src + (size_t)(d.k0 + kk) * d.N + n)) : z;
    }
  };
  const int nvb = 2 * (int)gridDim.x;
  const int tb = nvb - 1 - (2 * (int)blockIdx.x + half);
  const int nrounds = (N_TR + nvb - 1) / nvb;
  TrD cur = decode(tb < N_TR ? tb : 0);
  f32x4 cv[4];
  if (tb < N_TR) tload(cur, cv);
  for (int j = 0; j < nrounds; ++j) {
    const int tt = tb + j * nvb;
    const bool valid = tt < N_TR, more = tt + nvb < N_TR;
    TrD nxt = decode(more ? tt + nvb : 0);
    f32x4 nv[4];
    if (more) tload(nxt, nv);
    if (valid) {
#pragma unroll
      for (int i = 0; i < 4; ++i) {
        const int kk = ty + 16 * i;
        ft[kk * 65 + 4 * tx + 0] = cv[i][0]; ft[kk * 65 + 4 * tx + 1] = cv[i][1]; ft[kk * 65 + 4 * tx + 2] = cv[i][2]; ft[kk * 65 + 4 * tx + 3] = cv[i][3];
      }
    }
    __syncthreads();
    if (valid) {
#pragma unroll
      for (int i = 0; i < 2; ++i) {
        const int c = t2 + 256 * i, nn = c >> 3, kc = (c & 7) * 8;
        f32x4 a, b;
#pragma unroll
        for (int e = 0; e < 4; ++e) { a[e] = ft[(kc + e) * 65 + nn]; b[e] = ft[(kc + 4 + e) * 65 + nn]; }
        const int n = cur.n0 + nn;
        int drow = n;
        if (cur.glu) drow = (n < 256) ? ((n >> 5) * 64 + (n & 31)) : (((n - 256) >> 5) * 64 + 32 + (n & 31));
        *(bf16x8*)(cur.dst + (size_t)drow * cur.K + cur.k0 + kc) = pack8(a, b);
      }
    }
    __syncthreads();
    cur = nxt;
    if (more) {
#pragma unroll
      for (int i = 0; i < 4; ++i) cv[i] = nv[i];
    }
  }
}

DI const float* x_row_src(const P& p, int layer, int row) {
  if (layer == 0) return row < NCTX ? p.in[I_XP] + (size_t)row * 1024 : p.in[I_XS] + (size_t)(row - NCTX) * 1024;
  return p.out + (size_t)row * 1024;
}
DI void norm_phase(const P& p, int layer, int which) {
  const int tid_ = get_tid();
  const int lane = tid_ & 63;
  const int gw = blockIdx.x * NWV + (tid_ >> 6), nw = gridDim.x * NWV;
  auto src_of = [&](int row) { return (which == 0) ? x_row_src(p, layer, row) : (const float*)(p.out + (size_t)row * 1024); };
  f32x4 v[4];
  if (gw < NT) {
    const float* xs = src_of(gw);
#pragma unroll
    for (int i = 0; i < 4; ++i) v[i] = *(const f32x4*)(xs + (i * 64 + lane) * 4);
  }
  for (int row = gw; row < NT; row += nw) {
    f32x4 nv[4];
    const bool more = row + nw < NT;
    if (more) {
      const float* xs = src_of(row + nw);
#pragma unroll
      for (int i = 0; i < 4; ++i) nv[i] = *(const f32x4*)(xs + (i * 64 + lane) * 4);
    }
    float ss = 0;
#pragma unroll
    for (int i = 0; i < 4; ++i) ss += v[i][0] * v[i][0] + v[i][1] * v[i][1] + v[i][2] * v[i][2] + v[i][3] * v[i][3];
    ss = wave_sum(ss);
    const float r = rsqrtf(ss * (1.f / 1024.f) + EPSF);
    if (which == 2) {
      f32x4 g[4];
#pragma unroll
      for (int i = 0; i < 4; ++i) g[i] = *(const f32x4*)(p.in[I_FNG] + (i * 64 + lane) * 4);
#pragma unroll
      for (int i = 0; i < 4; ++i) {
        int e = (i * 64 + lane) * 4;
        f32x4 o = v[i] * r * g[i];
        *(f32x4*)(p.out + (size_t)row * 1024 + e) = o;
      }
    } else {
      const float* gn = p.in[which == 0 ? I_N1G : I_N2G] + layer * 1024;
      const float* md = (const float*)(p.ws + OFF_MOD) + ((size_t)layer * 5 + mod_index(row)) * 6144 + (which == 0 ? 0 : 3072);
      u16* h = (u16*)(p.ws + OFF_H) + (size_t)row * 1024;
      f32x4 g[4], sh[4], sc[4];
#pragma unroll
      for (int i = 0; i < 4; ++i) {
        int e = (i * 64 + lane) * 4;
        g[i] = *(const f32x4*)(gn + e);
        sh[i] = *(const f32x4*)(md + e);
        sc[i] = *(const f32x4*)(md + 1024 + e);
      }
#pragma unroll
      for (int i = 0; i < 4; ++i) {
        int e = (i * 64 + lane) * 4;
        f32x4 o = v[i] * r * g[i] * (1.f + sc[i]) + sh[i];
        *(u32x2*)(h + e) = pack4(o);
      }
    }
    if (more) {
#pragma unroll
      for (int i = 0; i < 4; ++i) v[i] = nv[i];
    }
  }
}

#define LAS3 __attribute__((address_space(3)))
template <int NI>
DI void stage_tile_dma(const u16* __restrict__ G, int ld, int row0, int k0, char* lds, int tid) {
#pragma unroll
  for (int i = 0; i < NI; ++i) {
    const int q = tid + NTHR * i, r = q >> 3, c = (q & 7) ^ ((r >> 1) & 7);
    __builtin_amdgcn_global_load_lds((const unsigned*)(G + (size_t)(row0 + r) * ld + k0 + c * 8), (LAS3 unsigned*)(lds + q * 16), 16, 0, 0);
  }
}
struct TD { const u16* A; const u16* B; int lda, ldb, k0, nk, m0, n0; };
template <int NB>
DI void stage_td(const TD& d, int kt, char* stage_base, int tid) {
  stage_tile_dma<4>(d.A, d.lda, d.m0, d.k0 + kt * 64, stage_base, tid);
  stage_tile_dma<2 * NB>(d.B, d.ldb, d.n0, d.k0 + kt * 64, stage_base + 32768, tid);
}
template <int NB>
DI void gemm_stream(const TD& cur, bool has_next, const TD& nxt, char* smem, int& buf, f32x16 (&acc)[4][NB]) {
  const int tid = get_tid(), lane = tid & 63, wave = tid >> 6, wm = wave >> 2, wn = wave & 3, l32 = lane & 31, hh = lane >> 5;
#pragma unroll
  for (int bi = 0; bi < 4; ++bi)
#pragma unroll
    for (int bj = 0; bj < NB; ++bj)
#pragma unroll
      for (int r = 0; r < 16; ++r) acc[bi][bj][r] = 0.f;
  const int swz = (l32 >> 1) & 7;
  const int arow = (wm * 128 + l32) * 128, brow = (wn * (NB * 32) + l32) * 128;
  const int c0 = ((0 + hh) ^ swz) * 16, c1 = ((2 + hh) ^ swz) * 16, c2 = ((4 + hh) ^ swz) * 16, c3 = ((6 + hh) ^ swz) * 16;
  asm volatile("s_waitcnt vmcnt(0)" ::: "memory");
  __syncthreads();
  const int nk = cur.nk;
  for (int kt = 0; kt < nk; ++kt) {
    const bool early = wave < 4;
    if (early) {
      if (kt + 1 < nk) stage_td<NB>(cur, kt + 1, smem + (buf ^ 1) * 65536, tid);
      else if (has_next) stage_td<NB>(nxt, 0, smem + (buf ^ 1) * 65536, tid);
    }
    const char* as = smem + buf * 65536 + arow;
    const char* bs = smem + buf * 65536 + 32768 + brow;
#pragma unroll
    for (int ks = 0; ks < 4; ++ks) {
      const int co = (ks == 0) ? c0 : (ks == 1) ? c1 : (ks == 2) ? c2 : c3;
      bf16x8 fa[4], fb[NB];
#pragma unroll
      for (int bi = 0; bi < 4; ++bi) fa[bi] = *(const bf16x8*)(as + bi * 4096 + co);
#pragma unroll
      for (int bj = 0; bj < NB; ++bj) fb[bj] = *(const bf16x8*)(bs + bj * 4096 + co);
      __builtin_amdgcn_s_setprio(1);
#pragma unroll
      for (int bi = 0; bi < 4; ++bi)
#pragma unroll
        for (int bj = 0; bj < NB; ++bj) acc[bi][bj] = MFMA32(fa[bi], fb[bj], acc[bi][bj]);
      __builtin_amdgcn_s_setprio(0);
      if (ks == 1 && !early) {
        if (kt + 1 < nk) stage_td<NB>(cur, kt + 1, smem + (buf ^ 1) * 65536, tid);
        else if (has_next) stage_td<NB>(nxt, 0, smem + (buf ^ 1) * 65536, tid);
      }
    }
    buf ^= 1;
    if (kt + 1 < nk) {
      asm volatile("s_waitcnt vmcnt(0)" ::: "memory");
      __syncthreads();
    }
  }
}

#if MEGA
#define XCD_ID()   ((int)((volatile int*)(smem + LDS_BYTES))[3])
#define XCD_RANK() ((int)((volatile int*)(smem + LDS_BYTES))[2])
#else
#define XCD_ID()   ((int)(blockIdx.x & 7))
#define XCD_RANK() ((int)(blockIdx.x >> 3))
#endif
#define EPI_IDX                                                                                        \
  const int tid = get_tid(), lane = tid & 63, wave = tid >> 6, wm = wave >> 2, wn = wave & 3, l32 = lane & 31, hh = lane >> 5; \
  (void)tid; (void)lane; (void)wave; (void)wm; (void)wn; (void)l32; (void)hh;
DI int crow(int r, int hh) { return (r & 3) + 8 * (r >> 2) + 4 * hh; }

DI void phase_g1(const P& p, int layer, char* smem) {
  EPI_IDX
  const u16* A = (const u16*)(p.ws + OFF_H);
  const u16* Bt = (const u16*)(p.ws + OFF_WIN) + (size_t)layer * 1920 * 1024;
  u16* proj = (u16*)(p.ws + OFF_PROJ);
  constexpr int MT = NT / 256, NTL = NP / 128, MPX = MT / 8;
  const int xcd_ = XCD_ID(), xj_ = XCD_RANK(), xn_ = gridDim.x >> 3;
  auto tile_at = [&](int u) { TD d; d.A = A; d.B = Bt; d.lda = 1024; d.ldb = 1024; d.k0 = 0; d.nk = 16; d.m0 = (xcd_ * MPX + u % MPX) * 256; d.n0 = (u / MPX) * 128; return d; };
  int buf = 0;
  TD cur = tile_at(xj_ < MPX * NTL ? xj_ : 0);
  if (xj_ < MPX * NTL) stage_td<1>(cur, 0, smem, tid);
  for (int u = xj_; u < MPX * NTL; u += xn_) {
    const bool has_next = (u + xn_ < MPX * NTL);
    const TD nxt = tile_at(has_next ? u + xn_ : u);
    const int m0 = cur.m0, n0 = cur.n0;
    f32x16 acc[4][1];
    gemm_stream<1>(cur, has_next, nxt, smem, buf, acc);
    cur = nxt;
    const bool lat = m0 >= NCTX;
    const int b_all = lat ? 32 + ((m0 - NCTX) >> 10) : (m0 >> 8);
    const int nkk = lat ? 1536 : 256;
#pragma unroll
    for (int bi = 0; bi < 4; ++bi)
#pragma unroll
      for (int bj = 0; bj < 1; ++bj) {
        const int rb = m0 + wm * 128 + bi * 32;
        const int cb = n0 + wn * 32 + bj * 32;
        const int col = cb + l32;
        if (cb < NP) {
#pragma unroll
          for (int r = 0; r < 16; ++r) proj[(size_t)(rb + crow(r, hh)) * NP + col] = f2bf(acc[bi][bj][r]);
        }
        const bool isdv = (cb >= 512 && cb < 768), isgv = (cb >= 1152 && cb < 1280);
        if (isdv || isgv) {
          u16* vt; int f;
          if (isdv) { f = col - 512; vt = (u16*)(p.ws + OFF_DVT) + vt_off(b_all, f >> 6, 4); }
          else { f = col - 1152; vt = (u16*)(p.ws + OFF_GVT) + vt_off(b_all, f >> 6, 2); }
          vt += (size_t)(f & 63) * nkk;
#pragma unroll
          for (int j = 0; j < 4; ++j) {
            int row = rb + 16 * (j >> 1) + 8 * hh + 4 * (j & 1);
            int key = lat ? 512 + ((row - NCTX) & 1023) : (row & 255);
            f32x4 v = {acc[bi][bj][4 * j], acc[bi][bj][4 * j + 1], acc[bi][bj][4 * j + 2], acc[bi][bj][4 * j + 3]};
            *(u32x2*)(vt + key) = pack4(v);
          }
        }
      }
  }
}

DI void phase_g2(const P& p, int layer, char* smem) {
  EPI_IDX
  constexpr int T_MQ = (NT / 256) * 2, T_MKV = (NKR / 256) * 2;
  const f32x2* tab32 = (const f32x2*)(p.ws + OFF_ROPE);
  auto tile_at = [&](int t) {
    TD d; d.k0 = 0;
    if (t < T_MQ) { d.A = (const u16*)(p.ws + OFF_CQN); d.B = (const u16*)(p.ws + OFF_WUQ) + (size_t)layer * 384 * 192; d.lda = 192; d.ldb = 192; d.nk = 3; d.m0 = (t >> 1) * 256; d.n0 = (t & 1) * 256; }
    else { const int t2 = t - T_MQ; d.A = (const u16*)(p.ws + OFF_CKVN); d.B = (const u16*)(p.ws + OFF_WUKV) + (size_t)layer * 512 * 128; d.lda = 128; d.ldb = 128; d.nk = 2; d.m0 = (t2 >> 1) * 256; d.n0 = (t2 & 1) * 256; }
    return d;
  };
  int buf = 0;
  const int t_first = blockIdx.x;
  TD cur = tile_at(t_first < T_MQ + T_MKV ? t_first : 0);
  if (t_first < T_MQ + T_MKV) stage_td<2>(cur, 0, smem, tid);
  for (int t = blockIdx.x; t < T_MQ + T_MKV; t += gridDim.x) {
    const bool has_next = (t + (int)gridDim.x < T_MQ + T_MKV);
    const TD nxt = tile_at(has_next ? t + (int)gridDim.x : t);
    f32x16 acc[4][2];
    const int m0 = cur.m0, n0 = cur.n0;
    gemm_stream<2>(cur, has_next, nxt, smem, buf, acc);
    cur = nxt;
    if (t < T_MQ) {
      const bool lat = m0 >= NCTX;
      const float scl = 0.10206207261596575f * LOG2E;
      u16* mq = (u16*)(p.ws + OFF_MQ);
#pragma unroll
      for (int bi = 0; bi < 4; ++bi)
#pragma unroll
        for (int bj = 0; bj < 2; ++bj) {
          const int rb = m0 + wm * 128 + bi * 32;
          const int cb = n0 + wn * 64 + bj * 32;
          const int col = cb + l32;
          if (cb < 384) {
            const bool isrope = lat && ((cb % 96) == 64);
            const int e = l32, w2 = e & 15, fi = w2 & 7;
            const bool isx2 = w2 >= 8, half = e >= 16;
#pragma unroll
            for (int r = 0; r < 16; ++r) {
              float v = acc[bi][bj][r];
              const int row = rb + crow(r, hh);
              if (isrope) {
                const int tt = (row - NCTX) & 1023;
                const int pos = half ? (tt & 63) : (tt >> 6);
                const f32x2 cs = tab32[pos * 16 + fi];
                float pv = __shfl_xor(v, 8);
                v = v * cs[0] + (isx2 ? pv : -pv) * cs[1];
              }
              mq[(size_t)row * 384 + col] = f2bf(v * scl);
            }
          }
        }
    } else {
      const bool lat = m0 >= NCTX;
      const int b_all = lat ? 32 + (m0 - NCTX) / 1536 : (m0 >> 8);
      const int nkk = lat ? 1536 : 256;
      const int kbase = lat ? (m0 - NCTX) % 1536 : (m0 & 255);
      u16* mk = (u16*)(p.ws + OFF_MKB);
#pragma unroll
      for (int bi = 0; bi < 4; ++bi)
#pragma unroll
        for (int bj = 0; bj < 2; ++bj) {
          const int rloc = wm * 128 + bi * 32;
          const int cb = n0 + wn * 64 + bj * 32;
          const int head = cb >> 7, wc = (cb & 127) + l32;
          if ((cb & 127) < 64) {
#pragma unroll
            for (int r = 0; r < 16; ++r) mk[(size_t)(m0 + rloc + crow(r, hh)) * 384 + head * 96 + wc] = f2bf(acc[bi][bj][r]);
          } else {
            u16* vt = (u16*)(p.ws + OFF_MVT) + vt_off(b_all, head, 4) + (size_t)(wc - 64) * nkk + kbase + rloc;
#pragma unroll
            for (int j = 0; j < 4; ++j) {
              f32x4 v = {acc[bi][bj][4 * j], acc[bi][bj][4 * j + 1], acc[bi][bj][4 * j + 2], acc[bi][bj][4 * j + 3]};
              *(u32x2*)(vt + 16 * (j >> 1) + 8 * hh + 4 * (j & 1)) = pack4(v);
            }
          }
        }
    }
  }
  {
    const int gw = blockIdx.x * NWV + wave, nw = gridDim.x * NWV;
    const f32x4 dd = *(const f32x4*)(p.in[I_SSMD] + layer * 256 + lane * 4);
    for (int row = gw; row < NT; row += nw) {
      const float* y0 = (const float*)(p.ws + OFF_YBUF) + (size_t)row * 256 + lane * 4;
      u16* prow = (u16*)(p.ws + OFF_PROJ) + (size_t)row * NP;
      f32x4 a = *(const f32x4*)y0, b = *(const f32x4*)(y0 + (size_t)NT * 256), c = ld4bf(prow + 1280 + lane * 4);
      f32x4 sv = a + b + c * dd;
      f32x4 g = {gelu_tanh(sv[0]), gelu_tanh(sv[1]), gelu_tanh(sv[2]), gelu_tanh(sv[3])};
      *(u32x2*)(prow + lane * 4) = pack4(g);
    }
  }
}

DI void phase_resid(const P& p, int layer, char* smem, bool is_out) {
  EPI_IDX
  const u16* A = is_out ? (const u16*)(p.ws + OFF_MIXED) : (const u16*)(p.ws + OFF_A);
  const int K = is_out ? 1024 : 4096;
  const u16* Bt = is_out ? (const u16*)(p.ws + OFF_WOUT) + (size_t)layer * 1024 * 1024 : (const u16*)(p.ws + OFF_W2) + (size_t)layer * 1024 * 4096;
  constexpr int MT = NT / 256, NTL = 4, MPX = MT / 8, NU = MPX * NTL;
  const int xcd_ = XCD_ID(), xj_ = XCD_RANK(), xn_ = gridDim.x >> 3;
  auto tile_at = [&](int u) {
    TD d; d.A = A; d.B = Bt; d.lda = K; d.ldb = K; d.nk = K / 64; d.k0 = 0;
    d.n0 = (u % NTL) * 256;
    d.m0 = (xcd_ * MPX + u / NTL) * 256;
    return d;
  };
  int buf = 0;
  TD cur = tile_at(xj_ < NU ? xj_ : 0);
  if (xj_ < NU) stage_td<2>(cur, 0, smem, tid);
  for (int u = xj_; u < NU; u += xn_) {
    const bool has_next = (u + xn_ < NU);
    const TD nxt = tile_at(has_next ? u + xn_ : u);
    const int m0 = cur.m0, n0 = cur.n0;
    f32x16 acc[4][2];
    gemm_stream<2>(cur, has_next, nxt, smem, buf, acc);
    cur = nxt;
    const float* gate = (const float*)(p.ws + OFF_MOD) + ((size_t)layer * 5 + mod_index(m0)) * 6144 + (is_out ? 2048 : 5120);
#pragma unroll
    for (int bi = 0; bi < 4; ++bi)
#pragma unroll
      for (int bj = 0; bj < 2; ++bj) {
        const int rb = m0 + wm * 128 + bi * 32;
        const int col = n0 + wn * 64 + bj * 32 + l32;
        const float g = gate[col];
        float rv[16];
#pragma unroll
        for (int r = 0; r < 16; ++r) {
          const int row = rb + crow(r, hh);
          rv[r] = (is_out && layer == 0) ? x_row_src(p, 0, row)[col] : p.out[(size_t)row * 1024 + col];
        }
#pragma unroll
        for (int r = 0; r < 16; ++r) p.out[(size_t)(rb + crow(r, hh)) * 1024 + col] = rv[r] + g * acc[bi][bj][r];
      }
  }
}

DI void phase_g5(const P& p, int layer, char* smem) {
  EPI_IDX
  const u16* A = (const u16*)(p.ws + OFF_H);
  const u16* Bt = (const u16*)(p.ws + OFF_W1) + (size_t)layer * 4096 * 1024;
  u16* a = (u16*)(p.ws + OFF_A);
  constexpr int MT = NT / 256, NTL = 16, MPX = MT / 8;
  const int xcd_ = XCD_ID(), xj_ = XCD_RANK(), xn_ = gridDim.x >> 3;
  auto tile_at = [&](int u) { TD d; d.A = A; d.B = Bt; d.lda = 1024; d.ldb = 1024; d.k0 = 0; d.nk = 16; d.m0 = (xcd_ * MPX + u % MPX) * 256; d.n0 = (u / MPX) * 256; return d; };
  int buf = 0;
  TD cur = tile_at(xj_ < MPX * NTL ? xj_ : 0);
  if (xj_ < MPX * NTL) stage_td<2>(cur, 0, smem, tid);
  for (int u = xj_; u < MPX * NTL; u += xn_) {
    const bool has_next = (u + xn_ < MPX * NTL);
    const TD nxt = tile_at(has_next ? u + xn_ : u);
    const int m0 = cur.m0, n0 = cur.n0;
    f32x16 acc[4][2];
    gemm_stream<2>(cur, has_next, nxt, smem, buf, acc);
    cur = nxt;
#pragma unroll
    for (int bi = 0; bi < 4; ++bi)
#pragma unroll
      for (int bj = 0; bj < 2; ++bj) {
        const int rb = m0 + wm * 128 + bi * 32;
        const int col = n0 + wn * 64 + bj * 32 + l32;
#pragma unroll
        for (int r = 0; r < 16; ++r) {
          float v = fmaxf(acc[bi][bj][r], 0.f);
          a[(size_t)(rb + crow(r, hh)) * 4096 + col] = f2bf(v * v);
        }
      }
  }
}

template <int R>
DI f32x4 rope4(f32x4 v, int lane, int t, const f32x2* tab) {
  constexpr int n = R / 4;
  const int e = (lane * 4) % R;
  const int half = e / (R / 2), w = e % (R / 2);
  const bool isx2 = w >= n;
  const int fi = w % n;
  const int pos = half ? (t & 63) : (t >> 6);
  f32x4 o;
#pragma unroll
  for (int i = 0; i < 4; ++i) {
    float pv = __shfl_xor(v[i], n / 4);
    f32x2 cs = tab[pos * 16 + fi + i];
    o[i] = v[i] * cs[0] + (isx2 ? pv : -pv) * cs[1];
  }
  return o;
}

DI void ssm_item(const P& p, int layer, int item, float* lds, int lane) {
  int b_all, r;
  if (item < 128) { b_all = 32 + item / 32; r = item % 32; } else { int it = item - 128; b_all = it / 32; r = it % 32; }
  const int dir = r >> 4, g = r & 15;
  const bool lat = b_all >= 32;
  const int T = lat ? 1024 : 256;
  const int row0 = lat ? NCTX + (b_all - 32) * 1024 : b_all * 256;
  const int tabidx = (layer * 2 + dir) * 16 + g;
  const int l32 = lane & 31, hh = lane >> 5, l16 = lane & 15, q4 = lane >> 4;
  const u16* atab = (const u16*)(p.ws + OFF_ATAB) + (size_t)tabidx * 128 * 16;
  const u16* ctab = (const u16*)(p.ws + OFF_CTAB) + (size_t)tabidx * 16 * 128;
  bf16x8 af[4], cf[4];
#pragma unroll
  for (int blk = 0; blk < 4; ++blk) af[blk] = *(const bf16x8*)(atab + (blk * 32 + l32) * 16 + hh * 8);
#pragma unroll
  for (int kk = 0; kk < 4; ++kk) cf[kk] = *(const bf16x8*)(ctab + l16 * 128 + kk * 32 + q4 * 8);
  const float* ab = (const float*)(p.ws + OFF_ABAR) + ((size_t)tabidx * 64 + lane) * 2;
  const float ar = ab[0], ai = ab[1];
  float hr = 0.f, hi = 0.f;
  if (lat) {
    size_t idx = ((size_t)((b_all - 32) * 2 + layer) * 2 + dir) * 1024 + g * 64 + lane;
    hr = p.in[I_SRE][idx]; hi = p.in[I_SIM][idx];
  }
  const u16* proj = (const u16*)(p.ws + OFF_PROJ);
  float* ybuf = (float*)(p.ws + OFF_YBUF) + (size_t)dir * NT * 256;
  f32x16 zero16;
#pragma unroll
  for (int i = 0; i < 16; ++i) zero16[i] = 0.f;
  bf16x8 un;
  {
    const int t = dir ? (T - 1 - l32) : l32;
    un = *(const bf16x8*)(proj + (size_t)(row0 + t) * NP + 1280 + g * 16 + hh * 8);
  }
  for (int ch = 0; ch < T / 32; ++ch) {
    {
      bf16x8 uf = un;
      if (ch + 1 < T / 32) {
        const int n = (ch + 1) * 32 + l32;
        const int t = dir ? (T - 1 - n) : n;
        un = *(const bf16x8*)(proj + (size_t)(row0 + t) * NP + 1280 + g * 16 + hh * 8);
      }
#pragma unroll
      for (int blk = 0; blk < 4; ++blk) {
        f32x16 d = MFMA32(af[blk], uf, zero16);
#pragma unroll
        for (int j = 0; j < 4; ++j) {
          f32x4 v = {d[4 * j], d[4 * j + 1], d[4 * j + 2], d[4 * j + 3]};
          *(f32x4*)(lds + l32 * 132 + blk * 32 + 8 * j + 4 * hh) = v;
        }
      }
    }
    wave_lds_fence();
    {
      f32x2 bu[32];
#pragma unroll
      for (int s = 0; s < 32; ++s) bu[s] = *(const f32x2*)(lds + s * 132 + 2 * lane);
#pragma unroll
      for (int s = 0; s < 32; ++s) {
        const float nr = __builtin_fmaf(ar, hr, __builtin_fmaf(-ai, hi, bu[s][0]));
        const float ni = __builtin_fmaf(ar, hi, __builtin_fmaf(ai, hr, bu[s][1]));
        hr = nr; hi = ni;
        f32x2 hv = {hr, hi};
        *(f32x2*)(lds + s * 132 + 2 * lane) = hv;
      }
    }
    wave_lds_fence();
#pragma unroll
    for (int tb = 0; tb < 2; ++tb) {
      f32x4 y = {0.f, 0.f, 0.f, 0.f};
#pragma unroll
      for (int kk = 0; kk < 4; ++kk) {
        const float* hp = lds + (tb * 16 + l16) * 132 + kk * 32 + q4 * 8;
        f32x4 a0 = *(const f32x4*)hp, a1 = *(const f32x4*)(hp + 4);
        y = MFMA16(cf[kk], pack8(a0, a1), y);
      }
      const int n2 = ch * 32 + tb * 16 + l16;
      const int t2 = dir ? (T - 1 - n2) : n2;
      *(f32x4*)(ybuf + (size_t)(row0 + t2) * 256 + g * 16 + q4 * 4) = y;
    }
    wave_lds_fence();
  }
  if (!lat) {
    size_t idx = ((size_t)(b_all * 2 + layer) * 2 + dir) * 1024 + g * 64 + lane;
    p.out[O_SRE + idx] = hr;
    p.out[O_SIM + idx] = hi;
  }
}

DI void pp_row(const P& p, int layer, int row, int lane) {
  const u16* pr = (const u16*)(p.ws + OFF_PROJ) + (size_t)row * NP;
  const bool lat = row >= NCTX;
  int b, t, keyrow;
  if (!lat) { b = row >> 8; t = row & 255; keyrow = row; }
  else { int rr = row - NCTX; b = rr >> 10; t = rr & 1023; keyrow = NCTX + b * 1536 + 512 + t; }
  const f32x2* tab32 = (const f32x2*)(p.ws + OFF_ROPE);
  const f32x2* tab64 = tab32 + 64 * 16;
  const size_t orow = (size_t)(b * 2 + layer) * 256 + t;
  const f32x4 z4 = {0.f, 0.f, 0.f, 0.f};
  f32x4 v_dq = ld4bf(pr + lane * 4);
  f32x4 v_dk = ld4bf(pr + 256 + lane * 4);
  f32x4 v_dv = ld4bf(pr + 512 + lane * 4);
  f32x4 v_gq = ld4bf(pr + 768 + lane * 4);
  f32x4 v_gk = lane < 32 ? ld4bf(pr + 1024 + lane * 4) : z4;
  f32x4 v_gv = lane < 32 ? ld4bf(pr + 1152 + lane * 4) : z4;
  f32x4 v_cq = lane < 48 ? ld4bf(pr + 1536 + lane * 4) : z4;
  f32x4 v_ckv = lane < 32 ? ld4bf(pr + 1728 + lane * 4) : z4;
  f32x4 v_kr = lane < 8 ? ld4bf(pr + 1856 + lane * 4) : z4;
  const f32x4 g_q = *(const f32x4*)(p.in[I_QNG] + layer * 64 + (lane & 15) * 4);
  const f32x4 g_k = *(const f32x4*)(p.in[I_KNG] + layer * 64 + (lane & 15) * 4);
  const f32x4 g_cq = lane < 48 ? *(const f32x4*)(p.in[I_MQNG] + layer * 192 + lane * 4) : z4;
  const f32x4 g_ckv = lane < 32 ? *(const f32x4*)(p.in[I_MKVNG] + layer * 128 + lane * 4) : z4;
  f32x2 cs32[4], cs64[4];
  {
    const int e32 = (lane * 4) & 31, w32 = e32 & 15, p32 = (e32 >> 4) ? (t & 63) : (t >> 6), f32i = w32 & 7;
    const int e64 = (lane * 4) & 63, w64 = e64 & 31, p64 = (e64 >> 5) ? (t & 63) : (t >> 6), f64i = w64 & 15;
    const f32x2 one = {1.f, 0.f};
#pragma unroll
    for (int i = 0; i < 4; ++i) {
      cs32[i] = lat ? tab32[p32 * 16 + f32i + i] : one;
      cs64[i] = lat ? tab64[p64 * 16 + f64i + i] : one;
    }
  }
  const bool x2_32 = ((lane * 4) & 15) >= 8, x2_64 = ((lane * 4) & 31) >= 16;
  auto rope32 = [&](f32x4 v) {
    f32x4 o;
#pragma unroll
    for (int i = 0; i < 4; ++i) { float pv = __shfl_xor(v[i], 2); o[i] = v[i] * cs32[i][0] + (x2_32 ? pv : -pv) * cs32[i][1]; }
    return o;
  };
  auto rope64 = [&](f32x4 v) {
    f32x4 o;
#pragma unroll
    for (int i = 0; i < 4; ++i) { float pv = __shfl_xor(v[i], 4); o[i] = v[i] * cs64[i][0] + (x2_64 ? pv : -pv) * cs64[i][1]; }
    return o;
  };
  if (!lat) {
    *(f32x4*)(p.out + O_DK + orow * 256 + lane * 4) = v_dk;
    *(f32x4*)(p.out + O_DV + orow * 256 + lane * 4) = v_dv;
    if (lane < 32) *(f32x4*)(p.out + O_GV + orow * 128 + lane * 4) = v_gv;
    if (lane < 8) *(f32x4*)(p.out + O_KR + orow * 32 + lane * 4) = v_kr;
  }
  {
    f32x4 v = v_dq;
    if (lat) v = rope32(v);
    v = v * (0.17677669529663687f * LOG2E);
    *(u32x2*)((u16*)(p.ws + OFF_DQ) + (size_t)row * 256 + lane * 4) = pack4(v);
  }
  {
    f32x4 v = v_dk;
    if (lat) v = rope32(v);
    *(u32x2*)((u16*)(p.ws + OFF_DKB) + (size_t)keyrow * 256 + lane * 4) = pack4(v);
  }
  {
    f32x4 v = v_gq;
    float ss = v[0] * v[0] + v[1] * v[1] + v[2] * v[2] + v[3] * v[3];
    ss += __shfl_xor(ss, 1); ss += __shfl_xor(ss, 2); ss += __shfl_xor(ss, 4); ss += __shfl_xor(ss, 8);
    float r = rsqrtf(ss * (1.f / 64.f) + EPSF);
    v = v * r * g_q;
    if (lat) v = rope64(v);
    v = v * (0.125f * LOG2E);
    *(u32x2*)((u16*)(p.ws + OFF_GQ) + (size_t)row * 256 + lane * 4) = pack4(v);
  }
  {
    f32x4 v = v_gk;
    float ss = v[0] * v[0] + v[1] * v[1] + v[2] * v[2] + v[3] * v[3];
    ss += __shfl_xor(ss, 1); ss += __shfl_xor(ss, 2); ss += __shfl_xor(ss, 4); ss += __shfl_xor(ss, 8);
    float r = rsqrtf(ss * (1.f / 64.f) + EPSF);
    v = v * r * g_k;
    if (!lat) { if (lane < 32) *(f32x4*)(p.out + O_GK + orow * 128 + lane * 4) = v; }
    else v = rope64(v);
    if (lane < 32) *(u32x2*)((u16*)(p.ws + OFF_GKB) + (size_t)keyrow * 128 + lane * 4) = pack4(v);
  }
  {
    f32x4 v = v_cq;
    float ss = wave_sum(v[0] * v[0] + v[1] * v[1] + v[2] * v[2] + v[3] * v[3]);
    float r = rsqrtf(ss * (1.f / 192.f) + EPSF);
    v = v * r * g_cq;
    if (lane < 48) *(u32x2*)((u16*)(p.ws + OFF_CQN) + (size_t)row * 192 + lane * 4) = pack4(v);
  }
  {
    f32x4 v = v_ckv;
    float ss = wave_sum(v[0] * v[0] + v[1] * v[1] + v[2] * v[2] + v[3] * v[3]);
    float r = rsqrtf(ss * (1.f / 128.f) + EPSF);
    v = v * r * g_ckv;
    if (lane < 32) {
      if (!lat) *(f32x4*)(p.out + O_CKV + orow * 128 + lane * 4) = v;
      *(u32x2*)((u16*)(p.ws + OFF_CKVN) + (size_t)keyrow * 128 + lane * 4) = pack4(v);
    }
  }
  {
    f32x4 v = v_kr;
    if (lat) v = rope32(v);
    if (lane < 8) {
      u32x2 pk = pack4(v);
      u16* mk = (u16*)(p.ws + OFF_MKB) + (size_t)keyrow * 384 + 64 + lane * 4;
#pragma unroll
      for (int hd = 0; hd < 4; ++hd) *(u32x2*)(mk + hd * 96) = pk;
    }
  }
}

DI void pp_cached(const P& p, int layer, int crow_, int lane) {
  const int b = crow_ >> 9, j = crow_ & 511;
  const int keyrow = NCTX + b * 1536 + j;
  const size_t src = (size_t)(b * 2 + layer) * 512 + j;
  const int jp = (j & ~15) | (((j >> 2) & 1) << 3) | (((j >> 3) & 1) << 2) | (j & 3);
  const f32x4 z4 = {0.f, 0.f, 0.f, 0.f};
  const int l31 = lane & 31, l7 = lane & 7;
  f32x4 v_dk = *(const f32x4*)(p.in[I_CDK] + src * 256 + lane * 4);
  f32x4 v_dv = *(const f32x4*)(p.in[I_CDV] + src * 256 + lane * 4);
  f32x4 v_gk = *(const f32x4*)(p.in[I_CGK] + src * 128 + l31 * 4);
  f32x4 v_gv = *(const f32x4*)(p.in[I_CGV] + src * 128 + l31 * 4);
  f32x4 v_ckv = *(const f32x4*)(p.in[I_CCKV] + src * 128 + l31 * 4);
  f32x4 v_kr = *(const f32x4*)(p.in[I_CKR] + src * 32 + l7 * 4);
  (void)z4;
  *(u32x2*)((u16*)(p.ws + OFF_DKB) + (size_t)keyrow * 256 + lane * 4) = pack4(v_dk);
  {
    u16* vt = (u16*)(p.ws + OFF_DVT) + vt_off(32 + b, lane >> 4, 4) + (size_t)((lane & 15) * 4) * 1536 + jp;
#pragma unroll
    for (int i = 0; i < 4; ++i) vt[(size_t)i * 1536] = f2bf(v_dv[i]);
  }
  if (lane < 32) {
    *(u32x2*)((u16*)(p.ws + OFF_GKB) + (size_t)keyrow * 128 + lane * 4) = pack4(v_gk);
    u16* vt = (u16*)(p.ws + OFF_GVT) + vt_off(32 + b, lane >> 4, 2) + (size_t)((lane & 15) * 4) * 1536 + jp;
#pragma unroll
    for (int i = 0; i < 4; ++i) vt[(size_t)i * 1536] = f2bf(v_gv[i]);
    *(u32x2*)((u16*)(p.ws + OFF_CKVN) + (size_t)keyrow * 128 + lane * 4) = pack4(v_ckv);
  }
  if (lane < 8) {
    u32x2 pk = pack4(v_kr);
    u16* mk = (u16*)(p.ws + OFF_MKB) + (size_t)keyrow * 384 + 64 + lane * 4;
#pragma unroll
    for (int hd = 0; hd < 4; ++hd) *(u32x2*)(mk + hd * 96) = pk;
  }
}

DI void phase_pp(const P& p, int layer, char* smem) {
  const int tid_ = get_tid();
  const int lane = tid_ & 63, wave = tid_ >> 6;
  float* lds = (float*)smem + wave * (32 * 132);
  const int gw = wave * (int)gridDim.x + (int)blockIdx.x, nw = gridDim.x * NWV;
  constexpr int N_SSM = 1152, N_ROWS = NT + 2048;
  for (int item = gw; item < N_SSM; item += nw) ssm_item(p, layer, item, lds, lane);
  const int rw0 = (nw > 256) ? 128 : 0;
  if (gw >= rw0) {
    for (int row = gw - rw0; row < N_ROWS; row += nw - rw0) {
      if (row < NT) pp_row(p, layer, row, lane);
      else pp_cached(p, layer, row - NT, lane);
    }
  }
}

template <int KW, int DK>
DI void attn_block(const u16* __restrict__ Kg, int ldk, const u16* __restrict__ Vt, int nk, const bf16x8 (&qf)[DK / 16], int kcol, char* smem,
                   int tid, f32x16 (&o)[2], float& lsum) {
  constexpr int KST = KW + 8, KS = DK / 16, KCH = KW / 8, KTOT = 64 * KCH, NKC = (KTOT + NTHR - 1) / NTHR;
  const int lane = tid & 63, l32 = lane & 31, hh = lane >> 5;
  u16* Ks = (u16*)smem;
  u16* Vs = Ks + 2 * 64 * KST;
  float m = -1e30f;
  lsum = 0.f;
#pragma unroll
  for (int db = 0; db < 2; ++db)
#pragma unroll
    for (int r = 0; r < 16; ++r) o[db][r] = 0.f;
  u32x4 rk[NKC], rv[1];
  const int nt = nk / 64;
#pragma unroll
  for (int i = 0; i < NKC; ++i) { int c = tid + NTHR * i, r = c / KCH, kc = (c % KCH) * 8; if (c < KTOT) rk[i] = *(const u32x4*)(Kg + (size_t)r * ldk + kc); }
  { int r = tid >> 3, kc = (tid & 7) * 8; rv[0] = *(const u32x4*)(Vt + (size_t)r * nk + kc); }
#pragma unroll
  for (int i = 0; i < NKC; ++i) { int c = tid + NTHR * i, r = c / KCH, kc = (c % KCH) * 8; if (c < KTOT) *(u32x4*)(Ks + r * KST + kc) = rk[i]; }
  { int r = tid >> 3, kc = (tid & 7) * 8; *(u32x4*)(Vs + r * 72 + kc) = rv[0]; }
  __syncthreads();
  for (int t = 0; t < nt; ++t) {
    const int buf = t & 1;
    const bool more = (t + 1 < nt);
    if (more) {
      const int kt = (t + 1) * 64;
#pragma unroll
      for (int i = 0; i < NKC; ++i) { int c = tid + NTHR * i, r = c / KCH, kc = (c % KCH) * 8; if (c < KTOT) rk[i] = *(const u32x4*)(Kg + (size_t)(kt + r) * ldk + kc); }
      { int r = tid >> 3, kc = (tid & 7) * 8; rv[0] = *(const u32x4*)(Vt + (size_t)r * nk + kt + kc); }
    }
    const u16* ks = Ks + buf * 64 * KST + l32 * KST + kcol + hh * 8;
    const u16* vs = Vs + buf * 64 * 72 + l32 * 72 + hh * 8;
    f32x16 sa[2];
#pragma unroll
    for (int kb = 0; kb < 2; ++kb) {
#pragma unroll
      for (int r = 0; r < 16; ++r) sa[kb][r] = 0.f;
      bf16x8 kf[KS];
#pragma unroll
      for (int s2 = 0; s2 < KS; ++s2) kf[s2] = *(const bf16x8*)(ks + kb * 32 * KST + s2 * 16);
#pragma unroll
      for (int s2 = 0; s2 < KS; ++s2) sa[kb] = MFMA32(kf[s2], qf[s2], sa[kb]);
    }
    float mx = sa[0][0];
#pragma unroll
    for (int r = 1; r < 16; ++r) mx = fmaxf(mx, sa[0][r]);
#pragma unroll
    for (int r = 0; r < 16; ++r) mx = fmaxf(mx, sa[1][r]);
    mx = fmaxf(mx, __shfl_xor(mx, 32));
    const float mn = fmaxf(m, mx);
    const float alpha = fexp2(m - mn);
    m = mn;
    float ps = 0.f;
#pragma unroll
    for (int kb = 0; kb < 2; ++kb)
#pragma unroll
      for (int r = 0; r < 16; ++r) { float e = fexp2(sa[kb][r] - mn); sa[kb][r] = e; ps += e; }
    lsum = lsum * alpha + ps;
#pragma unroll
    for (int db = 0; db < 2; ++db)
#pragma unroll
      for (int r = 0; r < 16; ++r) o[db][r] *= alpha;
#pragma unroll
    for (int s2 = 0; s2 < 4; ++s2) {
      const int kb = s2 >> 1, rb = 8 * (s2 & 1);
      f32x4 p0 = {sa[kb][rb], sa[kb][rb + 1], sa[kb][rb + 2], sa[kb][rb + 3]};
      f32x4 p1 = {sa[kb][rb + 4], sa[kb][rb + 5], sa[kb][rb + 6], sa[kb][rb + 7]};
      bf16x8 pf = pack8(p0, p1);
      bf16x8 v0 = *(const bf16x8*)(vs + s2 * 16);
      bf16x8 v1 = *(const bf16x8*)(vs + 32 * 72 + s2 * 16);
      o[0] = MFMA32(v0, pf, o[0]);
      o[1] = MFMA32(v1, pf, o[1]);
    }
    if (more) {
      const int nb = buf ^ 1;
#pragma unroll
      for (int i = 0; i < NKC; ++i) { int c = tid + NTHR * i, r = c / KCH, kc = (c % KCH) * 8; if (c < KTOT) *(u32x4*)(Ks + nb * 64 * KST + r * KST + kc) = rk[i]; }
      { int r = tid >> 3, kc = (tid & 7) * 8; *(u32x4*)(Vs + nb * 64 * 72 + r * 72 + kc) = rv[0]; }
    }
    __syncthreads();
  }
  lsum += __shfl_xor(lsum, 32);
}

DI void store_o(u16* dst  , const f32x16 (&o)[2], float scale, int hh) {
#pragma unroll
  for (int db = 0; db < 2; ++db)
#pragma unroll
    for (int j = 0; j < 4; ++j) {
      const int dv = db * 32 + 8 * j + 4 * hh;
      f32x4 v = {o[db][4 * j] * scale, o[db][4 * j + 1] * scale, o[db][4 * j + 2] * scale, o[db][4 * j + 3] * scale};
      *(u32x2*)(dst + dv) = pack4(v);
    }
}

DI void attn_item(const P& p, int layer, int item, char* smem, int tid) {
  const int lane = tid & 63, wave = tid >> 6, l32 = lane & 31, hh = lane >> 5;
  bool lat; int kind, b, hd, qblk;
  if (item < 256) {
    lat = true;
    if (item < 128) { kind = 0; b = item >> 5; hd = (item >> 3) & 3; qblk = item & 7; }
    else { int it = item - 128; kind = 1 + (it >> 6); it &= 63; b = it >> 4; hd = (it >> 2) & 3; qblk = it & 3; }
  } else {
    lat = false;
    int it = item - 256;
    if (it < 256) { kind = 0; b = it >> 3; hd = (it >> 1) & 3; qblk = it & 1; }
    else { it -= 256; kind = 1 + (it >> 7); it &= 127; b = it >> 2; hd = it & 3; qblk = 0; }
  }
  const int nk = lat ? 1536 : 256;
  const int b_all = lat ? 32 + b : b;
  const int keyrow0 = lat ? NCTX + b * 1536 : b * 256;
  const int tok0 = lat ? NCTX + b * 1024 : b * 256;
  f32x16 o[2]; float ls;
  if (kind == 0) {
    const int ns = wave & 1, qb = wave >> 1;
    const int q0 = tok0 + qblk * 128 + qb * 32;
    const u16* Q = (const u16*)(p.ws + OFF_DQ) + (size_t)(q0 + l32) * 256 + hd * 64 + ns * 32 + hh * 8;
    bf16x8 qf[2];
    qf[0] = *(const bf16x8*)Q; qf[1] = *(const bf16x8*)(Q + 16);
    attn_block<64, 32>((const u16*)(p.ws + OFF_DKB) + (size_t)keyrow0 * 256 + hd * 64, 256, (const u16*)(p.ws + OFF_DVT) + vt_off(b_all, hd, 4), nk, qf, ns * 32,
                       smem, tid, o, ls);
    float d1 = 0.f, d2 = 0.f;
    if (lane < 32) { d1 = p.in[I_LQ1][layer * 32 + lane] * p.in[I_LK1][layer * 32 + lane]; d2 = p.in[I_LQ2][layer * 32 + lane] * p.in[I_LK2][layer * 32 + lane]; }
    d1 = wave_sum(d1); d2 = wave_sum(d2);
    int ly_ = layer; asm volatile("" : "+s"(ly_));
    const float lam_init = ly_ == 0 ? 0.2f : (0.8f - 0.6f * 0.7408182206817179f);
    const float lam = expf(d1) - expf(d2) + lam_init;
    float* cmb = (float*)smem + qb * (64 * 33);
    if (ns == 1) {
      const float sc = lam / ls;
#pragma unroll
      for (int db = 0; db < 2; ++db)
#pragma unroll
        for (int r = 0; r < 16; ++r) cmb[(db * 32 + crow(r, hh)) * 33 + l32] = o[db][r] * sc;
    }
    __syncthreads();
    if (ns == 0) {
      const float i0 = 1.f / ls;
      float ss = 0.f;
#pragma unroll
      for (int db = 0; db < 2; ++db)
#pragma unroll
        for (int r = 0; r < 16; ++r) { float d = o[db][r] * i0 - cmb[(db * 32 + crow(r, hh)) * 33 + l32]; o[db][r] = d; ss += d * d; }
      ss += __shfl_xor(ss, 32);
      const float rr = rsqrtf(ss * (1.f / 64.f) + EPSF) * (1.f - lam_init);
      u16* dst = (u16*)(p.ws + OFF_MIXED) + (size_t)(q0 + l32) * 1024 + hd * 64;
#pragma unroll
      for (int db = 0; db < 2; ++db)
#pragma unroll
        for (int j = 0; j < 4; ++j) {
          const int dv = db * 32 + 8 * j + 4 * hh;
          f32x4 g = *(const f32x4*)(p.in[I_SUBLN] + layer * 64 + dv);
          f32x4 v = {o[db][4 * j] * rr * g[0], o[db][4 * j + 1] * rr * g[1], o[db][4 * j + 2] * rr * g[2], o[db][4 * j + 3] * rr * g[3]};
          *(u32x2*)(dst + dv) = pack4(v);
        }
    }
    __syncthreads();
  } else if (kind == 1) {
    const int q0 = tok0 + qblk * 256 + wave * 32;
    const u16* Q = (const u16*)(p.ws + OFF_GQ) + (size_t)(q0 + l32) * 256 + hd * 64 + hh * 8;
    bf16x8 qf[4];
#pragma unroll
    for (int s2 = 0; s2 < 4; ++s2) qf[s2] = *(const bf16x8*)(Q + s2 * 16);
    attn_block<64, 64>((const u16*)(p.ws + OFF_GKB) + (size_t)keyrow0 * 128 + (hd >> 1) * 64, 128, (const u16*)(p.ws + OFF_GVT) + vt_off(b_all, hd >> 1, 2), nk, qf, 0,
                       smem, tid, o, ls);
    store_o((u16*)(p.ws + OFF_MIXED) + (size_t)(q0 + l32) * 1024 + 256 + hd * 64, o, 1.f / ls, hh);
  } else {
    const int q0 = tok0 + qblk * 256 + wave * 32;
    const u16* Q = (const u16*)(p.ws + OFF_MQ) + (size_t)(q0 + l32) * 384 + hd * 96 + hh * 8;
    bf16x8 qf[6];
#pragma unroll
    for (int s2 = 0; s2 < 6; ++s2) qf[s2] = *(const bf16x8*)(Q + s2 * 16);
    attn_block<96, 96>((const u16*)(p.ws + OFF_MKB) + (size_t)keyrow0 * 384 + hd * 96, 384, (const u16*)(p.ws + OFF_MVT) + vt_off(b_all, hd, 4), nk, qf, 0,
                       smem, tid, o, ls);
    store_o((u16*)(p.ws + OFF_MIXED) + (size_t)(q0 + l32) * 1024 + 768 + hd * 64, o, 1.f / ls, hh);
  }
}

DI void phase_at(const P& p, int layer, char* smem) {
  EPI_IDX
  constexpr int N_ITEMS = 768;
  if (gridDim.x == 256) {
    const int b = blockIdx.x;
    attn_item(p, layer, b, smem, tid);
    __syncthreads();
    if (b < 128) {
      attn_item(p, layer, 256 + b, smem, tid); __syncthreads();
      attn_item(p, layer, 512 + b, smem, tid); __syncthreads();
      attn_item(p, layer, 640 + b, smem, tid); __syncthreads();
    } else if (b < 192) {
      attn_item(p, layer, 256 + 128 + 2 * (b - 128), smem, tid); __syncthreads();
      attn_item(p, layer, 256 + 128 + 2 * (b - 128) + 1, smem, tid); __syncthreads();
    }
  } else {
    for (int item = blockIdx.x; item < N_ITEMS; item += gridDim.x) {
      attn_item(p, layer, item, smem, tid);
      __syncthreads();
    }
  }
  {
    constexpr int T_GLU = (NT / 256) * 2;
    auto tile_at = [&](int t) { TD d; d.A = (const u16*)(p.ws + OFF_PROJ); d.lda = NP; d.B = (const u16*)(p.ws + OFF_WGLU) + (size_t)layer * 512 * 256; d.ldb = 256; d.k0 = 0; d.nk = 4; d.m0 = (t >> 1) * 256; d.n0 = (t & 1) * 256; return d; };
    int buf = 0;
    const int t0 = (int)gridDim.x - 1 - (int)blockIdx.x;
    TD cur = tile_at(t0 < T_GLU ? t0 : 0);
    if (t0 < T_GLU) stage_td<2>(cur, 0, smem, tid);
    for (int t = t0; t < T_GLU; t += gridDim.x) {
      const bool has_next = (t + (int)gridDim.x < T_GLU);
      const TD nxt = tile_at(has_next ? t + (int)gridDim.x : t);
      const int m0 = cur.m0, n0 = cur.n0;
      f32x16 acc[4][2];
      gemm_stream<2>(cur, has_next, nxt, smem, buf, acc);
      cur = nxt;
      u16* mixed = (u16*)(p.ws + OFF_MIXED);
      const int q = (n0 + wn * 64) >> 6;
#pragma unroll
      for (int bi = 0; bi < 4; ++bi) {
        const int rb = m0 + wm * 128 + bi * 32;
#pragma unroll
        for (int r = 0; r < 16; ++r) {
          float z = acc[bi][0][r], g = acc[bi][1][r];
          mixed[(size_t)(rb + crow(r, hh)) * 1024 + 512 + q * 32 + l32] = f2bf(z * fsigmoid(g));
        }
      }
    }
  }
}

#define XB_TMO      128
#define XB_XCNT(j)  (256  + 64 * (j))
#define XB_XSUB(j)  (1280 + 64 * (j))
#define XB_XGEN(j)  (2304 + 64 * (j))
#define XB_TOP      3328
#define XB_TOPGEN   3392
#define XCD_BAR_WORDS 3456
#define XB_SPIN_CAP (1u << 22)
#define LAS __attribute__((address_space(3)))
DI unsigned xb_ld(unsigned* p) { return __hip_atomic_load(p, __ATOMIC_RELAXED, __HIP_MEMORY_SCOPE_AGENT); }
DI unsigned xb_add(unsigned* p, unsigned v) { return __hip_atomic_fetch_add(p, v, __ATOMIC_RELAXED, __HIP_MEMORY_SCOPE_AGENT); }
DI unsigned xb_xcc_id() { return (unsigned)__builtin_amdgcn_s_getreg((3 << 11) | 20) & 0xFu; }
#define XB_SPIN(cond, bar) do { unsigned _sp = 0; while (cond) { __builtin_amdgcn_s_sleep(1); \
    if ((++_sp & 255u) == 0u) { if (xb_ld(&(bar)[XB_TMO])) break; if (_sp > XB_SPIN_CAP) { atomicAdd(&(bar)[XB_TMO], 1u); break; } } } } while (0)
struct XcdBarrier { unsigned* bar; unsigned x; volatile LAS unsigned* st; };
DI XcdBarrier xcd_barrier_post(unsigned* bar, volatile LAS unsigned* st) {
  XcdBarrier b; b.bar = bar; b.x = xb_xcc_id(); b.st = st;
  if (threadIdx.x == 0) st[2] = xb_add(&bar[XB_XCNT(b.x)], 1u);
  return b;
}
DI void xcd_barrier_complete(unsigned* bar, unsigned x, unsigned& nloc, unsigned& nx) {
  const unsigned G = gridDim.x * gridDim.y * gridDim.z;
  unsigned sum, cnt, mine, sp = 0u;
  for (;;) {
    sum = 0u; cnt = 0u; mine = 0u;
#pragma unroll
    for (unsigned j = 0; j < 16; ++j) { const unsigned c = xb_ld(&bar[XB_XCNT(j)]); sum += c; cnt += (c > 0u) ? 1u : 0u; mine = (j == x) ? c : mine; }
    if (sum == G) break;
    __builtin_amdgcn_s_sleep(1);
    if ((++sp & 255u) == 0u) { if (xb_ld(&bar[XB_TMO])) break; if (sp > XB_SPIN_CAP) { atomicAdd(&bar[XB_TMO], 1u); break; } }
  }
  nloc = mine > 0u ? mine : 1u; nx = cnt > 0u ? cnt : 1u;
}
DI void xcd_barrier(const XcdBarrier& b) {
  asm volatile("s_waitcnt vmcnt(0)" ::: "memory");
  __syncthreads();
  if (threadIdx.x == 0) {
    unsigned* bar = b.bar;
    __builtin_amdgcn_s_waitcnt(0);
    unsigned nloc = b.st[0], nx = b.st[1];
    if (nloc == 0u) { xcd_barrier_complete(bar, b.x, nloc, nx); b.st[0] = nloc; b.st[1] = nx; }
    const unsigned old = xb_add(&bar[XB_XSUB(b.x)], 1u);
    const unsigned gen = old / nloc;
    if (old + 1u == (gen + 1u) * nloc) {
      __builtin_amdgcn_fence(__ATOMIC_RELEASE, "agent");
      asm volatile("s_waitcnt vmcnt(0)" ::: "memory");
      const unsigned og = xb_add(&bar[XB_TOP], 1u);
      const unsigned tg = og / nx;
      if (og + 1u == (tg + 1u) * nx) xb_add(&bar[XB_TOPGEN], 1u);
      else XB_SPIN(xb_ld(&bar[XB_TOPGEN]) == tg, bar);
      __builtin_amdgcn_fence(__ATOMIC_ACQUIRE, "agent");
      xb_add(&bar[XB_XGEN(b.x)], 1u);
      asm volatile("s_waitcnt vmcnt(0)" ::: "memory");
    } else {
      XB_SPIN(xb_ld(&bar[XB_XGEN(b.x)]) == gen, bar);
      __builtin_amdgcn_fence(__ATOMIC_ACQUIRE, "agent");
      asm volatile("s_waitcnt vmcnt(0)" ::: "memory");
    }
  }
  __syncthreads();
}

DI void run_phase(const P& p_, int ph, int layer, char* smem) {
  P p = p_;
  size_t zoff = 0;
  asm volatile("" : "+s"(zoff));
  p.ws = p_.ws + zoff;
  p.out = p_.out + zoff;
  switch (ph) {
    case 0: prologue(p, smem); break;
    case 1: norm_phase(p, layer, 0); break;
    case 2: phase_g1(p, layer, smem); break;
    case 3: phase_pp(p, layer, smem); break;
    case 4: phase_g2(p, layer, smem); break;
    case 5: phase_at(p, layer, smem); break;
    case 6: phase_resid(p, layer, smem, true); break;
    case 7: norm_phase(p, layer, 1); break;
    case 8: phase_g5(p, layer, smem); break;
    case 9: phase_resid(p, layer, smem, false); break;
    case 10: norm_phase(p, 0, 2); break;
  }
}

extern __shared__ __attribute__((aligned(16))) char dyn_smem[];

__global__ void __launch_bounds__(512) fwd_mega(P p) {
  if (p.ws == nullptr) { cg::grid_group grid = cg::this_grid(); grid.sync(); }
  volatile LAS unsigned* st = (volatile LAS unsigned*)(dyn_smem + LDS_BYTES);
  if (threadIdx.x == 0) { st[0] = 0u; st[1] = 0u; st[2] = 0u; st[3] = 0u; }
  __syncthreads();
  XcdBarrier xb = xcd_barrier_post((unsigned*)(p.ws + OFF_BAR), st);
  run_phase(p, 0, 0, dyn_smem);
  xcd_barrier(xb);
  if (threadIdx.x == 0) {
    unsigned* bar = (unsigned*)(p.ws + OFF_BAR);
    bool ok = (gridDim.x & 7u) == 0u;
    for (unsigned j = 0; j < 16; ++j) { const unsigned c = xb_ld(&bar[XB_XCNT(j)]); ok = ok && (c == (j < 8 ? gridDim.x >> 3 : 0u)); }
    if (ok) st[3] = xb.x; else { st[2] = blockIdx.x >> 3; st[3] = blockIdx.x & 7u; }
  }
  __syncthreads();
  for (int l = 0; l < 2; ++l) {
    for (int ph = 1; ph <= 9; ++ph) {
      run_phase(p, ph, l, dyn_smem);
      xcd_barrier(xb);
    }
  }
  run_phase(p, 10, 0, dyn_smem);
}

#if !MEGA
__global__ void __launch_bounds__(512) fwd_phase(P p, int ph, int layer) { run_phase(p, ph, layer, dyn_smem); }
#endif

extern "C" void kernel_launch(void* const* d_in, const int* in_sizes, int n_in, void* d_out, int out_size, void* d_ws, size_t ws_size,
                              hipStream_t stream) {
  static int grid_blocks = 0;
  if (!grid_blocks) {
    int dev = 0, cus = 0, per_cu = 0;
    (void)hipGetDevice(&dev);
    (void)hipDeviceGetAttribute(&cus, hipDeviceAttributeMultiprocessorCount, dev);
    (void)hipFuncSetAttribute((const void*)fwd_mega, hipFuncAttributeMaxDynamicSharedMemorySize, LDS_BYTES + 16);
#if !MEGA
    (void)hipFuncSetAttribute((const void*)fwd_phase, hipFuncAttributeMaxDynamicSharedMemorySize, LDS_BYTES);
#endif
    (void)hipOccupancyMaxActiveBlocksPerMultiprocessor(&per_cu, (const void*)fwd_mega, NTHR, LDS_BYTES + 16);
    if (per_cu < 1) per_cu = 1;
    if (per_cu > 1) per_cu = 1;
    grid_blocks = cus * per_cu;
    if (ws_size < WS_NEED) fprintf(stderr, "kernel_launch: workspace too small: %zu < %zu\n", ws_size, (size_t)WS_NEED);
  }
  P p{};
  for (int i = 0; i < N_IN; ++i) p.in[i] = (const float*)d_in[i];
  p.out = (float*)d_out;
  p.ws = (char*)d_ws;
#if MEGA
  (void)hipMemsetAsync((char*)d_ws + OFF_BAR, 0, XCD_BAR_WORDS * 4, stream);
  void* args[] = {&p};
  hipError_t e = hipLaunchCooperativeKernel((const void*)fwd_mega, dim3(grid_blocks), dim3(NTHR), args, LDS_BYTES + 16, stream);
  if (e != hipSuccess) fprintf(stderr, "cooperative launch failed: %s (grid %d)\n", hipGetErrorString(e), grid_blocks);
#else
  hipLaunchKernelGGL(fwd_phase, dim3(grid_blocks), dim3(NTHR), LDS_BYTES, stream, p, 0, 0);
  for (int l = 0; l < 2; ++l)
    for (int ph = 1; ph <= 9; ++ph) hipLaunchKernelGGL(fwd_phase, dim3(grid_blocks), dim3(NTHR), LDS_BYTES, stream, p, ph, l);
  hipLaunchKernelGGL(fwd_phase, dim3(grid_blocks), dim3(NTHR), LDS_BYTES, stream, p, 10, 0);
#endif
}
```

```cpp
#include <hip/hip_runtime.h>
#include <hip/hip_cooperative_groups.h>
#include <cstdio>
namespace cg = cooperative_groups;

#ifndef MEGA
#define MEGA 1
#endif

#define DI __device__ __forceinline__
typedef unsigned short u16;
typedef __attribute__((ext_vector_type(8))) short bf16x8;
typedef __attribute__((ext_vector_type(4))) short bf16x4;
typedef __attribute__((ext_vector_type(2))) __bf16 bf2_t;
typedef __attribute__((ext_vector_type(2))) float f32x2;
typedef __attribute__((ext_vector_type(4))) float f32x4;
typedef __attribute__((ext_vector_type(16))) float f32x16;
typedef __attribute__((ext_vector_type(4))) unsigned u32x4;
typedef __attribute__((ext_vector_type(2))) unsigned u32x2;

#define MFMA32(a, b, c) __builtin_amdgcn_mfma_f32_32x32x16_bf16((a), (b), (c), 0, 0, 0)
#define MFMA16(a, b, c) __builtin_amdgcn_mfma_f32_16x16x32_bf16((a), (b), (c), 0, 0, 0)

constexpr int NT = 12288;
constexpr int NCTX = 8192;
constexpr int NKR = 14336;
constexpr int NP = 1920;
constexpr float EPSF = 1e-6f;
constexpr float LOG2E = 1.4426950408889634f;

enum { I_XP = 0, I_XS, I_CDK, I_CDV, I_CGK, I_CGV, I_CCKV, I_CKR, I_SRE, I_SIM, I_C, I_CCTX, I_N1G, I_N2G, I_WADA, I_BADA,
       I_WIN, I_WOUT, I_LQ1, I_LK1, I_LQ2, I_LK2, I_SUBLN, I_QNG, I_KNG, I_ARE, I_AIM, I_LOGDT, I_BRE, I_BIM, I_CRE, I_CIM,
       I_SSMD, I_WGLU, I_MQNG, I_MKVNG, I_WUQ, I_WUKV, I_W1, I_W2, I_FNG, N_IN };

constexpr size_t O_Y = 0;
constexpr size_t O_DK = 12582912;
constexpr size_t O_DV = 16777216;
constexpr size_t O_GK = 20971520;
constexpr size_t O_GV = 23068672;
constexpr size_t O_CKV = 25165824;
constexpr size_t O_KR = 27262976;
constexpr size_t O_SRE = 27787264;
constexpr size_t O_SIM = 27918336;

constexpr size_t al256(size_t x) { return (x + 255) & ~(size_t)255; }
constexpr size_t OFF_MOD = 0;
constexpr size_t OFF_CTR = al256(OFF_MOD + 2 * 5 * 6144 * 4);
constexpr size_t OFF_BAR = al256(OFF_CTR + 256);
constexpr size_t OFF_ROPE = al256(OFF_BAR + 3456 * 4);
constexpr size_t OFF_ABAR = al256(OFF_ROPE + 2 * 64 * 16 * 8);
constexpr size_t OFF_ATAB = al256(OFF_ABAR + 64 * 64 * 8);
constexpr size_t OFF_CTAB = al256(OFF_ATAB + 64 * 128 * 16 * 2);
constexpr size_t OFF_WIN = al256(OFF_CTAB + 64 * 16 * 128 * 2);
constexpr size_t OFF_WOUT = al256(OFF_WIN + (size_t)2 * 1920 * 1024 * 2);
constexpr size_t OFF_W1 = al256(OFF_WOUT + (size_t)2 * 1024 * 1024 * 2);
constexpr size_t OFF_W2 = al256(OFF_W1 + (size_t)2 * 4096 * 1024 * 2);
constexpr size_t OFF_WUQ = al256(OFF_W2 + (size_t)2 * 4096 * 1024 * 2);
constexpr size_t OFF_WUKV = al256(OFF_WUQ + (size_t)2 * 384 * 192 * 2);
constexpr size_t OFF_WGLU = al256(OFF_WUKV + (size_t)2 * 512 * 128 * 2);
constexpr size_t OFF_H = al256(OFF_WGLU + (size_t)2 * 512 * 256 * 2);
constexpr size_t OFF_MIXED = OFF_H;
constexpr size_t OFF_BIG = al256(OFF_H + (size_t)NT * 1024 * 2);
constexpr size_t OFF_PROJ = OFF_BIG;
constexpr size_t OFF_DQ = al256(OFF_PROJ + (size_t)NT * NP * 4);
constexpr size_t OFF_DKB = al256(OFF_DQ + (size_t)NT * 256 * 2);
constexpr size_t OFF_DVT = al256(OFF_DKB + (size_t)NKR * 256 * 2);
constexpr size_t OFF_GQ = al256(OFF_DVT + (size_t)NKR * 256 * 2);
constexpr size_t OFF_GKB = al256(OFF_GQ + (size_t)NT * 256 * 2);
constexpr size_t OFF_GVT = al256(OFF_GKB + (size_t)NKR * 128 * 2);
constexpr size_t OFF_MQ = al256(OFF_GVT + (size_t)NKR * 128 * 2);
constexpr size_t OFF_MKB = al256(OFF_MQ + (size_t)NT * 384 * 2);
constexpr size_t OFF_MVT = al256(OFF_MKB + (size_t)NKR * 384 * 2);
constexpr size_t OFF_CQN = al256(OFF_MVT + (size_t)NKR * 256 * 2);
constexpr size_t OFF_CKVN = al256(OFF_CQN + (size_t)NT * 192 * 2);
constexpr size_t OFF_YBUF = al256(OFF_CKVN + (size_t)NKR * 128 * 2);
constexpr size_t OFF_END1 = al256(OFF_YBUF + (size_t)2 * NT * 256 * 4);
constexpr size_t OFF_A = OFF_BIG;
constexpr size_t OFF_END2 = al256(OFF_A + (size_t)NT * 4096 * 2);
constexpr size_t WS_NEED = OFF_END1 > OFF_END2 ? OFF_END1 : OFF_END2;
static_assert(WS_NEED <= (size_t)256 * 1024 * 1024, "workspace over 256 MiB");

constexpr int NTHR = 512;
constexpr int NWV = NTHR / 64;
constexpr int LDS_BYTES = 8 * 32 * 132 * 4;

struct P {
  const float* in[N_IN];
  float* out;
  char* ws;
};

DI unsigned pack2(float a, float b) { f32x2 v = {a, b}; return __builtin_bit_cast(unsigned, __builtin_convertvector(v, bf2_t)); }
DI u16 f2bf(float a) { return (u16)(pack2(a, 0.f) & 0xffffu); }
DI bf16x8 pack8(f32x4 a, f32x4 b) {
  u32x4 r = {pack2(a[0], a[1]), pack2(a[2], a[3]), pack2(b[0], b[1]), pack2(b[2], b[3])};
  return __builtin_bit_cast(bf16x8, r);
}
DI f32x4 ld4bf(const u16* p) {
  const u32x2 w = *(const u32x2*)p;
  f32x4 r = {__uint_as_float(w[0] << 16), __uint_as_float(w[0] & 0xffff0000u), __uint_as_float(w[1] << 16), __uint_as_float(w[1] & 0xffff0000u)};
  return r;
}
DI f32x4 ld4bf_nt(const u16* p) {
  const u32x2 w = __builtin_nontemporal_load((const u32x2*)p);
  f32x4 r = {__uint_as_float(w[0] << 16), __uint_as_float(w[0] & 0xffff0000u), __uint_as_float(w[1] << 16), __uint_as_float(w[1] & 0xffff0000u)};
  return r;
}
DI u32x2 pack4(f32x4 a) { u32x2 r = {pack2(a[0], a[1]), pack2(a[2], a[3])}; return r; }
DI int get_tid() { int t = threadIdx.x; asm volatile("" : "+v"(t)); return t; }
DI float fexp2(float x) { return __builtin_amdgcn_exp2f(x); }
DI float frcp(float x) { return __builtin_amdgcn_rcpf(x); }
DI float fsigmoid(float w) { return frcp(1.f + fexp2(-w * LOG2E)); }
DI float gelu_tanh(float x) { return x * fsigmoid(1.5957691216057308f * (x + 0.044715f * x * x * x)); }
DI float wave_sum(float v) {
#pragma unroll
  for (int o = 32; o >= 1; o >>= 1) v += __shfl_xor(v, o);
  return v;
}
DI void wave_lds_fence() {
  asm volatile("s_waitcnt lgkmcnt(0)" ::: "memory");
  __builtin_amdgcn_wave_barrier();
}
DI int fetch_item(int* ctr, int lane) {
  int v = 0;
  if (lane == 0) v = atomicAdd(ctr, 1);
  return __builtin_amdgcn_readfirstlane(v);
}
DI size_t vt_off(int b_all, int head, int H) {
  if (b_all < 32) return ((size_t)(b_all * H + head) * 64) * 256;
  return (size_t)32 * H * 64 * 256 + ((size_t)((b_all - 32) * H + head) * 64) * 1536;
}
DI int mod_index(int row) { return row < NCTX ? 0 : 1 + ((row - NCTX) >> 10); }

DI void prologue(const P& p, char* smem) {
  const int tid = get_tid();
  float* fs = (float*)smem;
  constexpr int N_ADA = 384, N_TAB = 64, N_MISC = 1, N_TR = 5700;
  constexpr int TOTAL = N_ADA + N_TAB + N_MISC;
  for (int it = blockIdx.x; it < TOTAL; it += gridDim.x) {
    if (it < N_ADA) {
      const int l = it / 192, ch = it % 192;
      float* sc = fs;
      float* red = fs + 5 * 1024;
      for (int i = tid; i < 5 * 1024; i += NTHR) {
        int m = i >> 10, k = i & 1023;
        float c = (m == 0) ? p.in[I_CCTX][k] : p.in[I_C][(m - 1) * 1024 + k];
        sc[i] = c * fsigmoid(c);
      }
      __syncthreads();
      const int col = tid & 31, kg = tid >> 5;
      const float* w = p.in[I_WADA] + ((size_t)l * 1024 + kg * 64) * 6144 + ch * 32 + col;
      float a0 = 0, a1 = 0, a2 = 0, a3 = 0, a4 = 0;
#pragma unroll 16
      for (int k = 0; k < 64; ++k) {
        float wv = __builtin_nontemporal_load(w + (size_t)k * 6144);
        int kk = kg * 64 + k;
        a0 += sc[kk] * wv; a1 += sc[1024 + kk] * wv; a2 += sc[2048 + kk] * wv; a3 += sc[3072 + kk] * wv; a4 += sc[4096 + kk] * wv;
      }
      red[(kg * 5 + 0) * 32 + col] = a0; red[(kg * 5 + 1) * 32 + col] = a1; red[(kg * 5 + 2) * 32 + col] = a2;
      red[(kg * 5 + 3) * 32 + col] = a3; red[(kg * 5 + 4) * 32 + col] = a4;
      __syncthreads();
      if (tid < 160) {
        int m = tid >> 5, c2 = tid & 31;
        float s = 0;
#pragma unroll
        for (int g = 0; g < 16; ++g) s += red[(g * 5 + m) * 32 + c2];
        int n = ch * 32 + c2;
        s += p.in[I_BADA][l * 6144 + n];
        ((float*)(p.ws + OFF_MOD))[((size_t)l * 5 + m) * 6144 + n] = s;
      }
      __syncthreads();
    } else if (it < N_ADA + N_TAB) {
      const int idx = it - N_ADA;
      if (tid < 64) {
        const int pp = tid;
        float are = p.in[I_ARE][idx * 64 + pp], aim = p.in[I_AIM][idx * 64 + pp];
        float dt = expf(p.in[I_LOGDT][idx]);
        float zr = are * dt, zi = aim * dt;
        float e = expf(zr);
        float abr = e * cosf(zi), abi = e * sinf(zi);
        float d2 = are * are + aim * aim;
        float nr = abr - 1.f, ni = abi;
        float qr = (nr * are + ni * aim) / d2, qi = (ni * are - nr * aim) / d2;
        u16* at = (u16*)(p.ws + OFF_ATAB) + (size_t)idx * 128 * 16;
        u16* ct = (u16*)(p.ws + OFF_CTAB) + (size_t)idx * 16 * 128;
        for (int c = 0; c < 16; ++c) {
          float bre = p.in[I_BRE][((size_t)idx * 64 + pp) * 16 + c], bim = p.in[I_BIM][((size_t)idx * 64 + pp) * 16 + c];
          at[(2 * pp) * 16 + c] = f2bf(qr * bre - qi * bim);
          at[(2 * pp + 1) * 16 + c] = f2bf(qr * bim + qi * bre);
          float cre = p.in[I_CRE][((size_t)idx * 16 + c) * 64 + pp], cim = p.in[I_CIM][((size_t)idx * 16 + c) * 64 + pp];
          ct[c * 128 + 2 * pp] = f2bf(cre);
          ct[c * 128 + 2 * pp + 1] = f2bf(-cim);
        }
        float* ab = (float*)(p.ws + OFF_ABAR) + ((size_t)idx * 64 + pp) * 2;
        ab[0] = abr; ab[1] = abi;
      }
    } else if (it < N_ADA + N_TAB + N_MISC) {
      f32x2* tab = (f32x2*)(p.ws + OFF_ROPE);
      for (int i = tid; i < 2 * 64 * 16; i += NTHR) {
        int kind = i >> 10, pos = (i >> 4) & 63, fi = i & 15;
        int n = kind ? 16 : 8;
        float freq = expf(-(float)(fi % n) / (float)n * 9.210340371976184f);
        float ang = (float)pos * freq;
        f32x2 cs = {cosf(ang), sinf(ang)};
        tab[i] = cs;
      }
      if (tid < 64) ((int*)(p.ws + OFF_CTR))[tid] = 0;
    }
  }
  struct TrD { const float* src; u16* dst; int K, N, k0, n0; bool glu; };
  auto decode = [&](int tt) {
    TrD d; d.glu = false;
    const int l = tt / 2850;
    int r = tt % 2850; int kt, nt;
    if (r < 480) { d.src = p.in[I_WIN] + (size_t)l * 1024 * 1888; d.dst = (u16*)(p.ws + OFF_WIN) + (size_t)l * 1920 * 1024; d.K = 1024; d.N = 1888; kt = r / 30; nt = r % 30; }
    else if (r < 736) { r -= 480; d.src = p.in[I_WOUT] + (size_t)l * 1024 * 1024; d.dst = (u16*)(p.ws + OFF_WOUT) + (size_t)l * 1024 * 1024; d.K = 1024; d.N = 1024; kt = r / 16; nt = r % 16; }
    else if (r < 1760) { r -= 736; d.src = p.in[I_W1] + (size_t)l * 1024 * 4096; d.dst = (u16*)(p.ws + OFF_W1) + (size_t)l * 4096 * 1024; d.K = 1024; d.N = 4096; kt = r / 64; nt = r % 64; }
    else if (r < 2784) { r -= 1760; d.src = p.in[I_W2] + (size_t)l * 4096 * 1024; d.dst = (u16*)(p.ws + OFF_W2) + (size_t)l * 1024 * 4096; d.K = 4096; d.N = 1024; kt = r / 16; nt = r % 16; }
    else if (r < 2802) { r -= 2784; d.src = p.in[I_WUQ] + (size_t)l * 192 * 384; d.dst = (u16*)(p.ws + OFF_WUQ) + (size_t)l * 384 * 192; d.K = 192; d.N = 384; kt = r / 6; nt = r % 6; }
    else if (r < 2818) { r -= 2802; d.src = p.in[I_WUKV] + (size_t)l * 128 * 512; d.dst = (u16*)(p.ws + OFF_WUKV) + (size_t)l * 512 * 128; d.K = 128; d.N = 512; kt = r / 8; nt = r % 8; }
    else { r -= 2818; d.src = p.in[I_WGLU] + (size_t)l * 256 * 512; d.dst = (u16*)(p.ws + OFF_WGLU) + (size_t)l * 512 * 256; d.K = 256; d.N = 512; kt = r / 8; nt = r % 8; d.glu = true; }
    d.k0 = kt * 64; d.n0 = nt * 64;
    return d;
  };
  const int half = tid >> 8, t2 = tid & 255;
  float* ft = fs + half * (64 * 65);
  const int tx = t2 & 15, ty = t2 >> 4;
  auto tload = [&](const TrD& d, f32x4 (&v)[4]) {
#pragma unroll
    for (int i = 0; i < 4; ++i) {
      const int kk = ty + 16 * i, n = d.n0 + 4 * tx;
      f32x4 z = {0.f, 0.f, 0.f, 0.f};
      v[i] = (n < d.N) ? __builtin_nontemporal_load((const f32x4*)(d.src + (size_t)(d.k0 + kk) * d.N + n)) : z;
    }
  };
  const int nvb = 2 * (int)gridDim.x;
  const int tb = nvb - 1 - (2 * (int)blockIdx.x + half);
  const int nrounds = (N_TR + nvb - 1) / nvb;
  TrD cur = decode(tb < N_TR ? tb : 0);
  f32x4 cv[4];
  if (tb < N_TR) tload(cur, cv);
  for (int j = 0; j < nrounds; ++j) {
    const int tt = tb + j * nvb;
    const bool valid = tt < N_TR, more = tt + nvb < N_TR;
    TrD nxt = decode(more ? tt + nvb : 0);
    f32x4 nv[4];
    if (more) tload(nxt, nv);
    if (valid) {
#pragma unroll
      for (int i = 0; i < 4; ++i) {
        const int kk = ty + 16 * i;
        ft[kk * 65 + 4 * tx + 0] = cv[i][0]; ft[kk * 65 + 4 * tx + 1] = cv[i][1]; ft[kk * 65 + 4 * tx + 2] = cv[i][2]; ft[kk * 65 + 4 * tx + 3] = cv[i][3];
      }
    }
    __syncthreads();
    if (valid) {
#pragma unroll
      for (int i = 0; i < 2; ++i) {
        const int c = t2 + 256 * i, nn = c >> 3, kc = (c & 7) * 8;
        f32x4 a, b;
#pragma unroll
        for (int e = 0; e < 4; ++e) { a[e] = ft[(kc + e) * 65 + nn]; b[e] = ft[(kc + 4 + e) * 65 + nn]; }
        const int n = cur.n0 + nn;
        int drow = n;
        if (cur.glu) drow = (n < 256) ? ((n >> 5) * 64 + (n & 31)) : (((n - 256) >> 5) * 64 + 32 + (n & 31));
        *(bf16x8*)(cur.dst + (size_t)drow * cur.K + cur.k0 + kc) = pack8(a, b);
      }
    }
    __syncthreads();
    cur = nxt;
    if (more) {
#pragma unroll
      for (int i = 0; i < 4; ++i) cv[i] = nv[i];
    }
  }
}

DI const float* x_row_src(const P& p, int layer, int row) {
  if (layer == 0) return row < NCTX ? p.in[I_XP] + (size_t)row * 1024 : p.in[I_XS] + (size_t)(row - NCTX) * 1024;
  return p.out + (size_t)row * 1024;
}
DI void norm_phase(const P& p, int layer, int which) {
  const int tid_ = get_tid();
  const int lane = tid_ & 63;
  const int gw = blockIdx.x * NWV + (tid_ >> 6), nw = gridDim.x * NWV;
  auto src_of = [&](int row) { return (which == 0) ? x_row_src(p, layer, row) : (const float*)(p.out + (size_t)row * 1024); };
  f32x4 v[4];
  if (gw < NT) {
    const float* xs = src_of(gw);
#pragma unroll
    for (int i = 0; i < 4; ++i) v[i] = *(const f32x4*)(xs + (i * 64 + lane) * 4);
  }
  for (int row = gw; row < NT; row += nw) {
    f32x4 nv[4];
    const bool more = row + nw < NT;
    if (more) {
      const float* xs = src_of(row + nw);
#pragma unroll
      for (int i = 0; i < 4; ++i) nv[i] = *(const f32x4*)(xs + (i * 64 + lane) * 4);
    }
    float ss = 0;
#pragma unroll
    for (int i = 0; i < 4; ++i) ss += v[i][0] * v[i][0] + v[i][1] * v[i][1] + v[i][2] * v[i][2] + v[i][3] * v[i][3];
    ss = wave_sum(ss);
    const float r = rsqrtf(ss * (1.f / 1024.f) + EPSF);
    if (which == 2) {
      f32x4 g[4];
#pragma unroll
      for (int i = 0; i < 4; ++i) g[i] = *(const f32x4*)(p.in[I_FNG] + (i * 64 + lane) * 4);
#pragma unroll
      for (int i = 0; i < 4; ++i) {
        int e = (i * 64 + lane) * 4;
        f32x4 o = v[i] * r * g[i];
        *(f32x4*)(p.out + (size_t)row * 1024 + e) = o;
      }
    } else {
      const float* gn = p.in[which == 0 ? I_N1G : I_N2G] + layer * 1024;
      const float* md = (const float*)(p.ws + OFF_MOD) + ((size_t)layer * 5 + mod_index(row)) * 6144 + (which == 0 ? 0 : 3072);
      u16* h = (u16*)(p.ws + OFF_H) + (size_t)row * 1024;
      f32x4 g[4], sh[4], sc[4];
#pragma unroll
      for (int i = 0; i < 4; ++i) {
        int e = (i * 64 + lane) * 4;
        g[i] = *(const f32x4*)(gn + e);
        sh[i] = *(const f32x4*)(md + e);
        sc[i] = *(const f32x4*)(md + 1024 + e);
      }
#pragma unroll
      for (int i = 0; i < 4; ++i) {
        int e = (i * 64 + lane) * 4;
        f32x4 o = v[i] * r * g[i] * (1.f + sc[i]) + sh[i];
        *(u32x2*)(h + e) = pack4(o);
      }
    }
    if (more) {
#pragma unroll
      for (int i = 0; i < 4; ++i) v[i] = nv[i];
    }
  }
}

#define LAS3 __attribute__((address_space(3)))
template <int NI>
DI void stage_tile_dma(const u16* __restrict__ G, int ld, int row0, int k0, char* lds, int tid) {
#pragma unroll
  for (int i = 0; i < NI; ++i) {
    const int q = tid + NTHR * i, r = q >> 3, c = (q & 7) ^ ((r >> 1) & 7);
    __builtin_amdgcn_global_load_lds((const unsigned*)(G + (size_t)(row0 + r) * ld + k0 + c * 8), (LAS3 unsigned*)(lds + q * 16), 16, 0, 0);
  }
}
struct TD { const u16* A; const u16* B; int lda, ldb, k0, nk, m0, n0; };
template <int NB>
DI void stage_td(const TD& d, int kt, char* stage_base, int tid) {
  stage_tile_dma<4>(d.A, d.lda, d.m0, d.k0 + kt * 64, stage_base, tid);
  stage_tile_dma<2 * NB>(d.B, d.ldb, d.n0, d.k0 + kt * 64, stage_base + 32768, tid);
}
template <int NB>
DI void gemm_stream(const TD& cur, bool has_next, const TD& nxt, char* smem, int& buf, f32x16 (&acc)[4][NB]) {
  const int tid = get_tid(), lane = tid & 63, wave = tid >> 6, wm = wave >> 2, wn = wave & 3, l32 = lane & 31, hh = lane >> 5;
#pragma unroll
  for (int bi = 0; bi < 4; ++bi)
#pragma unroll
    for (int bj = 0; bj < NB; ++bj)
#pragma unroll
      for (int r = 0; r < 16; ++r) acc[bi][bj][r] = 0.f;
  const int swz = (l32 >> 1) & 7;
  const int arow = (wm * 128 + l32) * 128, brow = (wn * (NB * 32) + l32) * 128;
  const int c0 = ((0 + hh) ^ swz) * 16, c1 = ((2 + hh) ^ swz) * 16, c2 = ((4 + hh) ^ swz) * 16, c3 = ((6 + hh) ^ swz) * 16;
  asm volatile("s_waitcnt vmcnt(0)" ::: "memory");
  __syncthreads();
  const int nk = cur.nk;
  for (int kt = 0; kt < nk; ++kt) {
    const bool early = wave < 4;
    if (early) {
      if (kt + 1 < nk) stage_td<NB>(cur, kt + 1, smem + (buf ^ 1) * 65536, tid);
      else if (has_next) stage_td<NB>(nxt, 0, smem + (buf ^ 1) * 65536, tid);
    }
    const char* as = smem + buf * 65536 + arow;
    const char* bs = smem + buf * 65536 + 32768 + brow;
#pragma unroll
    for (int ks = 0; ks < 4; ++ks) {
      const int co = (ks == 0) ? c0 : (ks == 1) ? c1 : (ks == 2) ? c2 : c3;
      bf16x8 fa[4], fb[NB];
#pragma unroll
      for (int bi = 0; bi < 4; ++bi) fa[bi] = *(const bf16x8*)(as + bi * 4096 + co);
#pragma unroll
      for (int bj = 0; bj < NB; ++bj) fb[bj] = *(const bf16x8*)(bs + bj * 4096 + co);
      __builtin_amdgcn_s_setprio(1);
#pragma unroll
      for (int bi = 0; bi < 4; ++bi)
#pragma unroll
        for (int bj = 0; bj < NB; ++bj) acc[bi][bj] = MFMA32(fa[bi], fb[bj], acc[bi][bj]);
      __builtin_amdgcn_s_setprio(0);
      if (ks == 1 && !early) {
        if (kt + 1 < nk) stage_td<NB>(cur, kt + 1, smem + (buf ^ 1) * 65536, tid);
        else if (has_next) stage_td<NB>(nxt, 0, smem + (buf ^ 1) * 65536, tid);
      }
    }
    buf ^= 1;
    if (kt + 1 < nk) {
      asm volatile("s_waitcnt vmcnt(0)" ::: "memory");
      __syncthreads();
    }
  }
}

#if MEGA
#define XCD_ID()   ((int)((volatile int*)(smem + LDS_BYTES))[3])
#define XCD_RANK() ((int)((volatile int*)(smem + LDS_BYTES))[2])
#else
#define XCD_ID()   ((int)(blockIdx.x & 7))
#define XCD_RANK() ((int)(blockIdx.x >> 3))
#endif
#define EPI_IDX                                                                                        \
  const int tid = get_tid(), lane = tid & 63, wave = tid >> 6, wm = wave >> 2, wn = wave & 3, l32 = lane & 31, hh = lane >> 5; \
  (void)tid; (void)lane; (void)wave; (void)wm; (void)wn; (void)l32; (void)hh;
DI int crow(int r, int hh) { return (r & 3) + 8 * (r >> 2) + 4 * hh; }

DI void phase_g1(const P& p, int layer, char* smem) {
  EPI_IDX
  const u16* A = (const u16*)(p.ws + OFF_H);
  const u16* Bt = (const u16*)(p.ws + OFF_WIN) + (size_t)layer * 1920 * 1024;
  u16* proj = (u16*)(p.ws + OFF_PROJ);
  constexpr int MT = NT / 256, NTL = NP / 128, MPX = MT / 8;
  const int xcd_ = XCD_ID(), xj_ = XCD_RANK(), xn_ = gridDim.x >> 3;
  auto tile_at = [&](int u) { TD d; d.A = A; d.B = Bt; d.lda = 1024; d.ldb = 1024; d.k0 = 0; d.nk = 16; d.m0 = (xcd_ * MPX + u % MPX) * 256; d.n0 = (u / MPX) * 128; return d; };
  int buf = 0;
  TD cur = tile_at(xj_ < MPX * NTL ? xj_ : 0);
  if (xj_ < MPX * NTL) stage_td<1>(cur, 0, smem, tid);
  for (int u = xj_; u < MPX * NTL; u += xn_) {
    const bool has_next = (u + xn_ < MPX * NTL);
    const TD nxt = tile_at(has_next ? u + xn_ : u);
    const int m0 = cur.m0, n0 = cur.n0;
    f32x16 acc[4][1];
    gemm_stream<1>(cur, has_next, nxt, smem, buf, acc);
    cur = nxt;
    const bool lat = m0 >= NCTX;
    const int b_all = lat ? 32 + ((m0 - NCTX) >> 10) : (m0 >> 8);
    const int nkk = lat ? 1536 : 256;
#pragma unroll
    for (int bi = 0; bi < 4; ++bi)
#pragma unroll
      for (int bj = 0; bj < 1; ++bj) {
        const int rb = m0 + wm * 128 + bi * 32;
        const int cb = n0 + wn * 32 + bj * 32;
        const int col = cb + l32;
        if (cb < NP) {
#pragma unroll
          for (int r = 0; r < 16; ++r) proj[(size_t)(rb + crow(r, hh)) * NP + col] = f2bf(acc[bi][bj][r]);
        }
        const bool isdv = (cb >= 512 && cb < 768), isgv = (cb >= 1152 && cb < 1280);
        if (isdv || isgv) {
          u16* vt; int f;
          if (isdv) { f = col - 512; vt = (u16*)(p.ws + OFF_DVT) + vt_off(b_all, f >> 6, 4); }
          else { f = col - 1152; vt = (u16*)(p.ws + OFF_GVT) + vt_off(b_all, f >> 6, 2); }
          vt += (size_t)(f & 63) * nkk;
#pragma unroll
          for (int j = 0; j < 4; ++j) {
            int row = rb + 16 * (j >> 1) + 8 * hh + 4 * (j & 1);
            int key = lat ? 512 + ((row - NCTX) & 1023) : (row & 255);
            f32x4 v = {acc[bi][bj][4 * j], acc[bi][bj][4 * j + 1], acc[bi][bj][4 * j + 2], acc[bi][bj][4 * j + 3]};
            *(u32x2*)(vt + key) = pack4(v);
          }
        }
      }
  }
}

DI void phase_g2(const P& p, int layer, char* smem) {
  EPI_IDX
  constexpr int T_MQ = (NT / 256) * 2, T_MKV = (NKR / 256) * 2;
  const f32x2* tab32 = (const f32x2*)(p.ws + OFF_ROPE);
  auto tile_at = [&](int t) {
    TD d; d.k0 = 0;
    if (t < T_MQ) { d.A = (const u16*)(p.ws + OFF_CQN); d.B = (const u16*)(p.ws + OFF_WUQ) + (size_t)layer * 384 * 192; d.lda = 192; d.ldb = 192; d.nk = 3; d.m0 = (t >> 1) * 256; d.n0 = (t & 1) * 256; }
    else { const int t2 = t - T_MQ; d.A = (const u16*)(p.ws + OFF_CKVN); d.B = (const u16*)(p.ws + OFF_WUKV) + (size_t)layer * 512 * 128; d.lda = 128; d.ldb = 128; d.nk = 2; d.m0 = (t2 >> 1) * 256; d.n0 = (t2 & 1) * 256; }
    return d;
  };
  int buf = 0;
  const int t_first = blockIdx.x;
  TD cur = tile_at(t_first < T_MQ + T_MKV ? t_first : 0);
  if (t_first < T_MQ + T_MKV) stage_td<2>(cur, 0, smem, tid);
  for (int t = blockIdx.x; t < T_MQ + T_MKV; t += gridDim.x) {
    const bool has_next = (t + (int)gridDim.x < T_MQ + T_MKV);
    const TD nxt = tile_at(has_next ? t + (int)gridDim.x : t);
    f32x16 acc[4][2];
    const int m0 = cur.m0, n0 = cur.n0;
    gemm_stream<2>(cur, has_next, nxt, smem, buf, acc);
    cur = nxt;
    if (t < T_MQ) {
      const bool lat = m0 >= NCTX;
      const float scl = 0.10206207261596575f * LOG2E;
      u16* mq = (u16*)(p.ws + OFF_MQ);
#pragma unroll
      for (int bi = 0; bi < 4; ++bi)
#pragma unroll
        for (int bj = 0; bj < 2; ++bj) {
          const int rb = m0 + wm * 128 + bi * 32;
          const int cb = n0 + wn * 64 + bj * 32;
          const int col = cb + l32;
          if (cb < 384) {
            const bool isrope = lat && ((cb % 96) == 64);
            const int e = l32, w2 = e & 15, fi = w2 & 7;
            const bool isx2 = w2 >= 8, half = e >= 16;
#pragma unroll
            for (int r = 0; r < 16; ++r) {
              float v = acc[bi][bj][r];
              const int row = rb + crow(r, hh);
              if (isrope) {
                const int tt = (row - NCTX) & 1023;
                const int pos = half ? (tt & 63) : (tt >> 6);
                const f32x2 cs = tab32[pos * 16 + fi];
                float pv = __shfl_xor(v, 8);
                v = v * cs[0] + (isx2 ? pv : -pv) * cs[1];
              }
              mq[(size_t)row * 384 + col] = f2bf(v * scl);
            }
          }
        }
    } else {
      const bool lat = m0 >= NCTX;
      const int b_all = lat ? 32 + (m0 - NCTX) / 1536 : (m0 >> 8);
      const int nkk = lat ? 1536 : 256;
      const int kbase = lat ? (m0 - NCTX) % 1536 : (m0 & 255);
      u16* mk = (u16*)(p.ws + OFF_MKB);
#pragma unroll
      for (int bi = 0; bi < 4; ++bi)
#pragma unroll
        for (int bj = 0; bj < 2; ++bj) {
          const int rloc = wm * 128 + bi * 32;
          const int cb = n0 + wn * 64 + bj * 32;
          const int head = cb >> 7, wc = (cb & 127) + l32;
          if ((cb & 127) < 64) {
#pragma unroll
            for (int r = 0; r < 16; ++r) mk[(size_t)(m0 + rloc + crow(r, hh)) * 384 + head * 96 + wc] = f2bf(acc[bi][bj][r]);
          } else {
            u16* vt = (u16*)(p.ws + OFF_MVT) + vt_off(b_all, head, 4) + (size_t)(wc - 64) * nkk + kbase + rloc;
#pragma unroll
            for (int j = 0; j < 4; ++j) {
              f32x4 v = {acc[bi][bj][4 * j], acc[bi][bj][4 * j + 1], acc[bi][bj][4 * j + 2], acc[bi][bj][4 * j + 3]};
              *(u32x2*)(vt + 16 * (j >> 1) + 8 * hh + 4 * (j & 1)) = pack4(v);
            }
          }
        }
    }
  }
  {
    const int gw = blockIdx.x * NWV + wave, nw = gridDim.x * NWV;
    const f32x4 dd = *(const f32x4*)(p.in[I_SSMD] + layer * 256 + lane * 4);
    for (int row = gw; row < NT; row += nw) {
      const float* y0 = (const float*)(p.ws + OFF_YBUF) + (size_t)row * 256 + lane * 4;
      u16* prow = (u16*)(p.ws + OFF_PROJ) + (size_t)row * NP;
      f32x4 a = *(const f32x4*)y0, b = *(const f32x4*)(y0 + (size_t)NT * 256), c = ld4bf(prow + 1280 + lane * 4);
      f32x4 sv = a + b + c * dd;
      f32x4 g = {gelu_tanh(sv[0]), gelu_tanh(sv[1]), gelu_tanh(sv[2]), gelu_tanh(sv[3])};
      *(u32x2*)(prow + lane * 4) = pack4(g);
    }
  }
}

DI void phase_resid(const P& p, int layer, char* smem, bool is_out) {
  EPI_IDX
  const u16* A = is_out ? (const u16*)(p.ws + OFF_MIXED) : (const u16*)(p.ws + OFF_A);
  const int K = is_out ? 1024 : 4096;
  const u16* Bt = is_out ? (const u16*)(p.ws + OFF_WOUT) + (size_t)layer * 1024 * 1024 : (const u16*)(p.ws + OFF_W2) + (size_t)layer * 1024 * 4096;
  constexpr int MT = NT / 256, NTL = 4, MPX = MT / 8, NU = MPX * NTL;
  const int xcd_ = XCD_ID(), xj_ = XCD_RANK(), xn_ = gridDim.x >> 3;
  auto tile_at = [&](int u) {
    TD d; d.A = A; d.B = Bt; d.lda = K; d.ldb = K; d.nk = K / 64; d.k0 = 0;
    d.n0 = (u % NTL) * 256;
    d.m0 = (xcd_ * MPX + u / NTL) * 256;
    return d;
  };
  int buf = 0;
  TD cur = tile_at(xj_ < NU ? xj_ : 0);
  if (xj_ < NU) stage_td<2>(cur, 0, smem, tid);
  for (int u = xj_; u < NU; u += xn_) {
    const bool has_next = (u + xn_ < NU);
    const TD nxt = tile_at(has_next ? u + xn_ : u);
    const int m0 = cur.m0, n0 = cur.n0;
    f32x16 acc[4][2];
    gemm_stream<2>(cur, has_next, nxt, smem, buf, acc);
    cur = nxt;
    const float* gate = (const float*)(p.ws + OFF_MOD) + ((size_t)layer * 5 + mod_index(m0)) * 6144 + (is_out ? 2048 : 5120);
#pragma unroll
    for (int bi = 0; bi < 4; ++bi)
#pragma unroll
      for (int bj = 0; bj < 2; ++bj) {
        const int rb = m0 + wm * 128 + bi * 32;
        const int col = n0 + wn * 64 + bj * 32 + l32;
        const float g = gate[col];
        float rv[16];
#pragma unroll
        for (int r = 0; r < 16; ++r) {
          const int row = rb + crow(r, hh);
          rv[r] = (is_out && layer == 0) ? x_row_src(p, 0, row)[col] : p.out[(size_t)row * 1024 + col];
        }
#pragma unroll
        for (int r = 0; r < 16; ++r) p.out[(size_t)(rb + crow(r, hh)) * 1024 + col] = rv[r] + g * acc[bi][bj][r];
      }
  }
}

DI void phase_g5(const P& p, int layer, char* smem) {
  EPI_IDX
  const u16* A = (const u16*)(p.ws + OFF_H);
  const u16* Bt = (const u16*)(p.ws + OFF_W1) + (size_t)layer * 4096 * 1024;
  u16* a = (u16*)(p.ws + OFF_A);
  constexpr int MT = NT / 256, NTL = 16, MPX = MT / 8;
  const int xcd_ = XCD_ID(), xj_ = XCD_RANK(), xn_ = gridDim.x >> 3;
  auto tile_at = [&](int u) { TD d; d.A = A; d.B = Bt; d.lda = 1024; d.ldb = 1024; d.k0 = 0; d.nk = 16; d.m0 = (xcd_ * MPX + u % MPX) * 256; d.n0 = (u / MPX) * 256; return d; };
  int buf = 0;
  TD cur = tile_at(xj_ < MPX * NTL ? xj_ : 0);
  if (xj_ < MPX * NTL) stage_td<2>(cur, 0, smem, tid);
  for (int u = xj_; u < MPX * NTL; u += xn_) {
    const bool has_next = (u + xn_ < MPX * NTL);
    const TD nxt = tile_at(has_next ? u + xn_ : u);
    const int m0 = cur.m0, n0 = cur.n0;
    f32x16 acc[4][2];
    gemm_stream<2>(cur, has_next, nxt, smem, buf, acc);
    cur = nxt;
#pragma unroll
    for (int bi = 0; bi < 4; ++bi)
#pragma unroll
      for (int bj = 0; bj < 2; ++bj) {
        const int rb = m0 + wm * 128 + bi * 32;
        const int col = n0 + wn * 64 + bj * 32 + l32;
#pragma unroll
        for (int r = 0; r < 16; ++r) {
          float v = fmaxf(acc[bi][bj][r], 0.f);
          a[(size_t)(rb + crow(r, hh)) * 4096 + col] = f2bf(v * v);
        }
      }
  }
}

template <int R>
DI f32x4 rope4(f32x4 v, int lane, int t, const f32x2* tab) {
  constexpr int n = R / 4;
  const int e = (lane * 4) % R;
  const int half = e / (R / 2), w = e % (R / 2);
  const bool isx2 = w >= n;
  const int fi = w % n;
  const int pos = half ? (t & 63) : (t >> 6);
  f32x4 o;
#pragma unroll
  for (int i = 0; i < 4; ++i) {
    float pv = __shfl_xor(v[i], n / 4);
    f32x2 cs = tab[pos * 16 + fi + i];
    o[i] = v[i] * cs[0] + (isx2 ? pv : -pv) * cs[1];
  }
  return o;
}

DI void ssm_item(const P& p, int layer, int item, float* lds, int lane) {
  int b_all, r;
  if (item < 128) { b_all = 32 + item / 32; r = item % 32; } else { int it = item - 128; b_all = it / 32; r = it % 32; }
  const int dir = r >> 4, g = r & 15;
  const bool lat = b_all >= 32;
  const int T = lat ? 1024 : 256;
  const int row0 = lat ? NCTX + (b_all - 32) * 1024 : b_all * 256;
  const int tabidx = (layer * 2 + dir) * 16 + g;
  const int l32 = lane & 31, hh = lane >> 5, l16 = lane & 15, q4 = lane >> 4;
  const u16* atab = (const u16*)(p.ws + OFF_ATAB) + (size_t)tabidx * 128 * 16;
  const u16* ctab = (const u16*)(p.ws + OFF_CTAB) + (size_t)tabidx * 16 * 128;
  bf16x8 af[4], cf[4];
#pragma unroll
  for (int blk = 0; blk < 4; ++blk) af[blk] = *(const bf16x8*)(atab + (blk * 32 + l32) * 16 + hh * 8);
#pragma unroll
  for (int kk = 0; kk < 4; ++kk) cf[kk] = *(const bf16x8*)(ctab + l16 * 128 + kk * 32 + q4 * 8);
  const float* ab = (const float*)(p.ws + OFF_ABAR) + ((size_t)tabidx * 64 + lane) * 2;
  const float ar = ab[0], ai = ab[1];
  float hr = 0.f, hi = 0.f;
  if (lat) {
    size_t idx = ((size_t)((b_all - 32) * 2 + layer) * 2 + dir) * 1024 + g * 64 + lane;
    hr = p.in[I_SRE][idx]; hi = p.in[I_SIM][idx];
  }
  const u16* proj = (const u16*)(p.ws + OFF_PROJ);
  float* ybuf = (float*)(p.ws + OFF_YBUF) + (size_t)dir * NT * 256;
  f32x16 zero16;
#pragma unroll
  for (int i = 0; i < 16; ++i) zero16[i] = 0.f;
  bf16x8 un;
  {
    const int t = dir ? (T - 1 - l32) : l32;
    un = *(const bf16x8*)(proj + (size_t)(row0 + t) * NP + 1280 + g * 16 + hh * 8);
  }
  for (int ch = 0; ch < T / 32; ++ch) {
    {
      bf16x8 uf = un;
      if (ch + 1 < T / 32) {
        const int n = (ch + 1) * 32 + l32;
        const int t = dir ? (T - 1 - n) : n;
        un = *(const bf16x8*)(proj + (size_t)(row0 + t) * NP + 1280 + g * 16 + hh * 8);
      }
#pragma unroll
      for (int blk = 0; blk < 4; ++blk) {
        f32x16 d = MFMA32(af[blk], uf, zero16);
#pragma unroll
        for (int j = 0; j < 4; ++j) {
          f32x4 v = {d[4 * j], d[4 * j + 1], d[4 * j + 2], d[4 * j + 3]};
          *(f32x4*)(lds + l32 * 132 + blk * 32 + 8 * j + 4 * hh) = v;
        }
      }
    }
    wave_lds_fence();
    {
      f32x2 bu[32];
#pragma unroll
      for (int s = 0; s < 32; ++s) bu[s] = *(const f32x2*)(lds + s * 132 + 2 * lane);
#pragma unroll
      for (int s = 0; s < 32; ++s) {
        const float nr = __builtin_fmaf(ar, hr, __builtin_fmaf(-ai, hi, bu[s][0]));
        const float ni = __builtin_fmaf(ar, hi, __builtin_fmaf(ai, hr, bu[s][1]));
        hr = nr; hi = ni;
        f32x2 hv = {hr, hi};
        *(f32x2*)(lds + s * 132 + 2 * lane) = hv;
      }
    }
    wave_lds_fence();
#pragma unroll
    for (int tb = 0; tb < 2; ++tb) {
      f32x4 y = {0.f, 0.f, 0.f, 0.f};
#pragma unroll
      for (int kk = 0; kk < 4; ++kk) {
        const float* hp = lds + (tb * 16 + l16) * 132 + kk * 32 + q4 * 8;
        f32x4 a0 = *(const f32x4*)hp, a1 = *(const f32x4*)(hp + 4);
        y = MFMA16(cf[kk], pack8(a0, a1), y);
      }
      const int n2 = ch * 32 + tb * 16 + l16;
      const int t2 = dir ? (T - 1 - n2) : n2;
      *(f32x4*)(ybuf + (size_t)(row0 + t2) * 256 + g * 16 + q4 * 4) = y;
    }
    wave_lds_fence();
  }
  if (!lat) {
    size_t idx = ((size_t)(b_all * 2 + layer) * 2 + dir) * 1024 + g * 64 + lane;
    p.out[O_SRE + idx] = hr;
    p.out[O_SIM + idx] = hi;
  }
}

DI void pp_row(const P& p, int layer, int row, int lane) {
  const u16* pr = (const u16*)(p.ws + OFF_PROJ) + (size_t)row * NP;
  const bool lat = row >= NCTX;
  int b, t, keyrow;
  if (!lat) { b = row >> 8; t = row & 255; keyrow = row; }
  else { int rr = row - NCTX; b = rr >> 10; t = rr & 1023; keyrow = NCTX + b * 1536 + 512 + t; }
  const f32x2* tab32 = (const f32x2*)(p.ws + OFF_ROPE);
  const f32x2* tab64 = tab32 + 64 * 16;
  const size_t orow = (size_t)(b * 2 + layer) * 256 + t;
  const f32x4 z4 = {0.f, 0.f, 0.f, 0.f};
  f32x4 v_dq = ld4bf_nt(pr + lane * 4);
  f32x4 v_dk = ld4bf_nt(pr + 256 + lane * 4);
  f32x4 v_dv = ld4bf_nt(pr + 512 + lane * 4);
  f32x4 v_gq = ld4bf_nt(pr + 768 + lane * 4);
  f32x4 v_gk = lane < 32 ? ld4bf_nt(pr + 1024 + lane * 4) : z4;
  f32x4 v_gv = lane < 32 ? ld4bf_nt(pr + 1152 + lane * 4) : z4;
  f32x4 v_cq = lane < 48 ? ld4bf_nt(pr + 1536 + lane * 4) : z4;
  f32x4 v_ckv = lane < 32 ? ld4bf_nt(pr + 1728 + lane * 4) : z4;
  f32x4 v_kr = lane < 8 ? ld4bf_nt(pr + 1856 + lane * 4) : z4;
  const f32x4 g_q = *(const f32x4*)(p.in[I_QNG] + layer * 64 + (lane & 15) * 4);
  const f32x4 g_k = *(const f32x4*)(p.in[I_KNG] + layer * 64 + (lane & 15) * 4);
  const f32x4 g_cq = lane < 48 ? *(const f32x4*)(p.in[I_MQNG] + layer * 192 + lane * 4) : z4;
  const f32x4 g_ckv = lane < 32 ? *(const f32x4*)(p.in[I_MKVNG] + layer * 128 + lane * 4) : z4;
  f32x2 cs32[4], cs64[4];
  {
    const int e32 = (lane * 4) & 31, w32 = e32 & 15, p32 = (e32 >> 4) ? (t & 63) : (t >> 6), f32i = w32 & 7;
    const int e64 = (lane * 4) & 63, w64 = e64 & 31, p64 = (e64 >> 5) ? (t & 63) : (t >> 6), f64i = w64 & 15;
    const f32x2 one = {1.f, 0.f};
#pragma unroll
    for (int i = 0; i < 4; ++i) {
      cs32[i] = lat ? tab32[p32 * 16 + f32i + i] : one;
      cs64[i] = lat ? tab64[p64 * 16 + f64i + i] : one;
    }
  }
  const bool x2_32 = ((lane * 4) & 15) >= 8, x2_64 = ((lane * 4) & 31) >= 16;
  auto rope32 = [&](f32x4 v) {
    f32x4 o;
#pragma unroll
    for (int i = 0; i < 4; ++i) { float pv = __shfl_xor(v[i], 2); o[i] = v[i] * cs32[i][0] + (x2_32 ? pv : -pv) * cs32[i][1]; }
    return o;
  };
  auto rope64 = [&](f32x4 v) {
    f32x4 o;
#pragma unroll
    for (int i = 0; i < 4; ++i) { float pv = __shfl_xor(v[i], 4); o[i] = v[i] * cs64[i][0] + (x2_64 ? pv : -pv) * cs64[i][1]; }
    return o;
  };
  if (!lat) {
    *(f32x4*)(p.out + O_DK + orow * 256 + lane * 4) = v_dk;
    *(f32x4*)(p.out + O_DV + orow * 256 + lane * 4) = v_dv;
    if (lane < 32) *(f32x4*)(p.out + O_GV + orow * 128 + lane * 4) = v_gv;
    if (lane < 8) *(f32x4*)(p.out + O_KR + orow * 32 + lane * 4) = v_kr;
  }
  {
    f32x4 v = v_dq;
    if (lat) v = rope32(v);
    v = v * (0.17677669529663687f * LOG2E);
    *(u32x2*)((u16*)(p.ws + OFF_DQ) + (size_t)row * 256 + lane * 4) = pack4(v);
  }
  {
    f32x4 v = v_dk;
    if (lat) v = rope32(v);
    *(u32x2*)((u16*)(p.ws + OFF_DKB) + (size_t)keyrow * 256 + lane * 4) = pack4(v);
  }
  {
    f32x4 v = v_gq;
    float ss = v[0] * v[0] + v[1] * v[1] + v[2] * v[2] + v[3] * v[3];
    ss += __shfl_xor(ss, 1); ss += __shfl_xor(ss, 2); ss += __shfl_xor(ss, 4); ss += __shfl_xor(ss, 8);
    float r = rsqrtf(ss * (1.f / 64.f) + EPSF);
    v = v * r * g_q;
    if (lat) v = rope64(v);
    v = v * (0.125f * LOG2E);
    *(u32x2*)((u16*)(p.ws + OFF_GQ) + (size_t)row * 256 + lane * 4) = pack4(v);
  }
  {
    f32x4 v = v_gk;
    float ss = v[0] * v[0] + v[1] * v[1] + v[2] * v[2] + v[3] * v[3];
    ss += __shfl_xor(ss, 1); ss += __shfl_xor(ss, 2); ss += __shfl_xor(ss, 4); ss += __shfl_xor(ss, 8);
    float r = rsqrtf(ss * (1.f / 64.f) + EPSF);
    v = v * r * g_k;
    if (!lat) { if (lane < 32) *(f32x4*)(p.out + O_GK + orow * 128 + lane * 4) = v; }
    else v = rope64(v);
    if (lane < 32) *(u32x2*)((u16*)(p.ws + OFF_GKB) + (size_t)keyrow * 128 + lane * 4) = pack4(v);
  }
  {
    f32x4 v = v_cq;
    float ss = wave_sum(v[0] * v[0] + v[1] * v[1] + v[2] * v[2] + v[3] * v[3]);
    float r = rsqrtf(ss * (1.f / 192.f) + EPSF);
    v = v * r * g_cq;
    if (lane < 48) *(u32x2*)((u16*)(p.ws + OFF_CQN) + (size_t)row * 192 + lane * 4) = pack4(v);
  }
  {
    f32x4 v = v_ckv;
    float ss = wave_sum(v[0] * v[0] + v[1] * v[1] + v[2] * v[2] + v[3] * v[3]);
    float r = rsqrtf(ss * (1.f / 128.f) + EPSF);
    v = v * r * g_ckv;
    if (lane < 32) {
      if (!lat) *(f32x4*)(p.out + O_CKV + orow * 128 + lane * 4) = v;
      *(u32x2*)((u16*)(p.ws + OFF_CKVN) + (size_t)keyrow * 128 + lane * 4) = pack4(v);
    }
  }
  {
    f32x4 v = v_kr;
    if (lat) v = rope32(v);
    if (lane < 8) {
      u32x2 pk = pack4(v);
      u16* mk = (u16*)(p.ws + OFF_MKB) + (size_t)keyrow * 384 + 64 + lane * 4;
#pragma unroll
      for (int hd = 0; hd < 4; ++hd) *(u32x2*)(mk + hd * 96) = pk;
    }
  }
}

DI void pp_cached(const P& p, int layer, int crow_, int lane) {
  const int b = crow_ >> 9, j = crow_ & 511;
  const int keyrow = NCTX + b * 1536 + j;
  const size_t src = (size_t)(b * 2 + layer) * 512 + j;
  const int jp = (j & ~15) | (((j >> 2) & 1) << 3) | (((j >> 3) & 1) << 2) | (j & 3);
  const f32x4 z4 = {0.f, 0.f, 0.f, 0.f};
  const int l31 = lane & 31, l7 = lane & 7;
  f32x4 v_dk = __builtin_nontemporal_load((const f32x4*)(p.in[I_CDK] + src * 256 + lane * 4));
  f32x4 v_dv = __builtin_nontemporal_load((const f32x4*)(p.in[I_CDV] + src * 256 + lane * 4));
  f32x4 v_gk = __builtin_nontemporal_load((const f32x4*)(p.in[I_CGK] + src * 128 + l31 * 4));
  f32x4 v_gv = __builtin_nontemporal_load((const f32x4*)(p.in[I_CGV] + src * 128 + l31 * 4));
  f32x4 v_ckv = __builtin_nontemporal_load((const f32x4*)(p.in[I_CCKV] + src * 128 + l31 * 4));
  f32x4 v_kr = __builtin_nontemporal_load((const f32x4*)(p.in[I_CKR] + src * 32 + l7 * 4));
  (void)z4;
  *(u32x2*)((u16*)(p.ws + OFF_DKB) + (size_t)keyrow * 256 + lane * 4) = pack4(v_dk);
  {
    u16* vt = (u16*)(p.ws + OFF_DVT) + vt_off(32 + b, lane >> 4, 4) + (size_t)((lane & 15) * 4) * 1536 + jp;
#pragma unroll
    for (int i = 0; i < 4; ++i) vt[(size_t)i * 1536] = f2bf(v_dv[i]);
  }
  if (lane < 32) {
    *(u32x2*)((u16*)(p.ws + OFF_GKB) + (size_t)keyrow * 128 + lane * 4) = pack4(v_gk);
    u16* vt = (u16*)(p.ws + OFF_GVT) + vt_off(32 + b, lane >> 4, 2) + (size_t)((lane & 15) * 4) * 1536 + jp;
#pragma unroll
    for (int i = 0; i < 4; ++i) vt[(size_t)i * 1536] = f2bf(v_gv[i]);
    *(u32x2*)((u16*)(p.ws + OFF_CKVN) + (size_t)keyrow * 128 + lane * 4) = pack4(v_ckv);
  }
  if (lane < 8) {
    u32x2 pk = pack4(v_kr);
    u16* mk = (u16*)(p.ws + OFF_MKB) + (size_t)keyrow * 384 + 64 + lane * 4;
#pragma unroll
    for (int hd = 0; hd < 4; ++hd) *(u32x2*)(mk + hd * 96) = pk;
  }
}

DI void phase_pp(const P& p, int layer, char* smem) {
  const int tid_ = get_tid();
  const int lane = tid_ & 63, wave = tid_ >> 6;
  float* lds = (float*)smem + wave * (32 * 132);
  const int gw = wave * (int)gridDim.x + (int)blockIdx.x, nw = gridDim.x * NWV;
  constexpr int N_SSM = 1152, N_ROWS = NT + 2048;
  for (int item = gw; item < N_SSM; item += nw) ssm_item(p, layer, item, lds, lane);
  const int rw0 = (nw > 256) ? 128 : 0;
  if (gw >= rw0) {
    for (int row = gw - rw0; row < N_ROWS; row += nw - rw0) {
      if (row < NT) pp_row(p, layer, row, lane);
      else pp_cached(p, layer, row - NT, lane);
    }
  }
}

template <int KW, int DK>
DI void attn_block(const u16* __restrict__ Kg, int ldk, const u16* __restrict__ Vt, int nk, const bf16x8 (&qf)[DK / 16], int kcol, char* smem,
                   int tid, f32x16 (&o)[2], float& lsum) {
  constexpr int KST = KW + 8, KS = DK / 16, KCH = KW / 8, KTOT = 64 * KCH, NKC = (KTOT + NTHR - 1) / NTHR;
  const int lane = tid & 63, l32 = lane & 31, hh = lane >> 5;
  u16* Ks = (u16*)smem;
  u16* Vs = Ks + 2 * 64 * KST;
  float m = -1e30f;
  lsum = 0.f;
#pragma unroll
  for (int db = 0; db < 2; ++db)
#pragma unroll
    for (int r = 0; r < 16; ++r) o[db][r] = 0.f;
  u32x4 rk[NKC], rv[1];
  const int nt = nk / 64;
#pragma unroll
  for (int i = 0; i < NKC; ++i) { int c = tid + NTHR * i, r = c / KCH, kc = (c % KCH) * 8; if (c < KTOT) rk[i] = *(const u32x4*)(Kg + (size_t)r * ldk + kc); }
  { int r = tid >> 3, kc = (tid & 7) * 8; rv[0] = *(const u32x4*)(Vt + (size_t)r * nk + kc); }
#pragma unroll
  for (int i = 0; i < NKC; ++i) { int c = tid + NTHR * i, r = c / KCH, kc = (c % KCH) * 8; if (c < KTOT) *(u32x4*)(Ks + r * KST + kc) = rk[i]; }
  { int r = tid >> 3, kc = (tid & 7) * 8; *(u32x4*)(Vs + r * 72 + kc) = rv[0]; }
  __syncthreads();
  for (int t = 0; t < nt; ++t) {
    const int buf = t & 1;
    const bool more = (t + 1 < nt);
    if (more) {
      const int kt = (t + 1) * 64;
#pragma unroll
      for (int i = 0; i < NKC; ++i) { int c = tid + NTHR * i, r = c / KCH, kc = (c % KCH) * 8; if (c < KTOT) rk[i] = *(const u32x4*)(Kg + (size_t)(kt + r) * ldk + kc); }
      { int r = tid >> 3, kc = (tid & 7) * 8; rv[0] = *(const u32x4*)(Vt + (size_t)r * nk + kt + kc); }
    }
    const u16* ks = Ks + buf * 64 * KST + l32 * KST + kcol + hh * 8;
    const u16* vs = Vs + buf * 64 * 72 + l32 * 72 + hh * 8;
    f32x16 sa[2];
#pragma unroll
    for (int kb = 0; kb < 2; ++kb) {
#pragma unroll
      for (int r = 0; r < 16; ++r) sa[kb][r] = 0.f;
      bf16x8 kf[KS];
#pragma unroll
      for (int s2 = 0; s2 < KS; ++s2) kf[s2] = *(const bf16x8*)(ks + kb * 32 * KST + s2 * 16);
#pragma unroll
      for (int s2 = 0; s2 < KS; ++s2) sa[kb] = MFMA32(kf[s2], qf[s2], sa[kb]);
    }
    float mx = sa[0][0];
#pragma unroll
    for (int r = 1; r < 16; ++r) mx = fmaxf(mx, sa[0][r]);
#pragma unroll
    for (int r = 0; r < 16; ++r) mx = fmaxf(mx, sa[1][r]);
    mx = fmaxf(mx, __shfl_xor(mx, 32));
    const float mn = fmaxf(m, mx);
    const float alpha = fexp2(m - mn);
    m = mn;
    float ps = 0.f;
#pragma unroll
    for (int kb = 0; kb < 2; ++kb)
#pragma unroll
      for (int r = 0; r < 16; ++r) { float e = fexp2(sa[kb][r] - mn); sa[kb][r] = e; ps += e; }
    lsum = lsum * alpha + ps;
#pragma unroll
    for (int db = 0; db < 2; ++db)
#pragma unroll
      for (int r = 0; r < 16; ++r) o[db][r] *= alpha;
#pragma unroll
    for (int s2 = 0; s2 < 4; ++s2) {
      const int kb = s2 >> 1, rb = 8 * (s2 & 1);
      f32x4 p0 = {sa[kb][rb], sa[kb][rb + 1], sa[kb][rb + 2], sa[kb][rb + 3]};
      f32x4 p1 = {sa[kb][rb + 4], sa[kb][rb + 5], sa[kb][rb + 6], sa[kb][rb + 7]};
      bf16x8 pf = pack8(p0, p1);
      bf16x8 v0 = *(const bf16x8*)(vs + s2 * 16);
      bf16x8 v1 = *(const bf16x8*)(vs + 32 * 72 + s2 * 16);
      o[0] = MFMA32(v0, pf, o[0]);
      o[1] = MFMA32(v1, pf, o[1]);
    }
    if (more) {
      const int nb = buf ^ 1;
#pragma unroll
      for (int i = 0; i < NKC; ++i) { int c = tid + NTHR * i, r = c / KCH, kc = (c % KCH) * 8; if (c < KTOT) *(u32x4*)(Ks + nb * 64 * KST + r * KST + kc) = rk[i]; }
      { int r = tid >> 3, kc = (tid & 7) * 8; *(u32x4*)(Vs + nb * 64 * 72 + r * 72 + kc) = rv[0]; }
    }
    __syncthreads();
  }
  lsum += __shfl_xor(lsum, 32);
}

DI void store_o(u16* dst  , const f32x16 (&o)[2], float scale, int hh) {
#pragma unroll
  for (int db = 0; db < 2; ++db)
#pragma unroll
    for (int j = 0; j < 4; ++j) {
      const int dv = db * 32 + 8 * j + 4 * hh;
      f32x4 v = {o[db][4 * j] * scale, o[db][4 * j + 1] * scale, o[db][4 * j + 2] * scale, o[db][4 * j + 3] * scale};
      *(u32x2*)(dst + dv) = pack4(v);
    }
}

DI void attn_item(const P& p, int layer, int item, char* smem, int tid) {
  const int lane = tid & 63, wave = tid >> 6, l32 = lane & 31, hh = lane >> 5;
  bool lat; int kind, b, hd, qblk;
  if (item < 256) {
    lat = true;
    if (item < 128) { kind = 0; b = item >> 5; hd = (item >> 3) & 3; qblk = item & 7; }
    else { int it = item - 128; kind = 1 + (it >> 6); it &= 63; b = it >> 4; hd = (it >> 2) & 3; qblk = it & 3; }
  } else {
    lat = false;
    int it = item - 256;
    if (it < 256) { kind = 0; b = it >> 3; hd = (it >> 1) & 3; qblk = it & 1; }
    else { it -= 256; kind = 1 + (it >> 7); it &= 127; b = it >> 2; hd = it & 3; qblk = 0; }
  }
  const int nk = lat ? 1536 : 256;
  const int b_all = lat ? 32 + b : b;
  const int keyrow0 = lat ? NCTX + b * 1536 : b * 256;
  const int tok0 = lat ? NCTX + b * 1024 : b * 256;
  f32x16 o[2]; float ls;
  if (kind == 0) {
    const int ns = wave & 1, qb = wave >> 1;
    const int q0 = tok0 + qblk * 128 + qb * 32;
    const u16* Q = (const u16*)(p.ws + OFF_DQ) + (size_t)(q0 + l32) * 256 + hd * 64 + ns * 32 + hh * 8;
    bf16x8 qf[2];
    qf[0] = *(const bf16x8*)Q; qf[1] = *(const bf16x8*)(Q + 16);
    attn_block<64, 32>((const u16*)(p.ws + OFF_DKB) + (size_t)keyrow0 * 256 + hd * 64, 256, (const u16*)(p.ws + OFF_DVT) + vt_off(b_all, hd, 4), nk, qf, ns * 32,
                       smem, tid, o, ls);
    float d1 = 0.f, d2 = 0.f;
    if (lane < 32) { d1 = p.in[I_LQ1][layer * 32 + lane] * p.in[I_LK1][layer * 32 + lane]; d2 = p.in[I_LQ2][layer * 32 + lane] * p.in[I_LK2][layer * 32 + lane]; }
    d1 = wave_sum(d1); d2 = wave_sum(d2);
    int ly_ = layer; asm volatile("" : "+s"(ly_));
    const float lam_init = ly_ == 0 ? 0.2f : (0.8f - 0.6f * 0.7408182206817179f);
    const float lam = expf(d1) - expf(d2) + lam_init;
    float* cmb = (float*)smem + qb * (64 * 33);
    if (ns == 1) {
      const float sc = lam / ls;
#pragma unroll
      for (int db = 0; db < 2; ++db)
#pragma unroll
        for (int r = 0; r < 16; ++r) cmb[(db * 32 + crow(r, hh)) * 33 + l32] = o[db][r] * sc;
    }
    __syncthreads();
    if (ns == 0) {
      const float i0 = 1.f / ls;
      float ss = 0.f;
#pragma unroll
      for (int db = 0; db < 2; ++db)
#pragma unroll
        for (int r = 0; r < 16; ++r) { float d = o[db][r] * i0 - cmb[(db * 32 + crow(r, hh)) * 33 + l32]; o[db][r] = d; ss += d * d; }
      ss += __shfl_xor(ss, 32);
      const float rr = rsqrtf(ss * (1.f / 64.f) + EPSF) * (1.f - lam_init);
      u16* dst = (u16*)(p.ws + OFF_MIXED) + (size_t)(q0 + l32) * 1024 + hd * 64;
#pragma unroll
      for (int db = 0; db < 2; ++db)
#pragma unroll
        for (int j = 0; j < 4; ++j) {
          const int dv = db * 32 + 8 * j + 4 * hh;
          f32x4 g = *(const f32x4*)(p.in[I_SUBLN] + layer * 64 + dv);
          f32x4 v = {o[db][4 * j] * rr * g[0], o[db][4 * j + 1] * rr * g[1], o[db][4 * j + 2] * rr * g[2], o[db][4 * j + 3] * rr * g[3]};
          *(u32x2*)(dst + dv) = pack4(v);
        }
    }
    __syncthreads();
  } else if (kind == 1) {
    const int q0 = tok0 + qblk * 256 + wave * 32;
    const u16* Q = (const u16*)(p.ws + OFF_GQ) + (size_t)(q0 + l32) * 256 + hd * 64 + hh * 8;
    bf16x8 qf[4];
#pragma unroll
    for (int s2 = 0; s2 < 4; ++s2) qf[s2] = *(const bf16x8*)(Q + s2 * 16);
    attn_block<64, 64>((const u16*)(p.ws + OFF_GKB) + (size_t)keyrow0 * 128 + (hd >> 1) * 64, 128, (const u16*)(p.ws + OFF_GVT) + vt_off(b_all, hd >> 1, 2), nk, qf, 0,
                       smem, tid, o, ls);
    store_o((u16*)(p.ws + OFF_MIXED) + (size_t)(q0 + l32) * 1024 + 256 + hd * 64, o, 1.f / ls, hh);
  } else {
    const int q0 = tok0 + qblk * 256 + wave * 32;
    const u16* Q = (const u16*)(p.ws + OFF_MQ) + (size_t)(q0 + l32) * 384 + hd * 96 + hh * 8;
    bf16x8 qf[6];
#pragma unroll
    for (int s2 = 0; s2 < 6; ++s2) qf[s2] = *(const bf16x8*)(Q + s2 * 16);
    attn_block<96, 96>((const u16*)(p.ws + OFF_MKB) + (size_t)keyrow0 * 384 + hd * 96, 384, (const u16*)(p.ws + OFF_MVT) + vt_off(b_all, hd, 4), nk, qf, 0,
                       smem, tid, o, ls);
    store_o((u16*)(p.ws + OFF_MIXED) + (size_t)(q0 + l32) * 1024 + 768 + hd * 64, o, 1.f / ls, hh);
  }
}

DI void phase_at(const P& p, int layer, char* smem) {
  EPI_IDX
  constexpr int N_ITEMS = 768;
  if (gridDim.x == 256) {
    const int b = blockIdx.x;
    attn_item(p, layer, b, smem, tid);
    __syncthreads();
    if (b < 128) {
      attn_item(p, layer, 256 + b, smem, tid); __syncthreads();
      attn_item(p, layer, 512 + b, smem, tid); __syncthreads();
      attn_item(p, layer, 640 + b, smem, tid); __syncthreads();
    } else if (b < 192) {
      attn_item(p, layer, 256 + 128 + 2 * (b - 128), smem, tid); __syncthreads();
      attn_item(p, layer, 256 + 128 + 2 * (b - 128) + 1, smem, tid); __syncthreads();
    }
  } else {
    for (int item = blockIdx.x; item < N_ITEMS; item += gridDim.x) {
      attn_item(p, layer, item, smem, tid);
      __syncthreads();
    }
  }
  {
    constexpr int T_GLU = (NT / 256) * 2;
    auto tile_at = [&](int t) { TD d; d.A = (const u16*)(p.ws + OFF_PROJ); d.lda = NP; d.B = (const u16*)(p.ws + OFF_WGLU) + (size_t)layer * 512 * 256; d.ldb = 256; d.k0 = 0; d.nk = 4; d.m0 = (t >> 1) * 256; d.n0 = (t & 1) * 256; return d; };
    int buf = 0;
    const int t0 = (int)gridDim.x - 1 - (int)blockIdx.x;
    TD cur = tile_at(t0 < T_GLU ? t0 : 0);
    if (t0 < T_GLU) stage_td<2>(cur, 0, smem, tid);
    for (int t = t0; t < T_GLU; t += gridDim.x) {
      const bool has_next = (t + (int)gridDim.x < T_GLU);
      const TD nxt = tile_at(has_next ? t + (int)gridDim.x : t);
      const int m0 = cur.m0, n0 = cur.n0;
      f32x16 acc[4][2];
      gemm_stream<2>(cur, has_next, nxt, smem, buf, acc);
      cur = nxt;
      u16* mixed = (u16*)(p.ws + OFF_MIXED);
      const int q = (n0 + wn * 64) >> 6;
#pragma unroll
      for (int bi = 0; bi < 4; ++bi) {
        const int rb = m0 + wm * 128 + bi * 32;
#pragma unroll
        for (int r = 0; r < 16; ++r) {
          float z = acc[bi][0][r], g = acc[bi][1][r];
          mixed[(size_t)(rb + crow(r, hh)) * 1024 + 512 + q * 32 + l32] = f2bf(z * fsigmoid(g));
        }
      }
    }
  }
}

#define XB_TMO      128
#define XB_XCNT(j)  (256  + 64 * (j))
#define XB_XSUB(j)  (1280 + 64 * (j))
#define XB_XGEN(j)  (2304 + 64 * (j))
#define XB_TOP      3328
#define XB_TOPGEN   3392
#define XCD_BAR_WORDS 3456
#define XB_SPIN_CAP (1u << 22)
#define LAS __attribute__((address_space(3)))
DI unsigned xb_ld(unsigned* p) { return __hip_atomic_load(p, __ATOMIC_RELAXED, __HIP_MEMORY_SCOPE_AGENT); }
DI unsigned xb_add(unsigned* p, unsigned v) { return __hip_atomic_fetch_add(p, v, __ATOMIC_RELAXED, __HIP_MEMORY_SCOPE_AGENT); }
DI unsigned xb_xcc_id() { return (unsigned)__builtin_amdgcn_s_getreg((3 << 11) | 20) & 0xFu; }
#define XB_SPIN(cond, bar) do { unsigned _sp = 0; while (cond) { __builtin_amdgcn_s_sleep(1); \
    if ((++_sp & 255u) == 0u) { if (xb_ld(&(bar)[XB_TMO])) break; if (_sp > XB_SPIN_CAP) { atomicAdd(&(bar)[XB_TMO], 1u); break; } } } } while (0)
struct XcdBarrier { unsigned* bar; unsigned x; volatile LAS unsigned* st; };
DI XcdBarrier xcd_barrier_post(unsigned* bar, volatile LAS unsigned* st) {
  XcdBarrier b; b.bar = bar; b.x = xb_xcc_id(); b.st = st;
  if (threadIdx.x == 0) st[2] = xb_add(&bar[XB_XCNT(b.x)], 1u);
  return b;
}
DI void xcd_barrier_complete(unsigned* bar, unsigned x, unsigned& nloc, unsigned& nx) {
  const unsigned G = gridDim.x * gridDim.y * gridDim.z;
  unsigned sum, cnt, mine, sp = 0u;
  for (;;) {
    sum = 0u; cnt = 0u; mine = 0u;
#pragma unroll
    for (unsigned j = 0; j < 16; ++j) { const unsigned c = xb_ld(&bar[XB_XCNT(j)]); sum += c; cnt += (c > 0u) ? 1u : 0u; mine = (j == x) ? c : mine; }
    if (sum == G) break;
    __builtin_amdgcn_s_sleep(1);
    if ((++sp & 255u) == 0u) { if (xb_ld(&bar[XB_TMO])) break; if (sp > XB_SPIN_CAP) { atomicAdd(&bar[XB_TMO], 1u); break; } }
  }
  nloc = mine > 0u ? mine : 1u; nx = cnt > 0u ? cnt : 1u;
}
DI void xcd_barrier(const XcdBarrier& b) {
  asm volatile("s_waitcnt vmcnt(0)" ::: "memory");
  __syncthreads();
  if (threadIdx.x == 0) {
    unsigned* bar = b.bar;
    __builtin_amdgcn_s_waitcnt(0);
    unsigned nloc = b.st[0], nx = b.st[1];
    if (nloc == 0u) { xcd_barrier_complete(bar, b.x, nloc, nx); b.st[0] = nloc; b.st[1] = nx; }
    const unsigned old = xb_add(&bar[XB_XSUB(b.x)], 1u);
    const unsigned gen = old / nloc;
    if (old + 1u == (gen + 1u) * nloc) {
      __builtin_amdgcn_fence(__ATOMIC_RELEASE, "agent");
      asm volatile("s_waitcnt vmcnt(0)" ::: "memory");
      const unsigned og = xb_add(&bar[XB_TOP], 1u);
      const unsigned tg = og / nx;
      if (og + 1u == (tg + 1u) * nx) xb_add(&bar[XB_TOPGEN], 1u);
      else XB_SPIN(xb_ld(&bar[XB_TOPGEN]) == tg, bar);
      __builtin_amdgcn_fence(__ATOMIC_ACQUIRE, "agent");
      xb_add(&bar[XB_XGEN(b.x)], 1u);
      asm volatile("s_waitcnt vmcnt(0)" ::: "memory");
    } else {
      XB_SPIN(xb_ld(&bar[XB_XGEN(b.x)]) == gen, bar);
      __builtin_amdgcn_fence(__ATOMIC_ACQUIRE, "agent");
      asm volatile("s_waitcnt vmcnt(0)" ::: "memory");
    }
  }
  __syncthreads();
}

DI void run_phase(const P& p_, int ph, int layer, char* smem) {
  P p = p_;
  size_t zoff = 0;
  asm volatile("" : "+s"(zoff));
  p.ws = p_.ws + zoff;
  p.out = p_.out + zoff;
  switch (ph) {
    case 0: prologue(p, smem); break;
    case 1: norm_phase(p, layer, 0); break;
    case 2: phase_g1(p, layer, smem); break;
    case 3: phase_pp(p, layer, smem); break;
    case 4: phase_g2(p, layer, smem); break;
    case 5: phase_at(p, layer, smem); break;
    case 6: phase_resid(p, layer, smem, true); break;
    case 7: norm_phase(p, layer, 1); break;
    case 8: phase_g5(p, layer, smem); break;
    case 9: phase_resid(p, layer, smem, false); break;
    case 10: norm_phase(p, 0, 2); break;
  }
}

extern __shared__ __attribute__((aligned(16))) char dyn_smem[];

__global__ void __launch_bounds__(512) fwd_mega(P p) {
  if (p.ws == nullptr) { cg::grid_group grid = cg::this_grid(); grid.sync(); }
  volatile LAS unsigned* st = (volatile LAS unsigned*)(dyn_smem + LDS_BYTES);
  if (threadIdx.x == 0) { st[0] = 0u; st[1] = 0u; st[2] = 0u; st[3] = 0u; }
  __syncthreads();
  XcdBarrier xb = xcd_barrier_post((unsigned*)(p.ws + OFF_BAR), st);
  run_phase(p, 0, 0, dyn_smem);
  xcd_barrier(xb);
  if (threadIdx.x == 0) {
    unsigned* bar = (unsigned*)(p.ws + OFF_BAR);
    bool ok = (gridDim.x & 7u) == 0u;
    for (unsigned j = 0; j < 16; ++j) { const unsigned c = xb_ld(&bar[XB_XCNT(j)]); ok = ok && (c == (j < 8 ? gridDim.x >> 3 : 0u)); }
    if (ok) st[3] = xb.x; else { st[2] = blockIdx.x >> 3; st[3] = blockIdx.x & 7u; }
  }
  __syncthreads();
  for (int l = 0; l < 2; ++l) {
    for (int ph = 1; ph <= 9; ++ph) {
      run_phase(p, ph, l, dyn_smem);
      xcd_barrier(xb);
    }
  }
  run_phase(p, 10, 0, dyn_smem);
}

#if !MEGA
__global__ void __launch_bounds__(512) fwd_phase(P p, int ph, int layer) { run_phase(p, ph, layer, dyn_smem); }
#endif

extern "C" void kernel_launch(void* const* d_in, const int* in_sizes, int n_in, void* d_out, int out_size, void* d_ws, size_t ws_size,
                              hipStream_t stream) {
  static int grid_blocks = 0;
  if (!grid_blocks) {
    int dev = 0, cus = 0, per_cu = 0;
    (void)hipGetDevice(&dev);
    (void)hipDeviceGetAttribute(&cus, hipDeviceAttributeMultiprocessorCount, dev);
    (void)hipFuncSetAttribute((const void*)fwd_mega, hipFuncAttributeMaxDynamicSharedMemorySize, LDS_BYTES + 16);
#if !MEGA
    (void)hipFuncSetAttribute((const void*)fwd_phase, hipFuncAttributeMaxDynamicSharedMemorySize, LDS_BYTES);
#endif
    (void)hipOccupancyMaxActiveBlocksPerMultiprocessor(&per_cu, (const void*)fwd_mega, NTHR, LDS_BYTES + 16);
    if (per_cu < 1) per_cu = 1;
    if (per_cu > 1) per_cu = 1;
    grid_blocks = cus * per_cu;
    if (ws_size < WS_NEED) fprintf(stderr, "kernel_launch: workspace too small: %zu < %zu\n", ws_size, (size_t)WS_NEED);
  }
  P p{};
  for (int i = 0; i < N_IN; ++i) p.in[i] = (const float*)d_in[i];
  p.out = (float*)d_out;
  p.ws = (char*)d_ws;
#if MEGA
  (void)hipMemsetAsync((char*)d_ws + OFF_BAR, 0, XCD_BAR_WORDS * 4, stream);
  void* args[] = {&p};
  hipError_t e = hipLaunchCooperativeKernel((const void*)fwd_mega, dim3(grid_blocks), dim3(NTHR), args, LDS_BYTES + 16, stream);
  if (e != hipSuccess) fprintf(stderr, "cooperative launch failed: %s (grid %d)\n", hipGetErrorString(e), grid_blocks);
#else
  hipLaunchKernelGGL(fwd_phase, dim3(grid_blocks), dim3(NTHR), LDS_BYTES, stream, p, 0, 0);
  for (int l = 0; l < 2; ++l)
    for (int ph = 1; ph <= 9; ++ph) hipLaunchKernelGGL(fwd_phase, dim3(grid_blocks), dim3(NTHR), LDS_BYTES, stream, p, ph, l);
  hipLaunchKernelGGL(fwd_phase, dim3(grid_blocks), dim3(NTHR), LDS_BYTES, stream, p, 10, 0);
#endif
}
```

```cpp
#include <hip/hip_runtime.h>
#include <hip/hip_cooperative_groups.h>
#include <cstdio>
namespace cg = cooperative_groups;

#ifndef MEGA
#define MEGA 1
#endif

#define DI __device__ __forceinline__
typedef unsigned short u16;
typedef __attribute__((ext_vector_type(8))) short bf16x8;
typedef __attribute__((ext_vector_type(4))) short bf16x4;
typedef __attribute__((ext_vector_type(2))) __bf16 bf2_t;
typedef __attribute__((ext_vector_type(2))) float f32x2;
typedef __attribute__((ext_vector_type(4))) float f32x4;
typedef __attribute__((ext_vector_type(16))) float f32x16;
typedef __attribute__((ext_vector_type(4))) unsigned u32x4;
typedef __attribute__((ext_vector_type(2))) unsigned u32x2;

#define MFMA32(a, b, c) __builtin_amdgcn_mfma_f32_32x32x16_bf16((a), (b), (c), 0, 0, 0)
#define MFMA16(a, b, c) __builtin_amdgcn_mfma_f32_16x16x32_bf16((a), (b), (c), 0, 0, 0)

constexpr int NT = 12288;
constexpr int NCTX = 8192;
constexpr int NKR = 14336;
constexpr int NP = 1920;
constexpr float EPSF = 1e-6f;
constexpr float LOG2E = 1.4426950408889634f;

enum { I_XP = 0, I_XS, I_CDK, I_CDV, I_CGK, I_CGV, I_CCKV, I_CKR, I_SRE, I_SIM, I_C, I_CCTX, I_N1G, I_N2G, I_WADA, I_BADA,
       I_WIN, I_WOUT, I_LQ1, I_LK1, I_LQ2, I_LK2, I_SUBLN, I_QNG, I_KNG, I_ARE, I_AIM, I_LOGDT, I_BRE, I_BIM, I_CRE, I_CIM,
       I_SSMD, I_WGLU, I_MQNG, I_MKVNG, I_WUQ, I_WUKV, I_W1, I_W2, I_FNG, N_IN };

constexpr size_t O_Y = 0;
constexpr size_t O_DK = 12582912;
constexpr size_t O_DV = 16777216;
constexpr size_t O_GK = 20971520;
constexpr size_t O_GV = 23068672;
constexpr size_t O_CKV = 25165824;
constexpr size_t O_KR = 27262976;
constexpr size_t O_SRE = 27787264;
constexpr size_t O_SIM = 27918336;

constexpr size_t al256(size_t x) { return (x + 255) & ~(size_t)255; }
constexpr size_t OFF_MOD = 0;
constexpr size_t OFF_CTR = al256(OFF_MOD + 2 * 5 * 6144 * 4);
constexpr size_t OFF_BAR = al256(OFF_CTR + 256);
constexpr size_t OFF_ROPE = al256(OFF_BAR + 3456 * 4);
constexpr size_t OFF_ABAR = al256(OFF_ROPE + 2 * 64 * 16 * 8);
constexpr size_t OFF_ATAB = al256(OFF_ABAR + 64 * 64 * 8);
constexpr size_t OFF_CTAB = al256(OFF_ATAB + 64 * 128 * 16 * 2);
constexpr size_t OFF_WIN = al256(OFF_CTAB + 64 * 16 * 128 * 2);
constexpr size_t OFF_WOUT = al256(OFF_WIN + (size_t)2 * 1920 * 1024 * 2);
constexpr size_t OFF_W1 = al256(OFF_WOUT + (size_t)2 * 1024 * 1024 * 2);
constexpr size_t OFF_W2 = al256(OFF_W1 + (size_t)2 * 4096 * 1024 * 2);
constexpr size_t OFF_WUQ = al256(OFF_W2 + (size_t)2 * 4096 * 1024 * 2);
constexpr size_t OFF_WUKV = al256(OFF_WUQ + (size_t)2 * 384 * 192 * 2);
constexpr size_t OFF_WGLU = al256(OFF_WUKV + (size_t)2 * 512 * 128 * 2);
constexpr size_t OFF_H = al256(OFF_WGLU + (size_t)2 * 512 * 256 * 2);
constexpr size_t OFF_MIXED = OFF_H;
constexpr size_t OFF_BIG = al256(OFF_H + (size_t)NT * 1024 * 2);
constexpr size_t OFF_PROJ = OFF_BIG;
constexpr size_t OFF_DQ = al256(OFF_PROJ + (size_t)NT * NP * 4);
constexpr size_t OFF_DKB = al256(OFF_DQ + (size_t)NT * 256 * 2);
constexpr size_t OFF_DVT = al256(OFF_DKB + (size_t)NKR * 256 * 2);
constexpr size_t OFF_GQ = al256(OFF_DVT + (size_t)NKR * 256 * 2);
constexpr size_t OFF_GKB = al256(OFF_GQ + (size_t)NT * 256 * 2);
constexpr size_t OFF_GVT = al256(OFF_GKB + (size_t)NKR * 128 * 2);
constexpr size_t OFF_MQ = al256(OFF_GVT + (size_t)NKR * 128 * 2);
constexpr size_t OFF_MKB = al256(OFF_MQ + (size_t)NT * 384 * 2);
constexpr size_t OFF_MVT = al256(OFF_MKB + (size_t)NKR * 384 * 2);
constexpr size_t OFF_CQN = al256(OFF_MVT + (size_t)NKR * 256 * 2);
constexpr size_t OFF_CKVN = al256(OFF_CQN + (size_t)NT * 192 * 2);
constexpr size_t OFF_YBUF = al256(OFF_CKVN + (size_t)NKR * 128 * 2);
constexpr size_t OFF_END1 = al256(OFF_YBUF + (size_t)2 * NT * 256 * 4);
constexpr size_t OFF_A = OFF_BIG;
constexpr size_t OFF_END2 = al256(OFF_A + (size_t)NT * 4096 * 2);
constexpr size_t WS_NEED = OFF_END1 > OFF_END2 ? OFF_END1 : OFF_END2;
static_assert(WS_NEED <= (size_t)256 * 1024 * 1024, "workspace over 256 MiB");

constexpr int NTHR = 512;
constexpr int NWV = NTHR / 64;
constexpr int LDS_BYTES = 8 * 32 * 132 * 4;

struct P {
  const float* in[N_IN];
  float* out;
  char* ws;
};

DI unsigned pack2(float a, float b) { f32x2 v = {a, b}; return __builtin_bit_cast(unsigned, __builtin_convertvector(v, bf2_t)); }
DI u16 f2bf(float a) { return (u16)(pack2(a, 0.f) & 0xffffu); }
DI bf16x8 pack8(f32x4 a, f32x4 b) {
  u32x4 r = {pack2(a[0], a[1]), pack2(a[2], a[3]), pack2(b[0], b[1]), pack2(b[2], b[3])};
  return __builtin_bit_cast(bf16x8, r);
}
DI f32x4 ld4bf(const u16* p) {
  const u32x2 w = *(const u32x2*)p;
  f32x4 r = {__uint_as_float(w[0] << 16), __uint_as_float(w[0] & 0xffff0000u), __uint_as_float(w[1] << 16), __uint_as_float(w[1] & 0xffff0000u)};
  return r;
}
DI f32x4 ld4bf_nt(const u16* p) {
  const u32x2 w = __builtin_nontemporal_load((const u32x2*)p);
  f32x4 r = {__uint_as_float(w[0] << 16), __uint_as_float(w[0] & 0xffff0000u), __uint_as_float(w[1] << 16), __uint_as_float(w[1] & 0xffff0000u)};
  return r;
}
DI u32x2 pack4(f32x4 a) { u32x2 r = {pack2(a[0], a[1]), pack2(a[2], a[3])}; return r; }
DI int get_tid() { int t = threadIdx.x; asm volatile("" : "+v"(t)); return t; }
DI float fexp2(float x) { return __builtin_amdgcn_exp2f(x); }
DI float frcp(float x) { return __builtin_amdgcn_rcpf(x); }
DI float fsigmoid(float w) { return frcp(1.f + fexp2(-w * LOG2E)); }
DI float gelu_tanh(float x) { return x * fsigmoid(1.5957691216057308f * (x + 0.044715f * x * x * x)); }
DI float wave_sum(float v) {
#pragma unroll
  for (int o = 32; o >= 1; o >>= 1) v += __shfl_xor(v, o);
  return v;
}
DI void wave_lds_fence() {
  asm volatile("s_waitcnt lgkmcnt(0)" ::: "memory");
  __builtin_amdgcn_wave_barrier();
}
DI int fetch_item(int* ctr, int lane) {
  int v = 0;
  if (lane == 0) v = atomicAdd(ctr, 1);
  return __builtin_amdgcn_readfirstlane(v);
}
DI size_t vt_off(int b_all, int head, int H) {
  if (b_all < 32) return ((size_t)(b_all * H + head) * 64) * 256;
  return (size_t)32 * H * 64 * 256 + ((size_t)((b_all - 32) * H + head) * 64) * 1536;
}
DI int mod_index(int row) { return row < NCTX ? 0 : 1 + ((row - NCTX) >> 10); }

DI void prologue(const P& p, char* smem) {
  const int tid = get_tid();
  float* fs = (float*)smem;
  constexpr int N_ADA = 384, N_TAB = 64, N_MISC = 1, N_TR = 5700;
  constexpr int TOTAL = N_ADA + N_TAB + N_MISC;
  for (int it = blockIdx.x; it < TOTAL; it += gridDim.x) {
    if (it < N_ADA) {
      const int l = it / 192, ch = it % 192;
      float* sc = fs;
      float* red = fs + 5 * 1024;
      for (int i = tid; i < 5 * 1024; i += NTHR) {
        int m = i >> 10, k = i & 1023;
        float c = (m == 0) ? p.in[I_CCTX][k] : p.in[I_C][(m - 1) * 1024 + k];
        sc[i] = c * fsigmoid(c);
      }
      __syncthreads();
      const int col = tid & 31, kg = tid >> 5;
      const float* w = p.in[I_WADA] + ((size_t)l * 1024 + kg * 64) * 6144 + ch * 32 + col;
      float a0 = 0, a1 = 0, a2 = 0, a3 = 0, a4 = 0;
#pragma unroll 16
      for (int k = 0; k < 64; ++k) {
        float wv = __builtin_nontemporal_load(w + (size_t)k * 6144);
        int kk = kg * 64 + k;
        a0 += sc[kk] * wv; a1 += sc[1024 + kk] * wv; a2 += sc[2048 + kk] * wv; a3 += sc[3072 + kk] * wv; a4 += sc[4096 + kk] * wv;
      }
      red[(kg * 5 + 0) * 32 + col] = a0; red[(kg * 5 + 1) * 32 + col] = a1; red[(kg * 5 + 2) * 32 + col] = a2;
      red[(kg * 5 + 3) * 32 + col] = a3; red[(kg * 5 + 4) * 32 + col] = a4;
      __syncthreads();
      if (tid < 160) {
        int m = tid >> 5, c2 = tid & 31;
        float s = 0;
#pragma unroll
        for (int g = 0; g < 16; ++g) s += red[(g * 5 + m) * 32 + c2];
        int n = ch * 32 + c2;
        s += p.in[I_BADA][l * 6144 + n];
        ((float*)(p.ws + OFF_MOD))[((size_t)l * 5 + m) * 6144 + n] = s;
      }
      __syncthreads();
    } else if (it < N_ADA + N_TAB) {
      const int idx = it - N_ADA;
      if (tid < 64) {
        const int pp = tid;
        float are = p.in[I_ARE][idx * 64 + pp], aim = p.in[I_AIM][idx * 64 + pp];
        float dt = expf(p.in[I_LOGDT][idx]);
        float zr = are * dt, zi = aim * dt;
        float e = expf(zr);
        float abr = e * cosf(zi), abi = e * sinf(zi);
        float d2 = are * are + aim * aim;
        float nr = abr - 1.f, ni = abi;
        float qr = (nr * are + ni * aim) / d2, qi = (ni * are - nr * aim) / d2;
        u16* at = (u16*)(p.ws + OFF_ATAB) + (size_t)idx * 128 * 16;
        u16* ct = (u16*)(p.ws + OFF_CTAB) + (size_t)idx * 16 * 128;
        for (int c = 0; c < 16; ++c) {
          float bre = p.in[I_BRE][((size_t)idx * 64 + pp) * 16 + c], bim = p.in[I_BIM][((size_t)idx * 64 + pp) * 16 + c];
          at[(2 * pp) * 16 + c] = f2bf(qr * bre - qi * bim);
          at[(2 * pp + 1) * 16 + c] = f2bf(qr * bim + qi * bre);
          float cre = p.in[I_CRE][((size_t)idx * 16 + c) * 64 + pp], cim = p.in[I_CIM][((size_t)idx * 16 + c) * 64 + pp];
          ct[c * 128 + 2 * pp] = f2bf(cre);
          ct[c * 128 + 2 * pp + 1] = f2bf(-cim);
        }
        float* ab = (float*)(p.ws + OFF_ABAR) + ((size_t)idx * 64 + pp) * 2;
        ab[0] = abr; ab[1] = abi;
      }
    } else if (it < N_ADA + N_TAB + N_MISC) {
      f32x2* tab = (f32x2*)(p.ws + OFF_ROPE);
      for (int i = tid; i < 2 * 64 * 16; i += NTHR) {
        int kind = i >> 10, pos = (i >> 4) & 63, fi = i & 15;
        int n = kind ? 16 : 8;
        float freq = expf(-(float)(fi % n) / (float)n * 9.210340371976184f);
        float ang = (float)pos * freq;
        f32x2 cs = {cosf(ang), sinf(ang)};
        tab[i] = cs;
      }
      if (tid < 64) ((int*)(p.ws + OFF_CTR))[tid] = 0;
    }
  }
  struct TrD { const float* src; u16* dst; int K, N, k0, n0; bool glu; };
  auto decode = [&](int tt) {
    TrD d; d.glu = false;
    const int l = tt / 2850;
    int r = tt % 2850; int kt, nt;
    if (r < 480) { d.src = p.in[I_WIN] + (size_t)l * 1024 * 1888; d.dst = (u16*)(p.ws + OFF_WIN) + (size_t)l * 1920 * 1024; d.K = 1024; d.N = 1888; kt = r / 30; nt = r % 30; }
    else if (r < 736) { r -= 480; d.src = p.in[I_WOUT] + (size_t)l * 1024 * 1024; d.dst = (u16*)(p.ws + OFF_WOUT) + (size_t)l * 1024 * 1024; d.K = 1024; d.N = 1024; kt = r / 16; nt = r % 16; }
    else if (r < 1760) { r -= 736; d.src = p.in[I_W1] + (size_t)l * 1024 * 4096; d.dst = (u16*)(p.ws + OFF_W1) + (size_t)l * 4096 * 1024; d.K = 1024; d.N = 4096; kt = r / 64; nt = r % 64; }
    else if (r < 2784) { r -= 1760; d.src = p.in[I_W2] + (size_t)l * 4096 * 1024; d.dst = (u16*)(p.ws + OFF_W2) + (size_t)l * 1024 * 4096; d.K = 4096; d.N = 1024; kt = r / 16; nt = r % 16; }
    else if (r < 2802) { r -= 2784; d.src = p.in[I_WUQ] + (size_t)l * 192 * 384; d.dst = (u16*)(p.ws + OFF_WUQ) + (size_t)l * 384 * 192; d.K = 192; d.N = 384; kt = r / 6; nt = r % 6; }
    else if (r < 2818) { r -= 2802; d.src = p.in[I_WUKV] + (size_t)l * 128 * 512; d.dst = (u16*)(p.ws + OFF_WUKV) + (size_t)l * 512 * 128; d.K = 128; d.N = 512; kt = r / 8; nt = r % 8; }
    else { r -= 2818; d.src = p.in[I_WGLU] + (size_t)l * 256 * 512; d.dst = (u16*)(p.ws + OFF_WGLU) + (size_t)l * 512 * 256; d.K = 256; d.N = 512; kt = r / 8; nt = r % 8; d.glu = true; }
    d.k0 = kt * 64; d.n0 = nt * 64;
    return d;
  };
  const int half = tid >> 8, t2 = tid & 255;
  float* ft = fs + half * (64 * 65);
  const int tx = t2 & 15, ty = t2 >> 4;
  auto tload = [&](const TrD& d, f32x4 (&v)[4]) {
#pragma unroll
    for (int i = 0; i < 4; ++i) {
      const int kk = ty + 16 * i, n = d.n0 + 4 * tx;
      f32x4 z = {0.f, 0.f, 0.f, 0.f};
      v[i] = (n < d.N) ? __builtin_nontemporal_load((const f32x4*)(d.src + (size_t)(d.k0 + kk) * d.N + n)) : z;
    }
  };
  const int nvb = 2 * (int)gridDim.x;
  const int tb = nvb - 1 - (2 * (int)blockIdx.x + half);
  const int nrounds = (N_TR + nvb - 1) / nvb;
  TrD cur = decode(tb < N_TR ? tb : 0);
  f32x4 cv[4];
  if (tb < N_TR) tload(cur, cv);
  for (int j = 0; j < nrounds; ++j) {
    const int tt = tb + j * nvb;
    const bool valid = tt < N_TR, more = tt + nvb < N_TR;
    TrD nxt = decode(more ? tt + nvb : 0);
    f32x4 nv[4];
    if (more) tload(nxt, nv);
    if (valid) {
#pragma unroll
      for (int i = 0; i < 4; ++i) {
        const int kk = ty + 16 * i;
        ft[kk * 65 + 4 * tx + 0] = cv[i][0]; ft[kk * 65 + 4 * tx + 1] = cv[i][1]; ft[kk * 65 + 4 * tx + 2] = cv[i][2]; ft[kk * 65 + 4 * tx + 3] = cv[i][3];
      }
    }
    __syncthreads();
    if (valid) {
#pragma unroll
      for (int i = 0; i < 2; ++i) {
        const int c = t2 + 256 * i, nn = c >> 3, kc = (c & 7) * 8;
        f32x4 a, b;
#pragma unroll
        for (int e = 0; e < 4; ++e) { a[e] = ft[(kc + e) * 65 + nn]; b[e] = ft[(kc + 4 + e) * 65 + nn]; }
        const int n = cur.n0 + nn;
        int drow = n;
        if (cur.glu) drow = (n < 256) ? ((n >> 5) * 64 + (n & 31)) : (((n - 256) >> 5) * 64 + 32 + (n & 31));
        *(bf16x8*)(cur.dst + (size_t)drow * cur.K + cur.k0 + kc) = pack8(a, b);
      }
    }
    __syncthreads();
    cur = nxt;
    if (more) {
#pragma unroll
      for (int i = 0; i < 4; ++i) cv[i] = nv[i];
    }
  }
}

DI const float* x_row_src(const P& p, int layer, int row) {
  if (layer == 0) return row < NCTX ? p.in[I_XP] + (size_t)row * 1024 : p.in[I_XS] + (size_t)(row - NCTX) * 1024;
  return p.out + (size_t)row * 1024;
}
DI void norm_phase(const P& p, int layer, int which) {
  const int tid_ = get_tid();
  const int lane = tid_ & 63;
  const int gw = blockIdx.x * NWV + (tid_ >> 6), nw = gridDim.x * NWV;
  auto src_of = [&](int row) { return (which == 0) ? x_row_src(p, layer, row) : (const float*)(p.out + (size_t)row * 1024); };
  f32x4 v[4];
  if (gw < NT) {
    const float* xs = src_of(gw);
#pragma unroll
    for (int i = 0; i < 4; ++i) v[i] = *(const f32x4*)(xs + (i * 64 + lane) * 4);
  }
  for (int row = gw; row < NT; row += nw) {
    f32x4 nv[4];
    const bool more = row + nw < NT;
    if (more) {
      const float* xs = src_of(row + nw);
#pragma unroll
      for (int i = 0; i < 4; ++i) nv[i] = *(const f32x4*)(xs + (i * 64 + lane) * 4);
    }
    float ss = 0;
#pragma unroll
    for (int i = 0; i < 4; ++i) ss += v[i][0] * v[i][0] + v[i][1] * v[i][1] + v[i][2] * v[i][2] + v[i][3] * v[i][3];
    ss = wave_sum(ss);
    const float r = rsqrtf(ss * (1.f / 1024.f) + EPSF);
    if (which == 2) {
      f32x4 g[4];
#pragma unroll
      for (int i = 0; i < 4; ++i) g[i] = *(const f32x4*)(p.in[I_FNG] + (i * 64 + lane) * 4);
#pragma unroll
      for (int i = 0; i < 4; ++i) {
        int e = (i * 64 + lane) * 4;
        f32x4 o = v[i] * r * g[i];
        *(f32x4*)(p.out + (size_t)row * 1024 + e) = o;
      }
    } else {
      const float* gn = p.in[which == 0 ? I_N1G : I_N2G] + layer * 1024;
      const float* md = (const float*)(p.ws + OFF_MOD) + ((size_t)layer * 5 + mod_index(row)) * 6144 + (which == 0 ? 0 : 3072);
      u16* h = (u16*)(p.ws + OFF_H) + (size_t)row * 1024;
      f32x4 g[4], sh[4], sc[4];
#pragma unroll
      for (int i = 0; i < 4; ++i) {
        int e = (i * 64 + lane) * 4;
        g[i] = *(const f32x4*)(gn + e);
        sh[i] = *(const f32x4*)(md + e);
        sc[i] = *(const f32x4*)(md + 1024 + e);
      }
#pragma unroll
      for (int i = 0; i < 4; ++i) {
        int e = (i * 64 + lane) * 4;
        f32x4 o = v[i] * r * g[i] * (1.f + sc[i]) + sh[i];
        *(u32x2*)(h + e) = pack4(o);
      }
    }
    if (more) {
#pragma unroll
      for (int i = 0; i < 4; ++i) v[i] = nv[i];
    }
  }
}

#define LAS3 __attribute__((address_space(3)))
template <int NI>
DI void stage_tile_dma(const u16* __restrict__ G, int ld, int row0, int k0, char* lds, int tid) {
#pragma unroll
  for (int i = 0; i < NI; ++i) {
    const int q = tid + NTHR * i, r = q >> 3, c = (q & 7) ^ ((r >> 1) & 7);
    __builtin_amdgcn_global_load_lds((const unsigned*)(G + (size_t)(row0 + r) * ld + k0 + c * 8), (LAS3 unsigned*)(lds + q * 16), 16, 0, 0);
  }
}
struct TD { const u16* A; const u16* B; int lda, ldb, k0, nk, m0, n0; };
template <int NB>
DI void stage_td(const TD& d, int kt, char* stage_base, int tid) {
  stage_tile_dma<4>(d.A, d.lda, d.m0, d.k0 + kt * 64, stage_base, tid);
  stage_tile_dma<2 * NB>(d.B, d.ldb, d.n0, d.k0 + kt * 64, stage_base + 32768, tid);
}
template <int NB>
DI void gemm_stream(const TD& cur, bool has_next, const TD& nxt, char* smem, int& buf, f32x16 (&acc)[4][NB]) {
  const int tid = get_tid(), lane = tid & 63, wave = tid >> 6, wm = wave >> 2, wn = wave & 3, l32 = lane & 31, hh = lane >> 5;
#pragma unroll
  for (int bi = 0; bi < 4; ++bi)
#pragma unroll
    for (int bj = 0; bj < NB; ++bj)
#pragma unroll
      for (int r = 0; r < 16; ++r) acc[bi][bj][r] = 0.f;
  const int swz = (l32 >> 1) & 7;
  const int arow = (wm * 128 + l32) * 128, brow = (wn * (NB * 32) + l32) * 128;
  const int c0 = ((0 + hh) ^ swz) * 16, c1 = ((2 + hh) ^ swz) * 16, c2 = ((4 + hh) ^ swz) * 16, c3 = ((6 + hh) ^ swz) * 16;
  asm volatile("s_waitcnt vmcnt(0)" ::: "memory");
  __syncthreads();
  const int nk = cur.nk;
  for (int kt = 0; kt < nk; ++kt) {
    const bool early = wave < 4;
    if (early) {
      if (kt + 1 < nk) stage_td<NB>(cur, kt + 1, smem + (buf ^ 1) * 65536, tid);
      else if (has_next) stage_td<NB>(nxt, 0, smem + (buf ^ 1) * 65536, tid);
    }
    const char* as = smem + buf * 65536 + arow;
    const char* bs = smem + buf * 65536 + 32768 + brow;
#pragma unroll
    for (int ks = 0; ks < 4; ++ks) {
      const int co = (ks == 0) ? c0 : (ks == 1) ? c1 : (ks == 2) ? c2 : c3;
      bf16x8 fa[4], fb[NB];
#pragma unroll
      for (int bi = 0; bi < 4; ++bi) fa[bi] = *(const bf16x8*)(as + bi * 4096 + co);
#pragma unroll
      for (int bj = 0; bj < NB; ++bj) fb[bj] = *(const bf16x8*)(bs + bj * 4096 + co);
      __builtin_amdgcn_s_setprio(1);
#pragma unroll
      for (int bi = 0; bi < 4; ++bi)
#pragma unroll
        for (int bj = 0; bj < NB; ++bj) acc[bi][bj] = MFMA32(fa[bi], fb[bj], acc[bi][bj]);
      __builtin_amdgcn_s_setprio(0);
      if (ks == 1 && !early) {
        if (kt + 1 < nk) stage_td<NB>(cur, kt + 1, smem + (buf ^ 1) * 65536, tid);
        else if (has_next) stage_td<NB>(nxt, 0, smem + (buf ^ 1) * 65536, tid);
      }
    }
    buf ^= 1;
    if (kt + 1 < nk) {
      asm volatile("s_waitcnt vmcnt(0)" ::: "memory");
      __syncthreads();
    }
  }
}

#if MEGA
#define XCD_ID()   ((int)((volatile int*)(smem + LDS_BYTES))[3])
#define XCD_RANK() ((int)((volatile int*)(smem + LDS_BYTES))[2])
#else
#define XCD_ID()   ((int)(blockIdx.x & 7))
#define XCD_RANK() ((int)(blockIdx.x >> 3))
#endif
#define EPI_IDX                                                                                        \
  const int tid = get_tid(), lane = tid & 63, wave = tid >> 6, wm = wave >> 2, wn = wave & 3, l32 = lane & 31, hh = lane >> 5; \
  (void)tid; (void)lane; (void)wave; (void)wm; (void)wn; (void)l32; (void)hh;
DI int crow(int r, int hh) { return (r & 3) + 8 * (r >> 2) + 4 * hh; }

DI void phase_g1(const P& p, int layer, char* smem) {
  EPI_IDX
  const u16* A = (const u16*)(p.ws + OFF_H);
  const u16* Bt = (const u16*)(p.ws + OFF_WIN) + (size_t)layer * 1920 * 1024;
  u16* proj = (u16*)(p.ws + OFF_PROJ);
  constexpr int MT = NT / 256, NTL = NP / 128, MPX = MT / 8;
  const int xcd_ = XCD_ID(), xj_ = XCD_RANK(), xn_ = gridDim.x >> 3;
  auto tile_at = [&](int u) { TD d; d.A = A; d.B = Bt; d.lda = 1024; d.ldb = 1024; d.k0 = 0; d.nk = 16; d.m0 = (xcd_ * MPX + u % MPX) * 256; d.n0 = (u / MPX) * 128; return d; };
  int buf = 0;
  TD cur = tile_at(xj_ < MPX * NTL ? xj_ : 0);
  if (xj_ < MPX * NTL) stage_td<1>(cur, 0, smem, tid);
  for (int u = xj_; u < MPX * NTL; u += xn_) {
    const bool has_next = (u + xn_ < MPX * NTL);
    const TD nxt = tile_at(has_next ? u + xn_ : u);
    const int m0 = cur.m0, n0 = cur.n0;
    f32x16 acc[4][1];
    gemm_stream<1>(cur, has_next, nxt, smem, buf, acc);
    cur = nxt;
    const bool lat = m0 >= NCTX;
    const int b_all = lat ? 32 + ((m0 - NCTX) >> 10) : (m0 >> 8);
    const int nkk = lat ? 1536 : 256;
#pragma unroll
    for (int bi = 0; bi < 4; ++bi)
#pragma unroll
      for (int bj = 0; bj < 1; ++bj) {
        const int rb = m0 + wm * 128 + bi * 32;
        const int cb = n0 + wn * 32 + bj * 32;
        const int col = cb + l32;
        if (cb < NP) {
#pragma unroll
          for (int r = 0; r < 16; ++r) proj[(size_t)(rb + crow(r, hh)) * NP + col] = f2bf(acc[bi][bj][r]);
        }
        const bool isdv = (cb >= 512 && cb < 768), isgv = (cb >= 1152 && cb < 1280);
        if (isdv || isgv) {
          u16* vt; int f;
          if (isdv) { f = col - 512; vt = (u16*)(p.ws + OFF_DVT) + vt_off(b_all, f >> 6, 4); }
          else { f = col - 1152; vt = (u16*)(p.ws + OFF_GVT) + vt_off(b_all, f >> 6, 2); }
          vt += (size_t)(f & 63) * nkk;
#pragma unroll
          for (int j = 0; j < 4; ++j) {
            int row = rb + 16 * (j >> 1) + 8 * hh + 4 * (j & 1);
            int key = lat ? 512 + ((row - NCTX) & 1023) : (row & 255);
            f32x4 v = {acc[bi][bj][4 * j], acc[bi][bj][4 * j + 1], acc[bi][bj][4 * j + 2], acc[bi][bj][4 * j + 3]};
            *(u32x2*)(vt + key) = pack4(v);
          }
        }
      }
  }
}

DI void phase_g2(const P& p, int layer, char* smem) {
  EPI_IDX
  constexpr int T_MQ = (NT / 256) * 2, T_MKV = (NKR / 256) * 2;
  const f32x2* tab32 = (const f32x2*)(p.ws + OFF_ROPE);
  auto tile_at = [&](int t) {
    TD d; d.k0 = 0;
    if (t < T_MQ) { d.A = (const u16*)(p.ws + OFF_CQN); d.B = (const u16*)(p.ws + OFF_WUQ) + (size_t)layer * 384 * 192; d.lda = 192; d.ldb = 192; d.nk = 3; d.m0 = (t >> 1) * 256; d.n0 = (t & 1) * 256; }
    else { const int t2 = t - T_MQ; d.A = (const u16*)(p.ws + OFF_CKVN); d.B = (const u16*)(p.ws + OFF_WUKV) + (size_t)layer * 512 * 128; d.lda = 128; d.ldb = 128; d.nk = 2; d.m0 = (t2 >> 1) * 256; d.n0 = (t2 & 1) * 256; }
    return d;
  };
  int buf = 0;
  const int t_first = blockIdx.x;
  TD cur = tile_at(t_first < T_MQ + T_MKV ? t_first : 0);
  if (t_first < T_MQ + T_MKV) stage_td<2>(cur, 0, smem, tid);
  for (int t = blockIdx.x; t < T_MQ + T_MKV; t += gridDim.x) {
    const bool has_next = (t + (int)gridDim.x < T_MQ + T_MKV);
    const TD nxt = tile_at(has_next ? t + (int)gridDim.x : t);
    f32x16 acc[4][2];
    const int m0 = cur.m0, n0 = cur.n0;
    gemm_stream<2>(cur, has_next, nxt, smem, buf, acc);
    cur = nxt;
    if (t < T_MQ) {
      const bool lat = m0 >= NCTX;
      const float scl = 0.10206207261596575f * LOG2E;
      u16* mq = (u16*)(p.ws + OFF_MQ);
#pragma unroll
      for (int bi = 0; bi < 4; ++bi)
#pragma unroll
        for (int bj = 0; bj < 2; ++bj) {
          const int rb = m0 + wm * 128 + bi * 32;
          const int cb = n0 + wn * 64 + bj * 32;
          const int col = cb + l32;
          if (cb < 384) {
            const bool isrope = lat && ((cb % 96) == 64);
            const int e = l32, w2 = e & 15, fi = w2 & 7;
            const bool isx2 = w2 >= 8, half = e >= 16;
#pragma unroll
            for (int r = 0; r < 16; ++r) {
              float v = acc[bi][bj][r];
              const int row = rb + crow(r, hh);
              if (isrope) {
                const int tt = (row - NCTX) & 1023;
                const int pos = half ? (tt & 63) : (tt >> 6);
                const f32x2 cs = tab32[pos * 16 + fi];
                float pv = __shfl_xor(v, 8);
                v = v * cs[0] + (isx2 ? pv : -pv) * cs[1];
              }
              mq[(size_t)row * 384 + col] = f2bf(v * scl);
            }
          }
        }
    } else {
      const bool lat = m0 >= NCTX;
      const int b_all = lat ? 32 + (m0 - NCTX) / 1536 : (m0 >> 8);
      const int nkk = lat ? 1536 : 256;
      const int kbase = lat ? (m0 - NCTX) % 1536 : (m0 & 255);
      u16* mk = (u16*)(p.ws + OFF_MKB);
#pragma unroll
      for (int bi = 0; bi < 4; ++bi)
#pragma unroll
        for (int bj = 0; bj < 2; ++bj) {
          const int rloc = wm * 128 + bi * 32;
          const int cb = n0 + wn * 64 + bj * 32;
          const int head = cb >> 7, wc = (cb & 127) + l32;
          if ((cb & 127) < 64) {
#pragma unroll
            for (int r = 0; r < 16; ++r) mk[(size_t)(m0 + rloc + crow(r, hh)) * 384 + head * 96 + wc] = f2bf(acc[bi][bj][r]);
          } else {
            u16* vt = (u16*)(p.ws + OFF_MVT) + vt_off(b_all, head, 4) + (size_t)(wc - 64) * nkk + kbase + rloc;
#pragma unroll
            for (int j = 0; j < 4; ++j) {
              f32x4 v = {acc[bi][bj][4 * j], acc[bi][bj][4 * j + 1], acc[bi][bj][4 * j + 2], acc[bi][bj][4 * j + 3]};
              *(u32x2*)(vt + 16 * (j >> 1) + 8 * hh + 4 * (j & 1)) = pack4(v);
            }
          }
        }
    }
  }
  {
    const int gw = blockIdx.x * NWV + wave, nw = gridDim.x * NWV;
    const f32x4 dd = *(const f32x4*)(p.in[I_SSMD] + layer * 256 + lane * 4);
    for (int row = gw; row < NT; row += nw) {
      const float* y0 = (const float*)(p.ws + OFF_YBUF) + (size_t)row * 256 + lane * 4;
      u16* prow = (u16*)(p.ws + OFF_PROJ) + (size_t)row * NP;
      f32x4 a = __builtin_nontemporal_load((const f32x4*)y0), b = __builtin_nontemporal_load((const f32x4*)(y0 + (size_t)NT * 256)), c = ld4bf(prow + 1280 + lane * 4);
      f32x4 sv = a + b + c * dd;
      f32x4 g = {gelu_tanh(sv[0]), gelu_tanh(sv[1]), gelu_tanh(sv[2]), gelu_tanh(sv[3])};
      *(u32x2*)(prow + lane * 4) = pack4(g);
    }
  }
}

DI void phase_resid(const P& p, int layer, char* smem, bool is_out) {
  EPI_IDX
  const u16* A = is_out ? (const u16*)(p.ws + OFF_MIXED) : (const u16*)(p.ws + OFF_A);
  const int K = is_out ? 1024 : 4096;
  const u16* Bt = is_out ? (const u16*)(p.ws + OFF_WOUT) + (size_t)layer * 1024 * 1024 : (const u16*)(p.ws + OFF_W2) + (size_t)layer * 1024 * 4096;
  constexpr int MT = NT / 256, NTL = 4, MPX = MT / 8, NU = MPX * NTL;
  const int xcd_ = XCD_ID(), xj_ = XCD_RANK(), xn_ = gridDim.x >> 3;
  auto tile_at = [&](int u) {
    TD d; d.A = A; d.B = Bt; d.lda = K; d.ldb = K; d.nk = K / 64; d.k0 = 0;
    d.n0 = (u % NTL) * 256;
    d.m0 = (xcd_ * MPX + u / NTL) * 256;
    return d;
  };
  int buf = 0;
  TD cur = tile_at(xj_ < NU ? xj_ : 0);
  if (xj_ < NU) stage_td<2>(cur, 0, smem, tid);
  for (int u = xj_; u < NU; u += xn_) {
    const bool has_next = (u + xn_ < NU);
    const TD nxt = tile_at(has_next ? u + xn_ : u);
    const int m0 = cur.m0, n0 = cur.n0;
    f32x16 acc[4][2];
    gemm_stream<2>(cur, has_next, nxt, smem, buf, acc);
    cur = nxt;
    const float* gate = (const float*)(p.ws + OFF_MOD) + ((size_t)layer * 5 + mod_index(m0)) * 6144 + (is_out ? 2048 : 5120);
#pragma unroll
    for (int bi = 0; bi < 4; ++bi)
#pragma unroll
      for (int bj = 0; bj < 2; ++bj) {
        const int rb = m0 + wm * 128 + bi * 32;
        const int col = n0 + wn * 64 + bj * 32 + l32;
        const float g = gate[col];
        float rv[16];
#pragma unroll
        for (int r = 0; r < 16; ++r) {
          const int row = rb + crow(r, hh);
          rv[r] = (is_out && layer == 0) ? x_row_src(p, 0, row)[col] : p.out[(size_t)row * 1024 + col];
        }
#pragma unroll
        for (int r = 0; r < 16; ++r) p.out[(size_t)(rb + crow(r, hh)) * 1024 + col] = rv[r] + g * acc[bi][bj][r];
      }
  }
}

DI void phase_g5(const P& p, int layer, char* smem) {
  EPI_IDX
  const u16* A = (const u16*)(p.ws + OFF_H);
  const u16* Bt = (const u16*)(p.ws + OFF_W1) + (size_t)layer * 4096 * 1024;
  u16* a = (u16*)(p.ws + OFF_A);
  constexpr int MT = NT / 256, NTL = 16, MPX = MT / 8;
  const int xcd_ = XCD_ID(), xj_ = XCD_RANK(), xn_ = gridDim.x >> 3;
  auto tile_at = [&](int u) { TD d; d.A = A; d.B = Bt; d.lda = 1024; d.ldb = 1024; d.k0 = 0; d.nk = 16; d.m0 = (xcd_ * MPX + u % MPX) * 256; d.n0 = (u / MPX) * 256; return d; };
  int buf = 0;
  TD cur = tile_at(xj_ < MPX * NTL ? xj_ : 0);
  if (xj_ < MPX * NTL) stage_td<2>(cur, 0, smem, tid);
  for (int u = xj_; u < MPX * NTL; u += xn_) {
    const bool has_next = (u + xn_ < MPX * NTL);
    const TD nxt = tile_at(has_next ? u + xn_ : u);
    const int m0 = cur.m0, n0 = cur.n0;
    f32x16 acc[4][2];
    gemm_stream<2>(cur, has_next, nxt, smem, buf, acc);
    cur = nxt;
#pragma unroll
    for (int bi = 0; bi < 4; ++bi)
#pragma unroll
      for (int bj = 0; bj < 2; ++bj) {
        const int rb = m0 + wm * 128 + bi * 32;
        const int col = n0 + wn * 64 + bj * 32 + l32;
#pragma unroll
        for (int r = 0; r < 16; ++r) {
          float v = fmaxf(acc[bi][bj][r], 0.f);
          a[(size_t)(rb + crow(r, hh)) * 4096 + col] = f2bf(v * v);
        }
      }
  }
}

template <int R>
DI f32x4 rope4(f32x4 v, int lane, int t, const f32x2* tab) {
  constexpr int n = R / 4;
  const int e = (lane * 4) % R;
  const int half = e / (R / 2), w = e % (R / 2);
  const bool isx2 = w >= n;
  const int fi = w % n;
  const int pos = half ? (t & 63) : (t >> 6);
  f32x4 o;
#pragma unroll
  for (int i = 0; i < 4; ++i) {
    float pv = __shfl_xor(v[i], n / 4);
    f32x2 cs = tab[pos * 16 + fi + i];
    o[i] = v[i] * cs[0] + (isx2 ? pv : -pv) * cs[1];
  }
  return o;
}

DI void ssm_item(const P& p, int layer, int item, float* lds, int lane) {
  int b_all, r;
  if (item < 128) { b_all = 32 + item / 32; r = item % 32; } else { int it = item - 128; b_all = it / 32; r = it % 32; }
  const int dir = r >> 4, g = r & 15;
  const bool lat = b_all >= 32;
  const int T = lat ? 1024 : 256;
  const int row0 = lat ? NCTX + (b_all - 32) * 1024 : b_all * 256;
  const int tabidx = (layer * 2 + dir) * 16 + g;
  const int l32 = lane & 31, hh = lane >> 5, l16 = lane & 15, q4 = lane >> 4;
  const u16* atab = (const u16*)(p.ws + OFF_ATAB) + (size_t)tabidx * 128 * 16;
  const u16* ctab = (const u16*)(p.ws + OFF_CTAB) + (size_t)tabidx * 16 * 128;
  bf16x8 af[4], cf[4];
#pragma unroll
  for (int blk = 0; blk < 4; ++blk) af[blk] = *(const bf16x8*)(atab + (blk * 32 + l32) * 16 + hh * 8);
#pragma unroll
  for (int kk = 0; kk < 4; ++kk) cf[kk] = *(const bf16x8*)(ctab + l16 * 128 + kk * 32 + q4 * 8);
  const float* ab = (const float*)(p.ws + OFF_ABAR) + ((size_t)tabidx * 64 + lane) * 2;
  const float ar = ab[0], ai = ab[1];
  float hr = 0.f, hi = 0.f;
  if (lat) {
    size_t idx = ((size_t)((b_all - 32) * 2 + layer) * 2 + dir) * 1024 + g * 64 + lane;
    hr = p.in[I_SRE][idx]; hi = p.in[I_SIM][idx];
  }
  const u16* proj = (const u16*)(p.ws + OFF_PROJ);
  float* ybuf = (float*)(p.ws + OFF_YBUF) + (size_t)dir * NT * 256;
  f32x16 zero16;
#pragma unroll
  for (int i = 0; i < 16; ++i) zero16[i] = 0.f;
  bf16x8 un;
  {
    const int t = dir ? (T - 1 - l32) : l32;
    un = *(const bf16x8*)(proj + (size_t)(row0 + t) * NP + 1280 + g * 16 + hh * 8);
  }
  for (int ch = 0; ch < T / 32; ++ch) {
    {
      bf16x8 uf = un;
      if (ch + 1 < T / 32) {
        const int n = (ch + 1) * 32 + l32;
        const int t = dir ? (T - 1 - n) : n;
        un = *(const bf16x8*)(proj + (size_t)(row0 + t) * NP + 1280 + g * 16 + hh * 8);
      }
#pragma unroll
      for (int blk = 0; blk < 4; ++blk) {
        f32x16 d = MFMA32(af[blk], uf, zero16);
#pragma unroll
        for (int j = 0; j < 4; ++j) {
          f32x4 v = {d[4 * j], d[4 * j + 1], d[4 * j + 2], d[4 * j + 3]};
          *(f32x4*)(lds + l32 * 132 + blk * 32 + 8 * j + 4 * hh) = v;
        }
      }
    }
    wave_lds_fence();
    {
      f32x2 bu[32];
#pragma unroll
      for (int s = 0; s < 32; ++s) bu[s] = *(const f32x2*)(lds + s * 132 + 2 * lane);
#pragma unroll
      for (int s = 0; s < 32; ++s) {
        const float nr = __builtin_fmaf(ar, hr, __builtin_fmaf(-ai, hi, bu[s][0]));
        const float ni = __builtin_fmaf(ar, hi, __builtin_fmaf(ai, hr, bu[s][1]));
        hr = nr; hi = ni;
        f32x2 hv = {hr, hi};
        *(f32x2*)(lds + s * 132 + 2 * lane) = hv;
      }
    }
    wave_lds_fence();
#pragma unroll
    for (int tb = 0; tb < 2; ++tb) {
      f32x4 y = {0.f, 0.f, 0.f, 0.f};
#pragma unroll
      for (int kk = 0; kk < 4; ++kk) {
        const float* hp = lds + (tb * 16 + l16) * 132 + kk * 32 + q4 * 8;
        f32x4 a0 = *(const f32x4*)hp, a1 = *(const f32x4*)(hp + 4);
        y = MFMA16(cf[kk], pack8(a0, a1), y);
      }
      const int n2 = ch * 32 + tb * 16 + l16;
      const int t2 = dir ? (T - 1 - n2) : n2;
      *(f32x4*)(ybuf + (size_t)(row0 + t2) * 256 + g * 16 + q4 * 4) = y;
    }
    wave_lds_fence();
  }
  if (!lat) {
    size_t idx = ((size_t)(b_all * 2 + layer) * 2 + dir) * 1024 + g * 64 + lane;
    p.out[O_SRE + idx] = hr;
    p.out[O_SIM + idx] = hi;
  }
}

DI void pp_row(const P& p, int layer, int row, int lane) {
  const u16* pr = (const u16*)(p.ws + OFF_PROJ) + (size_t)row * NP;
  const bool lat = row >= NCTX;
  int b, t, keyrow;
  if (!lat) { b = row >> 8; t = row & 255; keyrow = row; }
  else { int rr = row - NCTX; b = rr >> 10; t = rr & 1023; keyrow = NCTX + b * 1536 + 512 + t; }
  const f32x2* tab32 = (const f32x2*)(p.ws + OFF_ROPE);
  const f32x2* tab64 = tab32 + 64 * 16;
  const size_t orow = (size_t)(b * 2 + layer) * 256 + t;
  const f32x4 z4 = {0.f, 0.f, 0.f, 0.f};
  f32x4 v_dq = ld4bf_nt(pr + lane * 4);
  f32x4 v_dk = ld4bf_nt(pr + 256 + lane * 4);
  f32x4 v_dv = ld4bf_nt(pr + 512 + lane * 4);
  f32x4 v_gq = ld4bf_nt(pr + 768 + lane * 4);
  f32x4 v_gk = lane < 32 ? ld4bf_nt(pr + 1024 + lane * 4) : z4;
  f32x4 v_gv = lane < 32 ? ld4bf_nt(pr + 1152 + lane * 4) : z4;
  f32x4 v_cq = lane < 48 ? ld4bf_nt(pr + 1536 + lane * 4) : z4;
  f32x4 v_ckv = lane < 32 ? ld4bf_nt(pr + 1728 + lane * 4) : z4;
  f32x4 v_kr = lane < 8 ? ld4bf_nt(pr + 1856 + lane * 4) : z4;
  const f32x4 g_q = *(const f32x4*)(p.in[I_QNG] + layer * 64 + (lane & 15) * 4);
  const f32x4 g_k = *(const f32x4*)(p.in[I_KNG] + layer * 64 + (lane & 15) * 4);
  const f32x4 g_cq = lane < 48 ? *(const f32x4*)(p.in[I_MQNG] + layer * 192 + lane * 4) : z4;
  const f32x4 g_ckv = lane < 32 ? *(const f32x4*)(p.in[I_MKVNG] + layer * 128 + lane * 4) : z4;
  f32x2 cs32[4], cs64[4];
  {
    const int e32 = (lane * 4) & 31, w32 = e32 & 15, p32 = (e32 >> 4) ? (t & 63) : (t >> 6), f32i = w32 & 7;
    const int e64 = (lane * 4) & 63, w64 = e64 & 31, p64 = (e64 >> 5) ? (t & 63) : (t >> 6), f64i = w64 & 15;
    const f32x2 one = {1.f, 0.f};
#pragma unroll
    for (int i = 0; i < 4; ++i) {
      cs32[i] = lat ? tab32[p32 * 16 + f32i + i] : one;
      cs64[i] = lat ? tab64[p64 * 16 + f64i + i] : one;
    }
  }
  const bool x2_32 = ((lane * 4) & 15) >= 8, x2_64 = ((lane * 4) & 31) >= 16;
  auto rope32 = [&](f32x4 v) {
    f32x4 o;
#pragma unroll
    for (int i = 0; i < 4; ++i) { float pv = __shfl_xor(v[i], 2); o[i] = v[i] * cs32[i][0] + (x2_32 ? pv : -pv) * cs32[i][1]; }
    return o;
  };
  auto rope64 = [&](f32x4 v) {
    f32x4 o;
#pragma unroll
    for (int i = 0; i < 4; ++i) { float pv = __shfl_xor(v[i], 4); o[i] = v[i] * cs64[i][0] + (x2_64 ? pv : -pv) * cs64[i][1]; }
    return o;
  };
  if (!lat) {
    *(f32x4*)(p.out + O_DK + orow * 256 + lane * 4) = v_dk;
    *(f32x4*)(p.out + O_DV + orow * 256 + lane * 4) = v_dv;
    if (lane < 32) *(f32x4*)(p.out + O_GV + orow * 128 + lane * 4) = v_gv;
    if (lane < 8) *(f32x4*)(p.out + O_KR + orow * 32 + lane * 4) = v_kr;
  }
  {
    f32x4 v = v_dq;
    if (lat) v = rope32(v);
    v = v * (0.17677669529663687f * LOG2E);
    *(u32x2*)((u16*)(p.ws + OFF_DQ) + (size_t)row * 256 + lane * 4) = pack4(v);
  }
  {
    f32x4 v = v_dk;
    if (lat) v = rope32(v);
    *(u32x2*)((u16*)(p.ws + OFF_DKB) + (size_t)keyrow * 256 + lane * 4) = pack4(v);
  }
  {
    f32x4 v = v_gq;
    float ss = v[0] * v[0] + v[1] * v[1] + v[2] * v[2] + v[3] * v[3];
    ss += __shfl_xor(ss, 1); ss += __shfl_xor(ss, 2); ss += __shfl_xor(ss, 4); ss += __shfl_xor(ss, 8);
    float r = rsqrtf(ss * (1.f / 64.f) + EPSF);
    v = v * r * g_q;
    if (lat) v = rope64(v);
    v = v * (0.125f * LOG2E);
    *(u32x2*)((u16*)(p.ws + OFF_GQ) + (size_t)row * 256 + lane * 4) = pack4(v);
  }
  {
    f32x4 v = v_gk;
    float ss = v[0] * v[0] + v[1] * v[1] + v[2] * v[2] + v[3] * v[3];
    ss += __shfl_xor(ss, 1); ss += __shfl_xor(ss, 2); ss += __shfl_xor(ss, 4); ss += __shfl_xor(ss, 8);
    float r = rsqrtf(ss * (1.f / 64.f) + EPSF);
    v = v * r * g_k;
    if (!lat) { if (lane < 32) *(f32x4*)(p.out + O_GK + orow * 128 + lane * 4) = v; }
    else v = rope64(v);
    if (lane < 32) *(u32x2*)((u16*)(p.ws + OFF_GKB) + (size_t)keyrow * 128 + lane * 4) = pack4(v);
  }
  {
    f32x4 v = v_cq;
    float ss = wave_sum(v[0] * v[0] + v[1] * v[1] + v[2] * v[2] + v[3] * v[3]);
    float r = rsqrtf(ss * (1.f / 192.f) + EPSF);
    v = v * r * g_cq;
    if (lane < 48) *(u32x2*)((u16*)(p.ws + OFF_CQN) + (size_t)row * 192 + lane * 4) = pack4(v);
  }
  {
    f32x4 v = v_ckv;
    float ss = wave_sum(v[0] * v[0] + v[1] * v[1] + v[2] * v[2] + v[3] * v[3]);
    float r = rsqrtf(ss * (1.f / 128.f) + EPSF);
    v = v * r * g_ckv;
    if (lane < 32) {
      if (!lat) *(f32x4*)(p.out + O_CKV + orow * 128 + lane * 4) = v;
      *(u32x2*)((u16*)(p.ws + OFF_CKVN) + (size_t)keyrow * 128 + lane * 4) = pack4(v);
    }
  }
  {
    f32x4 v = v_kr;
    if (lat) v = rope32(v);
    if (lane < 8) {
      u32x2 pk = pack4(v);
      u16* mk = (u16*)(p.ws + OFF_MKB) + (size_t)keyrow * 384 + 64 + lane * 4;
#pragma unroll
      for (int hd = 0; hd < 4; ++hd) *(u32x2*)(mk + hd * 96) = pk;
    }
  }
}

DI void pp_cached(const P& p, int layer, int crow_, int lane) {
  const int b = crow_ >> 9, j = crow_ & 511;
  const int keyrow = NCTX + b * 1536 + j;
  const size_t src = (size_t)(b * 2 + layer) * 512 + j;
  const int jp = (j & ~15) | (((j >> 2) & 1) << 3) | (((j >> 3) & 1) << 2) | (j & 3);
  const f32x4 z4 = {0.f, 0.f, 0.f, 0.f};
  const int l31 = lane & 31, l7 = lane & 7;
  f32x4 v_dk = __builtin_nontemporal_load((const f32x4*)(p.in[I_CDK] + src * 256 + lane * 4));
  f32x4 v_dv = __builtin_nontemporal_load((const f32x4*)(p.in[I_CDV] + src * 256 + lane * 4));
  f32x4 v_gk = __builtin_nontemporal_load((const f32x4*)(p.in[I_CGK] + src * 128 + l31 * 4));
  f32x4 v_gv = __builtin_nontemporal_load((const f32x4*)(p.in[I_CGV] + src * 128 + l31 * 4));
  f32x4 v_ckv = __builtin_nontemporal_load((const f32x4*)(p.in[I_CCKV] + src * 128 + l31 * 4));
  f32x4 v_kr = __builtin_nontemporal_load((const f32x4*)(p.in[I_CKR] + src * 32 + l7 * 4));
  (void)z4;
  *(u32x2*)((u16*)(p.ws + OFF_DKB) + (size_t)keyrow * 256 + lane * 4) = pack4(v_dk);
  {
    u16* vt = (u16*)(p.ws + OFF_DVT) + vt_off(32 + b, lane >> 4, 4) + (size_t)((lane & 15) * 4) * 1536 + jp;
#pragma unroll
    for (int i = 0; i < 4; ++i) vt[(size_t)i * 1536] = f2bf(v_dv[i]);
  }
  if (lane < 32) {
    *(u32x2*)((u16*)(p.ws + OFF_GKB) + (size_t)keyrow * 128 + lane * 4) = pack4(v_gk);
    u16* vt = (u16*)(p.ws + OFF_GVT) + vt_off(32 + b, lane >> 4, 2) + (size_t)((lane & 15) * 4) * 1536 + jp;
#pragma unroll
    for (int i = 0; i < 4; ++i) vt[(size_t)i * 1536] = f2bf(v_gv[i]);
    *(u32x2*)((u16*)(p.ws + OFF_CKVN) + (size_t)keyrow * 128 + lane * 4) = pack4(v_ckv);
  }
  if (lane < 8) {
    u32x2 pk = pack4(v_kr);
    u16* mk = (u16*)(p.ws + OFF_MKB) + (size_t)keyrow * 384 + 64 + lane * 4;
#pragma unroll
    for (int hd = 0; hd < 4; ++hd) *(u32x2*)(mk + hd * 96) = pk;
  }
}

DI void phase_pp(const P& p, int layer, char* smem) {
  const int tid_ = get_tid();
  const int lane = tid_ & 63, wave = tid_ >> 6;
  float* lds = (float*)smem + wave * (32 * 132);
  const int gw = wave * (int)gridDim.x + (int)blockIdx.x, nw = gridDim.x * NWV;
  constexpr int N_SSM = 1152, N_ROWS = NT + 2048;
  for (int item = gw; item < N_SSM; item += nw) ssm_item(p, layer, item, lds, lane);
  const int rw0 = (nw > 256) ? 128 : 0;
  if (gw >= rw0) {
    for (int row = gw - rw0; row < N_ROWS; row += nw - rw0) {
      if (row < NT) pp_row(p, layer, row, lane);
      else pp_cached(p, layer, row - NT, lane);
    }
  }
}

template <int KW, int DK>
DI void attn_block(const u16* __restrict__ Kg, int ldk, const u16* __restrict__ Vt, int nk, const bf16x8 (&qf)[DK / 16], int kcol, char* smem,
                   int tid, f32x16 (&o)[2], float& lsum) {
  constexpr int KST = KW + 8, KS = DK / 16, KCH = KW / 8, KTOT = 64 * KCH, NKC = (KTOT + NTHR - 1) / NTHR;
  const int lane = tid & 63, l32 = lane & 31, hh = lane >> 5;
  u16* Ks = (u16*)smem;
  u16* Vs = Ks + 2 * 64 * KST;
  float m = -1e30f;
  lsum = 0.f;
#pragma unroll
  for (int db = 0; db < 2; ++db)
#pragma unroll
    for (int r = 0; r < 16; ++r) o[db][r] = 0.f;
  u32x4 rk[NKC], rv[1];
  const int nt = nk / 64;
#pragma unroll
  for (int i = 0; i < NKC; ++i) { int c = tid + NTHR * i, r = c / KCH, kc = (c % KCH) * 8; if (c < KTOT) rk[i] = *(const u32x4*)(Kg + (size_t)r * ldk + kc); }
  { int r = tid >> 3, kc = (tid & 7) * 8; rv[0] = *(const u32x4*)(Vt + (size_t)r * nk + kc); }
#pragma unroll
  for (int i = 0; i < NKC; ++i) { int c = tid + NTHR * i, r = c / KCH, kc = (c % KCH) * 8; if (c < KTOT) *(u32x4*)(Ks + r * KST + kc) = rk[i]; }
  { int r = tid >> 3, kc = (tid & 7) * 8; *(u32x4*)(Vs + r * 72 + kc) = rv[0]; }
  __syncthreads();
  for (int t = 0; t < nt; ++t) {
    const int buf = t & 1;
    const bool more = (t + 1 < nt);
    if (more) {
      const int kt = (t + 1) * 64;
#pragma unroll
      for (int i = 0; i < NKC; ++i) { int c = tid + NTHR * i, r = c / KCH, kc = (c % KCH) * 8; if (c < KTOT) rk[i] = *(const u32x4*)(Kg + (size_t)(kt + r) * ldk + kc); }
      { int r = tid >> 3, kc = (tid & 7) * 8; rv[0] = *(const u32x4*)(Vt + (size_t)r * nk + kt + kc); }
    }
    const u16* ks = Ks + buf * 64 * KST + l32 * KST + kcol + hh * 8;
    const u16* vs = Vs + buf * 64 * 72 + l32 * 72 + hh * 8;
    f32x16 sa[2];
#pragma unroll
    for (int kb = 0; kb < 2; ++kb) {
#pragma unroll
      for (int r = 0; r < 16; ++r) sa[kb][r] = 0.f;
      bf16x8 kf[KS];
#pragma unroll
      for (int s2 = 0; s2 < KS; ++s2) kf[s2] = *(const bf16x8*)(ks + kb * 32 * KST + s2 * 16);
#pragma unroll
      for (int s2 = 0; s2 < KS; ++s2) sa[kb] = MFMA32(kf[s2], qf[s2], sa[kb]);
    }
    float mx = sa[0][0];
#pragma unroll
    for (int r = 1; r < 16; ++r) mx = fmaxf(mx, sa[0][r]);
#pragma unroll
    for (int r = 0; r < 16; ++r) mx = fmaxf(mx, sa[1][r]);
    mx = fmaxf(mx, __shfl_xor(mx, 32));
    const float mn = fmaxf(m, mx);
    const float alpha = fexp2(m - mn);
    m = mn;
    float ps = 0.f;
#pragma unroll
    for (int kb = 0; kb < 2; ++kb)
#pragma unroll
      for (int r = 0; r < 16; ++r) { float e = fexp2(sa[kb][r] - mn); sa[kb][r] = e; ps += e; }
    lsum = lsum * alpha + ps;
#pragma unroll
    for (int db = 0; db < 2; ++db)
#pragma unroll
      for (int r = 0; r < 16; ++r) o[db][r] *= alpha;
#pragma unroll
    for (int s2 = 0; s2 < 4; ++s2) {
      const int kb = s2 >> 1, rb = 8 * (s2 & 1);
      f32x4 p0 = {sa[kb][rb], sa[kb][rb + 1], sa[kb][rb + 2], sa[kb][rb + 3]};
      f32x4 p1 = {sa[kb][rb + 4], sa[kb][rb + 5], sa[kb][rb + 6], sa[kb][rb + 7]};
      bf16x8 pf = pack8(p0, p1);
      bf16x8 v0 = *(const bf16x8*)(vs + s2 * 16);
      bf16x8 v1 = *(const bf16x8*)(vs + 32 * 72 + s2 * 16);
      o[0] = MFMA32(v0, pf, o[0]);
      o[1] = MFMA32(v1, pf, o[1]);
    }
    if (more) {
      const int nb = buf ^ 1;
#pragma unroll
      for (int i = 0; i < NKC; ++i) { int c = tid + NTHR * i, r = c / KCH, kc = (c % KCH) * 8; if (c < KTOT) *(u32x4*)(Ks + nb * 64 * KST + r * KST + kc) = rk[i]; }
      { int r = tid >> 3, kc = (tid & 7) * 8; *(u32x4*)(Vs + nb * 64 * 72 + r * 72 + kc) = rv[0]; }
    }
    __syncthreads();
  }
  lsum += __shfl_xor(lsum, 32);
}

DI void store_o(u16* dst  , const f32x16 (&o)[2], float scale, int hh) {
#pragma unroll
  for (int db = 0; db < 2; ++db)
#pragma unroll
    for (int j = 0; j < 4; ++j) {
      const int dv = db * 32 + 8 * j + 4 * hh;
      f32x4 v = {o[db][4 * j] * scale, o[db][4 * j + 1] * scale, o[db][4 * j + 2] * scale, o[db][4 * j + 3] * scale};
      *(u32x2*)(dst + dv) = pack4(v);
    }
}

DI void attn_item(const P& p, int layer, int item, char* smem, int tid) {
  const int lane = tid & 63, wave = tid >> 6, l32 = lane & 31, hh = lane >> 5;
  bool lat; int kind, b, hd, qblk;
  if (item < 256) {
    lat = true;
    if (item < 128) { kind = 0; b = item >> 5; hd = (item >> 3) & 3; qblk = item & 7; }
    else { int it = item - 128; kind = 1 + (it >> 6); it &= 63; b = it >> 4; hd = (it >> 2) & 3; qblk = it & 3; }
  } else {
    lat = false;
    int it = item - 256;
    if (it < 256) { kind = 0; b = it >> 3; hd = (it >> 1) & 3; qblk = it & 1; }
    else { it -= 256; kind = 1 + (it >> 7); it &= 127; b = it >> 2; hd = it & 3; qblk = 0; }
  }
  const int nk = lat ? 1536 : 256;
  const int b_all = lat ? 32 + b : b;
  const int keyrow0 = lat ? NCTX + b * 1536 : b * 256;
  const int tok0 = lat ? NCTX + b * 1024 : b * 256;
  f32x16 o[2]; float ls;
  if (kind == 0) {
    const int ns = wave & 1, qb = wave >> 1;
    const int q0 = tok0 + qblk * 128 + qb * 32;
    const u16* Q = (const u16*)(p.ws + OFF_DQ) + (size_t)(q0 + l32) * 256 + hd * 64 + ns * 32 + hh * 8;
    bf16x8 qf[2];
    qf[0] = *(const bf16x8*)Q; qf[1] = *(const bf16x8*)(Q + 16);
    attn_block<64, 32>((const u16*)(p.ws + OFF_DKB) + (size_t)keyrow0 * 256 + hd * 64, 256, (const u16*)(p.ws + OFF_DVT) + vt_off(b_all, hd, 4), nk, qf, ns * 32,
                       smem, tid, o, ls);
    float d1 = 0.f, d2 = 0.f;
    if (lane < 32) { d1 = p.in[I_LQ1][layer * 32 + lane] * p.in[I_LK1][layer * 32 + lane]; d2 = p.in[I_LQ2][layer * 32 + lane] * p.in[I_LK2][layer * 32 + lane]; }
    d1 = wave_sum(d1); d2 = wave_sum(d2);
    int ly_ = layer; asm volatile("" : "+s"(ly_));
    const float lam_init = ly_ == 0 ? 0.2f : (0.8f - 0.6f * 0.7408182206817179f);
    const float lam = expf(d1) - expf(d2) + lam_init;
    float* cmb = (float*)smem + qb * (64 * 33);
    if (ns == 1) {
      const float sc = lam / ls;
#pragma unroll
      for (int db = 0; db < 2; ++db)
#pragma unroll
        for (int r = 0; r < 16; ++r) cmb[(db * 32 + crow(r, hh)) * 33 + l32] = o[db][r] * sc;
    }
    __syncthreads();
    if (ns == 0) {
      const float i0 = 1.f / ls;
      float ss = 0.f;
#pragma unroll
      for (int db = 0; db < 2; ++db)
#pragma unroll
        for (int r = 0; r < 16; ++r) { float d = o[db][r] * i0 - cmb[(db * 32 + crow(r, hh)) * 33 + l32]; o[db][r] = d; ss += d * d; }
      ss += __shfl_xor(ss, 32);
      const float rr = rsqrtf(ss * (1.f / 64.f) + EPSF) * (1.f - lam_init);
      u16* dst = (u16*)(p.ws + OFF_MIXED) + (size_t)(q0 + l32) * 1024 + hd * 64;
#pragma unroll
      for (int db = 0; db < 2; ++db)
#pragma unroll
        for (int j = 0; j < 4; ++j) {
          const int dv = db * 32 + 8 * j + 4 * hh;
          f32x4 g = *(const f32x4*)(p.in[I_SUBLN] + layer * 64 + dv);
          f32x4 v = {o[db][4 * j] * rr * g[0], o[db][4 * j + 1] * rr * g[1], o[db][4 * j + 2] * rr * g[2], o[db][4 * j + 3] * rr * g[3]};
          *(u32x2*)(dst + dv) = pack4(v);
        }
    }
    __syncthreads();
  } else if (kind == 1) {
    const int q0 = tok0 + qblk * 256 + wave * 32;
    const u16* Q = (const u16*)(p.ws + OFF_GQ) + (size_t)(q0 + l32) * 256 + hd * 64 + hh * 8;
    bf16x8 qf[4];
#pragma unroll
    for (int s2 = 0; s2 < 4; ++s2) qf[s2] = *(const bf16x8*)(Q + s2 * 16);
    attn_block<64, 64>((const u16*)(p.ws + OFF_GKB) + (size_t)keyrow0 * 128 + (hd >> 1) * 64, 128, (const u16*)(p.ws + OFF_GVT) + vt_off(b_all, hd >> 1, 2), nk, qf, 0,
                       smem, tid, o, ls);
    store_o((u16*)(p.ws + OFF_MIXED) + (size_t)(q0 + l32) * 1024 + 256 + hd * 64, o, 1.f / ls, hh);
  } else {
    const int q0 = tok0 + qblk * 256 + wave * 32;
    const u16* Q = (const u16*)(p.ws + OFF_MQ) + (size_t)(q0 + l32) * 384 + hd * 96 + hh * 8;
    bf16x8 qf[6];
#pragma unroll
    for (int s2 = 0; s2 < 6; ++s2) qf[s2] = *(const bf16x8*)(Q + s2 * 16);
    attn_block<96, 96>((const u16*)(p.ws + OFF_MKB) + (size_t)keyrow0 * 384 + hd * 96, 384, (const u16*)(p.ws + OFF_MVT) + vt_off(b_all, hd, 4), nk, qf, 0,
                       smem, tid, o, ls);
    store_o((u16*)(p.ws + OFF_MIXED) + (size_t)(q0 + l32) * 1024 + 768 + hd * 64, o, 1.f / ls, hh);
  }
}

DI void phase_at(const P& p, int layer, char* smem) {
  EPI_IDX
  constexpr int N_ITEMS = 768;
  if (gridDim.x == 256) {
    const int b = blockIdx.x;
    attn_item(p, layer, b, smem, tid);
    __syncthreads();
    if (b < 128) {
      attn_item(p, layer, 256 + b, smem, tid); __syncthreads();
      attn_item(p, layer, 512 + b, smem, tid); __syncthreads();
      attn_item(p, layer, 640 + b, smem, tid); __syncthreads();
    } else if (b < 192) {
      attn_item(p, layer, 256 + 128 + 2 * (b - 128), smem, tid); __syncthreads();
      attn_item(p, layer, 256 + 128 + 2 * (b - 128) + 1, smem, tid); __syncthreads();
    }
  } else {
    for (int item = blockIdx.x; item < N_ITEMS; item += gridDim.x) {
      attn_item(p, layer, item, smem, tid);
      __syncthreads();
    }
  }
  {
    constexpr int T_GLU = (NT / 256) * 2;
    auto tile_at = [&](int t) { TD d; d.A = (const u16*)(p.ws + OFF_PROJ); d.lda = NP; d.B = (const u16*)(p.ws + OFF_WGLU) + (size_t)layer * 512 * 256; d.ldb = 256; d.k0 = 0; d.nk = 4; d.m0 = (t >> 1) * 256; d.n0 = (t & 1) * 256; return d; };
    int buf = 0;
    const int t0 = (int)gridDim.x - 1 - (int)blockIdx.x;
    TD cur = tile_at(t0 < T_GLU ? t0 : 0);
    if (t0 < T_GLU) stage_td<2>(cur, 0, smem, tid);
    for (int t = t0; t < T_GLU; t += gridDim.x) {
      const bool has_next = (t + (int)gridDim.x < T_GLU);
      const TD nxt = tile_at(has_next ? t + (int)gridDim.x : t);
      const int m0 = cur.m0, n0 = cur.n0;
      f32x16 acc[4][2];
      gemm_stream<2>(cur, has_next, nxt, smem, buf, acc);
      cur = nxt;
      u16* mixed = (u16*)(p.ws + OFF_MIXED);
      const int q = (n0 + wn * 64) >> 6;
#pragma unroll
      for (int bi = 0; bi < 4; ++bi) {
        const int rb = m0 + wm * 128 + bi * 32;
#pragma unroll
        for (int r = 0; r < 16; ++r) {
          float z = acc[bi][0][r], g = acc[bi][1][r];
          mixed[(size_t)(rb + crow(r, hh)) * 1024 + 512 + q * 32 + l32] = f2bf(z * fsigmoid(g));
        }
      }
    }
  }
}

#define XB_TMO      128
#define XB_XCNT(j)  (256  + 64 * (j))
#define XB_XSUB(j)  (1280 + 64 * (j))
#define XB_XGEN(j)  (2304 + 64 * (j))
#define XB_TOP      3328
#define XB_TOPGEN   3392
#define XCD_BAR_WORDS 3456
#define XB_SPIN_CAP (1u << 22)
#define LAS __attribute__((address_space(3)))
DI unsigned xb_ld(unsigned* p) { return __hip_atomic_load(p, __ATOMIC_RELAXED, __HIP_MEMORY_SCOPE_AGENT); }
DI unsigned xb_add(unsigned* p, unsigned v) { return __hip_atomic_fetch_add(p, v, __ATOMIC_RELAXED, __HIP_MEMORY_SCOPE_AGENT); }
DI unsigned xb_xcc_id() { return (unsigned)__builtin_amdgcn_s_getreg((3 << 11) | 20) & 0xFu; }
#define XB_SPIN(cond, bar) do { unsigned _sp = 0; while (cond) { __builtin_amdgcn_s_sleep(1); \
    if ((++_sp & 255u) == 0u) { if (xb_ld(&(bar)[XB_TMO])) break; if (_sp > XB_SPIN_CAP) { atomicAdd(&(bar)[XB_TMO], 1u); break; } } } } while (0)
struct XcdBarrier { unsigned* bar; unsigned x; volatile LAS unsigned* st; };
DI XcdBarrier xcd_barrier_post(unsigned* bar, volatile LAS unsigned* st) {
  XcdBarrier b; b.bar = bar; b.x = xb_xcc_id(); b.st = st;
  if (threadIdx.x == 0) st[2] = xb_add(&bar[XB_XCNT(b.x)], 1u);
  return b;
}
DI void xcd_barrier_complete(unsigned* bar, unsigned x, unsigned& nloc, unsigned& nx) {
  const unsigned G = gridDim.x * gridDim.y * gridDim.z;
  unsigned sum, cnt, mine, sp = 0u;
  for (;;) {
    sum = 0u; cnt = 0u; mine = 0u;
#pragma unroll
    for (unsigned j = 0; j < 16; ++j) { const unsigned c = xb_ld(&bar[XB_XCNT(j)]); sum += c; cnt += (c > 0u) ? 1u : 0u; mine = (j == x) ? c : mine; }
    if (sum == G) break;
    __builtin_amdgcn_s_sleep(1);
    if ((++sp & 255u) == 0u) { if (xb_ld(&bar[XB_TMO])) break; if (sp > XB_SPIN_CAP) { atomicAdd(&bar[XB_TMO], 1u); break; } }
  }
  nloc = mine > 0u ? mine : 1u; nx = cnt > 0u ? cnt : 1u;
}
DI void xcd_barrier(const XcdBarrier& b) {
  asm volatile("s_waitcnt vmcnt(0)" ::: "memory");
  __syncthreads();
  if (threadIdx.x == 0) {
    unsigned* bar = b.bar;
    __builtin_amdgcn_s_waitcnt(0);
    unsigned nloc = b.st[0], nx = b.st[1];
    if (nloc == 0u) { xcd_barrier_complete(bar, b.x, nloc, nx); b.st[0] = nloc; b.st[1] = nx; }
    const unsigned old = xb_add(&bar[XB_XSUB(b.x)], 1u);
    const unsigned gen = old / nloc;
    if (old + 1u == (gen + 1u) * nloc) {
      __builtin_amdgcn_fence(__ATOMIC_RELEASE, "agent");
      asm volatile("s_waitcnt vmcnt(0)" ::: "memory");
      const unsigned og = xb_add(&bar[XB_TOP], 1u);
      const unsigned tg = og / nx;
      if (og + 1u == (tg + 1u) * nx) xb_add(&bar[XB_TOPGEN], 1u);
      else XB_SPIN(xb_ld(&bar[XB_TOPGEN]) == tg, bar);
      __builtin_amdgcn_fence(__ATOMIC_ACQUIRE, "agent");
      xb_add(&bar[XB_XGEN(b.x)], 1u);
      asm volatile("s_waitcnt vmcnt(0)" ::: "memory");
    } else {
      XB_SPIN(xb_ld(&bar[XB_XGEN(b.x)]) == gen, bar);
      __builtin_amdgcn_fence(__ATOMIC_ACQUIRE, "agent");
      asm volatile("s_waitcnt vmcnt(0)" ::: "memory");
    }
  }
  __syncthreads();
}

DI void run_phase(const P& p_, int ph, int layer, char* smem) {
  P p = p_;
  size_t zoff = 0;
  asm volatile("" : "+s"(zoff));
  p.ws = p_.ws + zoff;
  p.out = p_.out + zoff;
  switch (ph) {
    case 0: prologue(p, smem); break;
    case 1: norm_phase(p, layer, 0); break;
    case 2: phase_g1(p, layer, smem); break;
    case 3: phase_pp(p, layer, smem); break;
    case 4: phase_g2(p, layer, smem); break;
    case 5: phase_at(p, layer, smem); break;
    case 6: phase_resid(p, layer, smem, true); break;
    case 7: norm_phase(p, layer, 1); break;
    case 8: phase_g5(p, layer, smem); break;
    case 9: phase_resid(p, layer, smem, false); break;
    case 10: norm_phase(p, 0, 2); break;
  }
}

extern __shared__ __attribute__((aligned(16))) char dyn_smem[];

__global__ void __launch_bounds__(512) fwd_mega(P p) {
  if (p.ws == nullptr) { cg::grid_group grid = cg::this_grid(); grid.sync(); }
  volatile LAS unsigned* st = (volatile LAS unsigned*)(dyn_smem + LDS_BYTES);
  if (threadIdx.x == 0) { st[0] = 0u; st[1] = 0u; st[2] = 0u; st[3] = 0u; }
  __syncthreads();
  XcdBarrier xb = xcd_barrier_post((unsigned*)(p.ws + OFF_BAR), st);
  run_phase(p, 0, 0, dyn_smem);
  xcd_barrier(xb);
  if (threadIdx.x == 0) {
    unsigned* bar = (unsigned*)(p.ws + OFF_BAR);
    bool ok = (gridDim.x & 7u) == 0u;
    for (unsigned j = 0; j < 16; ++j) { const unsigned c = xb_ld(&bar[XB_XCNT(j)]); ok = ok && (c == (j < 8 ? gridDim.x >> 3 : 0u)); }
    if (ok) st[3] = xb.x; else { st[2] = blockIdx.x >> 3; st[3] = blockIdx.x & 7u; }
  }
  __syncthreads();
  for (int l = 0; l < 2; ++l) {
    for (int ph = 1; ph <= 9; ++ph) {
      run_phase(p, ph, l, dyn_smem);
      xcd_barrier(xb);
    }
  }
  run_phase(p, 10, 0, dyn_smem);
}

#if !MEGA
__global__ void __launch_bounds__(512) fwd_phase(P p, int ph, int layer) { run_phase(p, ph, layer, dyn_smem); }
#endif

extern "C" void kernel_launch(void* const* d_in, const int* in_sizes, int n_in, void* d_out, int out_size, void* d_ws, size_t ws_size,
                              hipStream_t stream) {
  static int grid_blocks = 0;
  if (!grid_blocks) {
    int dev = 0, cus = 0, per_cu = 0;
    (void)hipGetDevice(&dev);
    (void)hipDeviceGetAttribute(&cus, hipDeviceAttributeMultiprocessorCount, dev);
    (void)hipFuncSetAttribute((const void*)fwd_mega, hipFuncAttributeMaxDynamicSharedMemorySize, LDS_BYTES + 16);
#if !MEGA
    (void)hipFuncSetAttribute((const void*)fwd_phase, hipFuncAttributeMaxDynamicSharedMemorySize, LDS_BYTES);
#endif
    (void)hipOccupancyMaxActiveBlocksPerMultiprocessor(&per_cu, (const void*)fwd_mega, NTHR, LDS_BYTES + 16);
    if (per_cu < 1) per_cu = 1;
    if (per_cu > 1) per_cu = 1;
    grid_blocks = cus * per_cu;
    if (ws_size < WS_NEED) fprintf(stderr, "kernel_launch: workspace too small: %zu < %zu\n", ws_size, (size_t)WS_NEED);
  }
  P p{};
  for (int i = 0; i < N_IN; ++i) p.in[i] = (const float*)d_in[i];
  p.out = (float*)d_out;
  p.ws = (char*)d_ws;
#if MEGA
  (void)hipMemsetAsync((char*)d_ws + OFF_BAR, 0, XCD_BAR_WORDS * 4, stream);
  void* args[] = {&p};
  hipError_t e = hipLaunchCooperativeKernel((const void*)fwd_mega, dim3(grid_blocks), dim3(NTHR), args, LDS_BYTES + 16, stream);
  if (e != hipSuccess) fprintf(stderr, "cooperative launch failed: %s (grid %d)\n", hipGetErrorString(e), grid_blocks);
#else
  hipLaunchKernelGGL(fwd_phase, dim3(grid_blocks), dim3(NTHR), LDS_BYTES, stream, p, 0, 0);
  for (int l = 0; l < 2; ++l)
    for (int ph = 1; ph <= 9; ++ph) hipLaunchKernelGGL(fwd_phase, dim3(grid_blocks), dim3(NTHR), LDS_BYTES, stream, p, ph, l);
  hipLaunchKernelGGL(fwd_phase, dim3(grid_blocks), dim3(NTHR), LDS_BYTES, stream, p, 10, 0);
#endif
}
```

```cpp
#include <hip/hip_runtime.h>
#include <hip/hip_cooperative_groups.h>
#include <cstdio>
namespace cg = cooperative_groups;

#ifndef MEGA
#define MEGA 1
#endif

#define DI __device__ __forceinline__
typedef unsigned short u16;
typedef __attribute__((ext_vector_type(8))) short bf16x8;
typedef __attribute__((ext_vector_type(4))) short bf16x4;
typedef __attribute__((ext_vector_type(2))) __bf16 bf2_t;
typedef __attribute__((ext_vector_type(2))) float f32x2;
typedef __attribute__((ext_vector_type(4))) float f32x4;
typedef __attribute__((ext_vector_type(16))) float f32x16;
typedef __attribute__((ext_vector_type(4))) unsigned u32x4;
typedef __attribute__((ext_vector_type(2))) unsigned u32x2;

#define MFMA32(a, b, c) __builtin_amdgcn_mfma_f32_32x32x16_bf16((a), (b), (c), 0, 0, 0)
#define MFMA16(a, b, c) __builtin_amdgcn_mfma_f32_16x16x32_bf16((a), (b), (c), 0, 0, 0)

constexpr int NT = 12288;
constexpr int NCTX = 8192;
constexpr int NKR = 14336;
constexpr int NP = 1920;
constexpr float EPSF = 1e-6f;
constexpr float LOG2E = 1.4426950408889634f;

enum { I_XP = 0, I_XS, I_CDK, I_CDV, I_CGK, I_CGV, I_CCKV, I_CKR, I_SRE, I_SIM, I_C, I_CCTX, I_N1G, I_N2G, I_WADA, I_BADA,
       I_WIN, I_WOUT, I_LQ1, I_LK1, I_LQ2, I_LK2, I_SUBLN, I_QNG, I_KNG, I_ARE, I_AIM, I_LOGDT, I_BRE, I_BIM, I_CRE, I_CIM,
       I_SSMD, I_WGLU, I_MQNG, I_MKVNG, I_WUQ, I_WUKV, I_W1, I_W2, I_FNG, N_IN };

constexpr size_t O_Y = 0;
constexpr size_t O_DK = 12582912;
constexpr size_t O_DV = 16777216;
constexpr size_t O_GK = 20971520;
constexpr size_t O_GV = 23068672;
constexpr size_t O_CKV = 25165824;
constexpr size_t O_KR = 27262976;
constexpr size_t O_SRE = 27787264;
constexpr size_t O_SIM = 27918336;

constexpr size_t al256(size_t x) { return (x + 255) & ~(size_t)255; }
constexpr size_t OFF_MOD = 0;
constexpr size_t OFF_CTR = al256(OFF_MOD + 2 * 5 * 6144 * 4);
constexpr size_t OFF_BAR = al256(OFF_CTR + 256);
constexpr size_t OFF_ROPE = al256(OFF_BAR + 3456 * 4);
constexpr size_t OFF_ABAR = al256(OFF_ROPE + 2 * 64 * 16 * 8);
constexpr size_t OFF_ATAB = al256(OFF_ABAR + 64 * 64 * 8);
constexpr size_t OFF_CTAB = al256(OFF_ATAB + 64 * 128 * 16 * 2);
constexpr size_t OFF_WIN = al256(OFF_CTAB + 64 * 16 * 128 * 2);
constexpr size_t OFF_WOUT = al256(OFF_WIN + (size_t)2 * 1920 * 1024 * 2);
constexpr size_t OFF_W1 = al256(OFF_WOUT + (size_t)2 * 1024 * 1024 * 2);
constexpr size_t OFF_W2 = al256(OFF_W1 + (size_t)2 * 4096 * 1024 * 2);
constexpr size_t OFF_WUQ = al256(OFF_W2 + (size_t)2 * 4096 * 1024 * 2);
constexpr size_t OFF_WUKV = al256(OFF_WUQ + (size_t)2 * 384 * 192 * 2);
constexpr size_t OFF_WGLU = al256(OFF_WUKV + (size_t)2 * 512 * 128 * 2);
constexpr size_t OFF_H = al256(OFF_WGLU + (size_t)2 * 512 * 256 * 2);
constexpr size_t OFF_MIXED = OFF_H;
constexpr size_t OFF_BIG = al256(OFF_H + (size_t)NT * 1024 * 2);
constexpr size_t OFF_PROJ = OFF_BIG;
constexpr size_t OFF_DQ = al256(OFF_PROJ + (size_t)NT * NP * 4);
constexpr size_t OFF_DKB = al256(OFF_DQ + (size_t)NT * 256 * 2);
constexpr size_t OFF_DVT = al256(OFF_DKB + (size_t)NKR * 256 * 2);
constexpr size_t OFF_GQ = al256(OFF_DVT + (size_t)NKR * 256 * 2);
constexpr size_t OFF_GKB = al256(OFF_GQ + (size_t)NT * 256 * 2);
constexpr size_t OFF_GVT = al256(OFF_GKB + (size_t)NKR * 128 * 2);
constexpr size_t OFF_MQ = al256(OFF_GVT + (size_t)NKR * 128 * 2);
constexpr size_t OFF_MKB = al256(OFF_MQ + (size_t)NT * 384 * 2);
constexpr size_t OFF_MVT = al256(OFF_MKB + (size_t)NKR * 384 * 2);
constexpr size_t OFF_CQN = al256(OFF_MVT + (size_t)NKR * 256 * 2);
constexpr size_t OFF_CKVN = al256(OFF_CQN + (size_t)NT * 192 * 2);
constexpr size_t OFF_YBUF = al256(OFF_CKVN + (size_t)NKR * 128 * 2);
constexpr size_t OFF_END1 = al256(OFF_YBUF + (size_t)2 * NT * 256 * 4);
constexpr size_t OFF_A = OFF_BIG;
constexpr size_t OFF_END2 = al256(OFF_A + (size_t)NT * 4096 * 2);
constexpr size_t WS_NEED = OFF_END1 > OFF_END2 ? OFF_END1 : OFF_END2;
static_assert(WS_NEED <= (size_t)256 * 1024 * 1024, "workspace over 256 MiB");

constexpr int NTHR = 512;
constexpr int NWV = NTHR / 64;
constexpr int LDS_BYTES = 8 * 32 * 132 * 4;

struct P {
  const float* in[N_IN];
  float* out;
  char* ws;
};

DI unsigned pack2(float a, float b) { f32x2 v = {a, b}; return __builtin_bit_cast(unsigned, __builtin_convertvector(v, bf2_t)); }
DI u16 f2bf(float a) { return (u16)(pack2(a, 0.f) & 0xffffu); }
DI bf16x8 pack8(f32x4 a, f32x4 b) {
  u32x4 r = {pack2(a[0], a[1]), pack2(a[2], a[3]), pack2(b[0], b[1]), pack2(b[2], b[3])};
  return __builtin_bit_cast(bf16x8, r);
}
DI f32x4 ld4bf(const u16* p) {
  const u32x2 w = *(const u32x2*)p;
  f32x4 r = {__uint_as_float(w[0] << 16), __uint_as_float(w[0] & 0xffff0000u), __uint_as_float(w[1] << 16), __uint_as_float(w[1] & 0xffff0000u)};
  return r;
}
DI f32x4 ld4bf_nt(const u16* p) {
  const u32x2 w = __builtin_nontemporal_load((const u32x2*)p);
  f32x4 r = {__uint_as_float(w[0] << 16), __uint_as_float(w[0] & 0xffff0000u), __uint_as_float(w[1] << 16), __uint_as_float(w[1] & 0xffff0000u)};
  return r;
}
DI u32x2 pack4(f32x4 a) { u32x2 r = {pack2(a[0], a[1]), pack2(a[2], a[3])}; return r; }
DI int get_tid() { int t = threadIdx.x; asm volatile("" : "+v"(t)); return t; }
DI float fexp2(float x) { return __builtin_amdgcn_exp2f(x); }
DI float frcp(float x) { return __builtin_amdgcn_rcpf(x); }
DI float fsigmoid(float w) { return frcp(1.f + fexp2(-w * LOG2E)); }
DI float gelu_tanh(float x) { return x * fsigmoid(1.5957691216057308f * (x + 0.044715f * x * x * x)); }
DI float wave_sum(float v) {
#pragma unroll
  for (int o = 32; o >= 1; o >>= 1) v += __shfl_xor(v, o);
  return v;
}
DI void wave_lds_fence() {
  asm volatile("s_waitcnt lgkmcnt(0)" ::: "memory");
  __builtin_amdgcn_wave_barrier();
}
DI int fetch_item(int* ctr, int lane) {
  int v = 0;
  if (lane == 0) v = atomicAdd(ctr, 1);
  return __builtin_amdgcn_readfirstlane(v);
}
DI size_t vt_off(int b_all, int head, int H) {
  if (b_all < 32) return ((size_t)(b_all * H + head) * 64) * 256;
  return (size_t)32 * H * 64 * 256 + ((size_t)((b_all - 32) * H + head) * 64) * 1536;
}
DI int mod_index(int row) { return row < NCTX ? 0 : 1 + ((row - NCTX) >> 10); }

DI void prologue(const P& p, char* smem) {
  const int tid = get_tid();
  float* fs = (float*)smem;
  constexpr int N_ADA = 384, N_TAB = 64, N_MISC = 1, N_TR = 5700;
  constexpr int TOTAL = N_ADA + N_TAB + N_MISC;
  for (int it = blockIdx.x; it < TOTAL; it += gridDim.x) {
    if (it < N_ADA) {
      const int l = it / 192, ch = it % 192;
      float* sc = fs;
      float* red = fs + 5 * 1024;
      for (int i = tid; i < 5 * 1024; i += NTHR) {
        int m = i >> 10, k = i & 1023;
        float c = (m == 0) ? p.in[I_CCTX][k] : p.in[I_C][(m - 1) * 1024 + k];
        sc[i] = c * fsigmoid(c);
      }
      __syncthreads();
      const int col = tid & 31, kg = tid >> 5;
      const float* w = p.in[I_WADA] + ((size_t)l * 1024 + kg * 64) * 6144 + ch * 32 + col;
      float a0 = 0, a1 = 0, a2 = 0, a3 = 0, a4 = 0;
#pragma unroll 16
      for (int k = 0; k < 64; ++k) {
        float wv = __builtin_nontemporal_load(w + (size_t)k * 6144);
        int kk = kg * 64 + k;
        a0 += sc[kk] * wv; a1 += sc[1024 + kk] * wv; a2 += sc[2048 + kk] * wv; a3 += sc[3072 + kk] * wv; a4 += sc[4096 + kk] * wv;
      }
      red[(kg * 5 + 0) * 32 + col] = a0; red[(kg * 5 + 1) * 32 + col] = a1; red[(kg * 5 + 2) * 32 + col] = a2;
      red[(kg * 5 + 3) * 32 + col] = a3; red[(kg * 5 + 4) * 32 + col] = a4;
      __syncthreads();
      if (tid < 160) {
        int m = tid >> 5, c2 = tid & 31;
        float s = 0;
#pragma unroll
        for (int g = 0; g < 16; ++g) s += red[(g * 5 + m) * 32 + c2];
        int n = ch * 32 + c2;
        s += p.in[I_BADA][l * 6144 + n];
        ((float*)(p.ws + OFF_MOD))[((size_t)l * 5 + m) * 6144 + n] = s;
      }
      __syncthreads();
    } else if (it < N_ADA + N_TAB) {
      const int idx = it - N_ADA;
      if (tid < 64) {
        const int pp = tid;
        float are = p.in[I_ARE][idx * 64 + pp], aim = p.in[I_AIM][idx * 64 + pp];
        float dt = expf(p.in[I_LOGDT][idx]);
        float zr = are * dt, zi = aim * dt;
        float e = expf(zr);
        float abr = e * cosf(zi), abi = e * sinf(zi);
        float d2 = are * are + aim * aim;
        float nr = abr - 1.f, ni = abi;
        float qr = (nr * are + ni * aim) / d2, qi = (ni * are - nr * aim) / d2;
        u16* at = (u16*)(p.ws + OFF_ATAB) + (size_t)idx * 128 * 16;
        u16* ct = (u16*)(p.ws + OFF_CTAB) + (size_t)idx * 16 * 128;
        for (int c = 0; c < 16; ++c) {
          float bre = p.in[I_BRE][((size_t)idx * 64 + pp) * 16 + c], bim = p.in[I_BIM][((size_t)idx * 64 + pp) * 16 + c];
          at[(2 * pp) * 16 + c] = f2bf(qr * bre - qi * bim);
          at[(2 * pp + 1) * 16 + c] = f2bf(qr * bim + qi * bre);
          float cre = p.in[I_CRE][((size_t)idx * 16 + c) * 64 + pp], cim = p.in[I_CIM][((size_t)idx * 16 + c) * 64 + pp];
          ct[c * 128 + 2 * pp] = f2bf(cre);
          ct[c * 128 + 2 * pp + 1] = f2bf(-cim);
        }
        float* ab = (float*)(p.ws + OFF_ABAR) + ((size_t)idx * 64 + pp) * 2;
        ab[0] = abr; ab[1] = abi;
      }
    } else if (it < N_ADA + N_TAB + N_MISC) {
      f32x2* tab = (f32x2*)(p.ws + OFF_ROPE);
      for (int i = tid; i < 2 * 64 * 16; i += NTHR) {
        int kind = i >> 10, pos = (i >> 4) & 63, fi = i & 15;
        int n = kind ? 16 : 8;
        float freq = expf(-(float)(fi % n) / (float)n * 9.210340371976184f);
        float ang = (float)pos * freq;
        f32x2 cs = {cosf(ang), sinf(ang)};
        tab[i] = cs;
      }
      if (tid < 64) ((int*)(p.ws + OFF_CTR))[tid] = 0;
    }
  }
  struct TrD { const float* src; u16* dst; int K, N, k0, n0; bool glu; };
  auto decode = [&](int tt) {
    TrD d; d.glu = false;
    const int l = tt / 2850;
    int r = tt % 2850; int kt, nt;
    if (r < 480) { d.src = p.in[I_WIN] + (size_t)l * 1024 * 1888; d.dst = (u16*)(p.ws + OFF_WIN) + (size_t)l * 1920 * 1024; d.K = 1024; d.N = 1888; kt = r / 30; nt = r % 30; }
    else if (r < 736) { r -= 480; d.src = p.in[I_WOUT] + (size_t)l * 1024 * 1024; d.dst = (u16*)(p.ws + OFF_WOUT) + (size_t)l * 1024 * 1024; d.K = 1024; d.N = 1024; kt = r / 16; nt = r % 16; }
    else if (r < 1760) { r -= 736; d.src = p.in[I_W1] + (size_t)l * 1024 * 4096; d.dst = (u16*)(p.ws + OFF_W1) + (size_t)l * 4096 * 1024; d.K = 1024; d.N = 4096; kt = r / 64; nt = r % 64; }
    else if (r < 2784) { r -= 1760; d.src = p.in[I_W2] + (size_t)l * 4096 * 1024; d.dst = (u16*)(p.ws + OFF_W2) + (size_t)l * 1024 * 4096; d.K = 4096; d.N = 1024; kt = r / 16; nt = r % 16; }
    else if (r < 2802) { r -= 2784; d.src = p.in[I_WUQ] + (size_t)l * 192 * 384; d.dst = (u16*)(p.ws + OFF_WUQ) + (size_t)l * 384 * 192; d.K = 192; d.N = 384; kt = r / 6; nt = r % 6; }
    else if (r < 2818) { r -= 2802; d.src = p.in[I_WUKV] + (size_t)l * 128 * 512; d.dst = (u16*)(p.ws + OFF_WUKV) + (size_t)l * 512 * 128; d.K = 128; d.N = 512; kt = r / 8; nt = r % 8; }
    else { r -= 2818; d.src = p.in[I_WGLU] + (size_t)l * 256 * 512; d.dst = (u16*)(p.ws + OFF_WGLU) + (size_t)l * 512 * 256; d.K = 256; d.N = 512; kt = r / 8; nt = r % 8; d.glu = true; }
    d.k0 = kt * 64; d.n0 = nt * 64;
    return d;
  };
  const int half = tid >> 8, t2 = tid & 255;
  float* ft = fs + half * (64 * 65);
  const int tx = t2 & 15, ty = t2 >> 4;
  auto tload = [&](const TrD& d, f32x4 (&v)[4]) {
#pragma unroll
    for (int i = 0; i < 4; ++i) {
      const int kk = ty + 16 * i, n = d.n0 + 4 * tx;
      f32x4 z = {0.f, 0.f, 0.f, 0.f};
      v[i] = (n < d.N) ? __builtin_nontemporal_load((const f32x4*)(d.src + (size_t)(d.k0 + kk) * d.N + n)) : z;
    }
  };
  const int nvb = 2 * (int)gridDim.x;
  const int tb = nvb - 1 - (2 * (int)blockIdx.x + half);
  const int nrounds = (N_TR + nvb - 1) / nvb;
  TrD cur = decode(tb < N_TR ? tb : 0);
  f32x4 cv[4];
  if (tb < N_TR) tload(cur, cv);
  for (int j = 0; j < nrounds; ++j) {
    const int tt = tb + j * nvb;
    const bool valid = tt < N_TR, more = tt + nvb < N_TR;
    TrD nxt = decode(more ? tt + nvb : 0);
    f32x4 nv[4];
    if (more) tload(nxt, nv);
    if (valid) {
#pragma unroll
      for (int i = 0; i < 4; ++i) {
        const int kk = ty + 16 * i;
        ft[kk * 65 + 4 * tx + 0] = cv[i][0]; ft[kk * 65 + 4 * tx + 1] = cv[i][1]; ft[kk * 65 + 4 * tx + 2] = cv[i][2]; ft[kk * 65 + 4 * tx + 3] = cv[i][3];
      }
    }
    __syncthreads();
    if (valid) {
#pragma unroll
      for (int i = 0; i < 2; ++i) {
        const int c = t2 + 256 * i, nn = c >> 3, kc = (c & 7) * 8;
        f32x4 a, b;
#pragma unroll
        for (int e = 0; e < 4; ++e) { a[e] = ft[(kc + e) * 65 + nn]; b[e] = ft[(kc + 4 + e) * 65 + nn]; }
        const int n = cur.n0 + nn;
        int drow = n;
        if (cur.glu) drow = (n < 256) ? ((n >> 5) * 64 + (n & 31)) : (((n - 256) >> 5) * 64 + 32 + (n & 31));
        *(bf16x8*)(cur.dst + (size_t)drow * cur.K + cur.k0 + kc) = pack8(a, b);
      }
    }
    __syncthreads();
    cur = nxt;
    if (more) {
#pragma unroll
      for (int i = 0; i < 4; ++i) cv[i] = nv[i];
    }
  }
}

DI const float* x_row_src(const P& p, int layer, int row) {
  if (layer == 0) return row < NCTX ? p.in[I_XP] + (size_t)row * 1024 : p.in[I_XS] + (size_t)(row - NCTX) * 1024;
  return p.out + (size_t)row * 1024;
}
DI void norm_phase(const P& p, int layer, int which) {
  const int tid_ = get_tid();
  const int lane = tid_ & 63;
  const int gw = blockIdx.x * NWV + (tid_ >> 6), nw = gridDim.x * NWV;
  auto src_of = [&](int row) { return (which == 0) ? x_row_src(p, layer, row) : (const float*)(p.out + (size_t)row * 1024); };
  f32x4 v[4];
  if (gw < NT) {
    const float* xs = src_of(gw);
#pragma unroll
    for (int i = 0; i < 4; ++i) v[i] = __builtin_nontemporal_load((const f32x4*)(xs + (i * 64 + lane) * 4));
  }
  for (int row = gw; row < NT; row += nw) {
    f32x4 nv[4];
    const bool more = row + nw < NT;
    if (more) {
      const float* xs = src_of(row + nw);
#pragma unroll
      for (int i = 0; i < 4; ++i) nv[i] = __builtin_nontemporal_load((const f32x4*)(xs + (i * 64 + lane) * 4));
    }
    float ss = 0;
#pragma unroll
    for (int i = 0; i < 4; ++i) ss += v[i][0] * v[i][0] + v[i][1] * v[i][1] + v[i][2] * v[i][2] + v[i][3] * v[i][3];
    ss = wave_sum(ss);
    const float r = rsqrtf(ss * (1.f / 1024.f) + EPSF);
    if (which == 2) {
      f32x4 g[4];
#pragma unroll
      for (int i = 0; i < 4; ++i) g[i] = *(const f32x4*)(p.in[I_FNG] + (i * 64 + lane) * 4);
#pragma unroll
      for (int i = 0; i < 4; ++i) {
        int e = (i * 64 + lane) * 4;
        f32x4 o = v[i] * r * g[i];
        *(f32x4*)(p.out + (size_t)row * 1024 + e) = o;
      }
    } else {
      const float* gn = p.in[which == 0 ? I_N1G : I_N2G] + layer * 1024;
      const float* md = (const float*)(p.ws + OFF_MOD) + ((size_t)layer * 5 + mod_index(row)) * 6144 + (which == 0 ? 0 : 3072);
      u16* h = (u16*)(p.ws + OFF_H) + (size_t)row * 1024;
      f32x4 g[4], sh[4], sc[4];
#pragma unroll
      for (int i = 0; i < 4; ++i) {
        int e = (i * 64 + lane) * 4;
        g[i] = *(const f32x4*)(gn + e);
        sh[i] = *(const f32x4*)(md + e);
        sc[i] = *(const f32x4*)(md + 1024 + e);
      }
#pragma unroll
      for (int i = 0; i < 4; ++i) {
        int e = (i * 64 + lane) * 4;
        f32x4 o = v[i] * r * g[i] * (1.f + sc[i]) + sh[i];
        *(u32x2*)(h + e) = pack4(o);
      }
    }
    if (more) {
#pragma unroll
      for (int i = 0; i < 4; ++i) v[i] = nv[i];
    }
  }
}

#define LAS3 __attribute__((address_space(3)))
template <int NI>
DI void stage_tile_dma(const u16* __restrict__ G, int ld, int row0, int k0, char* lds, int tid) {
#pragma unroll
  for (int i = 0; i < NI; ++i) {
    const int q = tid + NTHR * i, r = q >> 3, c = (q & 7) ^ ((r >> 1) & 7);
    __builtin_amdgcn_global_load_lds((const unsigned*)(G + (size_t)(row0 + r) * ld + k0 + c * 8), (LAS3 unsigned*)(lds + q * 16), 16, 0, 0);
  }
}
struct TD { const u16* A; const u16* B; int lda, ldb, k0, nk, m0, n0; };
template <int NB>
DI void stage_td(const TD& d, int kt, char* stage_base, int tid) {
  stage_tile_dma<4>(d.A, d.lda, d.m0, d.k0 + kt * 64, stage_base, tid);
  stage_tile_dma<2 * NB>(d.B, d.ldb, d.n0, d.k0 + kt * 64, stage_base + 32768, tid);
}
template <int NB>
DI void gemm_stream(const TD& cur, bool has_next, const TD& nxt, char* smem, int& buf, f32x16 (&acc)[4][NB]) {
  const int tid = get_tid(), lane = tid & 63, wave = tid >> 6, wm = wave >> 2, wn = wave & 3, l32 = lane & 31, hh = lane >> 5;
#pragma unroll
  for (int bi = 0; bi < 4; ++bi)
#pragma unroll
    for (int bj = 0; bj < NB; ++bj)
#pragma unroll
      for (int r = 0; r < 16; ++r) acc[bi][bj][r] = 0.f;
  const int swz = (l32 >> 1) & 7;
  const int arow = (wm * 128 + l32) * 128, brow = (wn * (NB * 32) + l32) * 128;
  const int c0 = ((0 + hh) ^ swz) * 16, c1 = ((2 + hh) ^ swz) * 16, c2 = ((4 + hh) ^ swz) * 16, c3 = ((6 + hh) ^ swz) * 16;
  asm volatile("s_waitcnt vmcnt(0)" ::: "memory");
  __syncthreads();
  const int nk = cur.nk;
  for (int kt = 0; kt < nk; ++kt) {
    const bool early = wave < 4;
    if (early) {
      if (kt + 1 < nk) stage_td<NB>(cur, kt + 1, smem + (buf ^ 1) * 65536, tid);
      else if (has_next) stage_td<NB>(nxt, 0, smem + (buf ^ 1) * 65536, tid);
    }
    const char* as = smem + buf * 65536 + arow;
    const char* bs = smem + buf * 65536 + 32768 + brow;
#pragma unroll
    for (int ks = 0; ks < 4; ++ks) {
      const int co = (ks == 0) ? c0 : (ks == 1) ? c1 : (ks == 2) ? c2 : c3;
      bf16x8 fa[4], fb[NB];
#pragma unroll
      for (int bi = 0; bi < 4; ++bi) fa[bi] = *(const bf16x8*)(as + bi * 4096 + co);
#pragma unroll
      for (int bj = 0; bj < NB; ++bj) fb[bj] = *(const bf16x8*)(bs + bj * 4096 + co);
      __builtin_amdgcn_s_setprio(1);
#pragma unroll
      for (int bi = 0; bi < 4; ++bi)
#pragma unroll
        for (int bj = 0; bj < NB; ++bj) acc[bi][bj] = MFMA32(fa[bi], fb[bj], acc[bi][bj]);
      __builtin_amdgcn_s_setprio(0);
      if (ks == 1 && !early) {
        if (kt + 1 < nk) stage_td<NB>(cur, kt + 1, smem + (buf ^ 1) * 65536, tid);
        else if (has_next) stage_td<NB>(nxt, 0, smem + (buf ^ 1) * 65536, tid);
      }
    }
    buf ^= 1;
    if (kt + 1 < nk) {
      asm volatile("s_waitcnt vmcnt(0)" ::: "memory");
      __syncthreads();
    }
  }
}

#if MEGA
#define XCD_ID()   ((int)((volatile int*)(smem + LDS_BYTES))[3])
#define XCD_RANK() ((int)((volatile int*)(smem + LDS_BYTES))[2])
#else
#define XCD_ID()   ((int)(blockIdx.x & 7))
#define XCD_RANK() ((int)(blockIdx.x >> 3))
#endif
#define EPI_IDX                                                                                        \
  const int tid = get_tid(), lane = tid & 63, wave = tid >> 6, wm = wave >> 2, wn = wave & 3, l32 = lane & 31, hh = lane >> 5; \
  (void)tid; (void)lane; (void)wave; (void)wm; (void)wn; (void)l32; (void)hh;
DI int crow(int r, int hh) { return (r & 3) + 8 * (r >> 2) + 4 * hh; }

DI void phase_g1(const P& p, int layer, char* smem) {
  EPI_IDX
  const u16* A = (const u16*)(p.ws + OFF_H);
  const u16* Bt = (const u16*)(p.ws + OFF_WIN) + (size_t)layer * 1920 * 1024;
  u16* proj = (u16*)(p.ws + OFF_PROJ);
  constexpr int MT = NT / 256, NTL = NP / 128, MPX = MT / 8;
  const int xcd_ = XCD_ID(), xj_ = XCD_RANK(), xn_ = gridDim.x >> 3;
  auto tile_at = [&](int u) { TD d; d.A = A; d.B = Bt; d.lda = 1024; d.ldb = 1024; d.k0 = 0; d.nk = 16; d.m0 = (xcd_ * MPX + u % MPX) * 256; d.n0 = (u / MPX) * 128; return d; };
  int buf = 0;
  TD cur = tile_at(xj_ < MPX * NTL ? xj_ : 0);
  if (xj_ < MPX * NTL) stage_td<1>(cur, 0, smem, tid);
  for (int u = xj_; u < MPX * NTL; u += xn_) {
    const bool has_next = (u + xn_ < MPX * NTL);
    const TD nxt = tile_at(has_next ? u + xn_ : u);
    const int m0 = cur.m0, n0 = cur.n0;
    f32x16 acc[4][1];
    gemm_stream<1>(cur, has_next, nxt, smem, buf, acc);
    cur = nxt;
    const bool lat = m0 >= NCTX;
    const int b_all = lat ? 32 + ((m0 - NCTX) >> 10) : (m0 >> 8);
    const int nkk = lat ? 1536 : 256;
#pragma unroll
    for (int bi = 0; bi < 4; ++bi)
#pragma unroll
      for (int bj = 0; bj < 1; ++bj) {
        const int rb = m0 + wm * 128 + bi * 32;
        const int cb = n0 + wn * 32 + bj * 32;
        const int col = cb + l32;
        if (cb < NP) {
#pragma unroll
          for (int r = 0; r < 16; ++r) proj[(size_t)(rb + crow(r, hh)) * NP + col] = f2bf(acc[bi][bj][r]);
        }
        const bool isdv = (cb >= 512 && cb < 768), isgv = (cb >= 1152 && cb < 1280);
        if (isdv || isgv) {
          u16* vt; int f;
          if (isdv) { f = col - 512; vt = (u16*)(p.ws + OFF_DVT) + vt_off(b_all, f >> 6, 4); }
          else { f = col - 1152; vt = (u16*)(p.ws + OFF_GVT) + vt_off(b_all, f >> 6, 2); }
          vt += (size_t)(f & 63) * nkk;
#pragma unroll
          for (int j = 0; j < 4; ++j) {
            int row = rb + 16 * (j >> 1) + 8 * hh + 4 * (j & 1);
            int key = lat ? 512 + ((row - NCTX) & 1023) : (row & 255);
            f32x4 v = {acc[bi][bj][4 * j], acc[bi][bj][4 * j + 1], acc[bi][bj][4 * j + 2], acc[bi][bj][4 * j + 3]};
            *(u32x2*)(vt + key) = pack4(v);
          }
        }
      }
  }
}

DI void phase_g2(const P& p, int layer, char* smem) {
  EPI_IDX
  constexpr int T_MQ = (NT / 256) * 2, T_MKV = (NKR / 256) * 2;
  const f32x2* tab32 = (const f32x2*)(p.ws + OFF_ROPE);
  auto tile_at = [&](int t) {
    TD d; d.k0 = 0;
    if (t < T_MQ) { d.A = (const u16*)(p.ws + OFF_CQN); d.B = (const u16*)(p.ws + OFF_WUQ) + (size_t)layer * 384 * 192; d.lda = 192; d.ldb = 192; d.nk = 3; d.m0 = (t >> 1) * 256; d.n0 = (t & 1) * 256; }
    else { const int t2 = t - T_MQ; d.A = (const u16*)(p.ws + OFF_CKVN); d.B = (const u16*)(p.ws + OFF_WUKV) + (size_t)layer * 512 * 128; d.lda = 128; d.ldb = 128; d.nk = 2; d.m0 = (t2 >> 1) * 256; d.n0 = (t2 & 1) * 256; }
    return d;
  };
  int buf = 0;
  const int t_first = blockIdx.x;
  TD cur = tile_at(t_first < T_MQ + T_MKV ? t_first : 0);
  if (t_first < T_MQ + T_MKV) stage_td<2>(cur, 0, smem, tid);
  for (int t = blockIdx.x; t < T_MQ + T_MKV; t += gridDim.x) {
    const bool has_next = (t + (int)gridDim.x < T_MQ + T_MKV);
    const TD nxt = tile_at(has_next ? t + (int)gridDim.x : t);
    f32x16 acc[4][2];
    const int m0 = cur.m0, n0 = cur.n0;
    gemm_stream<2>(cur, has_next, nxt, smem, buf, acc);
    cur = nxt;
    if (t < T_MQ) {
      const bool lat = m0 >= NCTX;
      const float scl = 0.10206207261596575f * LOG2E;
      u16* mq = (u16*)(p.ws + OFF_MQ);
#pragma unroll
      for (int bi = 0; bi < 4; ++bi)
#pragma unroll
        for (int bj = 0; bj < 2; ++bj) {
          const int rb = m0 + wm * 128 + bi * 32;
          const int cb = n0 + wn * 64 + bj * 32;
          const int col = cb + l32;
          if (cb < 384) {
            const bool isrope = lat && ((cb % 96) == 64);
            const int e = l32, w2 = e & 15, fi = w2 & 7;
            const bool isx2 = w2 >= 8, half = e >= 16;
#pragma unroll
            for (int r = 0; r < 16; ++r) {
              float v = acc[bi][bj][r];
              const int row = rb + crow(r, hh);
              if (isrope) {
                const int tt = (row - NCTX) & 1023;
                const int pos = half ? (tt & 63) : (tt >> 6);
                const f32x2 cs = tab32[pos * 16 + fi];
                float pv = __shfl_xor(v, 8);
                v = v * cs[0] + (isx2 ? pv : -pv) * cs[1];
              }
              mq[(size_t)row * 384 + col] = f2bf(v * scl);
            }
          }
        }
    } else {
      const bool lat = m0 >= NCTX;
      const int b_all = lat ? 32 + (m0 - NCTX) / 1536 : (m0 >> 8);
      const int nkk = lat ? 1536 : 256;
      const int kbase = lat ? (m0 - NCTX) % 1536 : (m0 & 255);
      u16* mk = (u16*)(p.ws + OFF_MKB);
#pragma unroll
      for (int bi = 0; bi < 4; ++bi)
#pragma unroll
        for (int bj = 0; bj < 2; ++bj) {
          const int rloc = wm * 128 + bi * 32;
          const int cb = n0 + wn * 64 + bj * 32;
          const int head = cb >> 7, wc = (cb & 127) + l32;
          if ((cb & 127) < 64) {
#pragma unroll
            for (int r = 0; r < 16; ++r) mk[(size_t)(m0 + rloc + crow(r, hh)) * 384 + head * 96 + wc] = f2bf(acc[bi][bj][r]);
          } else {
            u16* vt = (u16*)(p.ws + OFF_MVT) + vt_off(b_all, head, 4) + (size_t)(wc - 64) * nkk + kbase + rloc;
#pragma unroll
            for (int j = 0; j < 4; ++j) {
              f32x4 v = {acc[bi][bj][4 * j], acc[bi][bj][4 * j + 1], acc[bi][bj][4 * j + 2], acc[bi][bj][4 * j + 3]};
              *(u32x2*)(vt + 16 * (j >> 1) + 8 * hh + 4 * (j & 1)) = pack4(v);
            }
          }
        }
    }
  }
  {
    const int gw = blockIdx.x * NWV + wave, nw = gridDim.x * NWV;
    const f32x4 dd = *(const f32x4*)(p.in[I_SSMD] + layer * 256 + lane * 4);
    for (int row = gw; row < NT; row += nw) {
      const float* y0 = (const float*)(p.ws + OFF_YBUF) + (size_t)row * 256 + lane * 4;
      u16* prow = (u16*)(p.ws + OFF_PROJ) + (size_t)row * NP;
      f32x4 a = __builtin_nontemporal_load((const f32x4*)y0), b = __builtin_nontemporal_load((const f32x4*)(y0 + (size_t)NT * 256)), c = ld4bf(prow + 1280 + lane * 4);
      f32x4 sv = a + b + c * dd;
      f32x4 g = {gelu_tanh(sv[0]), gelu_tanh(sv[1]), gelu_tanh(sv[2]), gelu_tanh(sv[3])};
      *(u32x2*)(prow + lane * 4) = pack4(g);
    }
  }
}

DI void phase_resid(const P& p, int layer, char* smem, bool is_out) {
  EPI_IDX
  const u16* A = is_out ? (const u16*)(p.ws + OFF_MIXED) : (const u16*)(p.ws + OFF_A);
  const int K = is_out ? 1024 : 4096;
  const u16* Bt = is_out ? (const u16*)(p.ws + OFF_WOUT) + (size_t)layer * 1024 * 1024 : (const u16*)(p.ws + OFF_W2) + (size_t)layer * 1024 * 4096;
  constexpr int MT = NT / 256, NTL = 4, MPX = MT / 8, NU = MPX * NTL;
  const int xcd_ = XCD_ID(), xj_ = XCD_RANK(), xn_ = gridDim.x >> 3;
  auto tile_at = [&](int u) {
    TD d; d.A = A; d.B = Bt; d.lda = K; d.ldb = K; d.nk = K / 64; d.k0 = 0;
    d.n0 = (u % NTL) * 256;
    d.m0 = (xcd_ * MPX + u / NTL) * 256;
    return d;
  };
  int buf = 0;
  TD cur = tile_at(xj_ < NU ? xj_ : 0);
  if (xj_ < NU) stage_td<2>(cur, 0, smem, tid);
  for (int u = xj_; u < NU; u += xn_) {
    const bool has_next = (u + xn_ < NU);
    const TD nxt = tile_at(has_next ? u + xn_ : u);
    const int m0 = cur.m0, n0 = cur.n0;
    f32x16 acc[4][2];
    gemm_stream<2>(cur, has_next, nxt, smem, buf, acc);
    cur = nxt;
    const float* gate = (const float*)(p.ws + OFF_MOD) + ((size_t)layer * 5 + mod_index(m0)) * 6144 + (is_out ? 2048 : 5120);
#pragma unroll
    for (int bi = 0; bi < 4; ++bi)
#pragma unroll
      for (int bj = 0; bj < 2; ++bj) {
        const int rb = m0 + wm * 128 + bi * 32;
        const int col = n0 + wn * 64 + bj * 32 + l32;
        const float g = gate[col];
        float rv[16];
#pragma unroll
        for (int r = 0; r < 16; ++r) {
          const int row = rb + crow(r, hh);
          rv[r] = (is_out && layer == 0) ? x_row_src(p, 0, row)[col] : p.out[(size_t)row * 1024 + col];
        }
#pragma unroll
        for (int r = 0; r < 16; ++r) p.out[(size_t)(rb + crow(r, hh)) * 1024 + col] = rv[r] + g * acc[bi][bj][r];
      }
  }
}

DI void phase_g5(const P& p, int layer, char* smem) {
  EPI_IDX
  const u16* A = (const u16*)(p.ws + OFF_H);
  const u16* Bt = (const u16*)(p.ws + OFF_W1) + (size_t)layer * 4096 * 1024;
  u16* a = (u16*)(p.ws + OFF_A);
  constexpr int MT = NT / 256, NTL = 16, MPX = MT / 8;
  const int xcd_ = XCD_ID(), xj_ = XCD_RANK(), xn_ = gridDim.x >> 3;
  auto tile_at = [&](int u) { TD d; d.A = A; d.B = Bt; d.lda = 1024; d.ldb = 1024; d.k0 = 0; d.nk = 16; d.m0 = (xcd_ * MPX + u % MPX) * 256; d.n0 = (u / MPX) * 256; return d; };
  int buf = 0;
  TD cur = tile_at(xj_ < MPX * NTL ? xj_ : 0);
  if (xj_ < MPX * NTL) stage_td<2>(cur, 0, smem, tid);
  for (int u = xj_; u < MPX * NTL; u += xn_) {
    const bool has_next = (u + xn_ < MPX * NTL);
    const TD nxt = tile_at(has_next ? u + xn_ : u);
    const int m0 = cur.m0, n0 = cur.n0;
    f32x16 acc[4][2];
    gemm_stream<2>(cur, has_next, nxt, smem, buf, acc);
    cur = nxt;
#pragma unroll
    for (int bi = 0; bi < 4; ++bi)
#pragma unroll
      for (int bj = 0; bj < 2; ++bj) {
        const int rb = m0 + wm * 128 + bi * 32;
        const int col = n0 + wn * 64 + bj * 32 + l32;
#pragma unroll
        for (int r = 0; r < 16; ++r) {
          float v = fmaxf(acc[bi][bj][r], 0.f);
          a[(size_t)(rb + crow(r, hh)) * 4096 + col] = f2bf(v * v);
        }
      }
  }
}

template <int R>
DI f32x4 rope4(f32x4 v, int lane, int t, const f32x2* tab) {
  constexpr int n = R / 4;
  const int e = (lane * 4) % R;
  const int half = e / (R / 2), w = e % (R / 2);
  const bool isx2 = w >= n;
  const int fi = w % n;
  const int pos = half ? (t & 63) : (t >> 6);
  f32x4 o;
#pragma unroll
  for (int i = 0; i < 4; ++i) {
    float pv = __shfl_xor(v[i], n / 4);
    f32x2 cs = tab[pos * 16 + fi + i];
    o[i] = v[i] * cs[0] + (isx2 ? pv : -pv) * cs[1];
  }
  return o;
}

DI void ssm_item(const P& p, int layer, int item, float* lds, int lane) {
  int b_all, r;
  if (item < 128) { b_all = 32 + item / 32; r = item % 32; } else { int it = item - 128; b_all = it / 32; r = it % 32; }
  const int dir = r >> 4, g = r & 15;
  const bool lat = b_all >= 32;
  const int T = lat ? 1024 : 256;
  const int row0 = lat ? NCTX + (b_all - 32) * 1024 : b_all * 256;
  const int tabidx = (layer * 2 + dir) * 16 + g;
  const int l32 = lane & 31, hh = lane >> 5, l16 = lane & 15, q4 = lane >> 4;
  const u16* atab = (const u16*)(p.ws + OFF_ATAB) + (size_t)tabidx * 128 * 16;
  const u16* ctab = (const u16*)(p.ws + OFF_CTAB) + (size_t)tabidx * 16 * 128;
  bf16x8 af[4], cf[4];
#pragma unroll
  for (int blk = 0; blk < 4; ++blk) af[blk] = *(const bf16x8*)(atab + (blk * 32 + l32) * 16 + hh * 8);
#pragma unroll
  for (int kk = 0; kk < 4; ++kk) cf[kk] = *(const bf16x8*)(ctab + l16 * 128 + kk * 32 + q4 * 8);
  const float* ab = (const float*)(p.ws + OFF_ABAR) + ((size_t)tabidx * 64 + lane) * 2;
  const float ar = ab[0], ai = ab[1];
  float hr = 0.f, hi = 0.f;
  if (lat) {
    size_t idx = ((size_t)((b_all - 32) * 2 + layer) * 2 + dir) * 1024 + g * 64 + lane;
    hr = p.in[I_SRE][idx]; hi = p.in[I_SIM][idx];
  }
  const u16* proj = (const u16*)(p.ws + OFF_PROJ);
  float* ybuf = (float*)(p.ws + OFF_YBUF) + (size_t)dir * NT * 256;
  f32x16 zero16;
#pragma unroll
  for (int i = 0; i < 16; ++i) zero16[i] = 0.f;
  bf16x8 un;
  {
    const int t = dir ? (T - 1 - l32) : l32;
    un = *(const bf16x8*)(proj + (size_t)(row0 + t) * NP + 1280 + g * 16 + hh * 8);
  }
  for (int ch = 0; ch < T / 32; ++ch) {
    {
      bf16x8 uf = un;
      if (ch + 1 < T / 32) {
        const int n = (ch + 1) * 32 + l32;
        const int t = dir ? (T - 1 - n) : n;
        un = *(const bf16x8*)(proj + (size_t)(row0 + t) * NP + 1280 + g * 16 + hh * 8);
      }
#pragma unroll
      for (int blk = 0; blk < 4; ++blk) {
        f32x16 d = MFMA32(af[blk], uf, zero16);
#pragma unroll
        for (int j = 0; j < 4; ++j) {
          f32x4 v = {d[4 * j], d[4 * j + 1], d[4 * j + 2], d[4 * j + 3]};
          *(f32x4*)(lds + l32 * 132 + blk * 32 + 8 * j + 4 * hh) = v;
        }
      }
    }
    wave_lds_fence();
    {
      f32x2 bu[32];
#pragma unroll
      for (int s = 0; s < 32; ++s) bu[s] = *(const f32x2*)(lds + s * 132 + 2 * lane);
#pragma unroll
      for (int s = 0; s < 32; ++s) {
        const float nr = __builtin_fmaf(ar, hr, __builtin_fmaf(-ai, hi, bu[s][0]));
        const float ni = __builtin_fmaf(ar, hi, __builtin_fmaf(ai, hr, bu[s][1]));
        hr = nr; hi = ni;
        f32x2 hv = {hr, hi};
        *(f32x2*)(lds + s * 132 + 2 * lane) = hv;
      }
    }
    wave_lds_fence();
#pragma unroll
    for (int tb = 0; tb < 2; ++tb) {
      f32x4 y = {0.f, 0.f, 0.f, 0.f};
#pragma unroll
      for (int kk = 0; kk < 4; ++kk) {
        const float* hp = lds + (tb * 16 + l16) * 132 + kk * 32 + q4 * 8;
        f32x4 a0 = *(const f32x4*)hp, a1 = *(const f32x4*)(hp + 4);
        y = MFMA16(cf[kk], pack8(a0, a1), y);
      }
      const int n2 = ch * 32 + tb * 16 + l16;
      const int t2 = dir ? (T - 1 - n2) : n2;
      *(f32x4*)(ybuf + (size_t)(row0 + t2) * 256 + g * 16 + q4 * 4) = y;
    }
    wave_lds_fence();
  }
  if (!lat) {
    size_t idx = ((size_t)(b_all * 2 + layer) * 2 + dir) * 1024 + g * 64 + lane;
    p.out[O_SRE + idx] = hr;
    p.out[O_SIM + idx] = hi;
  }
}

DI void pp_row(const P& p, int layer, int row, int lane) {
  const u16* pr = (const u16*)(p.ws + OFF_PROJ) + (size_t)row * NP;
  const bool lat = row >= NCTX;
  int b, t, keyrow;
  if (!lat) { b = row >> 8; t = row & 255; keyrow = row; }
  else { int rr = row - NCTX; b = rr >> 10; t = rr & 1023; keyrow = NCTX + b * 1536 + 512 + t; }
  const f32x2* tab32 = (const f32x2*)(p.ws + OFF_ROPE);
  const f32x2* tab64 = tab32 + 64 * 16;
  const size_t orow = (size_t)(b * 2 + layer) * 256 + t;
  const f32x4 z4 = {0.f, 0.f, 0.f, 0.f};
  f32x4 v_dq = ld4bf_nt(pr + lane * 4);
  f32x4 v_dk = ld4bf_nt(pr + 256 + lane * 4);
  f32x4 v_dv = ld4bf_nt(pr + 512 + lane * 4);
  f32x4 v_gq = ld4bf_nt(pr + 768 + lane * 4);
  f32x4 v_gk = lane < 32 ? ld4bf_nt(pr + 1024 + lane * 4) : z4;
  f32x4 v_gv = lane < 32 ? ld4bf_nt(pr + 1152 + lane * 4) : z4;
  f32x4 v_cq = lane < 48 ? ld4bf_nt(pr + 1536 + lane * 4) : z4;
  f32x4 v_ckv = lane < 32 ? ld4bf_nt(pr + 1728 + lane * 4) : z4;
  f32x4 v_kr = lane < 8 ? ld4bf_nt(pr + 1856 + lane * 4) : z4;
  const f32x4 g_q = *(const f32x4*)(p.in[I_QNG] + layer * 64 + (lane & 15) * 4);
  const f32x4 g_k = *(const f32x4*)(p.in[I_KNG] + layer * 64 + (lane & 15) * 4);
  const f32x4 g_cq = lane < 48 ? *(const f32x4*)(p.in[I_MQNG] + layer * 192 + lane * 4) : z4;
  const f32x4 g_ckv = lane < 32 ? *(const f32x4*)(p.in[I_MKVNG] + layer * 128 + lane * 4) : z4;
  f32x2 cs32[4], cs64[4];
  {
    const int e32 = (lane * 4) & 31, w32 = e32 & 15, p32 = (e32 >> 4) ? (t & 63) : (t >> 6), f32i = w32 & 7;
    const int e64 = (lane * 4) & 63, w64 = e64 & 31, p64 = (e64 >> 5) ? (t & 63) : (t >> 6), f64i = w64 & 15;
    const f32x2 one = {1.f, 0.f};
#pragma unroll
    for (int i = 0; i < 4; ++i) {
      cs32[i] = lat ? tab32[p32 * 16 + f32i + i] : one;
      cs64[i] = lat ? tab64[p64 * 16 + f64i + i] : one;
    }
  }
  const bool x2_32 = ((lane * 4) & 15) >= 8, x2_64 = ((lane * 4) & 31) >= 16;
  auto rope32 = [&](f32x4 v) {
    f32x4 o;
#pragma unroll
    for (int i = 0; i < 4; ++i) { float pv = __shfl_xor(v[i], 2); o[i] = v[i] * cs32[i][0] + (x2_32 ? pv : -pv) * cs32[i][1]; }
    return o;
  };
  auto rope64 = [&](f32x4 v) {
    f32x4 o;
#pragma unroll
    for (int i = 0; i < 4; ++i) { float pv = __shfl_xor(v[i], 4); o[i] = v[i] * cs64[i][0] + (x2_64 ? pv : -pv) * cs64[i][1]; }
    return o;
  };
  if (!lat) {
    *(f32x4*)(p.out + O_DK + orow * 256 + lane * 4) = v_dk;
    *(f32x4*)(p.out + O_DV + orow * 256 + lane * 4) = v_dv;
    if (lane < 32) *(f32x4*)(p.out + O_GV + orow * 128 + lane * 4) = v_gv;
    if (lane < 8) *(f32x4*)(p.out + O_KR + orow * 32 + lane * 4) = v_kr;
  }
  {
    f32x4 v = v_dq;
    if (lat) v = rope32(v);
    v = v * (0.17677669529663687f * LOG2E);
    *(u32x2*)((u16*)(p.ws + OFF_DQ) + (size_t)row * 256 + lane * 4) = pack4(v);
  }
  {
    f32x4 v = v_dk;
    if (lat) v = rope32(v);
    *(u32x2*)((u16*)(p.ws + OFF_DKB) + (size_t)keyrow * 256 + lane * 4) = pack4(v);
  }
  {
    f32x4 v = v_gq;
    float ss = v[0] * v[0] + v[1] * v[1] + v[2] * v[2] + v[3] * v[3];
    ss += __shfl_xor(ss, 1); ss += __shfl_xor(ss, 2); ss += __shfl_xor(ss, 4); ss += __shfl_xor(ss, 8);
    float r = rsqrtf(ss * (1.f / 64.f) + EPSF);
    v = v * r * g_q;
    if (lat) v = rope64(v);
    v = v * (0.125f * LOG2E);
    *(u32x2*)((u16*)(p.ws + OFF_GQ) + (size_t)row * 256 + lane * 4) = pack4(v);
  }
  {
    f32x4 v = v_gk;
    float ss = v[0] * v[0] + v[1] * v[1] + v[2] * v[2] + v[3] * v[3];
    ss += __shfl_xor(ss, 1); ss += __shfl_xor(ss, 2); ss += __shfl_xor(ss, 4); ss += __shfl_xor(ss, 8);
    float r = rsqrtf(ss * (1.f / 64.f) + EPSF);
    v = v * r * g_k;
    if (!lat) { if (lane < 32) *(f32x4*)(p.out + O_GK + orow * 128 + lane * 4) = v; }
    else v = rope64(v);
    if (lane < 32) *(u32x2*)((u16*)(p.ws + OFF_GKB) + (size_t)keyrow * 128 + lane * 4) = pack4(v);
  }
  {
    f32x4 v = v_cq;
    float ss = wave_sum(v[0] * v[0] + v[1] * v[1] + v[2] * v[2] + v[3] * v[3]);
    float r = rsqrtf(ss * (1.f / 192.f) + EPSF);
    v = v * r * g_cq;
    if (lane < 48) *(u32x2*)((u16*)(p.ws + OFF_CQN) + (size_t)row * 192 + lane * 4) = pack4(v);
  }
  {
    f32x4 v = v_ckv;
    float ss = wave_sum(v[0] * v[0] + v[1] * v[1] + v[2] * v[2] + v[3] * v[3]);
    float r = rsqrtf(ss * (1.f / 128.f) + EPSF);
    v = v * r * g_ckv;
    if (lane < 32) {
      if (!lat) *(f32x4*)(p.out + O_CKV + orow * 128 + lane * 4) = v;
      *(u32x2*)((u16*)(p.ws + OFF_CKVN) + (size_t)keyrow * 128 + lane * 4) = pack4(v);
    }
  }
  {
    f32x4 v = v_kr;
    if (lat) v = rope32(v);
    if (lane < 8) {
      u32x2 pk = pack4(v);
      u16* mk = (u16*)(p.ws + OFF_MKB) + (size_t)keyrow * 384 + 64 + lane * 4;
#pragma unroll
      for (int hd = 0; hd < 4; ++hd) *(u32x2*)(mk + hd * 96) = pk;
    }
  }
}

DI void pp_cached(const P& p, int layer, int crow_, int lane) {
  const int b = crow_ >> 9, j = crow_ & 511;
  const int keyrow = NCTX + b * 1536 + j;
  const size_t src = (size_t)(b * 2 + layer) * 512 + j;
  const int jp = (j & ~15) | (((j >> 2) & 1) << 3) | (((j >> 3) & 1) << 2) | (j & 3);
  const f32x4 z4 = {0.f, 0.f, 0.f, 0.f};
  const int l31 = lane & 31, l7 = lane & 7;
  f32x4 v_dk = __builtin_nontemporal_load((const f32x4*)(p.in[I_CDK] + src * 256 + lane * 4));
  f32x4 v_dv = __builtin_nontemporal_load((const f32x4*)(p.in[I_CDV] + src * 256 + lane * 4));
  f32x4 v_gk = __builtin_nontemporal_load((const f32x4*)(p.in[I_CGK] + src * 128 + l31 * 4));
  f32x4 v_gv = __builtin_nontemporal_load((const f32x4*)(p.in[I_CGV] + src * 128 + l31 * 4));
  f32x4 v_ckv = __builtin_nontemporal_load((const f32x4*)(p.in[I_CCKV] + src * 128 + l31 * 4));
  f32x4 v_kr = __builtin_nontemporal_load((const f32x4*)(p.in[I_CKR] + src * 32 + l7 * 4));
  (void)z4;
  *(u32x2*)((u16*)(p.ws + OFF_DKB) + (size_t)keyrow * 256 + lane * 4) = pack4(v_dk);
  {
    u16* vt = (u16*)(p.ws + OFF_DVT) + vt_off(32 + b, lane >> 4, 4) + (size_t)((lane & 15) * 4) * 1536 + jp;
#pragma unroll
    for (int i = 0; i < 4; ++i) vt[(size_t)i * 1536] = f2bf(v_dv[i]);
  }
  if (lane < 32) {
    *(u32x2*)((u16*)(p.ws + OFF_GKB) + (size_t)keyrow * 128 + lane * 4) = pack4(v_gk);
    u16* vt = (u16*)(p.ws + OFF_GVT) + vt_off(32 + b, lane >> 4, 2) + (size_t)((lane & 15) * 4) * 1536 + jp;
#pragma unroll
    for (int i = 0; i < 4; ++i) vt[(size_t)i * 1536] = f2bf(v_gv[i]);
    *(u32x2*)((u16*)(p.ws + OFF_CKVN) + (size_t)keyrow * 128 + lane * 4) = pack4(v_ckv);
  }
  if (lane < 8) {
    u32x2 pk = pack4(v_kr);
    u16* mk = (u16*)(p.ws + OFF_MKB) + (size_t)keyrow * 384 + 64 + lane * 4;
#pragma unroll
    for (int hd = 0; hd < 4; ++hd) *(u32x2*)(mk + hd * 96) = pk;
  }
}

DI void phase_pp(const P& p, int layer, char* smem) {
  const int tid_ = get_tid();
  const int lane = tid_ & 63, wave = tid_ >> 6;
  float* lds = (float*)smem + wave * (32 * 132);
  const int gw = wave * (int)gridDim.x + (int)blockIdx.x, nw = gridDim.x * NWV;
  constexpr int N_SSM = 1152, N_ROWS = NT + 2048;
  for (int item = gw; item < N_SSM; item += nw) ssm_item(p, layer, item, lds, lane);
  const int rw0 = (nw > 256) ? 128 : 0;
  if (gw >= rw0) {
    for (int row = gw - rw0; row < N_ROWS; row += nw - rw0) {
      if (row < NT) pp_row(p, layer, row, lane);
      else pp_cached(p, layer, row - NT, lane);
    }
  }
}

template <int KW, int DK>
DI void attn_block(const u16* __restrict__ Kg, int ldk, const u16* __restrict__ Vt, int nk, const bf16x8 (&qf)[DK / 16], int kcol, char* smem,
                   int tid, f32x16 (&o)[2], float& lsum) {
  constexpr int KST = KW + 8, KS = DK / 16, KCH = KW / 8, KTOT = 64 * KCH, NKC = (KTOT + NTHR - 1) / NTHR;
  const int lane = tid & 63, l32 = lane & 31, hh = lane >> 5;
  u16* Ks = (u16*)smem;
  u16* Vs = Ks + 2 * 64 * KST;
  float m = -1e30f;
  lsum = 0.f;
#pragma unroll
  for (int db = 0; db < 2; ++db)
#pragma unroll
    for (int r = 0; r < 16; ++r) o[db][r] = 0.f;
  u32x4 rk[NKC], rv[1];
  const int nt = nk / 64;
#pragma unroll
  for (int i = 0; i < NKC; ++i) { int c = tid + NTHR * i, r = c / KCH, kc = (c % KCH) * 8; if (c < KTOT) rk[i] = *(const u32x4*)(Kg + (size_t)r * ldk + kc); }
  { int r = tid >> 3, kc = (tid & 7) * 8; rv[0] = *(const u32x4*)(Vt + (size_t)r * nk + kc); }
#pragma unroll
  for (int i = 0; i < NKC; ++i) { int c = tid + NTHR * i, r = c / KCH, kc = (c % KCH) * 8; if (c < KTOT) *(u32x4*)(Ks + r * KST + kc) = rk[i]; }
  { int r = tid >> 3, kc = (tid & 7) * 8; *(u32x4*)(Vs + r * 72 + kc) = rv[0]; }
  __syncthreads();
  for (int t = 0; t < nt; ++t) {
    const int buf = t & 1;
    const bool more = (t + 1 < nt);
    if (more) {
      const int kt = (t + 1) * 64;
#pragma unroll
      for (int i = 0; i < NKC; ++i) { int c = tid + NTHR * i, r = c / KCH, kc = (c % KCH) * 8; if (c < KTOT) rk[i] = *(const u32x4*)(Kg + (size_t)(kt + r) * ldk + kc); }
      { int r = tid >> 3, kc = (tid & 7) * 8; rv[0] = *(const u32x4*)(Vt + (size_t)r * nk + kt + kc); }
    }
    const u16* ks = Ks + buf * 64 * KST + l32 * KST + kcol + hh * 8;
    const u16* vs = Vs + buf * 64 * 72 + l32 * 72 + hh * 8;
    f32x16 sa[2];
#pragma unroll
    for (int kb = 0; kb < 2; ++kb) {
#pragma unroll
      for (int r = 0; r < 16; ++r) sa[kb][r] = 0.f;
      bf16x8 kf[KS];
#pragma unroll
      for (int s2 = 0; s2 < KS; ++s2) kf[s2] = *(const bf16x8*)(ks + kb * 32 * KST + s2 * 16);
#pragma unroll
      for (int s2 = 0; s2 < KS; ++s2) sa[kb] = MFMA32(kf[s2], qf[s2], sa[kb]);
    }
    float mx = sa[0][0];
#pragma unroll
    for (int r = 1; r < 16; ++r) mx = fmaxf(mx, sa[0][r]);
#pragma unroll
    for (int r = 0; r < 16; ++r) mx = fmaxf(mx, sa[1][r]);
    mx = fmaxf(mx, __shfl_xor(mx, 32));
    const float mn = fmaxf(m, mx);
    const float alpha = fexp2(m - mn);
    m = mn;
    float ps = 0.f;
#pragma unroll
    for (int kb = 0; kb < 2; ++kb)
#pragma unroll
      for (int r = 0; r < 16; ++r) { float e = fexp2(sa[kb][r] - mn); sa[kb][r] = e; ps += e; }
    lsum = lsum * alpha + ps;
#pragma unroll
    for (int db = 0; db < 2; ++db)
#pragma unroll
      for (int r = 0; r < 16; ++r) o[db][r] *= alpha;
#pragma unroll
    for (int s2 = 0; s2 < 4; ++s2) {
      const int kb = s2 >> 1, rb = 8 * (s2 & 1);
      f32x4 p0 = {sa[kb][rb], sa[kb][rb + 1], sa[kb][rb + 2], sa[kb][rb + 3]};
      f32x4 p1 = {sa[kb][rb + 4], sa[kb][rb + 5], sa[kb][rb + 6], sa[kb][rb + 7]};
      bf16x8 pf = pack8(p0, p1);
      bf16x8 v0 = *(const bf16x8*)(vs + s2 * 16);
      bf16x8 v1 = *(const bf16x8*)(vs + 32 * 72 + s2 * 16);
      o[0] = MFMA32(v0, pf, o[0]);
      o[1] = MFMA32(v1, pf, o[1]);
    }
    if (more) {
      const int nb = buf ^ 1;
#pragma unroll
      for (int i = 0; i < NKC; ++i) { int c = tid + NTHR * i, r = c / KCH, kc = (c % KCH) * 8; if (c < KTOT) *(u32x4*)(Ks + nb * 64 * KST + r * KST + kc) = rk[i]; }
      { int r = tid >> 3, kc = (tid & 7) * 8; *(u32x4*)(Vs + nb * 64 * 72 + r * 72 + kc) = rv[0]; }
    }
    __syncthreads();
  }
  lsum += __shfl_xor(lsum, 32);
}

DI void store_o(u16* dst  , const f32x16 (&o)[2], float scale, int hh) {
#pragma unroll
  for (int db = 0; db < 2; ++db)
#pragma unroll
    for (int j = 0; j < 4; ++j) {
      const int dv = db * 32 + 8 * j + 4 * hh;
      f32x4 v = {o[db][4 * j] * scale, o[db][4 * j + 1] * scale, o[db][4 * j + 2] * scale, o[db][4 * j + 3] * scale};
      *(u32x2*)(dst + dv) = pack4(v);
    }
}

DI void attn_item(const P& p, int layer, int item, char* smem, int tid) {
  const int lane = tid & 63, wave = tid >> 6, l32 = lane & 31, hh = lane >> 5;
  bool lat; int kind, b, hd, qblk;
  if (item < 256) {
    lat = true;
    if (item < 128) { kind = 0; b = item >> 5; hd = (item >> 3) & 3; qblk = item & 7; }
    else { int it = item - 128; kind = 1 + (it >> 6); it &= 63; b = it >> 4; hd = (it >> 2) & 3; qblk = it & 3; }
  } else {
    lat = false;
    int it = item - 256;
    if (it < 256) { kind = 0; b = it >> 3; hd = (it >> 1) & 3; qblk = it & 1; }
    else { it -= 256; kind = 1 + (it >> 7); it &= 127; b = it >> 2; hd = it & 3; qblk = 0; }
  }
  const int nk = lat ? 1536 : 256;
  const int b_all = lat ? 32 + b : b;
  const int keyrow0 = lat ? NCTX + b * 1536 : b * 256;
  const int tok0 = lat ? NCTX + b * 1024 : b * 256;
  f32x16 o[2]; float ls;
  if (kind == 0) {
    const int ns = wave & 1, qb = wave >> 1;
    const int q0 = tok0 + qblk * 128 + qb * 32;
    const u16* Q = (const u16*)(p.ws + OFF_DQ) + (size_t)(q0 + l32) * 256 + hd * 64 + ns * 32 + hh * 8;
    bf16x8 qf[2];
    qf[0] = *(const bf16x8*)Q; qf[1] = *(const bf16x8*)(Q + 16);
    attn_block<64, 32>((const u16*)(p.ws + OFF_DKB) + (size_t)keyrow0 * 256 + hd * 64, 256, (const u16*)(p.ws + OFF_DVT) + vt_off(b_all, hd, 4), nk, qf, ns * 32,
                       smem, tid, o, ls);
    float d1 = 0.f, d2 = 0.f;
    if (lane < 32) { d1 = p.in[I_LQ1][layer * 32 + lane] * p.in[I_LK1][layer * 32 + lane]; d2 = p.in[I_LQ2][layer * 32 + lane] * p.in[I_LK2][layer * 32 + lane]; }
    d1 = wave_sum(d1); d2 = wave_sum(d2);
    int ly_ = layer; asm volatile("" : "+s"(ly_));
    const float lam_init = ly_ == 0 ? 0.2f : (0.8f - 0.6f * 0.7408182206817179f);
    const float lam = expf(d1) - expf(d2) + lam_init;
    float* cmb = (float*)smem + qb * (64 * 33);
    if (ns == 1) {
      const float sc = lam / ls;
#pragma unroll
      for (int db = 0; db < 2; ++db)
#pragma unroll
        for (int r = 0; r < 16; ++r) cmb[(db * 32 + crow(r, hh)) * 33 + l32] = o[db][r] * sc;
    }
    __syncthreads();
    if (ns == 0) {
      const float i0 = 1.f / ls;
      float ss = 0.f;
#pragma unroll
      for (int db = 0; db < 2; ++db)
#pragma unroll
        for (int r = 0; r < 16; ++r) { float d = o[db][r] * i0 - cmb[(db * 32 + crow(r, hh)) * 33 + l32]; o[db][r] = d; ss += d * d; }
      ss += __shfl_xor(ss, 32);
      const float rr = rsqrtf(ss * (1.f / 64.f) + EPSF) * (1.f - lam_init);
      u16* dst = (u16*)(p.ws + OFF_MIXED) + (size_t)(q0 + l32) * 1024 + hd * 64;
#pragma unroll
      for (int db = 0; db < 2; ++db)
#pragma unroll
        for (int j = 0; j < 4; ++j) {
          const int dv = db * 32 + 8 * j + 4 * hh;
          f32x4 g = *(const f32x4*)(p.in[I_SUBLN] + layer * 64 + dv);
          f32x4 v = {o[db][4 * j] * rr * g[0], o[db][4 * j + 1] * rr * g[1], o[db][4 * j + 2] * rr * g[2], o[db][4 * j + 3] * rr * g[3]};
          *(u32x2*)(dst + dv) = pack4(v);
        }
    }
    __syncthreads();
  } else if (kind == 1) {
    const int q0 = tok0 + qblk * 256 + wave * 32;
    const u16* Q = (const u16*)(p.ws + OFF_GQ) + (size_t)(q0 + l32) * 256 + hd * 64 + hh * 8;
    bf16x8 qf[4];
#pragma unroll
    for (int s2 = 0; s2 < 4; ++s2) qf[s2] = *(const bf16x8*)(Q + s2 * 16);
    attn_block<64, 64>((const u16*)(p.ws + OFF_GKB) + (size_t)keyrow0 * 128 + (hd >> 1) * 64, 128, (const u16*)(p.ws + OFF_GVT) + vt_off(b_all, hd >> 1, 2), nk, qf, 0,
                       smem, tid, o, ls);
    store_o((u16*)(p.ws + OFF_MIXED) + (size_t)(q0 + l32) * 1024 + 256 + hd * 64, o, 1.f / ls, hh);
  } else {
    const int q0 = tok0 + qblk * 256 + wave * 32;
    const u16* Q = (const u16*)(p.ws + OFF_MQ) + (size_t)(q0 + l32) * 384 + hd * 96 + hh * 8;
    bf16x8 qf[6];
#pragma unroll
    for (int s2 = 0; s2 < 6; ++s2) qf[s2] = *(const bf16x8*)(Q + s2 * 16);
    attn_block<96, 96>((const u16*)(p.ws + OFF_MKB) + (size_t)keyrow0 * 384 + hd * 96, 384, (const u16*)(p.ws + OFF_MVT) + vt_off(b_all, hd, 4), nk, qf, 0,
                       smem, tid, o, ls);
    store_o((u16*)(p.ws + OFF_MIXED) + (size_t)(q0 + l32) * 1024 + 768 + hd * 64, o, 1.f / ls, hh);
  }
}

DI void phase_at(const P& p, int layer, char* smem) {
  EPI_IDX
  constexpr int N_ITEMS = 768;
  if (gridDim.x == 256) {
    const int b = blockIdx.x;
    attn_item(p, layer, b, smem, tid);
    __syncthreads();
    if (b < 128) {
      attn_item(p, layer, 256 + b, smem, tid); __syncthreads();
      attn_item(p, layer, 512 + b, smem, tid); __syncthreads();
      attn_item(p, layer, 640 + b, smem, tid); __syncthreads();
    } else if (b < 192) {
      attn_item(p, layer, 256 + 128 + 2 * (b - 128), smem, tid); __syncthreads();
      attn_item(p, layer, 256 + 128 + 2 * (b - 128) + 1, smem, tid); __syncthreads();
    }
  } else {
    for (int item = blockIdx.x; item < N_ITEMS; item += gridDim.x) {
      attn_item(p, layer, item, smem, tid);
      __syncthreads();
    }
  }
  {
    constexpr int T_GLU = (NT / 256) * 2;
    auto tile_at = [&](int t) { TD d; d.A = (const u16*)(p.ws + OFF_PROJ); d.lda = NP; d.B = (const u16*)(p.ws + OFF_WGLU) + (size_t)layer * 512 * 256; d.ldb = 256; d.k0 = 0; d.nk = 4; d.m0 = (t >> 1) * 256; d.n0 = (t & 1) * 256; return d; };
    int buf = 0;
    const int t0 = (int)gridDim.x - 1 - (int)blockIdx.x;
    TD cur = tile_at(t0 < T_GLU ? t0 : 0);
    if (t0 < T_GLU) stage_td<2>(cur, 0, smem, tid);
    for (int t = t0; t < T_GLU; t += gridDim.x) {
      const bool has_next = (t + (int)gridDim.x < T_GLU);
      const TD nxt = tile_at(has_next ? t + (int)gridDim.x : t);
      const int m0 = cur.m0, n0 = cur.n0;
      f32x16 acc[4][2];
      gemm_stream<2>(cur, has_next, nxt, smem, buf, acc);
      cur = nxt;
      u16* mixed = (u16*)(p.ws + OFF_MIXED);
      const int q = (n0 + wn * 64) >> 6;
#pragma unroll
      for (int bi = 0; bi < 4; ++bi) {
        const int rb = m0 + wm * 128 + bi * 32;
#pragma unroll
        for (int r = 0; r < 16; ++r) {
          float z = acc[bi][0][r], g = acc[bi][1][r];
          mixed[(size_t)(rb + crow(r, hh)) * 1024 + 512 + q * 32 + l32] = f2bf(z * fsigmoid(g));
        }
      }
    }
  }
}

#define XB_TMO      128
#define XB_XCNT(j)  (256  + 64 * (j))
#define XB_XSUB(j)  (1280 + 64 * (j))
#define XB_XGEN(j)  (2304 + 64 * (j))
#define XB_TOP      3328
#define XB_TOPGEN   3392
#define XCD_BAR_WORDS 3456
#define XB_SPIN_CAP (1u << 22)
#define LAS __attribute__((address_space(3)))
DI unsigned xb_ld(unsigned* p) { return __hip_atomic_load(p, __ATOMIC_RELAXED, __HIP_MEMORY_SCOPE_AGENT); }
DI unsigned xb_add(unsigned* p, unsigned v) { return __hip_atomic_fetch_add(p, v, __ATOMIC_RELAXED, __HIP_MEMORY_SCOPE_AGENT); }
DI unsigned xb_xcc_id() { return (unsigned)__builtin_amdgcn_s_getreg((3 << 11) | 20) & 0xFu; }
#define XB_SPIN(cond, bar) do { unsigned _sp = 0; while (cond) { __builtin_amdgcn_s_sleep(1); \
    if ((++_sp & 255u) == 0u) { if (xb_ld(&(bar)[XB_TMO])) break; if (_sp > XB_SPIN_CAP) { atomicAdd(&(bar)[XB_TMO], 1u); break; } } } } while (0)
struct XcdBarrier { unsigned* bar; unsigned x; volatile LAS unsigned* st; };
DI XcdBarrier xcd_barrier_post(unsigned* bar, volatile LAS unsigned* st) {
  XcdBarrier b; b.bar = bar; b.x = xb_xcc_id(); b.st = st;
  if (threadIdx.x == 0) st[2] = xb_add(&bar[XB_XCNT(b.x)], 1u);
  return b;
}
DI void xcd_barrier_complete(unsigned* bar, unsigned x, unsigned& nloc, unsigned& nx) {
  const unsigned G = gridDim.x * gridDim.y * gridDim.z;
  unsigned sum, cnt, mine, sp = 0u;
  for (;;) {
    sum = 0u; cnt = 0u; mine = 0u;
#pragma unroll
    for (unsigned j = 0; j < 16; ++j) { const unsigned c = xb_ld(&bar[XB_XCNT(j)]); sum += c; cnt += (c > 0u) ? 1u : 0u; mine = (j == x) ? c : mine; }
    if (sum == G) break;
    __builtin_amdgcn_s_sleep(1);
    if ((++sp & 255u) == 0u) { if (xb_ld(&bar[XB_TMO])) break; if (sp > XB_SPIN_CAP) { atomicAdd(&bar[XB_TMO], 1u); break; } }
  }
  nloc = mine > 0u ? mine : 1u; nx = cnt > 0u ? cnt : 1u;
}
DI void xcd_barrier(const XcdBarrier& b) {
  asm volatile("s_waitcnt vmcnt(0)" ::: "memory");
  __syncthreads();
  if (threadIdx.x == 0) {
    unsigned* bar = b.bar;
    __builtin_amdgcn_s_waitcnt(0);
    unsigned nloc = b.st[0], nx = b.st[1];
    if (nloc == 0u) { xcd_barrier_complete(bar, b.x, nloc, nx); b.st[0] = nloc; b.st[1] = nx; }
    const unsigned old = xb_add(&bar[XB_XSUB(b.x)], 1u);
    const unsigned gen = old / nloc;
    if (old + 1u == (gen + 1u) * nloc) {
      __builtin_amdgcn_fence(__ATOMIC_RELEASE, "agent");
      asm volatile("s_waitcnt vmcnt(0)" ::: "memory");
      const unsigned og = xb_add(&bar[XB_TOP], 1u);
      const unsigned tg = og / nx;
      if (og + 1u == (tg + 1u) * nx) xb_add(&bar[XB_TOPGEN], 1u);
      else XB_SPIN(xb_ld(&bar[XB_TOPGEN]) == tg, bar);
      __builtin_amdgcn_fence(__ATOMIC_ACQUIRE, "agent");
      xb_add(&bar[XB_XGEN(b.x)], 1u);
      asm volatile("s_waitcnt vmcnt(0)" ::: "memory");
    } else {
      XB_SPIN(xb_ld(&bar[XB_XGEN(b.x)]) == gen, bar);
      __builtin_amdgcn_fence(__ATOMIC_ACQUIRE, "agent");
      asm volatile("s_waitcnt vmcnt(0)" ::: "memory");
    }
  }
  __syncthreads();
}

DI void run_phase(const P& p_, int ph, int layer, char* smem) {
  P p = p_;
  size_t zoff = 0;
  asm volatile("" : "+s"(zoff));
  p.ws = p_.ws + zoff;
  p.out = p_.out + zoff;
  switch (ph) {
    case 0: prologue(p, smem); break;
    case 1: norm_phase(p, layer, 0); break;
    case 2: phase_g1(p, layer, smem); break;
    case 3: phase_pp(p, layer, smem); break;
    case 4: phase_g2(p, layer, smem); break;
    case 5: phase_at(p, layer, smem); break;
    case 6: phase_resid(p, layer, smem, true); break;
    case 7: norm_phase(p, layer, 1); break;
    case 8: phase_g5(p, layer, smem); break;
    case 9: phase_resid(p, layer, smem, false); break;
    case 10: norm_phase(p, 0, 2); break;
  }
}

extern __shared__ __attribute__((aligned(16))) char dyn_smem[];

__global__ void __launch_bounds__(512) fwd_mega(P p) {
  if (p.ws == nullptr) { cg::grid_group grid = cg::this_grid(); grid.sync(); }
  volatile LAS unsigned* st = (volatile LAS unsigned*)(dyn_smem + LDS_BYTES);
  if (threadIdx.x == 0) { st[0] = 0u; st[1] = 0u; st[2] = 0u; st[3] = 0u; }
  __syncthreads();
  XcdBarrier xb = xcd_barrier_post((unsigned*)(p.ws + OFF_BAR), st);
  run_phase(p, 0, 0, dyn_smem);
  xcd_barrier(xb);
  if (threadIdx.x == 0) {
    unsigned* bar = (unsigned*)(p.ws + OFF_BAR);
    bool ok = (gridDim.x & 7u) == 0u;
    for (unsigned j = 0; j < 16; ++j) { const unsigned c = xb_ld(&bar[XB_XCNT(j)]); ok = ok && (c == (j < 8 ? gridDim.x >> 3 : 0u)); }
    if (ok) st[3] = xb.x; else { st[2] = blockIdx.x >> 3; st[3] = blockIdx.x & 7u; }
  }
  __syncthreads();
  for (int l = 0; l < 2; ++l) {
    for (int ph = 1; ph <= 9; ++ph) {
      run_phase(p, ph, l, dyn_smem);
      xcd_barrier(xb);
    }
  }
  run_phase(p, 10, 0, dyn_smem);
}

#if !MEGA
__global__ void __launch_bounds__(512) fwd_phase(P p, int ph, int layer) { run_phase(p, ph, layer, dyn_smem); }
#endif

extern "C" void kernel_launch(void* const* d_in, const int* in_sizes, int n_in, void* d_out, int out_size, void* d_ws, size_t ws_size,
                              hipStream_t stream) {
  static int grid_blocks = 0;
  if (!grid_blocks) {
    int dev = 0, cus = 0, per_cu = 0;
    (void)hipGetDevice(&dev);
    (void)hipDeviceGetAttribute(&cus, hipDeviceAttributeMultiprocessorCount, dev);
    (void)hipFuncSetAttribute((const void*)fwd_mega, hipFuncAttributeMaxDynamicSharedMemorySize, LDS_BYTES + 16);
#if !MEGA
    (void)hipFuncSetAttribute((const void*)fwd_phase, hipFuncAttributeMaxDynamicSharedMemorySize, LDS_BYTES);
#endif
    (void)hipOccupancyMaxActiveBlocksPerMultiprocessor(&per_cu, (const void*)fwd_mega, NTHR, LDS_BYTES + 16);
    if (per_cu < 1) per_cu = 1;
    if (per_cu > 1) per_cu = 1;
    grid_blocks = cus * per_cu;
    if (ws_size < WS_NEED) fprintf(stderr, "kernel_launch: workspace too small: %zu < %zu\n", ws_size, (size_t)WS_NEED);
  }
  P p{};
  for (int i = 0; i < N_IN; ++i) p.in[i] = (const float*)d_in[i];
  p.out = (float*)d_out;
  p.ws = (char*)d_ws;
#if MEGA
  (void)hipMemsetAsync((char*)d_ws + OFF_BAR, 0, XCD_BAR_WORDS * 4, stream);
  void* args[] = {&p};
  hipError_t e = hipLaunchCooperativeKernel((const void*)fwd_mega, dim3(grid_blocks), dim3(NTHR), args, LDS_BYTES + 16, stream);
  if (e != hipSuccess) fprintf(stderr, "cooperative launch failed: %s (grid %d)\n", hipGetErrorString(e), grid_blocks);
#else
  hipLaunchKernelGGL(fwd_phase, dim3(grid_blocks), dim3(NTHR), LDS_BYTES, stream, p, 0, 0);
  for (int l = 0; l < 2; ++l)
    for (int ph = 1; ph <= 9; ++ph) hipLaunchKernelGGL(fwd_phase, dim3(grid_blocks), dim3(NTHR), LDS_BYTES, stream, p, ph, l);
  hipLaunchKernelGGL(fwd_phase, dim3(grid_blocks), dim3(NTHR), LDS_BYTES, stream, p, 10, 0);
#endif
}
```

```cpp
#include <hip/hip_runtime.h>
#include <hip/hip_cooperative_groups.h>
#include <cstdio>
namespace cg = cooperative_groups;

#ifndef MEGA
#define MEGA 1
#endif

#define DI __device__ __forceinline__
typedef unsigned short u16;
typedef __attribute__((ext_vector_type(8))) short bf16x8;
typedef __attribute__((ext_vector_type(4))) short bf16x4;
typedef __attribute__((ext_vector_type(2))) __bf16 bf2_t;
typedef __attribute__((ext_vector_type(2))) float f32x2;
typedef __attribute__((ext_vector_type(4))) float f32x4;
typedef __attribute__((ext_vector_type(16))) float f32x16;
typedef __attribute__((ext_vector_type(4))) unsigned u32x4;
typedef __attribute__((ext_vector_type(2))) unsigned u32x2;

#define MFMA32(a, b, c) __builtin_amdgcn_mfma_f32_32x32x16_bf16((a), (b), (c), 0, 0, 0)
#define MFMA16(a, b, c) __builtin_amdgcn_mfma_f32_16x16x32_bf16((a), (b), (c), 0, 0, 0)

constexpr int NT = 12288;
constexpr int NCTX = 8192;
constexpr int NKR = 14336;
constexpr int NP = 1920;
constexpr float EPSF = 1e-6f;
constexpr float LOG2E = 1.4426950408889634f;

enum { I_XP = 0, I_XS, I_CDK, I_CDV, I_CGK, I_CGV, I_CCKV, I_CKR, I_SRE, I_SIM, I_C, I_CCTX, I_N1G, I_N2G, I_WADA, I_BADA,
       I_WIN, I_WOUT, I_LQ1, I_LK1, I_LQ2, I_LK2, I_SUBLN, I_QNG, I_KNG, I_ARE, I_AIM, I_LOGDT, I_BRE, I_BIM, I_CRE, I_CIM,
       I_SSMD, I_WGLU, I_MQNG, I_MKVNG, I_WUQ, I_WUKV, I_W1, I_W2, I_FNG, N_IN };

constexpr size_t O_Y = 0;
constexpr size_t O_DK = 12582912;
constexpr size_t O_DV = 16777216;
constexpr size_t O_GK = 20971520;
constexpr size_t O_GV = 23068672;
constexpr size_t O_CKV = 25165824;
constexpr size_t O_KR = 27262976;
constexpr size_t O_SRE = 27787264;
constexpr size_t O_SIM = 27918336;

constexpr size_t al256(size_t x) { return (x + 255) & ~(size_t)255; }
constexpr size_t OFF_MOD = 0;
constexpr size_t OFF_CTR = al256(OFF_MOD + 2 * 5 * 6144 * 4);
constexpr size_t OFF_BAR = al256(OFF_CTR + 256);
constexpr size_t OFF_ROPE = al256(OFF_BAR + 3456 * 4);
constexpr size_t OFF_ABAR = al256(OFF_ROPE + 2 * 64 * 16 * 8);
constexpr size_t OFF_ATAB = al256(OFF_ABAR + 64 * 64 * 8);
constexpr size_t OFF_CTAB = al256(OFF_ATAB + 64 * 128 * 16 * 2);
constexpr size_t OFF_WIN = al256(OFF_CTAB + 64 * 16 * 128 * 2);
constexpr size_t OFF_WOUT = al256(OFF_WIN + (size_t)2 * 1920 * 1024 * 2);
constexpr size_t OFF_W1 = al256(OFF_WOUT + (size_t)2 * 1024 * 1024 * 2);
constexpr size_t OFF_W2 = al256(OFF_W1 + (size_t)2 * 4096 * 1024 * 2);
constexpr size_t OFF_WUQ = al256(OFF_W2 + (size_t)2 * 4096 * 1024 * 2);
constexpr size_t OFF_WUKV = al256(OFF_WUQ + (size_t)2 * 384 * 192 * 2);
constexpr size_t OFF_WGLU = al256(OFF_WUKV + (size_t)2 * 512 * 128 * 2);
constexpr size_t OFF_H = al256(OFF_WGLU + (size_t)2 * 512 * 256 * 2);
constexpr size_t OFF_MIXED = OFF_H;
constexpr size_t OFF_BIG = al256(OFF_H + (size_t)NT * 1024 * 2);
constexpr size_t OFF_PROJ = OFF_BIG;
constexpr size_t OFF_DQ = al256(OFF_PROJ + (size_t)NT * NP * 4);
constexpr size_t OFF_DKB = al256(OFF_DQ + (size_t)NT * 256 * 2);
constexpr size_t OFF_DVT = al256(OFF_DKB + (size_t)NKR * 256 * 2);
constexpr size_t OFF_GQ = al256(OFF_DVT + (size_t)NKR * 256 * 2);
constexpr size_t OFF_GKB = al256(OFF_GQ + (size_t)NT * 256 * 2);
constexpr size_t OFF_GVT = al256(OFF_GKB + (size_t)NKR * 128 * 2);
constexpr size_t OFF_MQ = al256(OFF_GVT + (size_t)NKR * 128 * 2);
constexpr size_t OFF_MKB = al256(OFF_MQ + (size_t)NT * 384 * 2);
constexpr size_t OFF_MVT = al256(OFF_MKB + (size_t)NKR * 384 * 2);
constexpr size_t OFF_CQN = al256(OFF_MVT + (size_t)NKR * 256 * 2);
constexpr size_t OFF_CKVN = al256(OFF_CQN + (size_t)NT * 192 * 2);
constexpr size_t OFF_YBUF = al256(OFF_CKVN + (size_t)NKR * 128 * 2);
constexpr size_t OFF_END1 = al256(OFF_YBUF + (size_t)2 * NT * 256 * 4);
constexpr size_t OFF_A = OFF_BIG;
constexpr size_t OFF_END2 = al256(OFF_A + (size_t)NT * 4096 * 2);
constexpr size_t WS_NEED = OFF_END1 > OFF_END2 ? OFF_END1 : OFF_END2;
static_assert(WS_NEED <= (size_t)256 * 1024 * 1024, "workspace over 256 MiB");

constexpr int NTHR = 512;
constexpr int NWV = NTHR / 64;
constexpr int LDS_BYTES = 8 * 32 * 132 * 4;

struct P {
  const float* in[N_IN];
  float* out;
  char* ws;
};

DI unsigned pack2(float a, float b) { f32x2 v = {a, b}; return __builtin_bit_cast(unsigned, __builtin_convertvector(v, bf2_t)); }
DI u16 f2bf(float a) { return (u16)(pack2(a, 0.f) & 0xffffu); }
DI bf16x8 pack8(f32x4 a, f32x4 b) {
  u32x4 r = {pack2(a[0], a[1]), pack2(a[2], a[3]), pack2(b[0], b[1]), pack2(b[2], b[3])};
  return __builtin_bit_cast(bf16x8, r);
}
DI f32x4 ld4bf(const u16* p) {
  const u32x2 w = *(const u32x2*)p;
  f32x4 r = {__uint_as_float(w[0] << 16), __uint_as_float(w[0] & 0xffff0000u), __uint_as_float(w[1] << 16), __uint_as_float(w[1] & 0xffff0000u)};
  return r;
}
DI f32x4 ld4bf_nt(const u16* p) {
  const u32x2 w = __builtin_nontemporal_load((const u32x2*)p);
  f32x4 r = {__uint_as_float(w[0] << 16), __uint_as_float(w[0] & 0xffff0000u), __uint_as_float(w[1] << 16), __uint_as_float(w[1] & 0xffff0000u)};
  return r;
}
DI u32x2 pack4(f32x4 a) { u32x2 r = {pack2(a[0], a[1]), pack2(a[2], a[3])}; return r; }
DI int get_tid() { int t = threadIdx.x; asm volatile("" : "+v"(t)); return t; }
DI float fexp2(float x) { return __builtin_amdgcn_exp2f(x); }
DI float frcp(float x) { return __builtin_amdgcn_rcpf(x); }
DI float fsigmoid(float w) { return frcp(1.f + fexp2(-w * LOG2E)); }
DI float gelu_tanh(float x) { return x * fsigmoid(1.5957691216057308f * (x + 0.044715f * x * x * x)); }
DI float wave_sum(float v) {
#pragma unroll
  for (int o = 32; o >= 1; o >>= 1) v += __shfl_xor(v, o);
  return v;
}
DI void wave_lds_fence() {
  asm volatile("s_waitcnt lgkmcnt(0)" ::: "memory");
  __builtin_amdgcn_wave_barrier();
}
DI int fetch_item(int* ctr, int lane) {
  int v = 0;
  if (lane == 0) v = atomicAdd(ctr, 1);
  return __builtin_amdgcn_readfirstlane(v);
}
DI size_t vt_off(int b_all, int head, int H) {
  if (b_all < 32) return ((size_t)(b_all * H + head) * 64) * 256;
  return (size_t)32 * H * 64 * 256 + ((size_t)((b_all - 32) * H + head) * 64) * 1536;
}
DI int mod_index(int row) { return row < NCTX ? 0 : 1 + ((row - NCTX) >> 10); }

DI void prologue(const P& p, char* smem) {
  const int tid = get_tid();
  float* fs = (float*)smem;
  constexpr int N_ADA = 384, N_TAB = 64, N_MISC = 1, N_TR = 5700;
  constexpr int TOTAL = N_ADA + N_TAB + N_MISC;
  for (int it = blockIdx.x; it < TOTAL; it += gridDim.x) {
    if (it < N_ADA) {
      const int l = it / 192, ch = it % 192;
      float* sc = fs;
      float* red = fs + 5 * 1024;
      for (int i = tid; i < 5 * 1024; i += NTHR) {
        int m = i >> 10, k = i & 1023;
        float c = (m == 0) ? p.in[I_CCTX][k] : p.in[I_C][(m - 1) * 1024 + k];
        sc[i] = c * fsigmoid(c);
      }
      __syncthreads();
      const int col = tid & 31, kg = tid >> 5;
      const float* w = p.in[I_WADA] + ((size_t)l * 1024 + kg * 64) * 6144 + ch * 32 + col;
      float a0 = 0, a1 = 0, a2 = 0, a3 = 0, a4 = 0;
#pragma unroll 16
      for (int k = 0; k < 64; ++k) {
        float wv = __builtin_nontemporal_load(w + (size_t)k * 6144);
        int kk = kg * 64 + k;
        a0 += sc[kk] * wv; a1 += sc[1024 + kk] * wv; a2 += sc[2048 + kk] * wv; a3 += sc[3072 + kk] * wv; a4 += sc[4096 + kk] * wv;
      }
      red[(kg * 5 + 0) * 32 + col] = a0; red[(kg * 5 + 1) * 32 + col] = a1; red[(kg * 5 + 2) * 32 + col] = a2;
      red[(kg * 5 + 3) * 32 + col] = a3; red[(kg * 5 + 4) * 32 + col] = a4;
      __syncthreads();
      if (tid < 160) {
        int m = tid >> 5, c2 = tid & 31;
        float s = 0;
#pragma unroll
        for (int g = 0; g < 16; ++g) s += red[(g * 5 + m) * 32 + c2];
        int n = ch * 32 + c2;
        s += p.in[I_BADA][l * 6144 + n];
        ((float*)(p.ws + OFF_MOD))[((size_t)l * 5 + m) * 6144 + n] = s;
      }
      __syncthreads();
    } else if (it < N_ADA + N_TAB) {
      const int idx = it - N_ADA;
      if (tid < 64) {
        const int pp = tid;
        float are = p.in[I_ARE][idx * 64 + pp], aim = p.in[I_AIM][idx * 64 + pp];
        float dt = expf(p.in[I_LOGDT][idx]);
        float zr = are * dt, zi = aim * dt;
        float e = expf(zr);
        float abr = e * cosf(zi), abi = e * sinf(zi);
        float d2 = are * are + aim * aim;
        float nr = abr - 1.f, ni = abi;
        float qr = (nr * are + ni * aim) / d2, qi = (ni * are - nr * aim) / d2;
        u16* at = (u16*)(p.ws + OFF_ATAB) + (size_t)idx * 128 * 16;
        u16* ct = (u16*)(p.ws + OFF_CTAB) + (size_t)idx * 16 * 128;
        for (int c = 0; c < 16; ++c) {
          float bre = p.in[I_BRE][((size_t)idx * 64 + pp) * 16 + c], bim = p.in[I_BIM][((size_t)idx * 64 + pp) * 16 + c];
          at[(2 * pp) * 16 + c] = f2bf(qr * bre - qi * bim);
          at[(2 * pp + 1) * 16 + c] = f2bf(qr * bim + qi * bre);
          float cre = p.in[I_CRE][((size_t)idx * 16 + c) * 64 + pp], cim = p.in[I_CIM][((size_t)idx * 16 + c) * 64 + pp];
          ct[c * 128 + 2 * pp] = f2bf(cre);
          ct[c * 128 + 2 * pp + 1] = f2bf(-cim);
        }
        float* ab = (float*)(p.ws + OFF_ABAR) + ((size_t)idx * 64 + pp) * 2;
        ab[0] = abr; ab[1] = abi;
      }
    } else if (it < N_ADA + N_TAB + N_MISC) {
      f32x2* tab = (f32x2*)(p.ws + OFF_ROPE);
      for (int i = tid; i < 2 * 64 * 16; i += NTHR) {
        int kind = i >> 10, pos = (i >> 4) & 63, fi = i & 15;
        int n = kind ? 16 : 8;
        float freq = expf(-(float)(fi % n) / (float)n * 9.210340371976184f);
        float ang = (float)pos * freq;
        f32x2 cs = {cosf(ang), sinf(ang)};
        tab[i] = cs;
      }
      if (tid < 64) ((int*)(p.ws + OFF_CTR))[tid] = 0;
    }
  }
  struct TrD { const float* src; u16* dst; int K, N, k0, n0; bool glu; };
  auto decode = [&](int tt) {
    TrD d; d.glu = false;
    const int l = tt / 2850;
    int r = tt % 2850; int kt, nt;
    if (r < 480) { d.src = p.in[I_WIN] + (size_t)l * 1024 * 1888; d.dst = (u16*)(p.ws + OFF_WIN) + (size_t)l * 1920 * 1024; d.K = 1024; d.N = 1888; kt = r / 30; nt = r % 30; }
    else if (r < 736) { r -= 480; d.src = p.in[I_WOUT] + (size_t)l * 1024 * 1024; d.dst = (u16*)(p.ws + OFF_WOUT) + (size_t)l * 1024 * 1024; d.K = 1024; d.N = 1024; kt = r / 16; nt = r % 16; }
    else if (r < 1760) { r -= 736; d.src = p.in[I_W1] + (size_t)l * 1024 * 4096; d.dst = (u16*)(p.ws + OFF_W1) + (size_t)l * 4096 * 1024; d.K = 1024; d.N = 4096; kt = r / 64; nt = r % 64; }
    else if (r < 2784) { r -= 1760; d.src = p.in[I_W2] + (size_t)l * 4096 * 1024; d.dst = (u16*)(p.ws + OFF_W2) + (size_t)l * 1024 * 4096; d.K = 4096; d.N = 1024; kt = r / 16; nt = r % 16; }
    else if (r < 2802) { r -= 2784; d.src = p.in[I_WUQ] + (size_t)l * 192 * 384; d.dst = (u16*)(p.ws + OFF_WUQ) + (size_t)l * 384 * 192; d.K = 192; d.N = 384; kt = r / 6; nt = r % 6; }
    else if (r < 2818) { r -= 2802; d.src = p.in[I_WUKV] + (size_t)l * 128 * 512; d.dst = (u16*)(p.ws + OFF_WUKV) + (size_t)l * 512 * 128; d.K = 128; d.N = 512; kt = r / 8; nt = r % 8; }
    else { r -= 2818; d.src = p.in[I_WGLU] + (size_t)l * 256 * 512; d.dst = (u16*)(p.ws + OFF_WGLU) + (size_t)l * 512 * 256; d.K = 256; d.N = 512; kt = r / 8; nt = r % 8; d.glu = true; }
    d.k0 = kt * 64; d.n0 = nt * 64;
    return d;
  };
  const int half = tid >> 8, t2 = tid & 255;
  float* ft = fs + half * (64 * 65);
  const int tx = t2 & 15, ty = t2 >> 4;
  auto tload = [&](const TrD& d, f32x4 (&v)[4]) {
#pragma unroll
    for (int i = 0; i < 4; ++i) {
      const int kk = ty + 16 * i, n = d.n0 + 4 * tx;
      f32x4 z = {0.f, 0.f, 0.f, 0.f};
      v[i] = (n < d.N) ? __builtin_nontemporal_load((const f32x4*)(d.src + (size_t)(d.k0 + kk) * d.N + n)) : z;
    }
  };
  const int nvb = 2 * (int)gridDim.x;
  const int tb = nvb - 1 - (2 * (int)blockIdx.x + half);
  const int nrounds = (N_TR + nvb - 1) / nvb;
  TrD cur = decode(tb < N_TR ? tb : 0);
  f32x4 cv[4];
  if (tb < N_TR) tload(cur, cv);
  for (int j = 0; j < nrounds; ++j) {
    const int tt = tb + j * nvb;
    const bool valid = tt < N_TR, more = tt + nvb < N_TR;
    TrD nxt = decode(more ? tt + nvb : 0);
    f32x4 nv[4];
    if (more) tload(nxt, nv);
    if (valid) {
#pragma unroll
      for (int i = 0; i < 4; ++i) {
        const int kk = ty + 16 * i;
        ft[kk * 65 + 4 * tx + 0] = cv[i][0]; ft[kk * 65 + 4 * tx + 1] = cv[i][1]; ft[kk * 65 + 4 * tx + 2] = cv[i][2]; ft[kk * 65 + 4 * tx + 3] = cv[i][3];
      }
    }
    __syncthreads();
    if (valid) {
#pragma unroll
      for (int i = 0; i < 2; ++i) {
        const int c = t2 + 256 * i, nn = c >> 3, kc = (c & 7) * 8;
        f32x4 a, b;
#pragma unroll
        for (int e = 0; e < 4; ++e) { a[e] = ft[(kc + e) * 65 + nn]; b[e] = ft[(kc + 4 + e) * 65 + nn]; }
        const int n = cur.n0 + nn;
        int drow = n;
        if (cur.glu) drow = (n < 256) ? ((n >> 5) * 64 + (n & 31)) : (((n - 256) >> 5) * 64 + 32 + (n & 31));
        *(bf16x8*)(cur.dst + (size_t)drow * cur.K + cur.k0 + kc) = pack8(a, b);
      }
    }
    __syncthreads();
    cur = nxt;
    if (more) {
#pragma unroll
      for (int i = 0; i < 4; ++i) cv[i] = nv[i];
    }
  }
}

DI const float* x_row_src(const P& p, int layer, int row) {
  if (layer == 0) return row < NCTX ? p.in[I_XP] + (size_t)row * 1024 : p.in[I_XS] + (size_t)(row - NCTX) * 1024;
  return p.out + (size_t)row * 1024;
}
DI void norm_phase(const P& p, int layer, int which) {
  const int tid_ = get_tid();
  const int lane = tid_ & 63;
  const int gw = blockIdx.x * NWV + (tid_ >> 6), nw = gridDim.x * NWV;
  auto src_of = [&](int row) { return (which == 0) ? x_row_src(p, layer, row) : (const float*)(p.out + (size_t)row * 1024); };
  f32x4 v[4];
  if (gw < NT) {
    const float* xs = src_of(gw);
#pragma unroll
    for (int i = 0; i < 4; ++i) v[i] = __builtin_nontemporal_load((const f32x4*)(xs + (i * 64 + lane) * 4));
  }
  for (int row = gw; row < NT; row += nw) {
    f32x4 nv[4];
    const bool more = row + nw < NT;
    if (more) {
      const float* xs = src_of(row + nw);
#pragma unroll
      for (int i = 0; i < 4; ++i) nv[i] = __builtin_nontemporal_load((const f32x4*)(xs + (i * 64 + lane) * 4));
    }
    float ss = 0;
#pragma unroll
    for (int i = 0; i < 4; ++i) ss += v[i][0] * v[i][0] + v[i][1] * v[i][1] + v[i][2] * v[i][2] + v[i][3] * v[i][3];
    ss = wave_sum(ss);
    const float r = rsqrtf(ss * (1.f / 1024.f) + EPSF);
    if (which == 2) {
      f32x4 g[4];
#pragma unroll
      for (int i = 0; i < 4; ++i) g[i] = *(const f32x4*)(p.in[I_FNG] + (i * 64 + lane) * 4);
#pragma unroll
      for (int i = 0; i < 4; ++i) {
        int e = (i * 64 + lane) * 4;
        f32x4 o = v[i] * r * g[i];
        *(f32x4*)(p.out + (size_t)row * 1024 + e) = o;
      }
    } else {
      const float* gn = p.in[which == 0 ? I_N1G : I_N2G] + layer * 1024;
      const float* md = (const float*)(p.ws + OFF_MOD) + ((size_t)layer * 5 + mod_index(row)) * 6144 + (which == 0 ? 0 : 3072);
      u16* h = (u16*)(p.ws + OFF_H) + (size_t)row * 1024;
      f32x4 g[4], sh[4], sc[4];
#pragma unroll
      for (int i = 0; i < 4; ++i) {
        int e = (i * 64 + lane) * 4;
        g[i] = *(const f32x4*)(gn + e);
        sh[i] = *(const f32x4*)(md + e);
        sc[i] = *(const f32x4*)(md + 1024 + e);
      }
#pragma unroll
      for (int i = 0; i < 4; ++i) {
        int e = (i * 64 + lane) * 4;
        f32x4 o = v[i] * r * g[i] * (1.f + sc[i]) + sh[i];
        *(u32x2*)(h + e) = pack4(o);
      }
    }
    if (more) {
#pragma unroll
      for (int i = 0; i < 4; ++i) v[i] = nv[i];
    }
  }
}

#define LAS3 __attribute__((address_space(3)))
template <int NI>
DI void stage_tile_dma(const u16* __restrict__ G, int ld, int row0, int k0, char* lds, int tid) {
#pragma unroll
  for (int i = 0; i < NI; ++i) {
    const int q = tid + NTHR * i, r = q >> 3, c = (q & 7) ^ ((r >> 1) & 7);
    __builtin_amdgcn_global_load_lds((const unsigned*)(G + (size_t)(row0 + r) * ld + k0 + c * 8), (LAS3 unsigned*)(lds + q * 16), 16, 0, 0);
  }
}
struct TD { const u16* A; const u16* B; int lda, ldb, k0, nk, m0, n0; };
template <int NB>
DI void stage_td(const TD& d, int kt, char* stage_base, int tid) {
  stage_tile_dma<4>(d.A, d.lda, d.m0, d.k0 + kt * 64, stage_base, tid);
  stage_tile_dma<2 * NB>(d.B, d.ldb, d.n0, d.k0 + kt * 64, stage_base + 32768, tid);
}
template <int NB>
DI void gemm_stream(const TD& cur, bool has_next, const TD& nxt, char* smem, int& buf, f32x16 (&acc)[4][NB]) {
  const int tid = get_tid(), lane = tid & 63, wave = tid >> 6, wm = wave >> 2, wn = wave & 3, l32 = lane & 31, hh = lane >> 5;
#pragma unroll
  for (int bi = 0; bi < 4; ++bi)
#pragma unroll
    for (int bj = 0; bj < NB; ++bj)
#pragma unroll
      for (int r = 0; r < 16; ++r) acc[bi][bj][r] = 0.f;
  const int swz = (l32 >> 1) & 7;
  const int arow = (wm * 128 + l32) * 128, brow = (wn * (NB * 32) + l32) * 128;
  const int c0 = ((0 + hh) ^ swz) * 16, c1 = ((2 + hh) ^ swz) * 16, c2 = ((4 + hh) ^ swz) * 16, c3 = ((6 + hh) ^ swz) * 16;
  asm volatile("s_waitcnt vmcnt(0)" ::: "memory");
  __syncthreads();
  const int nk = cur.nk;
  for (int kt = 0; kt < nk; ++kt) {
    const bool early = wave < 4;
    if (early) {
      if (kt + 1 < nk) stage_td<NB>(cur, kt + 1, smem + (buf ^ 1) * 65536, tid);
      else if (has_next) stage_td<NB>(nxt, 0, smem + (buf ^ 1) * 65536, tid);
    }
    const char* as = smem + buf * 65536 + arow;
    const char* bs = smem + buf * 65536 + 32768 + brow;
#pragma unroll
    for (int ks = 0; ks < 4; ++ks) {
      const int co = (ks == 0) ? c0 : (ks == 1) ? c1 : (ks == 2) ? c2 : c3;
      bf16x8 fa[4], fb[NB];
#pragma unroll
      for (int bi = 0; bi < 4; ++bi) fa[bi] = *(const bf16x8*)(as + bi * 4096 + co);
#pragma unroll
      for (int bj = 0; bj < NB; ++bj) fb[bj] = *(const bf16x8*)(bs + bj * 4096 + co);
      __builtin_amdgcn_s_setprio(1);
#pragma unroll
      for (int bi = 0; bi < 4; ++bi)
#pragma unroll
        for (int bj = 0; bj < NB; ++bj) acc[bi][bj] = MFMA32(fa[bi], fb[bj], acc[bi][bj]);
      __builtin_amdgcn_s_setprio(0);
      if (ks == 1 && !early) {
        if (kt + 1 < nk) stage_td<NB>(cur, kt + 1, smem + (buf ^ 1) * 65536, tid);
        else if (has_next) stage_td<NB>(nxt, 0, smem + (buf ^ 1) * 65536, tid);
      }
    }
    buf ^= 1;
    if (kt + 1 < nk) {
      asm volatile("s_waitcnt vmcnt(0)" ::: "memory");
      __syncthreads();
    }
  }
}

#if MEGA
#define XCD_ID()   ((int)((volatile int*)(smem + LDS_BYTES))[3])
#define XCD_RANK() ((int)((volatile int*)(smem + LDS_BYTES))[2])
#else
#define XCD_ID()   ((int)(blockIdx.x & 7))
#define XCD_RANK() ((int)(blockIdx.x >> 3))
#endif
#define EPI_IDX                                                                                        \
  const int tid = get_tid(), lane = tid & 63, wave = tid >> 6, wm = wave >> 2, wn = wave & 3, l32 = lane & 31, hh = lane >> 5; \
  (void)tid; (void)lane; (void)wave; (void)wm; (void)wn; (void)l32; (void)hh;
DI int crow(int r, int hh) { return (r & 3) + 8 * (r >> 2) + 4 * hh; }

DI void phase_g1(const P& p, int layer, char* smem) {
  EPI_IDX
  const u16* A = (const u16*)(p.ws + OFF_H);
  const u16* Bt = (const u16*)(p.ws + OFF_WIN) + (size_t)layer * 1920 * 1024;
  u16* proj = (u16*)(p.ws + OFF_PROJ);
  constexpr int MT = NT / 256, NTL = NP / 128, MPX = MT / 8;
  const int xcd_ = XCD_ID(), xj_ = XCD_RANK(), xn_ = gridDim.x >> 3;
  auto tile_at = [&](int u) { TD d; d.A = A; d.B = Bt; d.lda = 1024; d.ldb = 1024; d.k0 = 0; d.nk = 16; d.m0 = (xcd_ * MPX + u % MPX) * 256; d.n0 = (u / MPX) * 128; return d; };
  int buf = 0;
  TD cur = tile_at(xj_ < MPX * NTL ? xj_ : 0);
  if (xj_ < MPX * NTL) stage_td<1>(cur, 0, smem, tid);
  for (int u = xj_; u < MPX * NTL; u += xn_) {
    const bool has_next = (u + xn_ < MPX * NTL);
    const TD nxt = tile_at(has_next ? u + xn_ : u);
    const int m0 = cur.m0, n0 = cur.n0;
    f32x16 acc[4][1];
    gemm_stream<1>(cur, has_next, nxt, smem, buf, acc);
    cur = nxt;
    const bool lat = m0 >= NCTX;
    const int b_all = lat ? 32 + ((m0 - NCTX) >> 10) : (m0 >> 8);
    const int nkk = lat ? 1536 : 256;
#pragma unroll
    for (int bi = 0; bi < 4; ++bi)
#pragma unroll
      for (int bj = 0; bj < 1; ++bj) {
        const int rb = m0 + wm * 128 + bi * 32;
        const int cb = n0 + wn * 32 + bj * 32;
        const int col = cb + l32;
        if (cb < NP) {
#pragma unroll
          for (int r = 0; r < 16; ++r) proj[(size_t)(rb + crow(r, hh)) * NP + col] = f2bf(acc[bi][bj][r]);
        }
        const bool isdv = (cb >= 512 && cb < 768), isgv = (cb >= 1152 && cb < 1280);
        if (isdv || isgv) {
          u16* vt; int f;
          if (isdv) { f = col - 512; vt = (u16*)(p.ws + OFF_DVT) + vt_off(b_all, f >> 6, 4); }
          else { f = col - 1152; vt = (u16*)(p.ws + OFF_GVT) + vt_off(b_all, f >> 6, 2); }
          vt += (size_t)(f & 63) * nkk;
#pragma unroll
          for (int j = 0; j < 4; ++j) {
            int row = rb + 16 * (j >> 1) + 8 * hh + 4 * (j & 1);
            int key = lat ? 512 + ((row - NCTX) & 1023) : (row & 255);
            f32x4 v = {acc[bi][bj][4 * j], acc[bi][bj][4 * j + 1], acc[bi][bj][4 * j + 2], acc[bi][bj][4 * j + 3]};
            *(u32x2*)(vt + key) = pack4(v);
          }
        }
      }
  }
}

DI void phase_g2(const P& p, int layer, char* smem) {
  EPI_IDX
  constexpr int T_MQ = (NT / 256) * 2, T_MKV = (NKR / 256) * 2;
  const f32x2* tab32 = (const f32x2*)(p.ws + OFF_ROPE);
  auto tile_at = [&](int t) {
    TD d; d.k0 = 0;
    if (t < T_MQ) { d.A = (const u16*)(p.ws + OFF_CQN); d.B = (const u16*)(p.ws + OFF_WUQ) + (size_t)layer * 384 * 192; d.lda = 192; d.ldb = 192; d.nk = 3; d.m0 = (t >> 1) * 256; d.n0 = (t & 1) * 256; }
    else { const int t2 = t - T_MQ; d.A = (const u16*)(p.ws + OFF_CKVN); d.B = (const u16*)(p.ws + OFF_WUKV) + (size_t)layer * 512 * 128; d.lda = 128; d.ldb = 128; d.nk = 2; d.m0 = (t2 >> 1) * 256; d.n0 = (t2 & 1) * 256; }
    return d;
  };
  int buf = 0;
  const int t_first = blockIdx.x;
  TD cur = tile_at(t_first < T_MQ + T_MKV ? t_first : 0);
  if (t_first < T_MQ + T_MKV) stage_td<2>(cur, 0, smem, tid);
  for (int t = blockIdx.x; t < T_MQ + T_MKV; t += gridDim.x) {
    const bool has_next = (t + (int)gridDim.x < T_MQ + T_MKV);
    const TD nxt = tile_at(has_next ? t + (int)gridDim.x : t);
    f32x16 acc[4][2];
    const int m0 = cur.m0, n0 = cur.n0;
    gemm_stream<2>(cur, has_next, nxt, smem, buf, acc);
    cur = nxt;
    if (t < T_MQ) {
      const bool lat = m0 >= NCTX;
      const float scl = 0.10206207261596575f * LOG2E;
      u16* mq = (u16*)(p.ws + OFF_MQ);
#pragma unroll
      for (int bi = 0; bi < 4; ++bi)
#pragma unroll
        for (int bj = 0; bj < 2; ++bj) {
          const int rb = m0 + wm * 128 + bi * 32;
          const int cb = n0 + wn * 64 + bj * 32;
          const int col = cb + l32;
          if (cb < 384) {
            const bool isrope = lat && ((cb % 96) == 64);
            const int e = l32, w2 = e & 15, fi = w2 & 7;
            const bool isx2 = w2 >= 8, half = e >= 16;
#pragma unroll
            for (int r = 0; r < 16; ++r) {
              float v = acc[bi][bj][r];
              const int row = rb + crow(r, hh);
              if (isrope) {
                const int tt = (row - NCTX) & 1023;
                const int pos = half ? (tt & 63) : (tt >> 6);
                const f32x2 cs = tab32[pos * 16 + fi];
                float pv = __shfl_xor(v, 8);
                v = v * cs[0] + (isx2 ? pv : -pv) * cs[1];
              }
              mq[(size_t)row * 384 + col] = f2bf(v * scl);
            }
          }
        }
    } else {
      const bool lat = m0 >= NCTX;
      const int b_all = lat ? 32 + (m0 - NCTX) / 1536 : (m0 >> 8);
      const int nkk = lat ? 1536 : 256;
      const int kbase = lat ? (m0 - NCTX) % 1536 : (m0 & 255);
      u16* mk = (u16*)(p.ws + OFF_MKB);
#pragma unroll
      for (int bi = 0; bi < 4; ++bi)
#pragma unroll
        for (int bj = 0; bj < 2; ++bj) {
          const int rloc = wm * 128 + bi * 32;
          const int cb = n0 + wn * 64 + bj * 32;
          const int head = cb >> 7, wc = (cb & 127) + l32;
          if ((cb & 127) < 64) {
#pragma unroll
            for (int r = 0; r < 16; ++r) mk[(size_t)(m0 + rloc + crow(r, hh)) * 384 + head * 96 + wc] = f2bf(acc[bi][bj][r]);
          } else {
            u16* vt = (u16*)(p.ws + OFF_MVT) + vt_off(b_all, head, 4) + (size_t)(wc - 64) * nkk + kbase + rloc;
#pragma unroll
            for (int j = 0; j < 4; ++j) {
              f32x4 v = {acc[bi][bj][4 * j], acc[bi][bj][4 * j + 1], acc[bi][bj][4 * j + 2], acc[bi][bj][4 * j + 3]};
              *(u32x2*)(vt + 16 * (j >> 1) + 8 * hh + 4 * (j & 1)) = pack4(v);
            }
          }
        }
    }
  }
  {
    const int gw = blockIdx.x * NWV + wave, nw = gridDim.x * NWV;
    const f32x4 dd = *(const f32x4*)(p.in[I_SSMD] + layer * 256 + lane * 4);
    for (int row = gw; row < NT; row += nw) {
      const float* y0 = (const float*)(p.ws + OFF_YBUF) + (size_t)row * 256 + lane * 4;
      u16* prow = (u16*)(p.ws + OFF_PROJ) + (size_t)row * NP;
      f32x4 a = __builtin_nontemporal_load((const f32x4*)y0), b = __builtin_nontemporal_load((const f32x4*)(y0 + (size_t)NT * 256)), c = ld4bf(prow + 1280 + lane * 4);
      f32x4 sv = a + b + c * dd;
      f32x4 g = {gelu_tanh(sv[0]), gelu_tanh(sv[1]), gelu_tanh(sv[2]), gelu_tanh(sv[3])};
      *(u32x2*)(prow + lane * 4) = pack4(g);
    }
  }
}

DI void phase_resid(const P& p, int layer, char* smem, bool is_out) {
  EPI_IDX
  const u16* A = is_out ? (const u16*)(p.ws + OFF_MIXED) : (const u16*)(p.ws + OFF_A);
  const int K = is_out ? 1024 : 4096;
  const u16* Bt = is_out ? (const u16*)(p.ws + OFF_WOUT) + (size_t)layer * 1024 * 1024 : (const u16*)(p.ws + OFF_W2) + (size_t)layer * 1024 * 4096;
  constexpr int MT = NT / 256, NTL = 4, MPX = MT / 8, NU = MPX * NTL;
  const int xcd_ = XCD_ID(), xj_ = XCD_RANK(), xn_ = gridDim.x >> 3;
  auto tile_at = [&](int u) {
    TD d; d.A = A; d.B = Bt; d.lda = K; d.ldb = K; d.nk = K / 64; d.k0 = 0;
    d.n0 = (u % NTL) * 256;
    d.m0 = (xcd_ * MPX + u / NTL) * 256;
    return d;
  };
  int buf = 0;
  TD cur = tile_at(xj_ < NU ? xj_ : 0);
  if (xj_ < NU) stage_td<2>(cur, 0, smem, tid);
  for (int u = xj_; u < NU; u += xn_) {
    const bool has_next = (u + xn_ < NU);
    const TD nxt = tile_at(has_next ? u + xn_ : u);
    const int m0 = cur.m0, n0 = cur.n0;
    f32x16 acc[4][2];
    gemm_stream<2>(cur, has_next, nxt, smem, buf, acc);
    cur = nxt;
    const float* gate = (const float*)(p.ws + OFF_MOD) + ((size_t)layer * 5 + mod_index(m0)) * 6144 + (is_out ? 2048 : 5120);
#pragma unroll
    for (int bi = 0; bi < 4; ++bi)
#pragma unroll
      for (int bj = 0; bj < 2; ++bj) {
        const int rb = m0 + wm * 128 + bi * 32;
        const int col = n0 + wn * 64 + bj * 32 + l32;
        const float g = gate[col];
        float rv[16];
#pragma unroll
        for (int r = 0; r < 16; ++r) {
          const int row = rb + crow(r, hh);
          rv[r] = __builtin_nontemporal_load(((is_out && layer == 0) ? x_row_src(p, 0, row) : (const float*)(p.out + (size_t)row * 1024)) + col);
        }
#pragma unroll
        for (int r = 0; r < 16; ++r) p.out[(size_t)(rb + crow(r, hh)) * 1024 + col] = rv[r] + g * acc[bi][bj][r];
      }
  }
}

DI void phase_g5(const P& p, int layer, char* smem) {
  EPI_IDX
  const u16* A = (const u16*)(p.ws + OFF_H);
  const u16* Bt = (const u16*)(p.ws + OFF_W1) + (size_t)layer * 4096 * 1024;
  u16* a = (u16*)(p.ws + OFF_A);
  constexpr int MT = NT / 256, NTL = 16, MPX = MT / 8;
  const int xcd_ = XCD_ID(), xj_ = XCD_RANK(), xn_ = gridDim.x >> 3;
  auto tile_at = [&](int u) { TD d; d.A = A; d.B = Bt; d.lda = 1024; d.ldb = 1024; d.k0 = 0; d.nk = 16; d.m0 = (xcd_ * MPX + u % MPX) * 256; d.n0 = (u / MPX) * 256; return d; };
  int buf = 0;
  TD cur = tile_at(xj_ < MPX * NTL ? xj_ : 0);
  if (xj_ < MPX * NTL) stage_td<2>(cur, 0, smem, tid);
  for (int u = xj_; u < MPX * NTL; u += xn_) {
    const bool has_next = (u + xn_ < MPX * NTL);
    const TD nxt = tile_at(has_next ? u + xn_ : u);
    const int m0 = cur.m0, n0 = cur.n0;
    f32x16 acc[4][2];
    gemm_stream<2>(cur, has_next, nxt, smem, buf, acc);
    cur = nxt;
#pragma unroll
    for (int bi = 0; bi < 4; ++bi)
#pragma unroll
      for (int bj = 0; bj < 2; ++bj) {
        const int rb = m0 + wm * 128 + bi * 32;
        const int col = n0 + wn * 64 + bj * 32 + l32;
#pragma unroll
        for (int r = 0; r < 16; ++r) {
          float v = fmaxf(acc[bi][bj][r], 0.f);
          a[(size_t)(rb + crow(r, hh)) * 4096 + col] = f2bf(v * v);
        }
      }
  }
}

template <int R>
DI f32x4 rope4(f32x4 v, int lane, int t, const f32x2* tab) {
  constexpr int n = R / 4;
  const int e = (lane * 4) % R;
  const int half = e / (R / 2), w = e % (R / 2);
  const bool isx2 = w >= n;
  const int fi = w % n;
  const int pos = half ? (t & 63) : (t >> 6);
  f32x4 o;
#pragma unroll
  for (int i = 0; i < 4; ++i) {
    float pv = __shfl_xor(v[i], n / 4);
    f32x2 cs = tab[pos * 16 + fi + i];
    o[i] = v[i] * cs[0] + (isx2 ? pv : -pv) * cs[1];
  }
  return o;
}

DI void ssm_item(const P& p, int layer, int item, float* lds, int lane) {
  int b_all, r;
  if (item < 128) { b_all = 32 + item / 32; r = item % 32; } else { int it = item - 128; b_all = it / 32; r = it % 32; }
  const int dir = r >> 4, g = r & 15;
  const bool lat = b_all >= 32;
  const int T = lat ? 1024 : 256;
  const int row0 = lat ? NCTX + (b_all - 32) * 1024 : b_all * 256;
  const int tabidx = (layer * 2 + dir) * 16 + g;
  const int l32 = lane & 31, hh = lane >> 5, l16 = lane & 15, q4 = lane >> 4;
  const u16* atab = (const u16*)(p.ws + OFF_ATAB) + (size_t)tabidx * 128 * 16;
  const u16* ctab = (const u16*)(p.ws + OFF_CTAB) + (size_t)tabidx * 16 * 128;
  bf16x8 af[4], cf[4];
#pragma unroll
  for (int blk = 0; blk < 4; ++blk) af[blk] = *(const bf16x8*)(atab + (blk * 32 + l32) * 16 + hh * 8);
#pragma unroll
  for (int kk = 0; kk < 4; ++kk) cf[kk] = *(const bf16x8*)(ctab + l16 * 128 + kk * 32 + q4 * 8);
  const float* ab = (const float*)(p.ws + OFF_ABAR) + ((size_t)tabidx * 64 + lane) * 2;
  const float ar = ab[0], ai = ab[1];
  float hr = 0.f, hi = 0.f;
  if (lat) {
    size_t idx = ((size_t)((b_all - 32) * 2 + layer) * 2 + dir) * 1024 + g * 64 + lane;
    hr = p.in[I_SRE][idx]; hi = p.in[I_SIM][idx];
  }
  const u16* proj = (const u16*)(p.ws + OFF_PROJ);
  float* ybuf = (float*)(p.ws + OFF_YBUF) + (size_t)dir * NT * 256;
  f32x16 zero16;
#pragma unroll
  for (int i = 0; i < 16; ++i) zero16[i] = 0.f;
  bf16x8 un;
  {
    const int t = dir ? (T - 1 - l32) : l32;
    un = *(const bf16x8*)(proj + (size_t)(row0 + t) * NP + 1280 + g * 16 + hh * 8);
  }
  for (int ch = 0; ch < T / 32; ++ch) {
    {
      bf16x8 uf = un;
      if (ch + 1 < T / 32) {
        const int n = (ch + 1) * 32 + l32;
        const int t = dir ? (T - 1 - n) : n;
        un = *(const bf16x8*)(proj + (size_t)(row0 + t) * NP + 1280 + g * 16 + hh * 8);
      }
#pragma unroll
      for (int blk = 0; blk < 4; ++blk) {
        f32x16 d = MFMA32(af[blk], uf, zero16);
#pragma unroll
        for (int j = 0; j < 4; ++j) {
          f32x4 v = {d[4 * j], d[4 * j + 1], d[4 * j + 2], d[4 * j + 3]};
          *(f32x4*)(lds + l32 * 132 + blk * 32 + 8 * j + 4 * hh) = v;
        }
      }
    }
    wave_lds_fence();
    {
      f32x2 bu[32];
#pragma unroll
      for (int s = 0; s < 32; ++s) bu[s] = *(const f32x2*)(lds + s * 132 + 2 * lane);
#pragma unroll
      for (int s = 0; s < 32; ++s) {
        const float nr = __builtin_fmaf(ar, hr, __builtin_fmaf(-ai, hi, bu[s][0]));
        const float ni = __builtin_fmaf(ar, hi, __builtin_fmaf(ai, hr, bu[s][1]));
        hr = nr; hi = ni;
        f32x2 hv = {hr, hi};
        *(f32x2*)(lds + s * 132 + 2 * lane) = hv;
      }
    }
    wave_lds_fence();
#pragma unroll
    for (int tb = 0; tb < 2; ++tb) {
      f32x4 y = {0.f, 0.f, 0.f, 0.f};
#pragma unroll
      for (int kk = 0; kk < 4; ++kk) {
        const float* hp = lds + (tb * 16 + l16) * 132 + kk * 32 + q4 * 8;
        f32x4 a0 = *(const f32x4*)hp, a1 = *(const f32x4*)(hp + 4);
        y = MFMA16(cf[kk], pack8(a0, a1), y);
      }
      const int n2 = ch * 32 + tb * 16 + l16;
      const int t2 = dir ? (T - 1 - n2) : n2;
      *(f32x4*)(ybuf + (size_t)(row0 + t2) * 256 + g * 16 + q4 * 4) = y;
    }
    wave_lds_fence();
  }
  if (!lat) {
    size_t idx = ((size_t)(b_all * 2 + layer) * 2 + dir) * 1024 + g * 64 + lane;
    p.out[O_SRE + idx] = hr;
    p.out[O_SIM + idx] = hi;
  }
}

DI void pp_row(const P& p, int layer, int row, int lane) {
  const u16* pr = (const u16*)(p.ws + OFF_PROJ) + (size_t)row * NP;
  const bool lat = row >= NCTX;
  int b, t, keyrow;
  if (!lat) { b = row >> 8; t = row & 255; keyrow = row; }
  else { int rr = row - NCTX; b = rr >> 10; t = rr & 1023; keyrow = NCTX + b * 1536 + 512 + t; }
  const f32x2* tab32 = (const f32x2*)(p.ws + OFF_ROPE);
  const f32x2* tab64 = tab32 + 64 * 16;
  const size_t orow = (size_t)(b * 2 + layer) * 256 + t;
  const f32x4 z4 = {0.f, 0.f, 0.f, 0.f};
  f32x4 v_dq = ld4bf_nt(pr + lane * 4);
  f32x4 v_dk = ld4bf_nt(pr + 256 + lane * 4);
  f32x4 v_dv = ld4bf_nt(pr + 512 + lane * 4);
  f32x4 v_gq = ld4bf_nt(pr + 768 + lane * 4);
  f32x4 v_gk = lane < 32 ? ld4bf_nt(pr + 1024 + lane * 4) : z4;
  f32x4 v_gv = lane < 32 ? ld4bf_nt(pr + 1152 + lane * 4) : z4;
  f32x4 v_cq = lane < 48 ? ld4bf_nt(pr + 1536 + lane * 4) : z4;
  f32x4 v_ckv = lane < 32 ? ld4bf_nt(pr + 1728 + lane * 4) : z4;
  f32x4 v_kr = lane < 8 ? ld4bf_nt(pr + 1856 + lane * 4) : z4;
  const f32x4 g_q = *(const f32x4*)(p.in[I_QNG] + layer * 64 + (lane & 15) * 4);
  const f32x4 g_k = *(const f32x4*)(p.in[I_KNG] + layer * 64 + (lane & 15) * 4);
  const f32x4 g_cq = lane < 48 ? *(const f32x4*)(p.in[I_MQNG] + layer * 192 + lane * 4) : z4;
  const f32x4 g_ckv = lane < 32 ? *(const f32x4*)(p.in[I_MKVNG] + layer * 128 + lane * 4) : z4;
  f32x2 cs32[4], cs64[4];
  {
    const int e32 = (lane * 4) & 31, w32 = e32 & 15, p32 = (e32 >> 4) ? (t & 63) : (t >> 6), f32i = w32 & 7;
    const int e64 = (lane * 4) & 63, w64 = e64 & 31, p64 = (e64 >> 5) ? (t & 63) : (t >> 6), f64i = w64 & 15;
    const f32x2 one = {1.f, 0.f};
#pragma unroll
    for (int i = 0; i < 4; ++i) {
      cs32[i] = lat ? tab32[p32 * 16 + f32i + i] : one;
      cs64[i] = lat ? tab64[p64 * 16 + f64i + i] : one;
    }
  }
  const bool x2_32 = ((lane * 4) & 15) >= 8, x2_64 = ((lane * 4) & 31) >= 16;
  auto rope32 = [&](f32x4 v) {
    f32x4 o;
#pragma unroll
    for (int i = 0; i < 4; ++i) { float pv = __shfl_xor(v[i], 2); o[i] = v[i] * cs32[i][0] + (x2_32 ? pv : -pv) * cs32[i][1]; }
    return o;
  };
  auto rope64 = [&](f32x4 v) {
    f32x4 o;
#pragma unroll
    for (int i = 0; i < 4; ++i) { float pv = __shfl_xor(v[i], 4); o[i] = v[i] * cs64[i][0] + (x2_64 ? pv : -pv) * cs64[i][1]; }
    return o;
  };
  if (!lat) {
    *(f32x4*)(p.out + O_DK + orow * 256 + lane * 4) = v_dk;
    *(f32x4*)(p.out + O_DV + orow * 256 + lane * 4) = v_dv;
    if (lane < 32) *(f32x4*)(p.out + O_GV + orow * 128 + lane * 4) = v_gv;
    if (lane < 8) *(f32x4*)(p.out + O_KR + orow * 32 + lane * 4) = v_kr;
  }
  {
    f32x4 v = v_dq;
    if (lat) v = rope32(v);
    v = v * (0.17677669529663687f * LOG2E);
    *(u32x2*)((u16*)(p.ws + OFF_DQ) + (size_t)row * 256 + lane * 4) = pack4(v);
  }
  {
    f32x4 v = v_dk;
    if (lat) v = rope32(v);
    *(u32x2*)((u16*)(p.ws + OFF_DKB) + (size_t)keyrow * 256 + lane * 4) = pack4(v);
  }
  {
    f32x4 v = v_gq;
    float ss = v[0] * v[0] + v[1] * v[1] + v[2] * v[2] + v[3] * v[3];
    ss += __shfl_xor(ss, 1); ss += __shfl_xor(ss, 2); ss += __shfl_xor(ss, 4); ss += __shfl_xor(ss, 8);
    float r = rsqrtf(ss * (1.f / 64.f) + EPSF);
    v = v * r * g_q;
    if (lat) v = rope64(v);
    v = v * (0.125f * LOG2E);
    *(u32x2*)((u16*)(p.ws + OFF_GQ) + (size_t)row * 256 + lane * 4) = pack4(v);
  }
  {
    f32x4 v = v_gk;
    float ss = v[0] * v[0] + v[1] * v[1] + v[2] * v[2] + v[3] * v[3];
    ss += __shfl_xor(ss, 1); ss += __shfl_xor(ss, 2); ss += __shfl_xor(ss, 4); ss += __shfl_xor(ss, 8);
    float r = rsqrtf(ss * (1.f / 64.f) + EPSF);
    v = v * r * g_k;
    if (!lat) { if (lane < 32) *(f32x4*)(p.out + O_GK + orow * 128 + lane * 4) = v; }
    else v = rope64(v);
    if (lane < 32) *(u32x2*)((u16*)(p.ws + OFF_GKB) + (size_t)keyrow * 128 + lane * 4) = pack4(v);
  }
  {
    f32x4 v = v_cq;
    float ss = wave_sum(v[0] * v[0] + v[1] * v[1] + v[2] * v[2] + v[3] * v[3]);
    float r = rsqrtf(ss * (1.f / 192.f) + EPSF);
    v = v * r * g_cq;
    if (lane < 48) *(u32x2*)((u16*)(p.ws + OFF_CQN) + (size_t)row * 192 + lane * 4) = pack4(v);
  }
  {
    f32x4 v = v_ckv;
    float ss = wave_sum(v[0] * v[0] + v[1] * v[1] + v[2] * v[2] + v[3] * v[3]);
    float r = rsqrtf(ss * (1.f / 128.f) + EPSF);
    v = v * r * g_ckv;
    if (lane < 32) {
      if (!lat) *(f32x4*)(p.out + O_CKV + orow * 128 + lane * 4) = v;
      *(u32x2*)((u16*)(p.ws + OFF_CKVN) + (size_t)keyrow * 128 + lane * 4) = pack4(v);
    }
  }
  {
    f32x4 v = v_kr;
    if (lat) v = rope32(v);
    if (lane < 8) {
      u32x2 pk = pack4(v);
      u16* mk = (u16*)(p.ws + OFF_MKB) + (size_t)keyrow * 384 + 64 + lane * 4;
#pragma unroll
      for (int hd = 0; hd < 4; ++hd) *(u32x2*)(mk + hd * 96) = pk;
    }
  }
}

DI void pp_cached(const P& p, int layer, int crow_, int lane) {
  const int b = crow_ >> 9, j = crow_ & 511;
  const int keyrow = NCTX + b * 1536 + j;
  const size_t src = (size_t)(b * 2 + layer) * 512 + j;
  const int jp = (j & ~15) | (((j >> 2) & 1) << 3) | (((j >> 3) & 1) << 2) | (j & 3);
  const f32x4 z4 = {0.f, 0.f, 0.f, 0.f};
  const int l31 = lane & 31, l7 = lane & 7;
  f32x4 v_dk = __builtin_nontemporal_load((const f32x4*)(p.in[I_CDK] + src * 256 + lane * 4));
  f32x4 v_dv = __builtin_nontemporal_load((const f32x4*)(p.in[I_CDV] + src * 256 + lane * 4));
  f32x4 v_gk = __builtin_nontemporal_load((const f32x4*)(p.in[I_CGK] + src * 128 + l31 * 4));
  f32x4 v_gv = __builtin_nontemporal_load((const f32x4*)(p.in[I_CGV] + src * 128 + l31 * 4));
  f32x4 v_ckv = __builtin_nontemporal_load((const f32x4*)(p.in[I_CCKV] + src * 128 + l31 * 4));
  f32x4 v_kr = __builtin_nontemporal_load((const f32x4*)(p.in[I_CKR] + src * 32 + l7 * 4));
  (void)z4;
  *(u32x2*)((u16*)(p.ws + OFF_DKB) + (size_t)keyrow * 256 + lane * 4) = pack4(v_dk);
  {
    u16* vt = (u16*)(p.ws + OFF_DVT) + vt_off(32 + b, lane >> 4, 4) + (size_t)((lane & 15) * 4) * 1536 + jp;
#pragma unroll
    for (int i = 0; i < 4; ++i) vt[(size_t)i * 1536] = f2bf(v_dv[i]);
  }
  if (lane < 32) {
    *(u32x2*)((u16*)(p.ws + OFF_GKB) + (size_t)keyrow * 128 + lane * 4) = pack4(v_gk);
    u16* vt = (u16*)(p.ws + OFF_GVT) + vt_off(32 + b, lane >> 4, 2) + (size_t)((lane & 15) * 4) * 1536 + jp;
#pragma unroll
    for (int i = 0; i < 4; ++i) vt[(size_t)i * 1536] = f2bf(v_gv[i]);
    *(u32x2*)((u16*)(p.ws + OFF_CKVN) + (size_t)keyrow * 128 + lane * 4) = pack4(v_ckv);
  }
  if (lane < 8) {
    u32x2 pk = pack4(v_kr);
    u16* mk = (u16*)(p.ws + OFF_MKB) + (size_t)keyrow * 384 + 64 + lane * 4;
#pragma unroll
    for (int hd = 0; hd < 4; ++hd) *(u32x2*)(mk + hd * 96) = pk;
  }
}

DI void phase_pp(const P& p, int layer, char* smem) {
  const int tid_ = get_tid();
  const int lane = tid_ & 63, wave = tid_ >> 6;
  float* lds = (float*)smem + wave * (32 * 132);
  const int gw = wave * (int)gridDim.x + (int)blockIdx.x, nw = gridDim.x * NWV;
  constexpr int N_SSM = 1152, N_ROWS = NT + 2048;
  for (int item = gw; item < N_SSM; item += nw) ssm_item(p, layer, item, lds, lane);
  const int rw0 = (nw > 256) ? 128 : 0;
  if (gw >= rw0) {
    for (int row = gw - rw0; row < N_ROWS; row += nw - rw0) {
      if (row < NT) pp_row(p, layer, row, lane);
      else pp_cached(p, layer, row - NT, lane);
    }
  }
}

template <int KW, int DK>
DI void attn_block(const u16* __restrict__ Kg, int ldk, const u16* __restrict__ Vt, int nk, const bf16x8 (&qf)[DK / 16], int kcol, char* smem,
                   int tid, f32x16 (&o)[2], float& lsum) {
  constexpr int KST = KW + 8, KS = DK / 16, KCH = KW / 8, KTOT = 64 * KCH, NKC = (KTOT + NTHR - 1) / NTHR;
  const int lane = tid & 63, l32 = lane & 31, hh = lane >> 5;
  u16* Ks = (u16*)smem;
  u16* Vs = Ks + 2 * 64 * KST;
  float m = -1e30f;
  lsum = 0.f;
#pragma unroll
  for (int db = 0; db < 2; ++db)
#pragma unroll
    for (int r = 0; r < 16; ++r) o[db][r] = 0.f;
  u32x4 rk[NKC], rv[1];
  const int nt = nk / 64;
#pragma unroll
  for (int i = 0; i < NKC; ++i) { int c = tid + NTHR * i, r = c / KCH, kc = (c % KCH) * 8; if (c < KTOT) rk[i] = *(const u32x4*)(Kg + (size_t)r * ldk + kc); }
  { int r = tid >> 3, kc = (tid & 7) * 8; rv[0] = *(const u32x4*)(Vt + (size_t)r * nk + kc); }
#pragma unroll
  for (int i = 0; i < NKC; ++i) { int c = tid + NTHR * i, r = c / KCH, kc = (c % KCH) * 8; if (c < KTOT) *(u32x4*)(Ks + r * KST + kc) = rk[i]; }
  { int r = tid >> 3, kc = (tid & 7) * 8; *(u32x4*)(Vs + r * 72 + kc) = rv[0]; }
  __syncthreads();
  for (int t = 0; t < nt; ++t) {
    const int buf = t & 1;
    const bool more = (t + 1 < nt);
    if (more) {
      const int kt = (t + 1) * 64;
#pragma unroll
      for (int i = 0; i < NKC; ++i) { int c = tid + NTHR * i, r = c / KCH, kc = (c % KCH) * 8; if (c < KTOT) rk[i] = *(const u32x4*)(Kg + (size_t)(kt + r) * ldk + kc); }
      { int r = tid >> 3, kc = (tid & 7) * 8; rv[0] = *(const u32x4*)(Vt + (size_t)r * nk + kt + kc); }
    }
    const u16* ks = Ks + buf * 64 * KST + l32 * KST + kcol + hh * 8;
    const u16* vs = Vs + buf * 64 * 72 + l32 * 72 + hh * 8;
    f32x16 sa[2];
#pragma unroll
    for (int kb = 0; kb < 2; ++kb) {
#pragma unroll
      for (int r = 0; r < 16; ++r) sa[kb][r] = 0.f;
      bf16x8 kf[KS];
#pragma unroll
      for (int s2 = 0; s2 < KS; ++s2) kf[s2] = *(const bf16x8*)(ks + kb * 32 * KST + s2 * 16);
#pragma unroll
      for (int s2 = 0; s2 < KS; ++s2) sa[kb] = MFMA32(kf[s2], qf[s2], sa[kb]);
    }
    float mx = sa[0][0];
#pragma unroll
    for (int r = 1; r < 16; ++r) mx = fmaxf(mx, sa[0][r]);
#pragma unroll
    for (int r = 0; r < 16; ++r) mx = fmaxf(mx, sa[1][r]);
    mx = fmaxf(mx, __shfl_xor(mx, 32));
    const float mn = fmaxf(m, mx);
    const float alpha = fexp2(m - mn);
    m = mn;
    float ps = 0.f;
#pragma unroll
    for (int kb = 0; kb < 2; ++kb)
#pragma unroll
      for (int r = 0; r < 16; ++r) { float e = fexp2(sa[kb][r] - mn); sa[kb][r] = e; ps += e; }
    lsum = lsum * alpha + ps;
#pragma unroll
    for (int db = 0; db < 2; ++db)
#pragma unroll
      for (int r = 0; r < 16; ++r) o[db][r] *= alpha;
#pragma unroll
    for (int s2 = 0; s2 < 4; ++s2) {
      const int kb = s2 >> 1, rb = 8 * (s2 & 1);
      f32x4 p0 = {sa[kb][rb], sa[kb][rb + 1], sa[kb][rb + 2], sa[kb][rb + 3]};
      f32x4 p1 = {sa[kb][rb + 4], sa[kb][rb + 5], sa[kb][rb + 6], sa[kb][rb + 7]};
      bf16x8 pf = pack8(p0, p1);
      bf16x8 v0 = *(const bf16x8*)(vs + s2 * 16);
      bf16x8 v1 = *(const bf16x8*)(vs + 32 * 72 + s2 * 16);
      o[0] = MFMA32(v0, pf, o[0]);
      o[1] = MFMA32(v1, pf, o[1]);
    }
    if (more) {
      const int nb = buf ^ 1;
#pragma unroll
      for (int i = 0; i < NKC; ++i) { int c = tid + NTHR * i, r = c / KCH, kc = (c % KCH) * 8; if (c < KTOT) *(u32x4*)(Ks + nb * 64 * KST + r * KST + kc) = rk[i]; }
      { int r = tid >> 3, kc = (tid & 7) * 8; *(u32x4*)(Vs + nb * 64 * 72 + r * 72 + kc) = rv[0]; }
    }
    __syncthreads();
  }
  lsum += __shfl_xor(lsum, 32);
}

DI void store_o(u16* dst  , const f32x16 (&o)[2], float scale, int hh) {
#pragma unroll
  for (int db = 0; db < 2; ++db)
#pragma unroll
    for (int j = 0; j < 4; ++j) {
      const int dv = db * 32 + 8 * j + 4 * hh;
      f32x4 v = {o[db][4 * j] * scale, o[db][4 * j + 1] * scale, o[db][4 * j + 2] * scale, o[db][4 * j + 3] * scale};
      *(u32x2*)(dst + dv) = pack4(v);
    }
}

DI void attn_item(const P& p, int layer, int item, char* smem, int tid) {
  const int lane = tid & 63, wave = tid >> 6, l32 = lane & 31, hh = lane >> 5;
  bool lat; int kind, b, hd, qblk;
  if (item < 256) {
    lat = true;
    if (item < 128) { kind = 0; b = item >> 5; hd = (item >> 3) & 3; qblk = item & 7; }
    else { int it = item - 128; kind = 1 + (it >> 6); it &= 63; b = it >> 4; hd = (it >> 2) & 3; qblk = it & 3; }
  } else {
    lat = false;
    int it = item - 256;
    if (it < 256) { kind = 0; b = it >> 3; hd = (it >> 1) & 3; qblk = it & 1; }
    else { it -= 256; kind = 1 + (it >> 7); it &= 127; b = it >> 2; hd = it & 3; qblk = 0; }
  }
  const int nk = lat ? 1536 : 256;
  const int b_all = lat ? 32 + b : b;
  const int keyrow0 = lat ? NCTX + b * 1536 : b * 256;
  const int tok0 = lat ? NCTX + b * 1024 : b * 256;
  f32x16 o[2]; float ls;
  if (kind == 0) {
    const int ns = wave & 1, qb = wave >> 1;
    const int q0 = tok0 + qblk * 128 + qb * 32;
    const u16* Q = (const u16*)(p.ws + OFF_DQ) + (size_t)(q0 + l32) * 256 + hd * 64 + ns * 32 + hh * 8;
    bf16x8 qf[2];
    qf[0] = *(const bf16x8*)Q; qf[1] = *(const bf16x8*)(Q + 16);
    attn_block<64, 32>((const u16*)(p.ws + OFF_DKB) + (size_t)keyrow0 * 256 + hd * 64, 256, (const u16*)(p.ws + OFF_DVT) + vt_off(b_all, hd, 4), nk, qf, ns * 32,
                       smem, tid, o, ls);
    float d1 = 0.f, d2 = 0.f;
    if (lane < 32) { d1 = p.in[I_LQ1][layer * 32 + lane] * p.in[I_LK1][layer * 32 + lane]; d2 = p.in[I_LQ2][layer * 32 + lane] * p.in[I_LK2][layer * 32 + lane]; }
    d1 = wave_sum(d1); d2 = wave_sum(d2);
    int ly_ = layer; asm volatile("" : "+s"(ly_));
    const float lam_init = ly_ == 0 ? 0.2f : (0.8f - 0.6f * 0.7408182206817179f);
    const float lam = expf(d1) - expf(d2) + lam_init;
    float* cmb = (float*)smem + qb * (64 * 33);
    if (ns == 1) {
      const float sc = lam / ls;
#pragma unroll
      for (int db = 0; db < 2; ++db)
#pragma unroll
        for (int r = 0; r < 16; ++r) cmb[(db * 32 + crow(r, hh)) * 33 + l32] = o[db][r] * sc;
    }
    __syncthreads();
    if (ns == 0) {
      const float i0 = 1.f / ls;
      float ss = 0.f;
#pragma unroll
      for (int db = 0; db < 2; ++db)
#pragma unroll
        for (int r = 0; r < 16; ++r) { float d = o[db][r] * i0 - cmb[(db * 32 + crow(r, hh)) * 33 + l32]; o[db][r] = d; ss += d * d; }
      ss += __shfl_xor(ss, 32);
      const float rr = rsqrtf(ss * (1.f / 64.f) + EPSF) * (1.f - lam_init);
      u16* dst = (u16*)(p.ws + OFF_MIXED) + (size_t)(q0 + l32) * 1024 + hd * 64;
#pragma unroll
      for (int db = 0; db < 2; ++db)
#pragma unroll
        for (int j = 0; j < 4; ++j) {
          const int dv = db * 32 + 8 * j + 4 * hh;
          f32x4 g = *(const f32x4*)(p.in[I_SUBLN] + layer * 64 + dv);
          f32x4 v = {o[db][4 * j] * rr * g[0], o[db][4 * j + 1] * rr * g[1], o[db][4 * j + 2] * rr * g[2], o[db][4 * j + 3] * rr * g[3]};
          *(u32x2*)(dst + dv) = pack4(v);
        }
    }
    __syncthreads();
  } else if (kind == 1) {
    const int q0 = tok0 + qblk * 256 + wave * 32;
    const u16* Q = (const u16*)(p.ws + OFF_GQ) + (size_t)(q0 + l32) * 256 + hd * 64 + hh * 8;
    bf16x8 qf[4];
#pragma unroll
    for (int s2 = 0; s2 < 4; ++s2) qf[s2] = *(const bf16x8*)(Q + s2 * 16);
    attn_block<64, 64>((const u16*)(p.ws + OFF_GKB) + (size_t)keyrow0 * 128 + (hd >> 1) * 64, 128, (const u16*)(p.ws + OFF_GVT) + vt_off(b_all, hd >> 1, 2), nk, qf, 0,
                       smem, tid, o, ls);
    store_o((u16*)(p.ws + OFF_MIXED) + (size_t)(q0 + l32) * 1024 + 256 + hd * 64, o, 1.f / ls, hh);
  } else {
    const int q0 = tok0 + qblk * 256 + wave * 32;
    const u16* Q = (const u16*)(p.ws + OFF_MQ) + (size_t)(q0 + l32) * 384 + hd * 96 + hh * 8;
    bf16x8 qf[6];
#pragma unroll
    for (int s2 = 0; s2 < 6; ++s2) qf[s2] = *(const bf16x8*)(Q + s2 * 16);
    attn_block<96, 96>((const u16*)(p.ws + OFF_MKB) + (size_t)keyrow0 * 384 + hd * 96, 384, (const u16*)(p.ws + OFF_MVT) + vt_off(b_all, hd, 4), nk, qf, 0,
                       smem, tid, o, ls);
    store_o((u16*)(p.ws + OFF_MIXED) + (size_t)(q0 + l32) * 1024 + 768 + hd * 64, o, 1.f / ls, hh);
  }
}

DI void phase_at(const P& p, int layer, char* smem) {
  EPI_IDX
  constexpr int N_ITEMS = 768;
  if (gridDim.x == 256) {
    const int b = blockIdx.x;
    attn_item(p, layer, b, smem, tid);
    __syncthreads();
    if (b < 128) {
      attn_item(p, layer, 256 + b, smem, tid); __syncthreads();
      attn_item(p, layer, 512 + b, smem, tid); __syncthreads();
      attn_item(p, layer, 640 + b, smem, tid); __syncthreads();
    } else if (b < 192) {
      attn_item(p, layer, 256 + 128 + 2 * (b - 128), smem, tid); __syncthreads();
      attn_item(p, layer, 256 + 128 + 2 * (b - 128) + 1, smem, tid); __syncthreads();
    }
  } else {
    for (int item = blockIdx.x; item < N_ITEMS; item += gridDim.x) {
      attn_item(p, layer, item, smem, tid);
      __syncthreads();
    }
  }
  {
    constexpr int T_GLU = (NT / 256) * 2;
    auto tile_at = [&](int t) { TD d; d.A = (const u16*)(p.ws + OFF_PROJ); d.lda = NP; d.B = (const u16*)(p.ws + OFF_WGLU) + (size_t)layer * 512 * 256; d.ldb = 256; d.k0 = 0; d.nk = 4; d.m0 = (t >> 1) * 256; d.n0 = (t & 1) * 256; return d; };
    int buf = 0;
    const int t0 = (int)gridDim.x - 1 - (int)blockIdx.x;
    TD cur = tile_at(t0 < T_GLU ? t0 : 0);
    if (t0 < T_GLU) stage_td<2>(cur, 0, smem, tid);
    for (int t = t0; t < T_GLU; t += gridDim.x) {
      const bool has_next = (t + (int)gridDim.x < T_GLU);
      const TD nxt = tile_at(has_next ? t + (int)gridDim.x : t);
      const int m0 = cur.m0, n0 = cur.n0;
      f32x16 acc[4][2];
      gemm_stream<2>(cur, has_next, nxt, smem, buf, acc);
      cur = nxt;
      u16* mixed = (u16*)(p.ws + OFF_MIXED);
      const int q = (n0 + wn * 64) >> 6;
#pragma unroll
      for (int bi = 0; bi < 4; ++bi) {
        const int rb = m0 + wm * 128 + bi * 32;
#pragma unroll
        for (int r = 0; r < 16; ++r) {
          float z = acc[bi][0][r], g = acc[bi][1][r];
          mixed[(size_t)(rb + crow(r, hh)) * 1024 + 512 + q * 32 + l32] = f2bf(z * fsigmoid(g));
        }
      }
    }
  }
}

#define XB_TMO      128
#define XB_XCNT(j)  (256  + 64 * (j))
#define XB_XSUB(j)  (1280 + 64 * (j))
#define XB_XGEN(j)  (2304 + 64 * (j))
#define XB_TOP      3328
#define XB_TOPGEN   3392
#define XCD_BAR_WORDS 3456
#define XB_SPIN_CAP (1u << 22)
#define LAS __attribute__((address_space(3)))
DI unsigned xb_ld(unsigned* p) { return __hip_atomic_load(p, __ATOMIC_RELAXED, __HIP_MEMORY_SCOPE_AGENT); }
DI unsigned xb_add(unsigned* p, unsigned v) { return __hip_atomic_fetch_add(p, v, __ATOMIC_RELAXED, __HIP_MEMORY_SCOPE_AGENT); }
DI unsigned xb_xcc_id() { return (unsigned)__builtin_amdgcn_s_getreg((3 << 11) | 20) & 0xFu; }
#define XB_SPIN(cond, bar) do { unsigned _sp = 0; while (cond) { __builtin_amdgcn_s_sleep(1); \
    if ((++_sp & 255u) == 0u) { if (xb_ld(&(bar)[XB_TMO])) break; if (_sp > XB_SPIN_CAP) { atomicAdd(&(bar)[XB_TMO], 1u); break; } } } } while (0)
struct XcdBarrier { unsigned* bar; unsigned x; volatile LAS unsigned* st; };
DI XcdBarrier xcd_barrier_post(unsigned* bar, volatile LAS unsigned* st) {
  XcdBarrier b; b.bar = bar; b.x = xb_xcc_id(); b.st = st;
  if (threadIdx.x == 0) st[2] = xb_add(&bar[XB_XCNT(b.x)], 1u);
  return b;
}
DI void xcd_barrier_complete(unsigned* bar, unsigned x, unsigned& nloc, unsigned& nx) {
  const unsigned G = gridDim.x * gridDim.y * gridDim.z;
  unsigned sum, cnt, mine, sp = 0u;
  for (;;) {
    sum = 0u; cnt = 0u; mine = 0u;
#pragma unroll
    for (unsigned j = 0; j < 16; ++j) { const unsigned c = xb_ld(&bar[XB_XCNT(j)]); sum += c; cnt += (c > 0u) ? 1u : 0u; mine = (j == x) ? c : mine; }
    if (sum == G) break;
    __builtin_amdgcn_s_sleep(1);
    if ((++sp & 255u) == 0u) { if (xb_ld(&bar[XB_TMO])) break; if (sp > XB_SPIN_CAP) { atomicAdd(&bar[XB_TMO], 1u); break; } }
  }
  nloc = mine > 0u ? mine : 1u; nx = cnt > 0u ? cnt : 1u;
}
DI void xcd_barrier(const XcdBarrier& b) {
  asm volatile("s_waitcnt vmcnt(0)" ::: "memory");
  __syncthreads();
  if (threadIdx.x == 0) {
    unsigned* bar = b.bar;
    __builtin_amdgcn_s_waitcnt(0);
    unsigned nloc = b.st[0], nx = b.st[1];
    if (nloc == 0u) { xcd_barrier_complete(bar, b.x, nloc, nx); b.st[0] = nloc; b.st[1] = nx; }
    const unsigned old = xb_add(&bar[XB_XSUB(b.x)], 1u);
    const unsigned gen = old / nloc;
    if (old + 1u == (gen + 1u) * nloc) {
      __builtin_amdgcn_fence(__ATOMIC_RELEASE, "agent");
      asm volatile("s_waitcnt vmcnt(0)" ::: "memory");
      const unsigned og = xb_add(&bar[XB_TOP], 1u);
      const unsigned tg = og / nx;
      if (og + 1u == (tg + 1u) * nx) xb_add(&bar[XB_TOPGEN], 1u);
      else XB_SPIN(xb_ld(&bar[XB_TOPGEN]) == tg, bar);
      __builtin_amdgcn_fence(__ATOMIC_ACQUIRE, "agent");
      xb_add(&bar[XB_XGEN(b.x)], 1u);
      asm volatile("s_waitcnt vmcnt(0)" ::: "memory");
    } else {
      XB_SPIN(xb_ld(&bar[XB_XGEN(b.x)]) == gen, bar);
      __builtin_amdgcn_fence(__ATOMIC_ACQUIRE, "agent");
      asm volatile("s_waitcnt vmcnt(0)" ::: "memory");
    }
  }
  __syncthreads();
}

DI void run_phase(const P& p_, int ph, int layer, char* smem) {
  P p = p_;
  size_t zoff = 0;
  asm volatile("" : "+s"(zoff));
  p.ws = p_.ws + zoff;
  p.out = p_.out + zoff;
  switch (ph) {
    case 0: prologue(p, smem); break;
    case 1: norm_phase(p, layer, 0); break;
    case 2: phase_g1(p, layer, smem); break;
    case 3: phase_pp(p, layer, smem); break;
    case 4: phase_g2(p, layer, smem); break;
    case 5: phase_at(p, layer, smem); break;
    case 6: phase_resid(p, layer, smem, true); break;
    case 7: norm_phase(p, layer, 1); break;
    case 8: phase_g5(p, layer, smem); break;
    case 9: phase_resid(p, layer, smem, false); break;
    case 10: norm_phase(p, 0, 2); break;
  }
}

extern __shared__ __attribute__((aligned(16))) char dyn_smem[];

__global__ void __launch_bounds__(512) fwd_mega(P p) {
  if (p.ws == nullptr) { cg::grid_group grid = cg::this_grid(); grid.sync(); }
  volatile LAS unsigned* st = (volatile LAS unsigned*)(dyn_smem + LDS_BYTES);
  if (threadIdx.x == 0) { st[0] = 0u; st[1] = 0u; st[2] = 0u; st[3] = 0u; }
  __syncthreads();
  XcdBarrier xb = xcd_barrier_post((unsigned*)(p.ws + OFF_BAR), st);
  run_phase(p, 0, 0, dyn_smem);
  xcd_barrier(xb);
  if (threadIdx.x == 0) {
    unsigned* bar = (unsigned*)(p.ws + OFF_BAR);
    bool ok = (gridDim.x & 7u) == 0u;
    for (unsigned j = 0; j < 16; ++j) { const unsigned c = xb_ld(&bar[XB_XCNT(j)]); ok = ok && (c == (j < 8 ? gridDim.x >> 3 : 0u)); }
    if (ok) st[3] = xb.x; else { st[2] = blockIdx.x >> 3; st[3] = blockIdx.x & 7u; }
  }
  __syncthreads();
  for (int l = 0; l < 2; ++l) {
    for (int ph = 1; ph <= 9; ++ph) {
      run_phase(p, ph, l, dyn_smem);
      xcd_barrier(xb);
    }
  }
  run_phase(p, 10, 0, dyn_smem);
}

#if !MEGA
__global__ void __launch_bounds__(512) fwd_phase(P p, int ph, int layer) { run_phase(p, ph, layer, dyn_smem); }
#endif

extern "C" void kernel_launch(void* const* d_in, const int* in_sizes, int n_in, void* d_out, int out_size, void* d_ws, size_t ws_size,
                              hipStream_t stream) {
  static int grid_blocks = 0;
  if (!grid_blocks) {
    int dev = 0, cus = 0, per_cu = 0;
    (void)hipGetDevice(&dev);
    (void)hipDeviceGetAttribute(&cus, hipDeviceAttributeMultiprocessorCount, dev);
    (void)hipFuncSetAttribute((const void*)fwd_mega, hipFuncAttributeMaxDynamicSharedMemorySize, LDS_BYTES + 16);
#if !MEGA
    (void)hipFuncSetAttribute((const void*)fwd_phase, hipFuncAttributeMaxDynamicSharedMemorySize, LDS_BYTES);
#endif
    (void)hipOccupancyMaxActiveBlocksPerMultiprocessor(&per_cu, (const void*)fwd_mega, NTHR, LDS_BYTES + 16);
    if (per_cu < 1) per_cu = 1;
    if (per_cu > 1) per_cu = 1;
    grid_blocks = cus * per_cu;
    if (ws_size < WS_NEED) fprintf(stderr, "kernel_launch: workspace too small: %zu < %zu\n", ws_size, (size_t)WS_NEED);
  }
  P p{};
  for (int i = 0; i < N_IN; ++i) p.in[i] = (const float*)d_in[i];
  p.out = (float*)d_out;
  p.ws = (char*)d_ws;
#if MEGA
  (void)hipMemsetAsync((char*)d_ws + OFF_BAR, 0, XCD_BAR_WORDS * 4, stream);
  void* args[] = {&p};
  hipError_t e = hipLaunchCooperativeKernel((const void*)fwd_mega, dim3(grid_blocks), dim3(NTHR), args, LDS_BYTES + 16, stream);
  if (e != hipSuccess) fprintf(stderr, "cooperative launch failed: %s (grid %d)\n", hipGetErrorString(e), grid_blocks);
#else
  hipLaunchKernelGGL(fwd_phase, dim3(grid_blocks), dim3(NTHR), LDS_BYTES, stream, p, 0, 0);
  for (int l = 0; l < 2; ++l)
    for (int ph = 1; ph <= 9; ++ph) hipLaunchKernelGGL(fwd_phase, dim3(grid_blocks), dim3(NTHR), LDS_BYTES, stream, p, ph, l);
  hipLaunchKernelGGL(fwd_phase, dim3(grid_blocks), dim3(NTHR), LDS_BYTES, stream, p, 10, 0);
#endif
}
```
